# Optimizing an MI355X kernel written in HIP

```python
import math
import jax, jax.numpy as jnp
from jax import lax
import numpy as np

D_MODEL = 1024
BATCH = 16
SEQ = 2048
DEPTH = 2

N_META = 16
BLOCK = 128
PAD = BLOCK - N_META

HEAD_DIM = 64
A_WIDTH = D_MODEL // 4
A_HEADS = A_WIDTH // HEAD_DIM
KV_RANK = 128
IDX_HEADS = 4
IDX_DIM = 64
TOPK_MAX = 256

B_WIDTH = D_MODEL // 2
S5_GROUP = 16
S5_GROUPS = B_WIDTH // S5_GROUP
S5_STATE = 64

C_WIDTH = D_MODEL // 4
C_HEADS = C_WIDTH // HEAD_DIM

MIX_WIDTH = A_WIDTH + B_WIDTH + C_WIDTH
D_FF = 4 * D_MODEL

NUM_BUCKETS = 32
MAX_DISTANCE = 128

RMS_EPS = 1e-6
NEG_INF = -1e30

PROJ_SIZES = (A_WIDTH, KV_RANK, IDX_HEADS * IDX_DIM, IDX_DIM, IDX_HEADS,
              B_WIDTH, C_WIDTH, C_WIDTH, C_WIDTH)
N_IN = sum(PROJ_SIZES)
SPLIT_POINTS = tuple(int(s) for s in np.cumsum(PROJ_SIZES)[:-1])

kernel_name = "hymba_dsa_s5_stickbreak_hybrid"


def rms_norm(x, g):
    x32 = x.astype(jnp.float32)
    y = x32 * lax.rsqrt(jnp.mean(x32 * x32, axis=-1, keepdims=True) + RMS_EPS)
    return (y * g.astype(jnp.float32)).astype(x.dtype)


def t5_bucket(n):
    max_exact = NUM_BUCKETS // 2
    n = jnp.maximum(n, 0)
    nf = jnp.maximum(n, max_exact).astype(jnp.float32)
    large = max_exact + (jnp.log(nf / max_exact) / math.log(MAX_DISTANCE / max_exact)
                         * (NUM_BUCKETS - max_exact)).astype(jnp.int32)
    large = jnp.minimum(large, NUM_BUCKETS - 1)
    return jnp.where(n < max_exact, n, large)


def dsa_attention(q_lat, ckv, iq, ik, iw, rel_bias, w_uv, k_top):
    bsz, plen = ckv.shape[:2]
    n_blocks = plen // BLOCK
    key_pos = jnp.arange(plen)

    def one_block(i):
        start = i * BLOCK
        t = start + jnp.arange(BLOCK)
        qb = lax.dynamic_slice_in_dim(q_lat, start, BLOCK, axis=1)
        iqb = lax.dynamic_slice_in_dim(iq, start, BLOCK, axis=1)
        iwb = lax.dynamic_slice_in_dim(iw, start, BLOCK, axis=1)
        idx_logits = jnp.einsum('bqhd,bkd->bqhk', iqb, ik).astype(jnp.float32) * IDX_DIM ** -0.5
        score = jnp.einsum('bqhk,bqh->bqk', jax.nn.relu(idx_logits),
                           iwb.astype(jnp.float32)) * IDX_HEADS ** -0.5
        admissible = (key_pos[None, :] <= t[:, None]) & (key_pos[None, :] >= PAD)
        score = jnp.where(admissible[None], score, NEG_INF)
        _, idx = lax.top_k(score, k_top)
        valid = (idx <= t[None, :, None]) & (idx >= PAD)
        c_sel = jax.vmap(lambda c, j: c[j])(ckv, idx)
        bias = rel_bias[t5_bucket(t[None, :, None] - idx)]
        logits = (jnp.einsum('bqhr,bqkr->bqhk', qb, c_sel).astype(jnp.float32)
                  + jnp.moveaxis(bias, -1, 2).astype(jnp.float32))
        logits = jnp.where(valid[:, :, None, :], logits, NEG_INF)
        p = jax.nn.softmax(logits, axis=-1).astype(ckv.dtype)
        o_lat = jnp.einsum('bqhk,bqkr->bqhr', p, c_sel)
        return jnp.einsum('bqhr,rhd->bqhd', o_lat, w_uv).reshape(bsz, BLOCK, -1)

    out = lax.map(one_block, jnp.arange(n_blocks))
    return jnp.moveaxis(out, 0, 1).reshape(bsz, plen, -1)


def stick_breaking_attention(q, k, v):
    bsz, plen = q.shape[:2]
    n_blocks = plen // BLOCK
    key_pos = jnp.arange(plen)

    def one_block(i):
        start = i * BLOCK
        t = start + jnp.arange(BLOCK)
        qb = lax.dynamic_slice_in_dim(q, start, BLOCK, axis=1)
        z = jnp.einsum('bqhd,bkhd->bhqk', qb, k).astype(jnp.float32) * HEAD_DIM ** -0.5
        strict = (key_pos[None, :] < t[:, None]) & (key_pos[None, :] >= PAD)
        log_keep = jnp.where(strict, jax.nn.log_sigmoid(-z), 0.0)
        later = lax.cumsum(log_keep, axis=3, reverse=True) - log_keep
        w = jnp.where(strict, jnp.exp(jax.nn.log_sigmoid(z) + later), 0.0).astype(v.dtype)
        return jnp.einsum('bhqk,bkhd->bqhd', w, v).reshape(bsz, BLOCK, -1)

    out = lax.map(one_block, jnp.arange(n_blocks))
    return jnp.moveaxis(out, 0, 1).reshape(bsz, plen, -1)


def _complex_linear_combine(e1, e2):
    a1r, a1i, b1r, b1i = e1
    a2r, a2i, b2r, b2i = e2
    return (a2r * a1r - a2i * a1i,
            a2r * a1i + a2i * a1r,
            a2r * b1r - a2i * b1i + b2r,
            a2r * b1i + a2i * b1r + b2i)


def s5_mixer(u, lam_re, lam_im, log_dt, b_re, b_im, c_re, c_im, d_skip, w_glu):
    bsz, seqlen, _ = u.shape
    u32 = u.astype(jnp.float32)
    ug = u32.reshape(bsz, seqlen, S5_GROUPS, S5_GROUP)
    dt = jnp.exp(log_dt.astype(jnp.float32))[:, None]
    lr = lam_re.astype(jnp.float32)
    li = lam_im.astype(jnp.float32)
    mag = jnp.exp(lr * dt)
    ar = mag * jnp.cos(li * dt)
    ai = mag * jnp.sin(li * dt)
    den = lr * lr + li * li
    nr, ni = ar - 1.0, ai
    fr = (nr * lr + ni * li) / den
    fi = (ni * lr - nr * li) / den
    bu_r0 = jnp.einsum('blgc,gpc->blgp', ug, b_re.astype(jnp.float32))
    bu_i0 = jnp.einsum('blgc,gpc->blgp', ug, b_im.astype(jnp.float32))
    bu_r = fr * bu_r0 - fi * bu_i0
    bu_i = fr * bu_i0 + fi * bu_r0
    a_r = jnp.broadcast_to(ar, (seqlen,) + ar.shape)
    a_i = jnp.broadcast_to(ai, (seqlen,) + ai.shape)

    def scan_one(br, bi):
        _, _, hr, hi = lax.associative_scan(_complex_linear_combine, (a_r, a_i, br, bi), axis=0)
        return hr, hi

    h_r, h_i = jax.vmap(scan_one)(bu_r, bu_i)
    y = (jnp.einsum('blgp,gcp->blgc', h_r, c_re.astype(jnp.float32))
         - jnp.einsum('blgp,gcp->blgc', h_i, c_im.astype(jnp.float32)))
    y = y.reshape(bsz, seqlen, B_WIDTH) + d_skip.astype(jnp.float32) * u32
    y = jax.nn.gelu(y)
    y = y * jax.nn.sigmoid(y @ w_glu.astype(jnp.float32))
    return y.astype(u.dtype)


def setup_inputs(seed: int = 0) -> dict:
    key = jax.random.key(seed)
    ks = jax.random.split(key, 24)
    f32 = jnp.float32
    nrm = lambda k, shape, s: jax.random.normal(k, shape, f32) * s
    gain = lambda k, shape: 1.0 + 0.02 * jax.random.normal(k, shape, f32)
    lam_im = jnp.broadcast_to(jnp.pi * jnp.arange(S5_STATE, dtype=f32), (DEPTH, S5_GROUPS, S5_STATE))
    return {
        "x": nrm(ks[0], (BATCH, SEQ, D_MODEL), 1.0),
        "meta_tokens": nrm(ks[1], (N_META, D_MODEL), 1.0),
        "rel_bias": nrm(ks[2], (NUM_BUCKETS, A_HEADS), 0.5),
        "norm1_g": gain(ks[3], (DEPTH, D_MODEL)),
        "w_in": nrm(ks[4], (DEPTH, D_MODEL, N_IN), D_MODEL ** -0.5),
        "kv_norm_g": gain(ks[5], (DEPTH, KV_RANK)),
        "w_uk": nrm(ks[6], (DEPTH, KV_RANK, A_HEADS, HEAD_DIM), KV_RANK ** -0.5),
        "w_uv": nrm(ks[7], (DEPTH, KV_RANK, A_HEADS, HEAD_DIM), KV_RANK ** -0.5),
        "lambda_re": -0.5 + nrm(ks[8], (DEPTH, S5_GROUPS, S5_STATE), 0.01),
        "lambda_im": lam_im + 0.0,
        "log_dt": jax.random.uniform(ks[9], (DEPTH, S5_GROUPS), f32, math.log(1e-3), math.log(1e-1)),
        "b_re": nrm(ks[10], (DEPTH, S5_GROUPS, S5_STATE, S5_GROUP), (2 * S5_GROUP) ** -0.5),
        "b_im": nrm(ks[11], (DEPTH, S5_GROUPS, S5_STATE, S5_GROUP), (2 * S5_GROUP) ** -0.5),
        "c_re": nrm(ks[12], (DEPTH, S5_GROUPS, S5_GROUP, S5_STATE), (2 * S5_STATE) ** -0.5),
        "c_im": nrm(ks[13], (DEPTH, S5_GROUPS, S5_GROUP, S5_STATE), (2 * S5_STATE) ** -0.5),
        "d_skip": nrm(ks[14], (DEPTH, B_WIDTH), 1.0),
        "w_glu": nrm(ks[15], (DEPTH, B_WIDTH, B_WIDTH), B_WIDTH ** -0.5),
        "gn_a": gain(ks[16], (DEPTH, A_WIDTH)),
        "gn_b": gain(ks[17], (DEPTH, B_WIDTH)),
        "gn_c": gain(ks[18], (DEPTH, C_WIDTH)),
        "w_out": nrm(ks[19], (DEPTH, MIX_WIDTH, D_MODEL), MIX_WIDTH ** -0.5),
        "norm2_g": gain(ks[20], (DEPTH, D_MODEL)),
        "w_mlp1": nrm(ks[21], (DEPTH, D_MODEL, D_FF), D_MODEL ** -0.5),
        "w_mlp2": nrm(ks[22], (DEPTH, D_FF, D_MODEL), D_FF ** -0.5),
        "final_g": gain(ks[23], (D_MODEL,)),
    }


def reference(x, meta_tokens, rel_bias, norm1_g, w_in, kv_norm_g, w_uk, w_uv, lambda_re,
              lambda_im, log_dt, b_re, b_im, c_re, c_im, d_skip, w_glu, gn_a, gn_b, gn_c,
              w_out, norm2_g, w_mlp1, w_mlp2, final_g):
    bsz, seq, _ = x.shape
    n_keys = seq + N_META
    k_top = min(TOPK_MAX, n_keys // 4)
    h = jnp.concatenate(
        [jnp.broadcast_to(meta_tokens.astype(x.dtype)[None], (bsz, N_META, D_MODEL)), x], axis=1)

    def pad_front(t):
        return jnp.pad(t, [(0, 0), (PAD, 0)] + [(0, 0)] * (t.ndim - 2))

    for l in range(DEPTH):
        hn = rms_norm(h, norm1_g[l])
        proj = hn @ w_in[l]
        qa, ckv, iq, ik, iw, ub, qc, kc, vc = jnp.split(proj, SPLIT_POINTS, axis=-1)

        ckv = rms_norm(ckv, kv_norm_g[l])
        qa = qa.reshape(bsz, n_keys, A_HEADS, HEAD_DIM)
        q_lat = jnp.einsum('blhd,rhd->blhr', qa, w_uk[l]) * HEAD_DIM ** -0.5
        ya = dsa_attention(pad_front(q_lat), pad_front(ckv),
                           pad_front(iq.reshape(bsz, n_keys, IDX_HEADS, IDX_DIM)),
                           pad_front(ik), pad_front(iw), rel_bias, w_uv[l], k_top)[:, PAD:]

        yb = s5_mixer(ub, lambda_re[l], lambda_im[l], log_dt[l], b_re[l], b_im[l],
                      c_re[l], c_im[l], d_skip[l], w_glu[l])

        hs = (bsz, n_keys, C_HEADS, HEAD_DIM)
        yc = stick_breaking_attention(pad_front(qc.reshape(hs)), pad_front(kc.reshape(hs)),
                                      pad_front(vc.reshape(hs)))[:, PAD:]

        y = jnp.concatenate([rms_norm(ya, gn_a[l]), rms_norm(yb, gn_b[l]),
                             rms_norm(yc, gn_c[l])], axis=-1)
        h = h + y @ w_out[l]

        hn = rms_norm(h, norm2_g[l])
        h = h + jnp.square(jax.nn.relu(hn @ w_mlp1[l])) @ w_mlp2[l]

    return rms_norm(h, final_g)[:, N_META:]
```

```cpp
#include <hip/hip_runtime.h>
#include <cstdio>
#include <cstdint>
namespace pg8 {
#define PG8_LAS __attribute__((address_space(3)))
typedef unsigned short bf16_t;
typedef short bf16x8 __attribute__((ext_vector_type(8)));
typedef float f32x4 __attribute__((ext_vector_type(4)));
typedef unsigned u32x4 __attribute__((ext_vector_type(4)));
constexpr int BM = 256, BK = 64, HALF = 128, HTB = HALF * BK * 2  , STAGE_BYTES = 8 * HTB, NXCD = 8, WGM = 8;

__host__ __device__ __forceinline__ int lds_byte(int r, int c) { const int st = (r >> 4) * 2 + (c >> 5), rr = r & 15, cc = c & 31, ob = rr * 64 + cc * 2; return st * 1024 + (ob ^ (((ob >> 9) & 1) << 5)); }
__host__ __device__ __forceinline__ void stage_rc(int b, int& R, int& C) { const int st = b / 1024, sb = b % 1024, swz = sb ^ (((sb >> 9) & 1) << 5); R = (st >> 1) * 16 + swz / 64; C = (st & 1) * 32 + (swz % 64) / 2; }
__host__ __device__ __forceinline__ int perm32(int rho) { const int n = rho >> 4, i = rho & 15; return 8 * (i >> 2) + 4 * n + (i & 3); }

struct Unit { int pm, pn; };
struct Gemm { const bf16_t* A; const bf16_t* Bt; int M, N, K; };

struct StaticOrder {
    int nM, nN, nwg, G, c;
    __host__ __device__ void init(int M, int N, int G_, int c_) { nM = M / BM; nN = N / BM; nwg = nM * nN; G = G_; c = c_; }
    __host__ __device__ bool next(int i, Unit& u) const {
        const long L = (long)i * G + c; if (L >= nwg) return false;
        int wgid = (int)L; { const int q = nwg / NXCD, r = nwg % NXCD, xcd = wgid % NXCD, off = wgid / NXCD; wgid = (xcd < r ? xcd * (q + 1) : r * (q + 1) + (xcd - r) * q) + off; }
        const int nig = WGM * nN, gid = wgid / nig, fm = gid * WGM, gsz = (nM - fm) < WGM ? (nM - fm) : WGM;
        u.pm = fm + ((wgid % nig) % gsz); u.pn = (wgid % nig) / gsz; return true;
    }
    __device__ __forceinline__ void a_ready(const Unit&) const {}
    __device__ __forceinline__ void done(const Unit&) const {}
};

__device__ __forceinline__ unsigned cvt_pk_bf16(float lo, float hi) { unsigned r; asm volatile("v_cvt_pk_bf16_f32 %0, %1, %2" : "=v"(r) : "v"(lo), "v"(hi)); return r; }
typedef float f32x2 __attribute__((ext_vector_type(2)));
#define PG8_GAS __attribute__((address_space(1)))
constexpr float RMS_EPS = 1e-6f;
__device__ __forceinline__ float bf_lo(unsigned w) { return __uint_as_float(w << 16); }
__device__ __forceinline__ float bf_hi(unsigned w) { return __uint_as_float(w & 0xffff0000u); }
typedef unsigned long long stat_t;
__device__ __forceinline__ void stat_add(stat_t* p, float q) { atomicAdd(p, (stat_t)((double)q * 4294967296.0)); }
__device__ __forceinline__ float stat_get(const stat_t* p) { const stat_t v = *p; return (float)(unsigned)(v >> 32) + (float)(unsigned)v * 2.3283064365386963e-10f; }
__device__ __forceinline__ float stat_val(stat_t s) { return (float)((double)s * (1.0 / 4294967296.0)); }
__device__ __forceinline__ float quad_sum(float q) { q += __shfl_xor(q, 16); q += __shfl_xor(q, 32); return q; }

struct EpiIn {
    static constexpr bool PERM = true, AFTER_DRAIN = false; static constexpr int MIDT = 0, MIDT2 = 0;
    bf16_t* O; const stat_t* ss; stat_t* sskv; bf16_t* U;
    __device__ __forceinline__ void operator()(const f32x4 (&acc)[2][2][4][2], const Unit& u, int wr, int wc, int fr, int fq) const {
        const int row0 = u.pm * BM + wr * 64 + fr, col0 = u.pn * BM + wc * 32 + 8 * fq;
        stat_t sv[2][4];
#pragma unroll
        for (int ai = 0; ai < 2; ++ai)
#pragma unroll
            for (int m = 0; m < 4; ++m) sv[ai][m] = *(const PG8_GAS stat_t*)(ss + row0 + ai * HALF + m * 16);
#pragma unroll
        for (int ai = 0; ai < 2; ++ai)
#pragma unroll
            for (int m = 0; m < 4; ++m) { const int row = row0 + ai * HALF + m * 16; const float r = rsqrtf(stat_val(sv[ai][m]) * (1.0f / 1024.0f) + RMS_EPS);
                bf16_t* rowp = O + (size_t)row * 2048 + col0;
#pragma unroll
                for (int bj = 0; bj < 2; ++bj) { const f32x4 v0 = acc[ai][bj][m][0] * r, v1 = acc[ai][bj][m][1] * r;
                    u32x4 w; w.x = cvt_pk_bf16(v0[0], v0[1]); w.y = cvt_pk_bf16(v0[2], v0[3]); w.z = cvt_pk_bf16(v1[0], v1[1]); w.w = cvt_pk_bf16(v1[2], v1[3]);
                    *(PG8_GAS u32x4*)(rowp + bj * HALF) = w;
                    if ((u.pn == 3 || u.pn == 4) && row < 32768) { const int gc = col0 + bj * HALF - 768, gg = gc >> 4, t = row & 2047;
                        *(PG8_GAS u32x4*)(U + ((size_t)gg * 1024 + (row >> 11) * 64 + (t >> 5)) * 640 + (t & 31) * 16 + (gc & 15)) = w; }
                    if (bj == 0 && u.pn == 1) { float q = (bf_lo(w.x) * bf_lo(w.x) + bf_hi(w.x) * bf_hi(w.x)) + (bf_lo(w.y) * bf_lo(w.y) + bf_hi(w.y) * bf_hi(w.y))
                                                      + (bf_lo(w.z) * bf_lo(w.z) + bf_hi(w.z) * bf_hi(w.z)) + (bf_lo(w.w) * bf_lo(w.w) + bf_hi(w.w) * bf_hi(w.w));
                        q = quad_sum(q); if (fq == 0) stat_add(sskv + row, q); } } }
    }
};
struct EpiGlu {
    static constexpr bool PERM = true, AFTER_DRAIN = false; static constexpr int MIDT = 0, MIDT2 = 0;
    const bf16_t* Y; bf16_t* O; stat_t* ssb;
    __device__ __forceinline__ void operator()(const f32x4 (&acc)[2][2][4][2], const Unit& u, int wr, int wc, int fr, int fq) const {
        const int row0 = u.pm * BM + wr * 64 + fr, col0 = u.pn * BM + wc * 32 + 8 * fq;
#pragma unroll
        for (int ai = 0; ai < 2; ++ai) {
            u32x4 yl[4][2];
#pragma unroll
            for (int m = 0; m < 4; ++m) { const int row = row0 + ai * HALF + m * 16; const PG8_GAS u32x4* rp = (const PG8_GAS u32x4*)(Y + (size_t)row * 512 + col0); yl[m][0] = rp[0]; yl[m][1] = rp[HALF / 8]; }
#pragma unroll
            for (int m = 0; m < 4; ++m) { const int row = row0 + ai * HALF + m * 16; float q = 0.f;
#pragma unroll
                for (int bj = 0; bj < 2; ++bj) { const u32x4 y8 = yl[m][bj];
                    const f32x4 g0 = acc[ai][bj][m][0], g1 = acc[ai][bj][m][1];
                    float o[8]; const float yv[8] = {bf_lo(y8.x), bf_hi(y8.x), bf_lo(y8.y), bf_hi(y8.y), bf_lo(y8.z), bf_hi(y8.z), bf_lo(y8.w), bf_hi(y8.w)};
                    const float gv[8] = {g0[0], g0[1], g0[2], g0[3], g1[0], g1[1], g1[2], g1[3]};
#pragma unroll
                    for (int j = 0; j < 8; ++j) o[j] = yv[j] * __builtin_amdgcn_rcpf(1.0f + __expf(-gv[j]));
                    u32x4 w; w.x = cvt_pk_bf16(o[0], o[1]); w.y = cvt_pk_bf16(o[2], o[3]); w.z = cvt_pk_bf16(o[4], o[5]); w.w = cvt_pk_bf16(o[6], o[7]);
                    *(PG8_GAS u32x4*)(O + (size_t)row * 1024 + col0 + bj * HALF) = w;
                    q += (bf_lo(w.x) * bf_lo(w.x) + bf_hi(w.x) * bf_hi(w.x)) + (bf_lo(w.y) * bf_lo(w.y) + bf_hi(w.y) * bf_hi(w.y))
                       + (bf_lo(w.z) * bf_lo(w.z) + bf_hi(w.z) * bf_hi(w.z)) + (bf_lo(w.w) * bf_lo(w.w) + bf_hi(w.w) * bf_hi(w.w)); }
                q = quad_sum(q); if (fq == 0) stat_add(ssb + row, q); } }
    }
};
template <bool OUT> struct EpiRes {
    static constexpr bool PERM = true, AFTER_DRAIN = false; static constexpr int MIDT = OUT ? 8 : 0, MIDT2 = OUT ? 12 : 0;
    bf16_t* H; stat_t* ssn; const stat_t* ssb; const stat_t* ssa; const stat_t* ssc;
    __device__ __forceinline__ void mid(f32x4 (&acc)[2][2][4][2], const Unit& u, int wr, int fr, int t) const {
        const stat_t* sn = (t == MIDT) ? ssb : ssa; const stat_t* sd = (t == MIDT) ? ssa : ssc;
        const float wn = (t == MIDT) ? (1.0f / 512.0f) : (1.0f / 256.0f);
        stat_t vn[2][4], vd[2][4];
#pragma unroll
        for (int ai = 0; ai < 2; ++ai)
#pragma unroll
            for (int m = 0; m < 4; ++m) { const int row = u.pm * BM + ai * HALF + wr * 64 + m * 16 + fr; vn[ai][m] = *(const PG8_GAS stat_t*)(sn + row); vd[ai][m] = *(const PG8_GAS stat_t*)(sd + row); }
#pragma unroll
        for (int ai = 0; ai < 2; ++ai)
#pragma unroll
            for (int m = 0; m < 4; ++m) {
                const float xn = stat_val(vn[ai][m]) * wn + RMS_EPS, xd = stat_val(vd[ai][m]) * (1.0f / 256.0f) + RMS_EPS;
                const float f = __builtin_amdgcn_sqrtf(xd * __builtin_amdgcn_rcpf(xn));
#pragma unroll
                for (int bj = 0; bj < 2; ++bj)
#pragma unroll
                    for (int n = 0; n < 2; ++n) acc[ai][bj][m][n] *= f; }
    }
    __device__ __forceinline__ void operator()(const f32x4 (&acc)[2][2][4][2], const Unit& u, int wr, int wc, int fr, int fq) const {
        const int row0 = u.pm * BM + wr * 64 + fr, col0 = u.pn * BM + wc * 32 + 8 * fq;
#pragma unroll
        for (int ai = 0; ai < 2; ++ai) {
            u32x4 h8[4][2]; stat_t sc[4];
#pragma unroll
            for (int m = 0; m < 4; ++m) { const int row = row0 + ai * HALF + m * 16; const PG8_GAS u32x4* rp = (const PG8_GAS u32x4*)(H + (size_t)row * 1024 + col0);
                h8[m][0] = rp[0]; h8[m][1] = rp[HALF / 8]; if (OUT) sc[m] = *(const PG8_GAS stat_t*)(ssc + row); }
#pragma unroll
            for (int m = 0; m < 4; ++m) { const int row = row0 + ai * HALF + m * 16; float q = 0.f; PG8_GAS u32x4* wp = (PG8_GAS u32x4*)(H + (size_t)row * 1024 + col0);
                float post = 1.0f; if (OUT) post = rsqrtf(stat_val(sc[m]) * (1.0f / 256.0f) + RMS_EPS);
#pragma unroll
                for (int bj = 0; bj < 2; ++bj) { const u32x4 hv = h8[m][bj];
                    const f32x4 a0 = acc[ai][bj][m][0] * post, a1 = acc[ai][bj][m][1] * post;
                    u32x4 w; w.x = cvt_pk_bf16(bf_lo(hv.x) + a0[0], bf_hi(hv.x) + a0[1]); w.y = cvt_pk_bf16(bf_lo(hv.y) + a0[2], bf_hi(hv.y) + a0[3]);
                    w.z = cvt_pk_bf16(bf_lo(hv.z) + a1[0], bf_hi(hv.z) + a1[1]); w.w = cvt_pk_bf16(bf_lo(hv.w) + a1[2], bf_hi(hv.w) + a1[3]);
                    wp[bj * (HALF / 8)] = w;
                    q += (bf_lo(w.x) * bf_lo(w.x) + bf_hi(w.x) * bf_hi(w.x)) + (bf_lo(w.y) * bf_lo(w.y) + bf_hi(w.y) * bf_hi(w.y))
                       + (bf_lo(w.z) * bf_lo(w.z) + bf_hi(w.z) * bf_hi(w.z)) + (bf_lo(w.w) * bf_lo(w.w) + bf_hi(w.w) * bf_hi(w.w)); }
                q = quad_sum(q); if (fq == 0) stat_add(ssn + row, q); } }
    }
};
struct EpiMlp1 {
    static constexpr bool PERM = true, AFTER_DRAIN = false; static constexpr int MIDT = 0, MIDT2 = 0;
    bf16_t* O; const stat_t* ss;
    __device__ __forceinline__ void operator()(const f32x4 (&acc)[2][2][4][2], const Unit& u, int wr, int wc, int fr, int fq) const {
        const int row0 = u.pm * BM + wr * 64 + fr, col0 = u.pn * BM + wc * 32 + 8 * fq;
#pragma unroll
        for (int ai = 0; ai < 2; ++ai)
#pragma unroll
            for (int m = 0; m < 4; ++m) { const int row = row0 + ai * HALF + m * 16; const float r = rsqrtf(stat_get(ss + row) * (1.0f / 1024.0f) + RMS_EPS);
                bf16_t* rowp = O + (size_t)row * 4096 + col0;
#pragma unroll
                for (int bj = 0; bj < 2; ++bj) { f32x4 v0 = acc[ai][bj][m][0] * r, v1 = acc[ai][bj][m][1] * r;
#pragma unroll
                    for (int j = 0; j < 4; ++j) { const float a = fmaxf(v0[j], 0.f), b = fmaxf(v1[j], 0.f); v0[j] = a * a; v1[j] = b * b; }
                    u32x4 w; w.x = cvt_pk_bf16(v0[0], v0[1]); w.y = cvt_pk_bf16(v0[2], v0[3]); w.z = cvt_pk_bf16(v1[0], v1[1]); w.w = cvt_pk_bf16(v1[2], v1[3]);
                    *(u32x4*)(rowp + bj * HALF) = w; } }
    }
};
__device__ __forceinline__ float relu_i(float x) { const int i = (int)__builtin_bit_cast(unsigned, x); return __builtin_bit_cast(float, (unsigned)(i > 0 ? i : 0)); }
__device__ __forceinline__ unsigned pk4_fp8(float a, float b, float c, float d) {
    a = __builtin_amdgcn_fmed3f(a, -448.f, 448.f); b = __builtin_amdgcn_fmed3f(b, -448.f, 448.f); c = __builtin_amdgcn_fmed3f(c, -448.f, 448.f); d = __builtin_amdgcn_fmed3f(d, -448.f, 448.f);
    int w = 0; w = __builtin_amdgcn_cvt_pk_fp8_f32(a, b, w, false); w = __builtin_amdgcn_cvt_pk_fp8_f32(c, d, w, true); return (unsigned)w;
}
constexpr float HID_SCALE = 0.25f; static_assert(HID_SCALE == 0.25f, "EpiMlp1F8B folds sqrt(HID_SCALE) = 0.5 into its column scales");
struct EpiMlp1F8 {
    static constexpr bool PERM = true, AFTER_DRAIN = false; static constexpr int MIDT = 0, MIDT2 = 0;
    unsigned char* O; const stat_t* ss;
    __device__ __forceinline__ void operator()(const f32x4 (&acc)[2][2][4][2], const Unit& u, int wr, int wc, int fr, int fq) const {
        typedef unsigned u32x2v __attribute__((ext_vector_type(2)));
        const int row0 = u.pm * BM + wr * 64 + fr, col0 = u.pn * BM + wc * 32 + 8 * fq;
#pragma unroll
        for (int ai = 0; ai < 2; ++ai)
#pragma unroll
            for (int m = 0; m < 4; ++m) { const int row = row0 + ai * HALF + m * 16; const float r = rsqrtf(stat_get(ss + row) * (1.0f / 1024.0f) + RMS_EPS);
                unsigned char* rowp = O + (size_t)row * 4096 + col0;
#pragma unroll
                for (int bj = 0; bj < 2; ++bj) { f32x4 v0 = acc[ai][bj][m][0] * r, v1 = acc[ai][bj][m][1] * r;
#pragma unroll
                    for (int j = 0; j < 4; ++j) { const float a = fmaxf(v0[j], 0.f), b = fmaxf(v1[j], 0.f); v0[j] = a * a * HID_SCALE; v1[j] = b * b * HID_SCALE; }
                    u32x2v w; w.x = pk4_fp8(v0[0], v0[1], v0[2], v0[3]); w.y = pk4_fp8(v1[0], v1[1], v1[2], v1[3]);
                    *(u32x2v*)(rowp + bj * HALF) = w; } }
    }
};
struct EpiMlp1F8B {
    static constexpr bool PERM = true, AFTER_DRAIN = false; static constexpr int MIDT = 0, MIDT2 = 0;
    unsigned char* O; const unsigned* wmax;
    __device__ __forceinline__ void operator()(const f32x4 (&acc)[2][2][4][2], const Unit& u, int wr, int wc, int fr, int fq) const {
        const int row0 = u.pm * BM + wr * 64 + fr, col0 = u.pn * BM + wc * 32 + 8 * fq;
        f32x4 cs[2][2];
#pragma unroll
        for (int bj = 0; bj < 2; ++bj)
#pragma unroll
            for (int n = 0; n < 2; ++n) { const u32x4 wm = *(const PG8_GAS u32x4*)(wmax + col0 + bj * HALF + 4 * n);
                cs[bj][n] = (f32x4){fmaxf(__uint_as_float(wm.x), 1e-30f), fmaxf(__uint_as_float(wm.y), 1e-30f), fmaxf(__uint_as_float(wm.z), 1e-30f), fmaxf(__uint_as_float(wm.w), 1e-30f)} * (0.5f / (448.0f * 8.0f)); }
        const bool odd = (fq & 1) != 0;
#pragma unroll
        for (int ai = 0; ai < 2; ++ai)
#pragma unroll
            for (int mp = 0; mp < 4; mp += 2) {
#pragma unroll
                for (int bj = 0; bj < 2; ++bj) { unsigned wa[2][2];
#pragma unroll
                    for (int q = 0; q < 2; ++q) { f32x4 v0 = acc[ai][bj][mp + q][0] * cs[bj][0], v1 = acc[ai][bj][mp + q][1] * cs[bj][1];
#pragma unroll
                        for (int j = 0; j < 4; ++j) { const float a = relu_i(v0[j]), b = relu_i(v1[j]); v0[j] = a * a; v1[j] = b * b; }
                        wa[q][0] = pk4_fp8(v0[0], v0[1], v0[2], v0[3]); wa[q][1] = pk4_fp8(v1[0], v1[1], v1[2], v1[3]); }
                    const unsigned s0 = odd ? wa[0][0] : wa[1][0], s1 = odd ? wa[0][1] : wa[1][1];
                    const unsigned r0 = (unsigned)__shfl_xor((int)s0, 16), r1 = (unsigned)__shfl_xor((int)s1, 16);
                    u32x4 o; if (odd) { o.x = r0; o.y = r1; o.z = wa[1][0]; o.w = wa[1][1]; } else { o.x = wa[0][0]; o.y = wa[0][1]; o.z = r0; o.w = r1; }
                    const int row = row0 + ai * HALF + (mp + (odd ? 1 : 0)) * 16;
                    *(PG8_GAS u32x4*)(O + (size_t)row * 4096 + (col0 & ~15) + bj * HALF) = o; } }
    }
};
struct EpiRes8 {
    static constexpr bool PERM = true, AFTER_DRAIN = false; static constexpr int MIDT = 0, MIDT2 = 0;
    bf16_t* H; stat_t* ssn; const unsigned* wmax;
    __device__ __forceinline__ void operator()(const f32x4 (&acc)[2][2][4][2], const Unit& u, int wr, int wc, int fr, int fq) const {
        const int row0 = u.pm * BM + wr * 64 + fr, col0 = u.pn * BM + wc * 32 + 8 * fq;
        f32x4 cs[2][2];
#pragma unroll
        for (int bj = 0; bj < 2; ++bj)
#pragma unroll
            for (int n = 0; n < 2; ++n) { const u32x4 wm = *(const u32x4*)(wmax + col0 + bj * HALF + 4 * n);
                cs[bj][n] = (f32x4){fmaxf(__uint_as_float(wm.x), 1e-30f), fmaxf(__uint_as_float(wm.y), 1e-30f), fmaxf(__uint_as_float(wm.z), 1e-30f), fmaxf(__uint_as_float(wm.w), 1e-30f)} * (1.0f / (448.0f * HID_SCALE)); }
#pragma unroll
        for (int ai = 0; ai < 2; ++ai) {
            u32x4 h8[4][2];
#pragma unroll
            for (int m = 0; m < 4; ++m) { const int row = row0 + ai * HALF + m * 16; const PG8_GAS u32x4* rp = (const PG8_GAS u32x4*)(H + (size_t)row * 1024 + col0); h8[m][0] = rp[0]; h8[m][1] = rp[HALF / 8]; }
#pragma unroll
            for (int m = 0; m < 4; ++m) { const int row = row0 + ai * HALF + m * 16; float q = 0.f; PG8_GAS u32x4* wp = (PG8_GAS u32x4*)(H + (size_t)row * 1024 + col0);
#pragma unroll
                for (int bj = 0; bj < 2; ++bj) { const u32x4 hv = h8[m][bj];
                    const f32x4 a0 = acc[ai][bj][m][0] * cs[bj][0], a1 = acc[ai][bj][m][1] * cs[bj][1];
                    u32x4 w; w.x = cvt_pk_bf16(bf_lo(hv.x) + a0[0], bf_hi(hv.x) + a0[1]); w.y = cvt_pk_bf16(bf_lo(hv.y) + a0[2], bf_hi(hv.y) + a0[3]);
                    w.z = cvt_pk_bf16(bf_lo(hv.z) + a1[0], bf_hi(hv.z) + a1[1]); w.w = cvt_pk_bf16(bf_lo(hv.w) + a1[2], bf_hi(hv.w) + a1[3]);
                    wp[bj * (HALF / 8)] = w;
                    q += (bf_lo(w.x) * bf_lo(w.x) + bf_hi(w.x) * bf_hi(w.x)) + (bf_lo(w.y) * bf_lo(w.y) + bf_hi(w.y) * bf_hi(w.y))
                       + (bf_lo(w.z) * bf_lo(w.z) + bf_hi(w.z) * bf_hi(w.z)) + (bf_lo(w.w) * bf_lo(w.w) + bf_hi(w.w) * bf_hi(w.w)); }
                q = quad_sum(q); if (fq == 0) stat_add(ssn + row, q); } }
    }
};
typedef int v8i_t __attribute__((ext_vector_type(8))); typedef int v4i_t __attribute__((ext_vector_type(4)));
template <class Epi, class Sched, bool ALIGN_EPI = false, bool SP2 = false, bool F8 = false>
__device__ __forceinline__ void gemm_phase(PG8_LAS unsigned char* lds, const Gemm g, const Sched& S, const Epi& E, const int wid_in) {
    int lane_; asm volatile("v_mbcnt_lo_u32_b32 %0, -1, 0\n\tv_mbcnt_hi_u32_b32 %0, -1, %0" : "=v"(lane_)); const int tid_ = wid_in * 64 + lane_;
    const int tid = tid_, wid = wid_in, lane = lane_, wr = wid >> 2, wc = wid & 3, fr = lane & 15, fq = lane >> 4;
    const int K = g.K, nt = K / BK;
    unsigned voffA[2], voffB[2];
#pragma unroll
    for (int i = 0; i < 2; ++i) { int R, C; stage_rc(tid * 16 + i * 8192, R, C); const int Rb = Epi::PERM ? ((R & ~31) + perm32(R & 31)) : R;
        voffA[i] = (unsigned)(R * K + C) * 2u; voffB[i] = (unsigned)(Rb * K + C) * 2u; }
    const size_t kstep = (size_t)(BK * 2);
    const size_t hstep = (size_t)HALF * K * 2;
    const size_t tstep = 2 * hstep;
    const unsigned ldsw = (unsigned)wid * 1024u;
    const int aoff = lds_byte(wr * 64 + fr, fq * 8), boff = lds_byte(wc * 32 + fr, fq * 8);
#define PG8_SA(b, h) (((b) * 2 + (h)) * HTB)
#define PG8_SB(b, h) ((4 + (b) * 2 + (h)) * HTB)
#define PG8_STAGE(bufoff, gbase, voff) do { _Pragma("unroll") for (int _i = 0; _i < 2; ++_i) \
        __builtin_amdgcn_global_load_lds((const unsigned*)((const char*)(gbase) + (voff)[_i]), (PG8_LAS unsigned*)(lds + (bufoff) + ldsw + _i * 8192), 16, 0, 0); } while (0)
#define PG8_LDA(dst, b, h) do { if constexpr (F8) { _Pragma("unroll") for (int m = 0; m < 4; ++m) dst##_8[m] = __builtin_shufflevector(*(const PG8_LAS v4i_t*)(lds + PG8_SA(b, h) + aoff + m * 2048), *(const PG8_LAS v4i_t*)(lds + PG8_SA(b, h) + aoff + m * 2048 + 1024), 0, 1, 2, 3, 4, 5, 6, 7); } \
        else { _Pragma("unroll") for (int m = 0; m < 4; ++m) _Pragma("unroll") for (int k = 0; k < 2; ++k) dst[m][k] = *(const PG8_LAS bf16x8*)(lds + PG8_SA(b, h) + aoff + m * 2048 + k * 1024); } } while (0)
#define PG8_LDB(dst, b, h) do { if constexpr (F8) { _Pragma("unroll") for (int n = 0; n < 2; ++n) dst##_8[n] = __builtin_shufflevector(*(const PG8_LAS v4i_t*)(lds + PG8_SB(b, h) + boff + n * 2048), *(const PG8_LAS v4i_t*)(lds + PG8_SB(b, h) + boff + n * 2048 + 1024), 0, 1, 2, 3, 4, 5, 6, 7); } \
        else { _Pragma("unroll") for (int n = 0; n < 2; ++n) _Pragma("unroll") for (int k = 0; k < 2; ++k) dst[n][k] = *(const PG8_LAS bf16x8*)(lds + PG8_SB(b, h) + boff + n * 2048 + k * 1024); } } while (0)
#define PG8_MMA(ai, bj, At, Bt) do { __builtin_amdgcn_s_setprio(1); \
        if constexpr (F8) { _Pragma("unroll") for (int m = 0; m < 4; ++m) _Pragma("unroll") for (int n = 0; n < 2; ++n) { \
            asm volatile("v_mfma_f32_16x16x128_f8f6f4 %0, %1, %2, %0" : "+v"(acc[ai][bj][m][n]) : "v"(Bt##_8[n]), "v"(At##_8[m])); } } \
        else { _Pragma("unroll") for (int m = 0; m < 4; ++m) _Pragma("unroll") for (int n = 0; n < 2; ++n) _Pragma("unroll") for (int k = 0; k < 2; ++k) \
            acc[ai][bj][m][n] = __builtin_amdgcn_mfma_f32_16x16x32_bf16(Bt[n][k], At[m][k], acc[ai][bj][m][n], 0, 0, 0); } \
        __builtin_amdgcn_s_setprio(0); } while (0)
#define PG8_WAIT_V(n) asm volatile("s_waitcnt vmcnt(" #n ")" ::: "memory")
#define PG8_WAIT_L(n) asm volatile("s_waitcnt lgkmcnt(" #n ")" ::: "memory")
#define PG8_BAR __builtin_amdgcn_s_barrier()
#define PG8_SCHED __builtin_amdgcn_sched_barrier(0)
    Unit cur, nxt; int ui = 0;
    if (!S.next(0, cur)) return;
    f32x4 acc[2][2][4][2];
#pragma unroll
    for (int a = 0; a < 2; ++a)
#pragma unroll
        for (int b = 0; b < 2; ++b)
#pragma unroll
            for (int m = 0; m < 4; ++m)
#pragma unroll
                for (int n = 0; n < 2; ++n) acc[a][b][m][n] = (f32x4){0.f, 0.f, 0.f, 0.f};
    bf16x8 At[4][2], B0[2][2], B1[2][2];
    v8i_t At_8[4], B0_8[2], B1_8[2];
    const char* cA = (const char*)g.A + (size_t)cur.pm * tstep; const char* cB = (const char*)g.Bt + (size_t)cur.pn * tstep;
    S.a_ready(cur);
    if constexpr (SP2) {
        PG8_STAGE(PG8_SB(0, 0), cB, voffB); PG8_STAGE(PG8_SB(0, 1), cB + hstep, voffB); PG8_STAGE(PG8_SA(0, 0), cA, voffA); PG8_STAGE(PG8_SA(0, 1), cA + hstep, voffA);
        if (wr == 1) PG8_BAR;
        PG8_WAIT_V(2); PG8_BAR;
        PG8_STAGE(PG8_SB(1, 0), cB + kstep, voffB); PG8_STAGE(PG8_SA(1, 0), cA + kstep, voffA); PG8_STAGE(PG8_SB(1, 1), cB + hstep + kstep, voffB);
        PG8_WAIT_V(6); PG8_BAR;
    } else {
        PG8_STAGE(PG8_SB(0, 0), cB, voffB); PG8_STAGE(PG8_SA(0, 0), cA, voffA); PG8_STAGE(PG8_SB(0, 1), cB + hstep, voffB); PG8_STAGE(PG8_SA(0, 1), cA + hstep, voffA);
        if (wr == 1) PG8_BAR;
        PG8_WAIT_V(4); PG8_BAR;
        PG8_STAGE(PG8_SB(1, 0), cB + kstep, voffB); PG8_STAGE(PG8_SA(1, 0), cA + kstep, voffA); PG8_STAGE(PG8_SB(1, 1), cB + hstep + kstep, voffB);
        PG8_WAIT_V(6); PG8_BAR;
    }
    for (;;) {
        const bool has_next = S.next(ui + 1, nxt);
        const char* nA = has_next ? (const char*)g.A + (size_t)nxt.pm * tstep : cA; const char* nB = has_next ? (const char*)g.Bt + (size_t)nxt.pn * tstep : cB;
        for (int t = 0; t < nt; t += 2) {
            const bool last = (t == nt - 2);
            const char* a1 = cA + (size_t)(t + 1) * kstep;
            const char* a2 = last ? nA : cA + (size_t)(t + 2) * kstep; const char* b2 = last ? nB : cB + (size_t)(t + 2) * kstep;
            const char* a3 = a2 + kstep; const char* b3 = b2 + kstep;
            if (last && has_next) S.a_ready(nxt);
            if constexpr (SP2) {
            PG8_LDB(B0, 0, 0); PG8_LDB(B1, 0, 1); PG8_SCHED; PG8_LDA(At, 0, 0); PG8_STAGE(PG8_SA(1, 1), a1 + hstep, voffA);
            PG8_WAIT_V(8); PG8_WAIT_L(0); PG8_BAR; PG8_MMA(0, 0, At, B0); PG8_MMA(0, 1, At, B1); PG8_BAR; PG8_SCHED;
            PG8_LDA(At, 0, 1); PG8_STAGE(PG8_SB(0, 0), b2, voffB); PG8_STAGE(PG8_SB(0, 1), b2 + hstep, voffB); PG8_STAGE(PG8_SA(0, 0), a2, voffA);
            PG8_WAIT_V(8); PG8_WAIT_L(0); PG8_BAR; PG8_MMA(1, 0, At, B0); PG8_MMA(1, 1, At, B1); PG8_BAR; PG8_SCHED;
            PG8_LDB(B0, 1, 0); PG8_LDB(B1, 1, 1); PG8_SCHED; PG8_LDA(At, 1, 0); PG8_STAGE(PG8_SA(0, 1), a2 + hstep, voffA);
            PG8_WAIT_V(8); PG8_WAIT_L(0); PG8_BAR; PG8_MMA(0, 0, At, B0); PG8_MMA(0, 1, At, B1); PG8_BAR; PG8_SCHED;
            PG8_LDA(At, 1, 1); PG8_STAGE(PG8_SB(1, 0), b3, voffB); PG8_STAGE(PG8_SB(1, 1), b3 + hstep, voffB); PG8_STAGE(PG8_SA(1, 0), a3, voffA);
            PG8_WAIT_V(8); PG8_WAIT_L(0); PG8_BAR; PG8_MMA(1, 0, At, B0); PG8_MMA(1, 1, At, B1); PG8_BAR; PG8_SCHED;
            } else {
            PG8_LDB(B0, 0, 0); PG8_SCHED; PG8_LDA(At, 0, 0); PG8_STAGE(PG8_SA(1, 1), a1 + hstep, voffA);
            PG8_WAIT_L(8); PG8_BAR; PG8_WAIT_L(0); PG8_MMA(0, 0, At, B0); PG8_BAR; PG8_SCHED;
            PG8_LDB(B1, 0, 1); PG8_STAGE(PG8_SB(0, 0), b2, voffB);
            PG8_BAR; PG8_WAIT_L(0); PG8_MMA(0, 1, At, B1); PG8_BAR;
            PG8_LDA(At, 0, 1); PG8_STAGE(PG8_SA(0, 0), a2, voffA);
            PG8_BAR; PG8_WAIT_L(0); PG8_MMA(1, 0, At, B0); PG8_BAR; PG8_SCHED;
            PG8_STAGE(PG8_SB(0, 1), b2 + hstep, voffB);
            PG8_WAIT_V(6); PG8_BAR; PG8_MMA(1, 1, At, B1); PG8_BAR;
            PG8_LDB(B0, 1, 0); PG8_SCHED; PG8_LDA(At, 1, 0); PG8_STAGE(PG8_SA(0, 1), a2 + hstep, voffA);
            PG8_WAIT_L(8); PG8_BAR; PG8_WAIT_L(0); PG8_MMA(0, 0, At, B0); PG8_BAR; PG8_SCHED;
            PG8_LDB(B1, 1, 1); PG8_STAGE(PG8_SB(1, 0), b3, voffB);
            PG8_BAR; PG8_WAIT_L(0); PG8_MMA(0, 1, At, B1); PG8_BAR;
            PG8_LDA(At, 1, 1); PG8_STAGE(PG8_SA(1, 0), a3, voffA);
            PG8_BAR; PG8_WAIT_L(0); PG8_MMA(1, 0, At, B0); PG8_BAR; PG8_SCHED;
            PG8_STAGE(PG8_SB(1, 1), b3 + hstep, voffB);
            PG8_WAIT_V(6); PG8_BAR; PG8_MMA(1, 1, At, B1); PG8_BAR;
            }
            if constexpr (Epi::MIDT > 0) { if (t + 2 == Epi::MIDT || t + 2 == Epi::MIDT2) { int l2_; asm volatile("v_mbcnt_lo_u32_b32 %0, -1, 0\n\tv_mbcnt_hi_u32_b32 %0, -1, %0" : "=v"(l2_)); E.mid(acc, cur, wr, l2_ & 15, t + 2); } }
        }
        if constexpr (F8) asm volatile("s_nop 15\n\ts_nop 15" ::: "memory");
        if constexpr (ALIGN_EPI) { if (wr == 0) PG8_BAR; }
        if constexpr (!Epi::AFTER_DRAIN) { int l2_; asm volatile("v_mbcnt_lo_u32_b32 %0, -1, 0\n\tv_mbcnt_hi_u32_b32 %0, -1, %0" : "=v"(l2_));
            E(acc, cur, wr, wc, l2_ & 15, l2_ >> 4); S.done(cur); }
        if (!has_next) break;
#pragma unroll
        for (int a = 0; a < 2; ++a)
#pragma unroll
            for (int b = 0; b < 2; ++b)
#pragma unroll
                for (int m = 0; m < 4; ++m)
#pragma unroll
                    for (int n = 0; n < 2; ++n) acc[a][b][m][n] = (f32x4){0.f, 0.f, 0.f, 0.f};
        cur = nxt; cA = nA; cB = nB; ++ui;
        if constexpr (ALIGN_EPI) { if (wr == 1) PG8_BAR; }
    }
    PG8_WAIT_V(0);
    if constexpr (!ALIGN_EPI) { if (wr == 0) PG8_BAR; }
    PG8_BAR;
    if constexpr (Epi::AFTER_DRAIN) { E.fused(acc, cur, wr, wc, fr, fq, lds, wid, lane); S.done(cur); }
#undef PG8_SA
#undef PG8_SB
#undef PG8_STAGE
#undef PG8_LDA
#undef PG8_LDB
#undef PG8_MMA
#undef PG8_WAIT_V
#undef PG8_WAIT_L
#undef PG8_BAR
#undef PG8_SCHED
}
}

constexpr int NWAVES = 8;
constexpr int BATCH = 16, SEQ = 2048, DM = 1024, DEPTH = 2, NMETA = 16, DFF = 4096;
constexpr int MROWS = 33024;
constexpr int MREAL = BATCH * SEQ, MVALID = MREAL + NMETA;
constexpr int NIN_SRC = 1988, NIN = 2048;
constexpr int PC_QA = 0, PC_CKV = 256, PC_IK = 384, PC_IW = 448, PC_IQ = 512, PC_UB = 768, PC_QC = 1280, PC_KC = 1536, PC_VC = 1792;
constexpr int YC_B = 0, YC_A = 512, YC_C = 768;
constexpr int TOPK = 256;

constexpr size_t MiB = 1u << 20;
constexpr size_t WS_CTL = 0;
constexpr size_t WS_STATS = 1 * MiB, CTL_ZERO_BYTES = 5 * MiB;
constexpr size_t STAT_STRIDE = 33024;
enum StatId { ST_SS1 = 0, ST_SSKV = 1, ST_SSB = 2, ST_SS2 = 3, ST_SSA = 4, ST_SSC = 5, ST_PER_LAYER = 6 };
constexpr size_t WS_W = 6 * MiB;
constexpr size_t W_LAYER = 23 * MiB, WO_IN = 0, WO_GLU = 4 * MiB, WO_OUT = 5 * MiB, WO_1 = 7 * MiB, WO_2 = 15 * MiB;
constexpr size_t WS_HB = 52 * MiB;
constexpr size_t WS_BIG = 118 * MiB;
constexpr size_t WS_P = WS_BIG, WS_YCAT = WS_BIG + 130 * MiB, WS_YG = WS_BIG + 196 * MiB;
constexpr size_t WS_END = 376 * MiB;
constexpr size_t WS_WUKF = 497 * MiB - 512 * 1024, WS_WUVF = WS_WUKF + 128 * 1024;
static_assert(WS_STATS + (2 * ST_PER_LAYER + 1) * STAT_STRIDE * 8 <= CTL_ZERO_BYTES && CTL_ZERO_BYTES <= WS_W && WS_W + 2 * W_LAYER <= WS_HB && WS_HB + (size_t)MROWS * 1024 * 2 <= WS_BIG && WS_P + (size_t)MROWS * 2048 * 2 <= WS_YCAT && WS_YCAT + (size_t)MROWS * 1024 * 2 <= WS_YG
              && WS_YG + (size_t)MROWS * 512 * 2 <= WS_BIG + (size_t)MROWS * 4096 * 2 && WS_BIG + (size_t)MROWS * 4096 * 2 <= WS_END, "d_ws map");
constexpr int CW_TMO = 0, CW_CODE = 1;
constexpr int CW_BAR = 4096;
constexpr int CW_WMAX1 = 65536 + 2048;
constexpr int CW_WMAX = 65536;
constexpr int CW_Q = 16384;

constexpr int RING_OFF = 0, RING_BYTES = 131072;
constexpr int LDSCTL_OFF = RING_BYTES, MISC_OFF = LDSCTL_OFF + 320;
constexpr int LDS_BYTES = 147456;

#define GAS __attribute__((address_space(1)))
#define LAS __attribute__((address_space(3)))
typedef unsigned short bf16;
typedef unsigned v4u __attribute__((ext_vector_type(4)));
typedef float f32x4 __attribute__((ext_vector_type(4)));
typedef GAS unsigned gu32;
#define RLX_AGENT __ATOMIC_RELAXED, __HIP_MEMORY_SCOPE_AGENT
#define LDS_WAIT() asm volatile("s_waitcnt lgkmcnt(0)" ::: "memory")
#define VM_WAIT() asm volatile("s_waitcnt vmcnt(0)" ::: "memory")
__device__ __forceinline__ unsigned f2bf(float f) { unsigned u = __builtin_bit_cast(unsigned, f); return (u + 0x7fffu + ((u >> 16) & 1u)) >> 16; }
__device__ __forceinline__ unsigned pk2(float lo, float hi) { return f2bf(lo) | (f2bf(hi) << 16); }
__device__ __forceinline__ float bf2f(bf16 v) { return __uint_as_float((unsigned)v << 16); }
__device__ __forceinline__ float bflo(unsigned w) { return __uint_as_float(w << 16); }
__device__ __forceinline__ float bfhi(unsigned w) { return __uint_as_float(w & 0xffff0000u); }

__device__ __forceinline__ int lane_id() { int l; asm volatile("v_mbcnt_lo_u32_b32 %0, -1, 0\n\tv_mbcnt_hi_u32_b32 %0, -1, %0" : "=v"(l)); return l; }
#define XB_TMO      128
#define XB_XCNT(j)  (256  + 64 * (j))
#define XB_XSUB(j)  (1280 + 64 * (j))
#define XB_XGEN(j)  (2304 + 64 * (j))
#define XB_TOP      3328
#define XB_TOPGEN   3392
#define XCD_BAR_WORDS 3456
#define XB_SPIN_CAP (1u << 21)

__device__ __forceinline__ unsigned xb_ld(unsigned* p)              { return __hip_atomic_load(p, __ATOMIC_RELAXED, __HIP_MEMORY_SCOPE_AGENT); }
__device__ __forceinline__ unsigned xb_add(unsigned* p, unsigned v) { return __hip_atomic_fetch_add(p, v, __ATOMIC_RELAXED, __HIP_MEMORY_SCOPE_AGENT); }
__device__ __forceinline__ unsigned xb_xcc_id() { return (unsigned)__builtin_amdgcn_s_getreg((3 << 11) | 20) & 0xFu; }
#define XB_SPIN(cond, bar) do { unsigned _sp = 0; while (cond) { __builtin_amdgcn_s_sleep(1); \
    if ((++_sp & 255u) == 0u) { if (xb_ld(&(bar)[XB_TMO])) break; if (_sp > XB_SPIN_CAP) { atomicAdd(&(bar)[XB_TMO], 1u); break; } } } } while (0)

struct XcdBarrier { unsigned* bar; unsigned x; volatile LAS unsigned* st; };
__device__ __forceinline__ XcdBarrier xcd_barrier_post(unsigned* bar, volatile LAS unsigned* st, int wave) {
    XcdBarrier b; b.bar = bar; b.x = xb_xcc_id(); b.st = st;
    if (wave == 0 && lane_id() == 0) (void)xb_add(&bar[XB_XCNT(b.x)], 1u);
    return b;
}
__device__ __forceinline__ void xcd_barrier_complete(unsigned* bar, unsigned x, unsigned& nloc, unsigned& nx) {
    const unsigned G = gridDim.x * gridDim.y * gridDim.z;
    unsigned sum, cnt, mine, sp = 0u;
    for (;;) {
        sum = 0u; cnt = 0u; mine = 0u;
#pragma unroll
        for (unsigned j = 0; j < 16; ++j) { const unsigned c = xb_ld(&bar[XB_XCNT(j)]); sum += c; cnt += (c > 0u) ? 1u : 0u; mine = (j == x) ? c : mine; }
        if (sum == G) break;
        __builtin_amdgcn_s_sleep(1);
        if ((++sp & 255u) == 0u) { if (xb_ld(&bar[XB_TMO])) break; if (sp > XB_SPIN_CAP) { atomicAdd(&bar[XB_TMO], 1u); break; } }
    }
    nloc = mine > 0u ? mine : 1u; nx = cnt > 0u ? cnt : 1u;
}
__device__ __forceinline__ void xcd_barrier(const XcdBarrier& b, int wave) {
    asm volatile("s_waitcnt vmcnt(0)" ::: "memory");
    __syncthreads();
    if (wave == 0 && lane_id() == 0) {
        unsigned* bar = b.bar;
        __builtin_amdgcn_s_waitcnt(0);
        unsigned nloc = b.st[0], nx = b.st[1];
        if (nloc == 0u) { xcd_barrier_complete(bar, b.x, nloc, nx); b.st[0] = nloc; b.st[1] = nx; }
        const unsigned old = xb_add(&bar[XB_XSUB(b.x)], 1u);
        const unsigned gen = old / nloc;
        if (old + 1u == (gen + 1u) * nloc) {
            __builtin_amdgcn_fence(__ATOMIC_RELEASE, "agent");
            asm volatile("s_waitcnt vmcnt(0)" ::: "memory");
            const unsigned og = xb_add(&bar[XB_TOP], 1u);
            const unsigned tg = og / nx;
            if (og + 1u == (tg + 1u) * nx) xb_add(&bar[XB_TOPGEN], 1u);
            else XB_SPIN(xb_ld(&bar[XB_TOPGEN]) == tg, bar);
            __builtin_amdgcn_fence(__ATOMIC_ACQUIRE, "agent");
            xb_add(&bar[XB_XGEN(b.x)], 1u);
            asm volatile("s_waitcnt vmcnt(0)" ::: "memory");
        } else {
            XB_SPIN(xb_ld(&bar[XB_XGEN(b.x)]) == gen, bar);
            __builtin_amdgcn_fence(__ATOMIC_ACQUIRE, "agent");
            asm volatile("s_waitcnt vmcnt(0)" ::: "memory");
        }
    }
    __syncthreads();
}


struct Args { const float* in[25]; float* out; unsigned char* ws; int ph_lo, ph_hi; };
struct Frame {
    LAS unsigned char* lds;
    volatile LAS unsigned* MISC;
    gu32* ctl;
    int wave;
    int vcu, G;
    float* out; unsigned char* ws;
};
using pg8::stat_t; using pg8::stat_get;
__device__ __forceinline__ stat_t* stat_ptr(Frame& F, int l, int id) { return (stat_t*)(F.ws + WS_STATS) + (size_t)(l * ST_PER_LAYER + id) * STAT_STRIDE; }
__device__ __forceinline__ bf16* wptr(Frame& F, int l, size_t off) { return (bf16*)(F.ws + WS_W + (size_t)l * W_LAYER + off); }
__device__ __forceinline__ float wave_sum(float v) {
#pragma unroll
    for (int o = 1; o < 64; o <<= 1) v += __shfl_xor(v, o);
    return v;
}
__device__ __forceinline__ float wave_max(float v) {
#pragma unroll
    for (int o = 1; o < 64; o <<= 1) v = fmaxf(v, __shfl_xor(v, o));
    return v;
}
__device__ __forceinline__ int key_row(int b, int kp) { return kp < NMETA ? MREAL + kp : b * SEQ + (kp - NMETA); }

__device__ __forceinline__ int win_srccol(int n) {
    if (n < 384) return n;
    if (n < 448) return 640 + (n - 384);
    if (n < 452) return 704 + (n - 448);
    if (n < 512) return -1;
    if (n < 768) return 384 + (n - 512);
    if (n < 1280) return 708 + (n - 768);
    return 1220 + (n - 1280);
}
__device__ __forceinline__ void p0_transpose_item(const Args& A, Frame& F, int l, int mat, int item, LAS float* scr) {
    const int lane = lane_id();
    int N, K, ldw; const float* W; bf16* WT;
    if (mat == 0) { N = 2048; K = 1024; ldw = NIN_SRC; W = A.in[4] + (size_t)l * 1024 * NIN_SRC; WT = wptr(F, l, WO_IN); }
    else if (mat == 1) { N = 512; K = 512; ldw = 512; W = A.in[16] + (size_t)l * 512 * 512; WT = wptr(F, l, WO_GLU); }
    else if (mat == 2) { N = 1024; K = 1024; ldw = 1024; W = A.in[20] + (size_t)l * 1024 * 1024; WT = wptr(F, l, WO_OUT); }
    else if (mat == 3) { N = 4096; K = 1024; ldw = 4096; W = A.in[22] + (size_t)l * 1024 * 4096; WT = wptr(F, l, WO_1); }
    else { N = 1024; K = 4096; ldw = 1024; W = A.in[23] + (size_t)l * 4096 * 1024; WT = wptr(F, l, WO_2); }
    if (mat == 3) {
        const int nblk = N / 32, kb = item / nblk, nb = item % nblk, k0 = 64 * kb, n0 = 32 * nb, kr = lane >> 3, c4 = lane & 7; float m[4] = {0.f, 0.f, 0.f, 0.f};
#pragma unroll
        for (int i = 0; i < 8; ++i) { const int kk = k0 + 8 * i + kr; const pg8::f32x4 v = *(const GAS pg8::f32x4*)(W + (size_t)kk * ldw + n0 + 4 * c4); const float g = A.in[21][l * 1024 + kk];
#pragma unroll
            for (int e_ = 0; e_ < 4; ++e_) m[e_] = fmaxf(m[e_], fabsf(v[e_] * g)); }
#pragma unroll
        for (int e_ = 0; e_ < 4; ++e_) { m[e_] = fmaxf(m[e_], __shfl_xor(m[e_], 8)); m[e_] = fmaxf(m[e_], __shfl_xor(m[e_], 16)); m[e_] = fmaxf(m[e_], __shfl_xor(m[e_], 32)); }
        if (lane < 8) {
#pragma unroll
            for (int e_ = 0; e_ < 4; ++e_) atomicMax((unsigned*)(F.ctl + CW_WMAX1 + l * 4096 + n0 + 4 * c4 + e_), __float_as_uint(m[e_])); }
        return; }
    if (mat == 4) {
        const int nblk = N / 32, kb = item / nblk, nb = item % nblk, k0 = 64 * kb, n0 = 32 * nb, kr = lane >> 3, c4 = lane & 7; float m[4] = {0.f, 0.f, 0.f, 0.f};
#pragma unroll
        for (int i = 0; i < 8; ++i) { const pg8::f32x4 v = *(const GAS pg8::f32x4*)(W + (size_t)(k0 + 8 * i + kr) * ldw + n0 + 4 * c4);
#pragma unroll
            for (int e_ = 0; e_ < 4; ++e_) m[e_] = fmaxf(m[e_], fabsf(v[e_])); }
#pragma unroll
        for (int e_ = 0; e_ < 4; ++e_) { m[e_] = fmaxf(m[e_], __shfl_xor(m[e_], 8)); m[e_] = fmaxf(m[e_], __shfl_xor(m[e_], 16)); m[e_] = fmaxf(m[e_], __shfl_xor(m[e_], 32)); }
        if (lane < 8) {
#pragma unroll
            for (int e_ = 0; e_ < 4; ++e_) atomicMax((unsigned*)(F.ctl + CW_WMAX + l * 1024 + n0 + 4 * c4 + e_), __float_as_uint(m[e_])); }
        return; }
    const int nblk = N / 32, kb = item / nblk, nb = item % nblk, k0 = 64 * kb, n0 = 32 * nb;
    const int kr = lane >> 3, c4 = lane & 7, n = n0 + 4 * c4;
    int sc = n; float cs = 1.f;
    if (mat == 0) { sc = win_srccol(n); if (n >= PC_QC && n < PC_KC) cs = 0.125f; }
#pragma unroll
    for (int i = 0; i < 8; ++i) { const int kk = 8 * i + kr, k = k0 + kk; int ks = k; float g = 1.f;
        if (mat == 0) g = A.in[3][l * 1024 + k];
        else if (mat == 2) { if (k < 512) { ks = 256 + k; g = A.in[18][l * 512 + k]; } else if (k < 768) { ks = k - 512; g = A.in[17][l * 256 + (k - 512)]; } else { ks = k; g = A.in[19][l * 256 + (k - 768)]; } }
        pg8::f32x4 v = (pg8::f32x4){0.f, 0.f, 0.f, 0.f}; if (sc >= 0) v = *(const GAS pg8::f32x4*)(W + (size_t)ks * ldw + sc);
        g *= cs;
#pragma unroll
        for (int e_ = 0; e_ < 4; ++e_) scr[kk * 33 + 4 * c4 + e_] = v[e_] * g; }
    LDS_WAIT(); asm volatile("" ::: "memory");
    const int c = lane & 7;
#pragma unroll
    for (int j = 0; j < 4; ++j) { const int nn = (lane >> 3) + 8 * j; const LAS float* s = scr + (8 * c) * 33 + nn;
        v4u o; o.x = pk2(s[0 * 33], s[1 * 33]); o.y = pk2(s[2 * 33], s[3 * 33]); o.z = pk2(s[4 * 33], s[5 * 33]); o.w = pk2(s[6 * 33], s[7 * 33]);
        *(GAS v4u*)(WT + (size_t)(n0 + nn) * K + k0 + 8 * c) = o; }
    LDS_WAIT(); asm volatile("" ::: "memory");
}
__device__ __forceinline__ void s5_build_item(const Args& A, Frame& F, int l, int kind, int g, int x, LAS float* scr);
__device__ __forceinline__ void p0_prologue(const Args& A, Frame& F) {
    const int lane = lane_id();
    LAS float* scr = (LAS float*)(F.lds + RING_OFF + F.wave * 16384);
    const int gw = F.vcu * NWAVES + F.wave, NGW = F.G * NWAVES;
    constexpr int I0 = 16 * 64, I1 = 8 * 16, I2 = 16 * 32, I3 = 16 * 128, I4 = 64 * 32, IL = I0 + I1 + I2 + I3 + I4;
    for (int it = gw; it < DEPTH * IL; it += NGW) {
        const int l = it / IL; int r = it % IL;
        if (r < I0) { p0_transpose_item(A, F, l, 0, r, scr); continue; } r -= I0;
        if (r < I1) { p0_transpose_item(A, F, l, 1, r, scr); continue; } r -= I1;
        if (r < I2) { p0_transpose_item(A, F, l, 2, r, scr); continue; } r -= I2;
        if (r < I3) { p0_transpose_item(A, F, l, 3, r, scr); continue; } r -= I3;
        p0_transpose_item(A, F, l, 4, r, scr);
    }
    for (int it = gw; it < DEPTH * 3 * 1024; it += NGW) { const int l = it / 3072, r = it % 3072; s5_build_item(A, F, l, r >> 10, (r >> 5) & 31, r & 31, scr); }
    for (int it = gw; it < DEPTH * 4 * 16 * 2; it += NGW) { const int tb_ = it & 1, fr_ = (it >> 1) & 15, h_ = (it >> 5) & 3, l_ = it >> 7; const int r32_ = lane & 31, hi_ = lane >> 5;
        const float* wuk_ = A.in[6] + (size_t)l_ * 128 * 256; const float* wuv_ = A.in[7] + (size_t)l_ * 128 * 256; const float* kvg_ = A.in[5] + l_ * 128;
        float v_[8];
        if (tb_ == 0) { const int c_ = fr_ >> 2, ks_ = fr_ & 3, rank_ = 32 * c_ + r32_; const float sc_ = kvg_[rank_] * 0.125f;
#pragma unroll
            for (int e_ = 0; e_ < 8; ++e_) v_[e_] = wuk_[((size_t)rank_ * 4 + h_) * 64 + ks_ * 16 + hi_ * 8 + e_] * sc_; }
        else { const int c_ = fr_ >> 2, s_ = (fr_ >> 1) & 1, db_ = fr_ & 1, d_ = 32 * db_ + r32_;
#pragma unroll
            for (int j_ = 0; j_ < 8; ++j_) { const int rk_ = 32 * c_ + 16 * s_ + 8 * (j_ >> 2) + 4 * hi_ + (j_ & 3); v_[j_] = wuv_[((size_t)rk_ * 4 + h_) * 64 + d_] * kvg_[rk_]; } }
        v4u o_; o_.x = pk2(v_[0], v_[1]); o_.y = pk2(v_[2], v_[3]); o_.z = pk2(v_[4], v_[5]); o_.w = pk2(v_[6], v_[7]);
        *((GAS v4u*)(F.ws + (tb_ == 0 ? WS_WUKF : WS_WUVF)) + ((size_t)(l_ * 4 + h_) * 16 + fr_) * 64 + lane) = o_; }
    bf16* Hb = (bf16*)(F.ws + WS_HB); stat_t* ss = stat_ptr(F, 0, ST_SS1);
    for (int m0 = gw * 4; m0 < MVALID; m0 += NGW * 4) {
        f32x4 v[4][4];
#pragma unroll
        for (int q = 0; q < 4; ++q) { const int m = m0 + q < MVALID ? m0 + q : MVALID - 1;
            const float* src = m < MREAL ? A.in[0] + (size_t)m * DM : A.in[1] + (size_t)(m - MREAL) * DM; const GAS f32x4* xr = (const GAS f32x4*)src + 2 * lane;
#pragma unroll
            for (int j = 0; j < 4; ++j) v[q][j] = xr[(j >> 1) * 128 + (j & 1)]; }
#pragma unroll
        for (int q = 0; q < 4; ++q) { const int m = m0 + q; if (m < MVALID) {
            GAS v4u* o16 = (GAS v4u*)(Hb + (size_t)m * DM) + lane; float s = 0.f;
#pragma unroll
            for (int jh = 0; jh < 2; ++jh) { v4u o;
#pragma unroll
                for (int i = 0; i < 2; ++i) { const f32x4 vv = v[q][2 * jh + i]; const unsigned w0 = pk2(vv.x, vv.y), w1 = pk2(vv.z, vv.w); o[2 * i] = w0; o[2 * i + 1] = w1;
                    s += (bflo(w0) * bflo(w0) + bfhi(w0) * bfhi(w0)) + (bflo(w1) * bflo(w1) + bfhi(w1) * bfhi(w1)); }
                o16[64 * jh] = o; }
            s = wave_sum(s); if (lane == 0) ss[m] = (stat_t)((double)s * 4294967296.0); } }
    }
}

__device__ __forceinline__ float log_sigmoid_f(float x) { return fminf(x, 0.f) - log1pf(__expf(-fabsf(x))); }
__device__ __forceinline__ float gelu_tanh_f(float x) { const float u = 0.7978845608028654f * (x + 0.044715f * x * x * x); return 0.5f * x * (1.0f + tanhf(u)); }
__device__ __forceinline__ unsigned mono_key(float f) { const unsigned u = __float_as_uint(f); return (u & 0x80000000u) ? ~u : (u | 0x80000000u); }
__device__ __forceinline__ int t5_bucket(int d) {
    if (d < 16) return d;
    const int v = 16 + (int)(logf((float)d / 16.0f) / 2.0794415416798357f * 16.0f);
    return v < 31 ? v : 31;
}

__device__ __forceinline__ void s5_naive_item(const Args& A, Frame& F, int l, int b, int g) {
    const int p = lane_id();
    const bf16* P = (const bf16*)(F.ws + WS_P); bf16* YG = (bf16*)(F.ws + WS_YG);
    const int lg = l * 32 + g;
    const float dt = expf(A.in[10][lg]), lr = A.in[8][lg * 64 + p], li = A.in[9][lg * 64 + p];
    const float mag = expf(lr * dt), ar = mag * cosf(li * dt), ai = mag * sinf(li * dt);
    const float den = lr * lr + li * li, nr = ar - 1.0f, ni = ai;
    const float fr_ = (nr * lr + ni * li) / den, fi_ = (ni * lr - nr * li) / den;
    float Br[16], Bi[16], Cr[16], Ci[16];
#pragma unroll
    for (int c = 0; c < 16; ++c) { const float br = A.in[11][((size_t)lg * 64 + p) * 16 + c], bi = A.in[12][((size_t)lg * 64 + p) * 16 + c];
        Br[c] = fr_ * br - fi_ * bi; Bi[c] = fr_ * bi + fi_ * br;
        Cr[c] = A.in[13][((size_t)lg * 16 + c) * 64 + p]; Ci[c] = A.in[14][((size_t)lg * 16 + c) * 64 + p]; }
    const int myc = ((p >> 5) & 1) * 8 + ((p >> 4) & 1) * 4 + ((p >> 3) & 1) * 2 + ((p >> 2) & 1);
    const float dsk = A.in[15][l * 512 + g * 16 + myc];
    float hr = 0.f, hi = 0.f;
    for (int kp = 0; kp < NMETA; ++kp) {
        const int row = key_row(b, kp);
        const v4u uw = *(const GAS v4u*)(P + (size_t)row * NIN + PC_UB + g * 16 + (p & 1) * 8);
        float u[16];
#pragma unroll
        for (int j = 0; j < 4; ++j) { const unsigned w0 = __builtin_amdgcn_readlane(uw[j], 0), w1 = __builtin_amdgcn_readlane(uw[j], 1);
            u[2 * j] = bflo(w0); u[2 * j + 1] = bfhi(w0); u[8 + 2 * j] = bflo(w1); u[8 + 2 * j + 1] = bfhi(w1); }
        float bur = 0.f, bui = 0.f;
#pragma unroll
        for (int c = 0; c < 16; ++c) { bur += Br[c] * u[c]; bui += Bi[c] * u[c]; }
        const float nhr = ar * hr - ai * hi + bur, nhi = ar * hi + ai * hr + bui; hr = nhr; hi = nhi;
        float v[16];
#pragma unroll
        for (int c = 0; c < 16; ++c) v[c] = Cr[c] * hr - Ci[c] * hi;
#pragma unroll
        for (int i = 0; i < 8; ++i) { const float send = (p & 32) ? v[i] : v[i + 8]; const float keep = (p & 32) ? v[i + 8] : v[i]; v[i] = keep + __shfl_xor(send, 32); }
#pragma unroll
        for (int i = 0; i < 4; ++i) { const float send = (p & 16) ? v[i] : v[i + 4]; const float keep = (p & 16) ? v[i + 4] : v[i]; v[i] = keep + __shfl_xor(send, 16); }
#pragma unroll
        for (int i = 0; i < 2; ++i) { const float send = (p & 8) ? v[i] : v[i + 2]; const float keep = (p & 8) ? v[i + 2] : v[i]; v[i] = keep + __shfl_xor(send, 8); }
        { const float send = (p & 4) ? v[0] : v[1]; const float keep = (p & 4) ? v[1] : v[0]; v[0] = keep + __shfl_xor(send, 4); }
        float y = v[0]; y += __shfl_xor(y, 1); y += __shfl_xor(y, 2);
        float um = u[0];
#pragma unroll
        for (int c = 1; c < 16; ++c) um = (myc == c) ? u[c] : um;
        y = gelu_tanh_f(y + dsk * um);
        if ((p & 3) == 0 && (b == 0 || kp >= NMETA)) YG[(size_t)row * 512 + g * 16 + myc] = (bf16)f2bf(y);
    }
}

__device__ __forceinline__ void dsa_naive_item(const Args& A, Frame& F, int l, int qi, LAS float* wl) {
    const int lane = lane_id();
    const bf16* P = (const bf16*)(F.ws + WS_P); bf16* Ycat = (bf16*)(F.ws + WS_YCAT);
    const stat_t* sskv = stat_ptr(F, l, ST_SSKV);
    LAS float* sc = wl;
    LAS unsigned* hist = (LAS unsigned*)(wl + 2080);
    LAS float* ql = wl + 2336;
    LAS float* qv = wl + 2848;
    LAS int* sel = (LAS int*)(wl + 3104);
    LAS float* ol = wl + 3360;
    int b, n, row;
    if (qi < MREAL) { b = qi >> 11; n = (qi & 2047) + NMETA + 1; row = qi; } else { b = 0; n = (qi - MREAL) + 1; row = qi; }
    const bf16* Pq = P + (size_t)row * NIN;
    LDS_WAIT(); asm volatile("" ::: "memory");
#pragma unroll
    for (int j = 0; j < 4; ++j) qv[lane + 64 * j] = bf2f(Pq[PC_IQ + lane + 64 * j]);
    float iw[4];
#pragma unroll
    for (int h = 0; h < 4; ++h) iw[h] = bf2f(Pq[PC_IW + h]);
    LDS_WAIT(); asm volatile("" ::: "memory");
#pragma unroll 1
    for (int kp = lane; kp < n; kp += 64) {
        const int krow = key_row(b, kp); const GAS v4u* ikp = (const GAS v4u*)(P + (size_t)krow * NIN + PC_IK);
        float d0 = 0.f, d1 = 0.f, d2 = 0.f, d3 = 0.f;
#pragma unroll 2
        for (int c = 0; c < 8; ++c) { const v4u w = ikp[c]; const float k8[8] = {bflo(w.x), bfhi(w.x), bflo(w.y), bfhi(w.y), bflo(w.z), bfhi(w.z), bflo(w.w), bfhi(w.w)};
#pragma unroll
            for (int j = 0; j < 8; ++j) { const float kk = k8[j]; d0 += qv[c * 8 + j] * kk; d1 += qv[64 + c * 8 + j] * kk; d2 += qv[128 + c * 8 + j] * kk; d3 += qv[192 + c * 8 + j] * kk; } }
        float s = iw[0] * fmaxf(d0, 0.f) + iw[1] * fmaxf(d1, 0.f) + iw[2] * fmaxf(d2, 0.f) + iw[3] * fmaxf(d3, 0.f);
        s += 0.0f;
        sc[kp] = s;
    }
    LDS_WAIT(); asm volatile("" ::: "memory");
    const int keff = n < TOPK ? n : TOPK;
    unsigned prefix = 0u; int krem = keff;
#pragma unroll 1
    for (int pass = 0; pass < 4; ++pass) {
        const int shift = 24 - 8 * pass;
#pragma unroll
        for (int j = 0; j < 4; ++j) hist[lane * 4 + j] = 0u;
        LDS_WAIT(); asm volatile("" ::: "memory");
        for (int kp = lane; kp < n; kp += 64) { const unsigned key = mono_key(sc[kp]);
            const bool match = (pass == 0) || ((key >> (shift + 8)) == (prefix >> (shift + 8)));
            if (match) __hip_atomic_fetch_add(&hist[(key >> shift) & 255u], 1u, __ATOMIC_RELAXED, __HIP_MEMORY_SCOPE_WORKGROUP); }
        LDS_WAIT(); asm volatile("" ::: "memory");
        const int c0 = (int)hist[lane * 4 + 0], c1 = (int)hist[lane * 4 + 1], c2 = (int)hist[lane * 4 + 2], c3 = (int)hist[lane * 4 + 3];
        const int tot = c0 + c1 + c2 + c3; int S = tot;
#pragma unroll
        for (int off = 1; off < 64; off <<= 1) { const int t = __shfl_down(S, off); if (lane + off < 64) S += t; }
        const int above = S - tot;
        const bool here = (above < krem) && (S >= krem);
        int bin = 0, newk = 0;
        if (here) { int a = above;
            if (a + c3 >= krem) { bin = 3; newk = krem - a; } else { a += c3;
            if (a + c2 >= krem) { bin = 2; newk = krem - a; } else { a += c2;
            if (a + c1 >= krem) { bin = 1; newk = krem - a; } else { a += c1; bin = 0; newk = krem - a; } } }
            bin += 4 * lane; }
        const unsigned long long mm = __ballot(here); const int src = mm ? (__ffsll((long long)mm) - 1) : 0;
        bin = __shfl(bin, src); krem = __shfl(newk, src);
        prefix |= (unsigned)bin << shift;
        LDS_WAIT(); asm volatile("" ::: "memory");
    }
    const unsigned T = prefix; const int rneed = krem;
    int selbase = 0, eqbase = 0;
    for (int k0 = 0; k0 < n; k0 += 64) { const int kp = k0 + lane; const bool valid = kp < n;
        const unsigned key = valid ? mono_key(sc[valid ? kp : 0]) : 0u;
        const bool gt = valid && key > T, eq = valid && key == T;
        const unsigned long long eqm = __ballot(eq); const unsigned long long lt = (1ull << lane) - 1ull;
        const int eqr = eqbase + __popcll(eqm & lt);
        const bool s = gt || (eq && eqr < rneed);
        const unsigned long long sm = __ballot(s);
        if (s) sel[selbase + __popcll(sm & lt)] = kp;
        selbase += __popcll(sm); eqbase += __popcll(eqm); }
    LDS_WAIT(); asm volatile("" ::: "memory");
#pragma unroll
    for (int j = 0; j < 4; ++j) qv[lane + 64 * j] = bf2f(Pq[PC_QA + lane + 64 * j]);
    LDS_WAIT(); asm volatile("" ::: "memory");
    const float* wuk = A.in[6] + (size_t)l * 128 * 256; const float* wuv = A.in[7] + (size_t)l * 128 * 256; const float* kvg = A.in[5] + l * 128;
#pragma unroll 1
    for (int h = 0; h < 4; ++h)
#pragma unroll 1
        for (int rr = 0; rr < 2; ++rr) { const int r = lane + 64 * rr; const GAS f32x4* wp = (const GAS f32x4*)(wuk + ((size_t)r * 4 + h) * 64); float a = 0.f;
#pragma unroll
            for (int d4 = 0; d4 < 16; ++d4) { const f32x4 w = wp[d4]; a += qv[h * 64 + d4 * 4] * w.x + qv[h * 64 + d4 * 4 + 1] * w.y + qv[h * 64 + d4 * 4 + 2] * w.z + qv[h * 64 + d4 * 4 + 3] * w.w; }
            ql[h * 128 + r] = a * kvg[r] * 0.125f; }
    LDS_WAIT(); asm volatile("" ::: "memory");
    float ya[4];
#pragma unroll 1
    for (int h = 0; h < 4; ++h) {
        float mx = -3.0e38f;
#pragma unroll 1
        for (int j = 0; j < 4; ++j) { const int i = lane + 64 * j;
            if (i < keff) { const int kp = sel[i]; const int krow = key_row(b, kp); const GAS v4u* cp = (const GAS v4u*)(P + (size_t)krow * NIN + PC_CKV); float d = 0.f;
#pragma unroll 4
                for (int c = 0; c < 16; ++c) { const v4u w = cp[c]; const LAS float* q8 = ql + h * 128 + c * 8;
                    d += q8[0] * bflo(w.x) + q8[1] * bfhi(w.x) + q8[2] * bflo(w.y) + q8[3] * bfhi(w.y) + q8[4] * bflo(w.z) + q8[5] * bfhi(w.z) + q8[6] * bflo(w.w) + q8[7] * bfhi(w.w); }
                const float rkv = rsqrtf(stat_get(sskv + krow) * (1.0f / 128.0f) + pg8::RMS_EPS);
                const float lgv = d * rkv + A.in[2][t5_bucket((n - 1) - kp) * 4 + h];
                sc[i] = lgv; sc[256 + i] = rkv; mx = fmaxf(mx, lgv); } }
        mx = wave_max(mx); float sum = 0.f;
        LDS_WAIT(); asm volatile("" ::: "memory");
#pragma unroll 1
        for (int j = 0; j < 4; ++j) { const int i = lane + 64 * j; if (i < keff) { const float e = __expf(sc[i] - mx); sc[i] = e; sum += e; } }
        sum = wave_sum(sum); const float inv = 1.0f / sum;
        LDS_WAIT(); asm volatile("" ::: "memory");
#pragma unroll 1
        for (int j = 0; j < 4; ++j) { const int i = lane + 64 * j; if (i < keff) qv[i] = sc[i] * inv * sc[256 + i]; }
        LDS_WAIT(); asm volatile("" ::: "memory");
        float o0 = 0.f, o1 = 0.f;
#pragma unroll 4
        for (int i = 0; i < keff; ++i) { const int krow = key_row(b, sel[i]); const float pw = qv[i]; const bf16* cp = P + (size_t)krow * NIN + PC_CKV;
            o0 += pw * bf2f(cp[lane]); o1 += pw * bf2f(cp[lane + 64]); }
        ol[lane] = o0 * kvg[lane]; ol[lane + 64] = o1 * kvg[lane + 64];
        LDS_WAIT(); asm volatile("" ::: "memory");
        float a = 0.f;
#pragma unroll 8
        for (int r = 0; r < 128; ++r) a += ol[r] * wuv[((size_t)r * 4 + h) * 64 + lane];
        ya[h] = a;
        LDS_WAIT(); asm volatile("" ::: "memory");
    }
    float ssq = 0.f;
#pragma unroll
    for (int h = 0; h < 4; ++h) { const unsigned w = f2bf(ya[h]); Ycat[(size_t)row * 1024 + YC_A + h * 64 + lane] = (bf16)w; const float v = __uint_as_float(w << 16); ssq += v * v; }
    ssq = wave_sum(ssq); if (lane == 0) pg8::stat_add(stat_ptr(F, l, ST_SSA) + row, ssq);
}

__device__ __forceinline__ void sb_naive_item(const Args& A, Frame& F, int l, int qi, LAS float* wl) {
    const int lane = lane_id();
    const bf16* P = (const bf16*)(F.ws + WS_P); bf16* Ycat = (bf16*)(F.ws + WS_YCAT);
    LAS float* qs = wl;
    LAS float* wbuf = wl + 64;
    LAS int* rbuf = (LAS int*)(wl + 128);
    int b, n, row;
    if (qi < MREAL) { b = qi >> 11; n = (qi & 2047) + NMETA; row = qi; } else { b = 0; n = qi - MREAL; row = qi; }
    const bf16* Pq = P + (size_t)row * NIN;
    float yc[4];
#pragma unroll 1
    for (int h = 0; h < 4; ++h) {
        LDS_WAIT(); asm volatile("" ::: "memory");
        qs[lane] = bf2f(Pq[PC_QC + h * 64 + lane]);
        LDS_WAIT(); asm volatile("" ::: "memory");
        float carry = 0.f, acc = 0.f;
        for (int top = n - 1; top >= 0; top -= 64) {
            const int kp = top - lane; const bool valid = kp >= 0; const int krow = key_row(b, valid ? kp : 0);
            const GAS v4u* kpn = (const GAS v4u*)(P + (size_t)krow * NIN + PC_KC + h * 64); float z = 0.f;
#pragma unroll
            for (int c = 0; c < 8; ++c) { const v4u w = kpn[c]; const LAS float* q8 = qs + c * 8;
                z += q8[0] * bflo(w.x) + q8[1] * bfhi(w.x) + q8[2] * bflo(w.y) + q8[3] * bfhi(w.y) + q8[4] * bflo(w.z) + q8[5] * bfhi(w.z) + q8[6] * bflo(w.w) + q8[7] * bfhi(w.w); }
            const float lk = valid ? log_sigmoid_f(-z) : 0.f;
            float incl = lk;
#pragma unroll
            for (int off = 1; off < 64; off <<= 1) { const float t = __shfl_up(incl, off); if (lane >= off) incl += t; }
            const float later = carry + incl - lk;
            const float w = valid ? __expf(log_sigmoid_f(z) + later) : 0.f;
            carry += __shfl(incl, 63);
            LDS_WAIT(); asm volatile("" ::: "memory");
            wbuf[lane] = w; rbuf[lane] = krow;
            LDS_WAIT(); asm volatile("" ::: "memory");
            const int cnt = top + 1 < 64 ? top + 1 : 64;
            for (int j = 0; j < cnt; ++j) acc += wbuf[j] * bf2f(P[(size_t)rbuf[j] * NIN + PC_VC + h * 64 + lane]);
        }
        yc[h] = acc;
    }
    float ssq = 0.f;
#pragma unroll
    for (int h = 0; h < 4; ++h) { const unsigned w = f2bf(yc[h]); Ycat[(size_t)row * 1024 + YC_C + h * 64 + lane] = (bf16)w; const float v = __uint_as_float(w << 16); ssq += v * v; }
    ssq = wave_sum(ssq); if (lane == 0) pg8::stat_add(stat_ptr(F, l, ST_SSC) + row, ssq);
}


typedef short bf16x8_t __attribute__((ext_vector_type(8)));
typedef short s16x4_t __attribute__((ext_vector_type(4)));
typedef float f32x16_t __attribute__((ext_vector_type(16)));
typedef float f32x2_t __attribute__((ext_vector_type(2)));
typedef __bf16 bf16x2_t __attribute__((ext_vector_type(2)));
typedef short v4i16_t __attribute__((ext_vector_type(4)));
typedef __attribute__((address_space(3))) const char* lds_cptr;
__device__ __forceinline__ s16x4_t vtr(lds_cptr p) { return __builtin_bit_cast(s16x4_t, __builtin_amdgcn_ds_read_tr16_b64_v4i16((__attribute__((address_space(3))) v4i16_t*)p)); }
__device__ __forceinline__ unsigned cvtpk(float lo, float hi) { f32x2_t v = {lo, hi}; bf16x2_t b = __builtin_convertvector(v, bf16x2_t); return __builtin_bit_cast(unsigned, b); }
__device__ __forceinline__ int crow(int r, int hi) { return (r & 3) + 8 * (r >> 2) + 4 * hi; }
__device__ __forceinline__ float relu_bits(float x) { const int i = (int)__float_as_uint(x); return __uint_as_float((unsigned)(i > 0 ? i : 0)); }
#define MFMA32(a, b, c) __builtin_amdgcn_mfma_f32_32x32x16_bf16((a), (b), (c), 0, 0, 0)

__device__ __forceinline__ void sb_mfma_unit(const Args& A, Frame& F, int l, int unit, LAS unsigned char* wl) {
    const int lane = lane_id(), r32 = lane & 31, hi = lane >> 5;
    const int qt = unit & 63, h = (unit >> 6) & 3, b = unit >> 8;
    const bf16* P = (const bf16*)(F.ws + WS_P); bf16* Ycat = (bf16*)(F.ws + WS_YCAT); stat_t* ssc = stat_ptr(F, l, ST_SSC);
    const int qrow0 = b * SEQ + 32 * qt;
    bf16x8_t qr[4];
#pragma unroll
    for (int ks = 0; ks < 4; ++ks) qr[ks] = *(const GAS bf16x8_t*)(P + (size_t)(qrow0 + r32) * NIN + PC_QC + h * 64 + ks * 16 + hi * 8);
    f32x16_t o0, o1;
#pragma unroll
    for (int r = 0; r < 16; ++r) { o0[r] = 0.f; o1[r] = 0.f; }
    float carry = 0.f;
    const int jt = qt >> 1;
    const lds_cptr vp = (lds_cptr)wl + ((lane >> 4) & 1) * 32 + (lane & 3) * 8 + (4 * hi + ((lane & 15) >> 2)) * 64;
    constexpr float LOG2E = 1.4426950408889634f;
    v4u vld[8]; bf16x8_t kf0[4], kf1[4];
#define SB_LOAD_TILE(it_) do { const int itt_ = (it_); const bool meta_ = itt_ < 0; const int kb_ = meta_ ? MREAL : b * SEQ + 64 * itt_; \
        _Pragma("unroll") for (int i = 0; i < 8; ++i) { int kl = (lane >> 3) + 8 * i; if (meta_ && kl > NMETA - 1) kl = NMETA - 1; \
            vld[i] = *(const GAS v4u*)(P + (size_t)(kb_ + kl) * NIN + PC_VC + h * 64 + (lane & 7) * 8); } \
        const int kr0 = (meta_ && r32 > NMETA - 1) ? NMETA - 1 : r32, kr1 = meta_ ? NMETA - 1 : 32 + r32; \
        _Pragma("unroll") for (int ks = 0; ks < 4; ++ks) { kf0[ks] = *(const GAS bf16x8_t*)(P + (size_t)(kb_ + kr0) * NIN + PC_KC + h * 64 + ks * 16 + hi * 8); \
                                                            kf1[ks] = *(const GAS bf16x8_t*)(P + (size_t)(kb_ + kr1) * NIN + PC_KC + h * 64 + ks * 16 + hi * 8); } } while (0)
    SB_LOAD_TILE(jt);
#pragma unroll 1
    for (int it = jt; it >= -1; --it) {
        const bool meta = it < 0;
        f32x16_t p0, p1;
#pragma unroll
        for (int r = 0; r < 16; ++r) { p0[r] = 0.f; p1[r] = 0.f; }
#pragma unroll
        for (int ks = 0; ks < 4; ++ks) { p0 = MFMA32(kf0[ks], qr[ks], p0); p1 = MFMA32(kf1[ks], qr[ks], p1); }
#pragma unroll
        for (int i = 0; i < 8; ++i) *(LAS v4u*)(wl + ((lane & 7) >> 2) * 4096 + ((lane >> 3) + 8 * i) * 64 + (lane & 3) * 16) = vld[i];
        if (it > -1) SB_LOAD_TILE(it - 1);
        const int lim = meta ? NMETA : (it == jt ? 32 * (qt & 1) + r32 : 64);
        float lk0[16], lk1[16];
#pragma unroll
        for (int r = 0; r < 16; ++r) {
            { const float Z = p0[r] * LOG2E; const float L = __builtin_amdgcn_logf(1.0f + __builtin_amdgcn_exp2f(-fabsf(Z))); const float nl = -(relu_bits(Z) + L);
              const bool valid = crow(r, hi) < lim; lk0[r] = valid ? nl : 0.f; p0[r] = valid ? Z + nl : -1.0e30f; }
            { const float Z = p1[r] * LOG2E; const float L = __builtin_amdgcn_logf(1.0f + __builtin_amdgcn_exp2f(-fabsf(Z))); const float nl = -(relu_bits(Z) + L);
              const bool valid = 32 + crow(r, hi) < lim; lk1[r] = valid ? nl : 0.f; p1[r] = valid ? Z + nl : -1.0e30f; }
        }
        float base[8]; float E = carry;
#pragma unroll
        for (int B = 7; B >= 0; --B) {
            const int rb = 4 * (B & 3);
            const float own = (B >> 2) ? ((lk1[rb] + lk1[rb + 1]) + (lk1[rb + 2] + lk1[rb + 3])) : ((lk0[rb] + lk0[rb + 1]) + (lk0[rb + 2] + lk0[rb + 3]));
            const auto rr = __builtin_amdgcn_permlane32_swap(__float_as_uint(own), __float_as_uint(own), false, false);
            const float lo_s = __uint_as_float(rr[0]), hi_s = __uint_as_float(rr[1]);
            base[B] = E + (hi ? 0.f : hi_s);
            E += lo_s + hi_s;
        }
        carry = E;
#pragma unroll
        for (int B = 0; B < 8; ++B) {
            const int rb = 4 * (B & 3);
            if (B >> 2) { const float l3 = base[B], l2 = l3 + lk1[rb + 3], l1 = l2 + lk1[rb + 2], l0 = l1 + lk1[rb + 1];
                p1[rb + 3] = __builtin_amdgcn_exp2f(p1[rb + 3] + l3); p1[rb + 2] = __builtin_amdgcn_exp2f(p1[rb + 2] + l2); p1[rb + 1] = __builtin_amdgcn_exp2f(p1[rb + 1] + l1); p1[rb] = __builtin_amdgcn_exp2f(p1[rb] + l0); }
            else { const float l3 = base[B], l2 = l3 + lk0[rb + 3], l1 = l2 + lk0[rb + 2], l0 = l1 + lk0[rb + 1];
                p0[rb + 3] = __builtin_amdgcn_exp2f(p0[rb + 3] + l3); p0[rb + 2] = __builtin_amdgcn_exp2f(p0[rb + 2] + l2); p0[rb + 1] = __builtin_amdgcn_exp2f(p0[rb + 1] + l1); p0[rb] = __builtin_amdgcn_exp2f(p0[rb] + l0); }
        }
        v4u pw[4];
#pragma unroll
        for (int j = 0; j < 4; ++j) { pw[0][j] = cvtpk(p0[2 * j], p0[2 * j + 1]); pw[1][j] = cvtpk(p0[8 + 2 * j], p0[8 + 2 * j + 1]); pw[2][j] = cvtpk(p1[2 * j], p1[2 * j + 1]); pw[3][j] = cvtpk(p1[8 + 2 * j], p1[8 + 2 * j + 1]); }
#pragma unroll
        for (int ks = 0; ks < 4; ++ks) {
            const s16x4_t a_lo = vtr(vp + ks * 1024), a_hi = vtr(vp + ks * 1024 + 512), b_lo = vtr(vp + 4096 + ks * 1024), b_hi = vtr(vp + 4096 + ks * 1024 + 512);
            const bf16x8_t v0 = (bf16x8_t){a_lo[0], a_lo[1], a_lo[2], a_lo[3], a_hi[0], a_hi[1], a_hi[2], a_hi[3]};
            const bf16x8_t v1 = (bf16x8_t){b_lo[0], b_lo[1], b_lo[2], b_lo[3], b_hi[0], b_hi[1], b_hi[2], b_hi[3]};
            const bf16x8_t pa = __builtin_bit_cast(bf16x8_t, pw[ks]);
            o0 = MFMA32(pa, v0, o0); o1 = MFMA32(pa, v1, o1); }
        if (__all(carry < -160.0f)) break;
    }
    LAS unsigned short* stg = (LAS unsigned short*)(wl + 8192);
#pragma unroll
    for (int r = 0; r < 16; ++r) { stg[crow(r, hi) * 64 + r32] = (unsigned short)f2bf(o0[r]); stg[crow(r, hi) * 64 + 32 + r32] = (unsigned short)f2bf(o1[r]); }
    LDS_WAIT(); asm volatile("" ::: "memory");
#pragma unroll
    for (int i = 0; i < 4; ++i) { const int row = i * 8 + (lane >> 3), ch = lane & 7; const v4u v = *(const LAS v4u*)(stg + row * 64 + ch * 8);
        float q = (bflo(v.x) * bflo(v.x) + bfhi(v.x) * bfhi(v.x)) + (bflo(v.y) * bflo(v.y) + bfhi(v.y) * bfhi(v.y)) + (bflo(v.z) * bflo(v.z) + bfhi(v.z) * bfhi(v.z)) + (bflo(v.w) * bflo(v.w) + bfhi(v.w) * bfhi(v.w));
        q += __shfl_xor(q, 1); q += __shfl_xor(q, 2); q += __shfl_xor(q, 4);
        if (ch == 0) pg8::stat_add(ssc + qrow0 + row, q);
        *(GAS v4u*)(Ycat + (size_t)(qrow0 + row) * 1024 + YC_C + h * 64 + ch * 8) = v; }
    LDS_WAIT(); asm volatile("" ::: "memory");
}

constexpr int DSA_HIST = 0, DSA_HIST_STRIDE = 257;
constexpr int DSA_ZC = 65792, DSA_ZC_STRIDE = 36;
constexpr int DSA_MASK = DSA_ZC + 64 * 36 * 4;
constexpr int DSA_Q = DSA_MASK + 64 * 34 * 2 * 4;
constexpr int DSA_BD = DSA_Q + 10 * 64 * 4;
constexpr int DSA_IQ = DSA_BD + 4 * 132 * 4, DSA_IQ_STRIDE = 528;
constexpr int DSA_END = DSA_IQ + 64 * DSA_IQ_STRIDE;
static_assert(DSA_END <= RING_BYTES, "DSA LDS map");
constexpr int DSA_CAP = 32;
constexpr unsigned KEY_ZERO = 0x80000000u;

__device__ __forceinline__ constexpr int crow0(int r) { return (r & 3) + 8 * (r >> 2); }
__device__ __forceinline__ unsigned off_a(unsigned row, unsigned ch) { return 2048u * (row >> 3) + 512u * (ch >> 2) + 64u * (row & 7) + 16u * ((ch & 3) ^ ((row >> 2) & 3)); }

__device__ __forceinline__ void dsa_scores(f32x16_t& s0, f32x16_t& s1, const bf16x8_t (&ikf)[2][4], const LAS unsigned char* iqrow, const float (&iw)[4]) {
#pragma unroll
    for (int r = 0; r < 16; ++r) { s0[r] = 0.f; s1[r] = 0.f; }
#pragma unroll
    for (int hp = 0; hp < 4; hp += 2) {
        f32x16_t a0, a1, b0, b1;
#pragma unroll
        for (int r = 0; r < 16; ++r) { a0[r] = 0.f; a1[r] = 0.f; b0[r] = 0.f; b1[r] = 0.f; }
#pragma unroll
        for (int ks = 0; ks < 4; ++ks) { const bf16x8_t qa = *(const LAS bf16x8_t*)(iqrow + hp * 128 + ks * 32), qb = *(const LAS bf16x8_t*)(iqrow + (hp + 1) * 128 + ks * 32);
            a0 = MFMA32(ikf[0][ks], qa, a0); a1 = MFMA32(ikf[1][ks], qa, a1); b0 = MFMA32(ikf[0][ks], qb, b0); b1 = MFMA32(ikf[1][ks], qb, b1); }
#pragma unroll
        for (int r = 0; r < 16; ++r) { s0[r] += iw[hp] * relu_bits(a0[r]); s1[r] += iw[hp] * relu_bits(a1[r]); }
#pragma unroll
        for (int r = 0; r < 16; ++r) { s0[r] += iw[hp + 1] * relu_bits(b0[r]); s1[r] += iw[hp + 1] * relu_bits(b1[r]); }
        __builtin_amdgcn_sched_barrier(0);
    }
}
__device__ __forceinline__ void dsa_load_ik(bf16x8_t (&ikf)[2][4], const bf16* P, int b, int j, int r32, int hi) {
    const int row0 = j == 0 ? MREAL + (r32 < NMETA ? r32 : NMETA - 1) : b * SEQ + 64 * (j - 1) + r32;
    const int row1 = j == 0 ? MREAL + NMETA - 1 : b * SEQ + 64 * (j - 1) + 32 + r32;
#pragma unroll
    for (int ks = 0; ks < 4; ++ks) { ikf[0][ks] = *(const GAS bf16x8_t*)(P + (size_t)row0 * NIN + PC_IK + ks * 16 + hi * 8);
                                     ikf[1][ks] = *(const GAS bf16x8_t*)(P + (size_t)row1 * NIN + PC_IK + ks * 16 + hi * 8); }
}


template <bool P0, bool EDGE>
__device__ __forceinline__ void dsa_hist_tile(const f32x16_t& s0, const f32x16_t& s1, LAS unsigned* hrow, const int shift, const unsigned psh, const int limh, unsigned& zcount) {
#pragma unroll
    for (int r = 0; r < 16; ++r) {
#pragma unroll
        for (int hf = 0; hf < 2; ++hf) {
            float sv = hf ? s1[r] : s0[r]; asm volatile("" : "+v"(sv) :: "memory");
            const unsigned u = __float_as_uint(sv);
            const unsigned key = u ^ ((unsigned)((int)u >> 31) | 0x80000000u);
            unsigned bin;
            if (P0) { bin = key >> 24;
                if (EDGE) { const bool valid = (32 * hf + crow0(r)) < limh; bin = valid ? bin : 256u; zcount += (valid && key == KEY_ZERO) ? 1u : 0u; }
                else zcount += (key == KEY_ZERO) ? 1u : 0u; }
            else { const unsigned d = (key >> shift) & 255u; bool m = (key >> (shift + 8)) == psh; if (EDGE) m = m && ((32 * hf + crow0(r)) < limh); bin = m ? d : 256u; }
            __hip_atomic_fetch_add(hrow + bin, 1u, __ATOMIC_RELAXED, __HIP_MEMORY_SCOPE_WORKGROUP);
        }
        if ((r & 1) == 1) asm volatile("" ::: "memory");
    }
}

__device__ __forceinline__ void dsa_unit(const Args& A, Frame& F, int l, int b, int qt) {
    const int lane = lane_id(), r32 = lane & 31, hi = lane >> 5, w = F.wave;
    LAS unsigned char* L = F.lds + RING_OFF;
    LAS unsigned* hist = (LAS unsigned*)(L + DSA_HIST); LAS unsigned* zc = (LAS unsigned*)(L + DSA_ZC); LAS unsigned* maskw = (LAS unsigned*)(L + DSA_MASK);
    LAS unsigned* qT = (LAS unsigned*)(L + DSA_Q); LAS unsigned* qK = qT + 64; LAS unsigned* qM = qT + 128; LAS unsigned* qJ = qT + 192; LAS unsigned* qR = qT + 256; LAS unsigned* qF = qT + 320; LAS unsigned* qT2 = qT + 384; LAS unsigned* qJ2 = qT + 448; LAS unsigned* qR2 = qT + 512; LAS unsigned* qC = qT + 576;
    LAS float* bd = (LAS float*)(L + DSA_BD);
    const bf16* P = (const bf16*)(F.ws + WS_P); bf16* Ycat = (bf16*)(F.ws + WS_YCAT);
    const int nt = qt + 2;
    const int t0 = 64 * qt, qrow0 = b * SEQ + t0;
    const int tid = w * 64 + lane;
    for (int i = tid; i < (DSA_MASK - DSA_HIST) / 4; i += 512) hist[i] = 0u;
    for (int i = tid; i < 4 * 132; i += 512) { const int h = i / 132, d = i % 132; bd[i] = A.in[2][t5_bucket(d) * 4 + h] * 1.4426950408889634f; }
    if (tid < 64) qF[tid] = 0u;
    {
        const int qh = w & 1, ts = w >> 1;
        const int ql = 32 * qh + r32;
        float iw[4];
        { const bf16* Pq = P + (size_t)(qrow0 + ql) * NIN;
#pragma unroll
          for (int h = 0; h < 4; ++h) iw[h] = bf2f(Pq[PC_IW + h]); }
#pragma unroll
        for (int i = 0; i < 4; ++i) { const int cidx = tid + 512 * i, row = cidx >> 5, ch = cidx & 31;
            *(LAS v4u*)(L + DSA_IQ + row * DSA_IQ_STRIDE + ch * 16) = *(const GAS v4u*)(P + (size_t)(qrow0 + row) * NIN + PC_IQ + ch * 8); }
        const LAS unsigned char* iqrow = L + DSA_IQ + ql * DSA_IQ_STRIDE + hi * 16;
        const int nq = NMETA + t0 + ql + 1;
        unsigned pref = 0u, Tq = 0u, candlim = 0u; int jstar = 1000, rprime = 0; bool fast = false;
        __syncthreads();
#pragma unroll 1
        for (int pass = 0; pass < 6; ++pass) {
            if (pass == 4) { if (qF[0] == 0u) continue; }
            const int shift = 24 - 8 * pass;
            bf16x8_t ikf[2][4];
            if (ts < nt) dsa_load_ik(ikf, P, b, ts, r32, hi);
#pragma unroll 1
            for (int j = ts; j < nt; j += 4) {
                f32x16_t s0, s1;
                dsa_scores(s0, s1, ikf, iqrow, iw);
                if (j + 4 < nt) dsa_load_ik(ikf, P, b, j + 4, r32, hi);
                const int lim = (j == 0) ? NMETA : ((j == nt - 1) ? ql + 1 : 64);
                const int limh = lim - 4 * hi;
                if (pass < 4) {
                    LAS unsigned* hrow = hist + ql * DSA_HIST_STRIDE;
                    const bool edge = (j == 0) || (j == nt - 1);
                    if (pass == 0) { unsigned zcount = 0u;
                        if (edge) dsa_hist_tile<true, true>(s0, s1, hrow, 24, 0u, limh, zcount); else dsa_hist_tile<true, false>(s0, s1, hrow, 24, 0u, limh, zcount);
                        __hip_atomic_fetch_add(zc + ql * DSA_ZC_STRIDE + j, zcount, __ATOMIC_RELAXED, __HIP_MEMORY_SCOPE_WORKGROUP);
                    } else { unsigned zdummy = 0u; const unsigned psh = pref >> (shift + 8);
                        if (edge) dsa_hist_tile<false, true>(s0, s1, hrow, shift, psh, limh, zdummy); else dsa_hist_tile<false, false>(s0, s1, hrow, shift, psh, limh, zdummy); }
                } else if (pass == 4) {
                    LAS unsigned* zrow = zc + ql * DSA_ZC_STRIDE;
#pragma unroll
                    for (int r = 0; r < 16; ++r) {
#pragma unroll
                        for (int hf = 0; hf < 2; ++hf) { const float s = (hf ? s1[r] : s0[r]); const unsigned key = mono_key(s);
                            const unsigned zs = ((32 * hf + crow0(r)) < limh && key == Tq) ? (unsigned)j : 35u; __hip_atomic_fetch_add(zrow + zs, 1u, __ATOMIC_RELAXED, __HIP_MEMORY_SCOPE_WORKGROUP); }
                        if ((r & 3) == 3) asm volatile("" ::: "memory"); }
                } else {
                    unsigned sel0 = 0u, sel1 = 0u;
                    LAS unsigned* lrow = hist + ql * DSA_HIST_STRIDE;
                    const unsigned posb = 64u * (unsigned)j + 4u * (unsigned)hi;
#define DSA_CAND(key_, kidx_) do { const unsigned slot_ = __hip_atomic_fetch_add(lrow, 1u, __ATOMIC_RELAXED, __HIP_MEMORY_SCOPE_WORKGROUP); \
                        if (slot_ < (unsigned)DSA_CAP) { lrow[1 + 2 * slot_] = (key_); lrow[2 + 2 * slot_] = posb + (unsigned)(kidx_); } } while (0)
                    if (!__any(j == jstar)) {
                        const unsigned Tj = (j < jstar) ? Tq : Tq + 1u;
                        if ((j == 0) || (j == nt - 1)) {
#pragma unroll
                            for (int r = 15; r >= 0; --r) {
                                { float sv = s0[r]; asm volatile("" : "+v"(sv) :: "memory"); const unsigned u = __float_as_uint(sv); const unsigned key = u ^ ((unsigned)((int)u >> 31) | 0x80000000u);
                                  sel0 = sel0 * 2u + ((key >= Tj && crow0(r) < limh) ? 1u : 0u); if ((key ^ Tq) < candlim && crow0(r) < limh) DSA_CAND(key, crow0(r)); }
                                { float sv = s1[r]; asm volatile("" : "+v"(sv) :: "memory"); const unsigned u = __float_as_uint(sv); const unsigned key = u ^ ((unsigned)((int)u >> 31) | 0x80000000u);
                                  sel1 = sel1 * 2u + ((key >= Tj && (32 + crow0(r)) < limh) ? 1u : 0u); if ((key ^ Tq) < candlim && (32 + crow0(r)) < limh) DSA_CAND(key, 32 + crow0(r)); } }
                        } else {
#pragma unroll
                            for (int r = 15; r >= 0; --r) {
                                { float sv = s0[r]; asm volatile("" : "+v"(sv) :: "memory"); const unsigned u = __float_as_uint(sv); const unsigned key = u ^ ((unsigned)((int)u >> 31) | 0x80000000u);
                                  sel0 = sel0 * 2u + ((key >= Tj) ? 1u : 0u); if ((key ^ Tq) < candlim) DSA_CAND(key, crow0(r)); }
                                { float sv = s1[r]; asm volatile("" : "+v"(sv) :: "memory"); const unsigned u = __float_as_uint(sv); const unsigned key = u ^ ((unsigned)((int)u >> 31) | 0x80000000u);
                                  sel1 = sel1 * 2u + ((key >= Tj) ? 1u : 0u); if ((key ^ Tq) < candlim) DSA_CAND(key, 32 + crow0(r)); } }
                        }
                    } else {
                    unsigned e0 = 0u, e1 = 0u, g0 = 0u, g1 = 0u;
#pragma unroll
                    for (int r = 15; r >= 0; --r) {
                        { const unsigned key = mono_key(s0[r]); const bool valid = crow0(r) < limh; e0 = e0 * 2u + ((valid && key == Tq) ? 1u : 0u); g0 = g0 * 2u + ((valid && key > Tq) ? 1u : 0u); }
                        { const unsigned key = mono_key(s1[r]); const bool valid = (32 + crow0(r)) < limh; e1 = e1 * 2u + ((valid && key == Tq) ? 1u : 0u); g1 = g1 * 2u + ((valid && key > Tq) ? 1u : 0u); } }
                    unsigned t0m = 0u, t1m = 0u;
                    if (j < jstar) { t0m = e0; t1m = e1; }
                    {
                        int E = 0; unsigned r0m = 0u, r1m = 0u;
#pragma unroll
                        for (int B = 0; B < 8; ++B) { const int rb = 4 * (B & 3); const unsigned em = (B >> 2) ? e1 : e0;
                            const int own = __popc((em >> rb) & 15u);
                            const auto rr = __builtin_amdgcn_permlane32_swap((unsigned)own, (unsigned)own, false, false);
                            const int lo_s = (int)rr[0], hi_s = (int)rr[1];
                            int rk = E + (hi ? lo_s : 0);
#pragma unroll
                            for (int i = 0; i < 4; ++i) { const bool isq = (em >> (rb + i)) & 1u; if (isq && rk < rprime) { if (B >> 2) r1m |= 1u << (rb + i); else r0m |= 1u << (rb + i); } rk += isq ? 1 : 0; }
                            E += lo_s + hi_s; }
                        if (j == jstar) { t0m = r0m; t1m = r1m; }
                    }
                    sel0 = g0 | t0m; sel1 = g1 | t1m;
                    if (__any(candlim != 0u)) {
#pragma unroll
                        for (int r = 0; r < 16; ++r) {
                            { float sv = s0[r]; asm volatile("" : "+v"(sv) :: "memory"); const unsigned key = mono_key(sv); if ((key ^ Tq) < candlim && crow0(r) < limh) DSA_CAND(key, crow0(r)); }
                            { float sv = s1[r]; asm volatile("" : "+v"(sv) :: "memory"); const unsigned key = mono_key(sv); if ((key ^ Tq) < candlim && (32 + crow0(r)) < limh) DSA_CAND(key, 32 + crow0(r)); } }
                    }
                    }
                    unsigned w0 = ((sel0 & 0xfu) | ((sel0 & 0xf0u) << 4) | ((sel0 & 0xf00u) << 8) | ((sel0 & 0xf000u) << 12)) << (4 * hi);
                    unsigned w1 = ((sel1 & 0xfu) | ((sel1 & 0xf0u) << 4) | ((sel1 & 0xf00u) << 8) | ((sel1 & 0xf000u) << 12)) << (4 * hi);
                    { const auto rr = __builtin_amdgcn_permlane32_swap(w0, w0, false, false); w0 = rr[0] | rr[1]; }
                    { const auto rr = __builtin_amdgcn_permlane32_swap(w1, w1, false, false); w1 = rr[0] | rr[1]; }
                    if (hi == 0) { maskw[(ql * 34 + j) * 2] = w0; maskw[(ql * 34 + j) * 2 + 1] = w1; }
                }
            }
            if (pass == 5) {
                if (fast) {
                    __syncthreads();
#pragma unroll 1
                    for (int it = 0; it < 4; ++it) { const int q = 8 * w + 2 * it + hi, i = r32;
                        const LAS unsigned* lr = hist + q * DSA_HIST_STRIDE; const unsigned c0 = lr[0]; const int cnt = (int)(c0 < (unsigned)DSA_CAP ? c0 : (unsigned)DSA_CAP); const int kr = (int)qK[q];
                        unsigned mk = 0u, mp = 0u; if (i < cnt) { mk = lr[1 + 2 * i]; mp = lr[2 + 2 * i]; }
                        int rank = 0;
#pragma unroll 1
                        for (int jj = 0; jj < DSA_CAP; ++jj) { if (!__any(jj < cnt)) break;
                            const unsigned kj = lr[1 + 2 * jj], pj = lr[2 + 2 * jj]; rank += (jj < cnt && (kj > mk || (kj == mk && pj < mp))) ? 1 : 0; }
                        if (i < cnt && rank < kr) __hip_atomic_fetch_or(maskw + (q * 34 + (int)(mp >> 6)) * 2 + (int)((mp >> 5) & 1u), 1u << (mp & 31u), __ATOMIC_RELAXED, __HIP_MEMORY_SCOPE_WORKGROUP); }
                }
                break; }
            __syncthreads();
            if (pass < 4) {
                const int qi = lane >> 3, part = lane & 7, q = 8 * w + qi; LAS unsigned* hr = hist + q * DSA_HIST_STRIDE + 32 * part;
                const int nqq = NMETA + t0 + q + 1; const int krem = (pass == 0) ? (nqq < TOPK ? nqq : TOPK) : (int)qK[q];
                int c[32]; int tot = 0;
#pragma unroll
                for (int i = 0; i < 32; ++i) { c[i] = (int)hr[i]; tot += c[i]; }
#pragma unroll
                for (int i = 0; i < 32; ++i) hr[i] = 0u;
                int S = tot;
#pragma unroll
                for (int off = 1; off < 8; off <<= 1) { const int t = __shfl_down(S, off); if (part + off < 8) S += t; }
                const int above = S - tot; const bool here = (above < krem) && (S >= krem);
                int a = above, bin = 0, newk = 0, cb = 0; bool done = false;
#pragma unroll
                for (int i = 31; i >= 0; --i) { const bool f = !done && (a + c[i] >= krem); bin = f ? i : bin; newk = f ? krem - a : newk; cb = f ? c[i] : cb; done = done || f; a += done ? 0 : c[i]; }
                if (here) { const unsigned np = ((pass == 0) ? 0u : qT[q]) | ((unsigned)(bin + 32 * part) << shift); qT[q] = np; qK[q] = (unsigned)newk; qM[q] = (unsigned)cb;
                    if (pass == 3 && cb > newk && np != KEY_ZERO) qF[0] = 1u;
                    if (pass == 1) {
                        if (cb <= DSA_CAP) { qT2[q] = np | 0xffffu; qJ2[q] = 0xffffffffu; qR2[q] = 0u; qC[q] = 0x10000u; }
                        else if (np == KEY_ZERO) { const LAS unsigned* zr = zc + q * DSA_ZC_STRIDE; int acc = 0, js = 1000, rp = 0;
#pragma unroll 1
                            for (int jj = 0; jj < nt; ++jj) { const int cz = (int)zr[jj]; if (js == 1000 && acc + cz >= newk) { js = jj; rp = newk - acc; } acc += cz; }
                            if (acc == cb) { qT2[q] = KEY_ZERO; qJ2[q] = (unsigned)js; qR2[q] = (unsigned)rp; qC[q] = 0u; } else qF[1] = 1u; }
                        else qF[1] = 1u; } }
            }
            if (pass == 3 || pass == 4) {
                __syncthreads();
                const bool generic = qF[0] != 0u;
                if (pass == 4 || !generic) {
#pragma unroll 1
                    for (int i = 0; i < 8; ++i) { const int q = 8 * w + i; const int m = (int)qM[q], rn = (int)qK[q];
                        int js = 1000, rp = 0;
                        if (m > rn) { const int c = lane < nt ? (int)zc[q * DSA_ZC_STRIDE + lane] : 0; int inc = c;
#pragma unroll
                            for (int off = 1; off < 64; off <<= 1) { const int t = __shfl_up(inc, off); if (lane >= off) inc += t; }
                            const bool here = (inc >= rn) && (inc - c < rn);
                            const unsigned long long mm = __ballot(here); const int src = mm ? (__ffsll((long long)mm) - 1) : 0;
                            js = src; rp = rn - __shfl(inc - c, src); }
                        if (lane == 0) { qJ[q] = (unsigned)js; qR[q] = (unsigned)rp; } }
                } else {
                    for (int i = tid; i < 64 * DSA_ZC_STRIDE; i += 512) zc[i] = 0u;
                }
            }
            __syncthreads();
            pref = qT[ql]; Tq = pref; jstar = (int)qJ[ql]; rprime = (int)qR[ql];
            if (pass == 1 && qF[1] == 0u) { fast = true; Tq = qT2[ql]; jstar = (int)qJ2[ql]; rprime = (int)qR2[ql]; candlim = qC[ql]; pass = 4; }
        }
    }
    __syncthreads();
    {
        const int h = w & 3, qh2 = w >> 2, ql = 32 * qh2 + r32;
        const stat_t* sskv = stat_ptr(F, l, ST_SSKV);
        LAS unsigned short* QL = (LAS unsigned short*)(L + w * 8192);
        {
            bf16x8_t qaf[4];
#pragma unroll
            for (int ks = 0; ks < 4; ++ks) qaf[ks] = *(const GAS bf16x8_t*)(P + (size_t)(qrow0 + ql) * NIN + PC_QA + h * 64 + ks * 16 + hi * 8);
#pragma unroll 1
            for (int c = 0; c < 4; ++c) {
                f32x16_t d;
#pragma unroll
                for (int r = 0; r < 16; ++r) d[r] = 0.f;
                const GAS bf16x8_t* wf = (const GAS bf16x8_t*)(F.ws + WS_WUKF) + ((size_t)(l * 4 + h) * 16 + 4 * c) * 64 + lane;
#pragma unroll
                for (int ks = 0; ks < 4; ++ks) d = MFMA32(wf[64 * ks], qaf[ks], d);
#pragma unroll
                for (int r = 0; r < 16; ++r) QL[r32 * 128 + 32 * c + crow(r, hi)] = (unsigned short)f2bf(d[r]); }
        }
        LDS_WAIT(); asm volatile("" ::: "memory");
        bf16x8_t qlf[8];
#pragma unroll
        for (int s = 0; s < 8; ++s) qlf[s] = *(const LAS bf16x8_t*)(QL + r32 * 128 + 16 * s + 8 * hi);
        LDS_WAIT(); asm volatile("" ::: "memory");
        __syncthreads();
        LAS unsigned char* ckb = L;
        LAS float* rkb = (LAS float*)(L + DSA_IQ);
#define DSA_DMA(j_, buf_) do { const int jj_ = (j_); const int row_ = 8 * w + ((lane >> 2) & 7); \
            const int grow_ = jj_ == 0 ? MREAL + (row_ < NMETA ? row_ : NMETA - 1) : b * SEQ + 64 * (jj_ - 1) + row_; \
            const bf16* gp_ = P + (size_t)grow_ * NIN + PC_CKV + (4 * (lane >> 5) + ((lane & 3) ^ ((row_ >> 2) & 3))) * 8; \
            __builtin_amdgcn_global_load_lds((const unsigned*)gp_, (LAS unsigned*)(ckb + (buf_) * 16384 + 2048 * w), 16, 0, 0); \
            __builtin_amdgcn_global_load_lds((const unsigned*)(gp_ + 64), (LAS unsigned*)(ckb + (buf_) * 16384 + 2048 * w + 1024), 16, 0, 0); } while (0)
        DSA_DMA(0, 0); if (1 < nt) DSA_DMA(1, 1);
        for (int i = tid; i < nt * 64; i += 512) { const int jj_ = i >> 6, kk_ = i & 63; const int grow_ = jj_ == 0 ? MREAL + (kk_ < NMETA ? kk_ : NMETA - 1) : b * SEQ + 64 * (jj_ - 1) + kk_;
            const float rks_ = rsqrtf(stat_get(sskv + grow_) * (1.0f / 128.0f) + pg8::RMS_EPS); rkb[jj_ * 128 + kk_] = rks_; rkb[jj_ * 128 + 64 + kk_] = rks_ * 1.4426950408889634f; }
        asm volatile("s_waitcnt vmcnt(0)" ::: "memory");
        __syncthreads();
        f32x16_t oT[4];
#pragma unroll
        for (int c = 0; c < 4; ++c)
#pragma unroll
            for (int r = 0; r < 16; ++r) oT[c][r] = 0.f;
        float mrun = -1.0e30f, lrun = 0.f;
        constexpr float LOG2E = 1.4426950408889634f;
        const float bfar = bd[h * 132 + 128]; const LAS float* bdh = bd + h * 132;
        const unsigned xr = (r32 >> 2) & 3u, rowpart = 2048u * (r32 >> 3) + 64u * (r32 & 7);
        const unsigned rrA = rowpart + 16u * ((unsigned)hi ^ xr), rrB = rowpart + 16u * (((unsigned)hi ^ xr) ^ 2u);
        const unsigned yb = 2u * ((lane >> 4) & 1) + ((lane & 3) >> 1), trpart = 64u * (4u * hi + ((lane & 15) >> 2)) + 8u * (lane & 1);
        const unsigned trA = trpart + 16u * (yb ^ (unsigned)hi), trB = trpart + 16u * (yb ^ (unsigned)hi ^ 2u);
        if (qh2 == 0) __builtin_amdgcn_s_setprio(2);
#pragma unroll 1
        for (int j0 = 0; j0 < nt; j0 += 2) {
            if (j0 + 2 < nt) DSA_DMA(j0 + 2, (j0 + 2) & 3);
            if (j0 + 3 < nt) DSA_DMA(j0 + 3, (j0 + 3) & 3);
#pragma unroll
            for (int jj = 0; jj < 2; ++jj) { const int j = j0 + jj; if (j >= nt) break;
            const LAS unsigned char* tb = ckb + (j & 3) * 16384; const LAS float* rk = rkb + j * 128;
            f32x16_t p0, p1;
#pragma unroll
            for (int r = 0; r < 16; ++r) { p0[r] = 0.f; p1[r] = 0.f; }
            { const LAS unsigned char* ra = tb + rrA; const LAS unsigned char* rb_ = tb + rrB;
              bf16x8_t a0 = *(const LAS bf16x8_t*)(ra), a1 = *(const LAS bf16x8_t*)(ra + 8192);
#pragma unroll
              for (int s = 0; s < 8; ++s) { bf16x8_t n0 = a0, n1 = a1;
                if (s < 7) { const LAS unsigned char* bp = ((s + 1) & 1) ? rb_ : ra; n0 = *(const LAS bf16x8_t*)(bp + 512 * ((s + 1) >> 1)); n1 = *(const LAS bf16x8_t*)(bp + 512 * ((s + 1) >> 1) + 8192); }
                p0 = MFMA32(a0, qlf[s], p0); p1 = MFMA32(a1, qlf[s], p1); a0 = n0; a1 = n1; } }
            const unsigned mw0 = maskw[(ql * 34 + j) * 2] >> (4 * hi), mw1 = maskw[(ql * 34 + j) * 2 + 1] >> (4 * hi);
            const int dbase = ((j == 0) ? (NMETA + t0 + ql) : (t0 + ql - 64 * (j - 1))) - 4 * hi;
            const bool nearb = __any((dbase - 63) < 128);
            const LAS float* rkh = rk + 4 * hi;
            float mx = -INFINITY;
            const unsigned NINF = 0xff800000u;
#define DSA_LOGITS(NEAR_) \
            _Pragma("unroll") for (int g = 0; g < 4; ++g) {        \
                const f32x4 ka = *(const LAS f32x4*)(rkh + 64 + 8 * g), kb = *(const LAS f32x4*)(rkh + 64 + 32 + 8 * g);        \
                _Pragma("unroll") for (int i = 0; i < 4; ++i) { const int r = 4 * g + i, c0 = 8 * g + i; \
                    float x0 = p0[r], x1 = p1[r]; asm volatile("" : "+v"(x0), "+v"(x1) :: "memory");        \
                    float b0 = bfar, b1 = bfar; \
                    if (NEAR_) { int d0 = dbase - c0; d0 = d0 < 0 ? 0 : (d0 > 128 ? 128 : d0); int d1 = dbase - 32 - c0; d1 = d1 < 0 ? 0 : (d1 > 128 ? 128 : d1); b0 = bdh[d0]; b1 = bdh[d1]; } \
                    const unsigned v0 = __float_as_uint(fmaf(x0, ka[i], b0)), v1 = __float_as_uint(fmaf(x1, kb[i], b1)); \
                    const unsigned m0 = (unsigned)(((int)(mw0 << (31 - c0))) >> 31), m1 = (unsigned)(((int)(mw1 << (31 - c0))) >> 31);        \
                    const float y0 = __uint_as_float((m0 & v0) | (~m0 & NINF)), y1 = __uint_as_float((m1 & v1) | (~m1 & NINF)); \
                    p0[r] = y0; p1[r] = y1; asm("v_max3_f32 %0, %1, %2, %3" : "=v"(mx) : "v"(mx), "v"(y0), "v"(y1)); } }
            if (nearb) { DSA_LOGITS(true) } else { DSA_LOGITS(false) }
#undef DSA_LOGITS
            { const auto rr = __builtin_amdgcn_permlane32_swap(__float_as_uint(mx), __float_as_uint(mx), false, false); mx = fmaxf(__uint_as_float(rr[0]), __uint_as_float(rr[1])); }
            const float mnew = fmaxf(mrun, mx);
            const float scl = __builtin_amdgcn_exp2f(mrun - mnew);
            if (__any(mnew > mrun)) {
#pragma unroll
                for (int c = 0; c < 4; ++c)
#pragma unroll
                    for (int r = 0; r < 16; ++r) oT[c][r] *= scl;
            }
            mrun = mnew; f32x2_t psv = (f32x2_t){0.f, 0.f}; const f32x2_t mv = (f32x2_t){mnew, mnew};
#pragma unroll
            for (int g = 0; g < 4; ++g) {
                const f32x4 ka = *(const LAS f32x4*)(rkh + 8 * g), kb = *(const LAS f32x4*)(rkh + 32 + 8 * g);
#pragma unroll
                for (int i = 0; i < 4; i += 2) { const int r = 4 * g + i;
                    f32x2_t xa = (f32x2_t){p0[r], p0[r + 1]}, xb = (f32x2_t){p1[r], p1[r + 1]}; asm volatile("" : "+v"(xa), "+v"(xb) :: "memory");
                    xa = xa - mv; xb = xb - mv;
                    const f32x2_t ea = (f32x2_t){__builtin_amdgcn_exp2f(xa.x), __builtin_amdgcn_exp2f(xa.y)}, eb = (f32x2_t){__builtin_amdgcn_exp2f(xb.x), __builtin_amdgcn_exp2f(xb.y)};
                    psv = psv + ea; psv = psv + eb;
                    const f32x2_t wa = ea * (f32x2_t){ka[i], ka[i + 1]}, wb = eb * (f32x2_t){kb[i], kb[i + 1]};
                    p0[r] = wa.x; p0[r + 1] = wa.y; p1[r] = wb.x; p1[r + 1] = wb.y; } }
            float ps = psv.x + psv.y;
            { const auto rr = __builtin_amdgcn_permlane32_swap(__float_as_uint(ps), __float_as_uint(ps), false, false); ps = __uint_as_float(rr[0]) + __uint_as_float(rr[1]); }
            lrun = lrun * scl + ps;
            v4u pw[4];
#pragma unroll
            for (int i = 0; i < 4; ++i) { pw[0][i] = cvtpk(p0[2 * i], p0[2 * i + 1]); pw[1][i] = cvtpk(p0[8 + 2 * i], p0[8 + 2 * i + 1]); pw[2][i] = cvtpk(p1[2 * i], p1[2 * i + 1]); pw[3][i] = cvtpk(p1[8 + 2 * i], p1[8 + 2 * i + 1]); }
            { const lds_cptr t0p = (lds_cptr)(tb + trA), t1p = (lds_cptr)(tb + trB);
              s16x4_t lo = vtr(t0p), hh = vtr(t1p + 2048);
#pragma unroll
              for (int i = 0; i < 16; ++i) { const int ks = i >> 2, c = i & 3;
                s16x4_t lo2 = lo, hh2 = hh;
                if (i < 15) { const int ks2 = (i + 1) >> 2, c2 = (i + 1) & 3; lo2 = vtr(t0p + 4096 * ks2 + 512 * c2); hh2 = vtr(t1p + 4096 * ks2 + 2048 + 512 * c2); }
                const bf16x8_t av = (bf16x8_t){lo[0], lo[1], lo[2], lo[3], hh[0], hh[1], hh[2], hh[3]};
                oT[c] = MFMA32(av, __builtin_bit_cast(bf16x8_t, pw[ks]), oT[c]);
                lo = lo2; hh = hh2; } }
            }
            asm volatile("s_waitcnt vmcnt(0)" ::: "memory");
            __syncthreads();
        }
        __builtin_amdgcn_s_setprio(0);
        { const int lane = lane_id(), r32 = lane & 31, hi = lane >> 5;
        const float linv = 1.0f / lrun;
        f32x16_t ot[2];
#pragma unroll
        for (int db = 0; db < 2; ++db)
#pragma unroll
            for (int r = 0; r < 16; ++r) ot[db][r] = 0.f;
#pragma unroll
        for (int c = 0; c < 4; ++c) {
#pragma unroll
            for (int s = 0; s < 2; ++s) {
                v4u pk;
#pragma unroll
                for (int i = 0; i < 4; ++i) pk[i] = cvtpk(oT[c][8 * s + 2 * i] * linv, oT[c][8 * s + 2 * i + 1] * linv);
                const bf16x8_t bfrag = __builtin_bit_cast(bf16x8_t, pk);
#pragma unroll
                for (int db = 0; db < 2; ++db) {
                    const bf16x8_t wa = *((const GAS bf16x8_t*)(F.ws + WS_WUVF) + ((size_t)(l * 4 + h) * 16 + 4 * c + 2 * s + db) * 64 + lane);
                    ot[db] = MFMA32(wa, bfrag, ot[db]); } } }
        LAS unsigned short* stg = (LAS unsigned short*)(L + 36864 + w * 4096);
#pragma unroll
        for (int db = 0; db < 2; ++db)
#pragma unroll
            for (int r = 0; r < 16; ++r) stg[r32 * 64 + 32 * db + crow(r, hi)] = (unsigned short)f2bf(ot[db][r]);
        LDS_WAIT(); asm volatile("" ::: "memory");
        stat_t* ssa = stat_ptr(F, l, ST_SSA);
#pragma unroll
        for (int i = 0; i < 4; ++i) { const int row = i * 8 + (lane >> 3), ch = lane & 7; const v4u v = *(const LAS v4u*)(stg + row * 64 + ch * 8);
            float q = (bflo(v.x) * bflo(v.x) + bfhi(v.x) * bfhi(v.x)) + (bflo(v.y) * bflo(v.y) + bfhi(v.y) * bfhi(v.y)) + (bflo(v.z) * bflo(v.z) + bfhi(v.z) * bfhi(v.z)) + (bflo(v.w) * bflo(v.w) + bfhi(v.w) * bfhi(v.w));
            q += __shfl_xor(q, 1); q += __shfl_xor(q, 2); q += __shfl_xor(q, 4);
            if (ch == 0) pg8::stat_add(ssa + qrow0 + 32 * qh2 + row, q);
            *(GAS v4u*)(Ycat + (size_t)(qrow0 + 32 * qh2 + row) * 1024 + YC_A + h * 64 + ch * 8) = v; }
        LDS_WAIT(); asm volatile("" ::: "memory");
        }
    }
    __syncthreads();
}


constexpr int S5T = 32, S5NC = SEQ / S5T, S5RG = BATCH * S5NC, S5KU = 640;
constexpr size_t WS_U = 376 * MiB, WS_TZ = 416 * MiB, TZ_LAYER = 20 * MiB, WS_MG = 456 * MiB, MG_LAYER = 4 * MiB, WS_HQ = 464 * MiB, WS_END2 = 497 * MiB;
static_assert(WS_HQ + (size_t)MROWS * 1024 <= WS_WUKF && WS_WUVF + 128 * 1024 <= WS_END2 && WS_END2 <= 512 * MiB, "HQ buffer / fragment tables");
static_assert((size_t)32 * S5RG * S5KU * 2 <= WS_TZ - WS_U && (size_t)32 * 512 * S5KU * 2 <= TZ_LAYER && (size_t)32 * 128 * 512 * 2 <= MG_LAYER, "S5 buffers");

struct S5P { float lrdt, lidt, fr, fi; };
__device__ __forceinline__ S5P s5_params(const Args& A, int lg, int p) {
    const float dt = expf(A.in[10][lg]), lr = A.in[8][lg * 64 + p], li = A.in[9][lg * 64 + p];
    const float mag = expf(lr * dt), ar = mag * cosf(li * dt), ai = mag * sinf(li * dt);
    const float den = lr * lr + li * li, nr = ar - 1.0f, ni = ai;
    S5P o; o.lrdt = lr * dt; o.lidt = li * dt; o.fr = (nr * lr + ni * li) / den; o.fi = (ni * lr - nr * li) / den; return o;
}
__device__ __forceinline__ void s5_apow(const S5P& q, int n, float& re, float& im) { const float m = expf(q.lrdt * (float)n); re = m * cosf(q.lidt * (float)n); im = m * sinf(q.lidt * (float)n); }

__device__ __forceinline__ void s5_build_item(const Args& A, Frame& F, int l, int kind, int g, int x, LAS float* scr) {
    const int lane = lane_id(), lg = l * 32 + g, p = lane;
    bf16* TZ = (bf16*)(F.ws + WS_TZ + (size_t)l * TZ_LAYER) + (size_t)g * 512 * S5KU;
    bf16* MG = (bf16*)(F.ws + WS_MG + (size_t)l * MG_LAYER) + (size_t)g * 128 * 512;
    const S5P q = s5_params(A, lg, p);
    if (kind == 0) {
        const int d = x;
        float pr, pi; s5_apow(q, d, pr, pi);
        LDS_WAIT(); asm volatile("" ::: "memory");
#pragma unroll
        for (int ch = 0; ch < 16; ++ch) { const float br = A.in[11][((size_t)lg * 64 + p) * 16 + ch], bi = A.in[12][((size_t)lg * 64 + p) * 16 + ch];
            const float b1r = q.fr * br - q.fi * bi, b1i = q.fr * bi + q.fi * br;
            scr[p * 34 + ch] = pr * b1r - pi * b1i; scr[p * 34 + 16 + ch] = pr * b1i + pi * b1r; }
        LDS_WAIT(); asm volatile("" ::: "memory");
        const int ch = lane >> 2, c4 = 4 * (lane & 3); float k0 = 0.f, k1 = 0.f, k2 = 0.f, k3 = 0.f;
#pragma unroll 16
        for (int pp = 0; pp < 64; ++pp) { const float cr = A.in[13][((size_t)lg * 16 + ch) * 64 + pp], ci = A.in[14][((size_t)lg * 16 + ch) * 64 + pp]; const LAS float* xr = scr + pp * 34 + c4; const LAS float* xi = xr + 16;
            k0 += cr * xr[0] - ci * xi[0]; k1 += cr * xr[1] - ci * xi[1]; k2 += cr * xr[2] - ci * xi[2]; k3 += cr * xr[3] - ci * xi[3]; }
        const unsigned long long kv = (unsigned long long)pk2(k0, k1) | ((unsigned long long)pk2(k2, k3) << 32);
        for (int tau = d; tau < S5T; ++tau) *(GAS unsigned long long*)(TZ + (size_t)(tau * 16 + ch) * S5KU + (tau - d) * 16 + c4) = kv;
        if (d > 0) for (int tau = 0; tau + d < S5T; ++tau) *(GAS unsigned long long*)(TZ + (size_t)(tau * 16 + ch) * S5KU + (tau + d) * 16 + c4) = 0ull;
        LDS_WAIT(); asm volatile("" ::: "memory");
    } else if (kind == 1) {
        const int tau = x; float pr, pi; s5_apow(q, tau + 1, pr, pi);
#pragma unroll 4
        for (int ch = 0; ch < 16; ++ch) { const float cr = A.in[13][((size_t)lg * 16 + ch) * 64 + p], ci = A.in[14][((size_t)lg * 16 + ch) * 64 + p];
            const float wr_ = cr * pr - ci * pi, wi_ = cr * pi + ci * pr;
            bf16* rowp = TZ + (size_t)(tau * 16 + ch) * S5KU + 512;
            rowp[p] = (bf16)f2bf(wr_); rowp[64 + p] = (bf16)f2bf(-wi_); }
    } else {
        const int sg = x; float pr, pi; s5_apow(q, S5T - 1 - sg, pr, pi);
        unsigned wre[8], wim[8];
#pragma unroll
        for (int c2 = 0; c2 < 8; ++c2) { float vr[2], vi[2];
#pragma unroll
            for (int e = 0; e < 2; ++e) { const int ch = 2 * c2 + e; const float br = A.in[11][((size_t)lg * 64 + p) * 16 + ch], bi = A.in[12][((size_t)lg * 64 + p) * 16 + ch];
                const float b1r = q.fr * br - q.fi * bi, b1i = q.fr * bi + q.fi * br; vr[e] = pr * b1r - pi * b1i; vi[e] = pr * b1i + pi * b1r; }
            wre[c2] = pk2(vr[0], vr[1]); wim[c2] = pk2(vi[0], vi[1]); }
        GAS v4u* r0 = (GAS v4u*)(MG + (size_t)(2 * p) * 512 + sg * 16); GAS v4u* r1 = (GAS v4u*)(MG + (size_t)(2 * p + 1) * 512 + sg * 16);
        r0[0] = (v4u){wre[0], wre[1], wre[2], wre[3]}; r0[1] = (v4u){wre[4], wre[5], wre[6], wre[7]};
        r1[0] = (v4u){wim[0], wim[1], wim[2], wim[3]}; r1[1] = (v4u){wim[4], wim[5], wim[6], wim[7]};
    }
}

typedef float f32x4_t __attribute__((ext_vector_type(4)));
__device__ __forceinline__ void s5_scan_task(const Args& A, Frame& F, int l, int g) {
    const int lane = lane_id(), w = F.wave, bcol = lane & 15, kg = lane >> 4, lg = l * 32 + g;
    const bf16* P = (const bf16*)(F.ws + WS_P);
    bf16* U = (bf16*)(F.ws + WS_U) + (size_t)g * S5RG * S5KU;
    const bf16* MG = (const bf16*)(F.ws + WS_MG + (size_t)l * MG_LAYER) + (size_t)g * 128 * 512;
    LAS unsigned char* ring = F.lds + RING_OFF;
    asm volatile("s_waitcnt vmcnt(0)" ::: "memory");
    __syncthreads();
#define S5_DMA(k_) do { const int kk_ = (k_); _Pragma("unroll") for (int i_ = 0; i_ < 2; ++i_) { const int r_ = 2 * w + i_; \
        __builtin_amdgcn_global_load_lds((const unsigned*)(U + (size_t)(r_ * S5NC + kk_) * S5KU + 8 * (lane ^ r_)), (LAS unsigned*)(ring + (kk_ & 7) * 16384 + r_ * 1024), 16, 0, 0); } } while (0)
#pragma unroll
    for (int k0 = 0; k0 < 7; ++k0) S5_DMA(k0);
    bf16x8_t af[16];
#pragma unroll
    for (int ks = 0; ks < 16; ++ks) af[ks] = *(const GAS bf16x8_t*)(MG + (size_t)(16 * w + bcol) * 512 + 32 * ks + 8 * kg);
    const int pA = 8 * w + 2 * kg;
    float aTr[2], aTi[2];
#pragma unroll
    for (int e = 0; e < 2; ++e) { const S5P q = s5_params(A, lg, pA + e); s5_apow(q, S5T, aTr[e], aTi[e]); }
    f32x4_t h;
    {
        f32x4_t s = (f32x4_t){0.f, 0.f, 0.f, 0.f};
#pragma unroll
        for (int ks = 0; ks < 16; ++ks) { const int sg = 2 * ks + (kg >> 1);
            if (sg >= 16) { const bf16x8_t bfm = *(const GAS bf16x8_t*)(P + (size_t)(MREAL + sg - 16) * NIN + PC_UB + g * 16 + 8 * (kg & 1)); s = __builtin_amdgcn_mfma_f32_16x16x32_bf16(af[ks], bfm, s, 0, 0, 0); } }
        h = s;
        bf16* hp = U + (size_t)(bcol * S5NC) * S5KU + 512 + pA;
        *(GAS unsigned*)hp = pk2(h[0], h[2]); *(GAS unsigned*)(hp + 64) = pk2(h[1], h[3]);
    }
    const unsigned lbase = (unsigned)bcol * 1024u + 16u * (unsigned)((kg ^ bcol) & 3), bc2 = (unsigned)bcol >> 2;
#pragma unroll 1
    for (int c = 0; c < S5NC - 1; ++c) {
        if (c <= S5NC - 2 - 6) asm volatile("s_waitcnt vmcnt(12)" ::: "memory"); else asm volatile("s_waitcnt vmcnt(0)" ::: "memory");
        __syncthreads();
        if (c + 7 <= S5NC - 2) S5_DMA(c + 7);
        const LAS unsigned char* bufp = ring + (c & 7) * 16384 + lbase;
        f32x4_t s4[4];
#pragma unroll
        for (int j = 0; j < 4; ++j) s4[j] = (f32x4_t){0.f, 0.f, 0.f, 0.f};
#pragma unroll
        for (int m = 0; m < 4; ++m)
#pragma unroll
            for (int j = 0; j < 4; ++j) { const bf16x8_t bfr = *(const LAS bf16x8_t*)(bufp + 256 * m + 64u * ((unsigned)j ^ bc2)); s4[j] = __builtin_amdgcn_mfma_f32_16x16x32_bf16(af[4 * m + j], bfr, s4[j], 0, 0, 0); }
        const f32x4_t s = (s4[0] + s4[1]) + (s4[2] + s4[3]);
        { const float r0 = aTr[0] * h[0] - aTi[0] * h[1] + s[0], i0 = aTr[0] * h[1] + aTi[0] * h[0] + s[1], r1 = aTr[1] * h[2] - aTi[1] * h[3] + s[2], i1 = aTr[1] * h[3] + aTi[1] * h[2] + s[3];
          h = (f32x4_t){r0, i0, r1, i1}; }
        bf16* hp = U + (size_t)(bcol * S5NC + (c + 1)) * S5KU + 512 + pA;
        *(GAS unsigned*)hp = pk2(h[0], h[2]); *(GAS unsigned*)(hp + 64) = pk2(h[1], h[3]);
    }
#undef S5_DMA
    __syncthreads();
}

struct S5Order {
    int G, c;
    __device__ __forceinline__ bool next(int i, pg8::Unit& u) const { const int L = i * G + c; if (L >= 256) return false; const int g = L >> 3, wi = L & 7; u.pm = 4 * g + (wi >> 1); u.pn = 2 * g + (wi & 1); return true; }
    __device__ __forceinline__ void a_ready(const pg8::Unit&) const {}
    __device__ __forceinline__ void done(const pg8::Unit&) const {}
};
namespace pg8 {
struct EpiS5 {
    static constexpr bool PERM = true, AFTER_DRAIN = false; static constexpr int MIDT = 0, MIDT2 = 0;
    const bf16_t* Pm; bf16_t* YG; const float* dsk;
    __device__ __forceinline__ void operator()(const f32x4 (&acc)[2][2][4][2], const Unit& u, int wr, int wc, int fr, int fq) const {
        const int g = u.pm >> 2, rg0 = (u.pm & 3) * BM + wr * 64 + fr, cg0 = (u.pn & 1) * BM + wc * 32 + 8 * fq;
        const int colq = g * 16 + (cg0 & 15);
        const f32x4 d0 = *(const PG8_GAS f32x4*)(dsk + colq), d1 = *(const PG8_GAS f32x4*)(dsk + colq + 4);
#pragma unroll
        for (int ai = 0; ai < 2; ++ai) {
            u32x4 ul[4][2];
#pragma unroll
            for (int m = 0; m < 4; ++m) { const int rg = rg0 + ai * HALF + m * 16, b = rg >> 6, c = rg & 63;
#pragma unroll
                for (int bj = 0; bj < 2; ++bj) { const int cg = cg0 + bj * HALF, tau = cg >> 4, ch = cg & 15; const size_t row = (size_t)b * 2048 + c * 32 + tau; const int col = g * 16 + ch;
                    ul[m][bj] = *(const PG8_GAS u32x4*)(Pm + row * 2048 + 768 + col); } }
#pragma unroll
            for (int m = 0; m < 4; ++m) { const int rg = rg0 + ai * HALF + m * 16, b = rg >> 6, c = rg & 63;
#pragma unroll
                for (int bj = 0; bj < 2; ++bj) { const int cg = cg0 + bj * HALF, tau = cg >> 4, ch = cg & 15; const size_t row = (size_t)b * 2048 + c * 32 + tau; const int col = g * 16 + ch;
                    const u32x4 u8 = ul[m][bj];
                    const f32x4 a0 = acc[ai][bj][m][0], a1 = acc[ai][bj][m][1];
                    float y[8] = {a0[0] + d0[0] * bf_lo(u8.x), a0[1] + d0[1] * bf_hi(u8.x), a0[2] + d0[2] * bf_lo(u8.y), a0[3] + d0[3] * bf_hi(u8.y),
                                  a1[0] + d1[0] * bf_lo(u8.z), a1[1] + d1[1] * bf_hi(u8.z), a1[2] + d1[2] * bf_lo(u8.w), a1[3] + d1[3] * bf_hi(u8.w)};
#pragma unroll
                    for (int j = 0; j < 8; ++j) { const float x = y[j], t = fminf(0.7978845608028654f * (x + 0.044715f * x * x * x), 15.0f); const float e = __expf(2.0f * t); y[j] = x * (1.0f - __builtin_amdgcn_rcpf(e + 1.0f)); }
                    u32x4 w; w.x = cvt_pk_bf16(y[0], y[1]); w.y = cvt_pk_bf16(y[2], y[3]); w.z = cvt_pk_bf16(y[4], y[5]); w.w = cvt_pk_bf16(y[6], y[7]);
                    *(PG8_GAS u32x4*)(YG + row * 512 + col) = w; } } }
    }
};
}


__device__ __forceinline__ void w2_quant_item(const Args& A, Frame& F, int l, int item, LAS float* scr) {
    const int lane = lane_id();
    const float* W = A.in[23] + (size_t)l * 4096 * 1024; unsigned char* WQ = (unsigned char*)wptr(F, l, WO_2);
    const int kb = item >> 5, nb = item & 31, k0 = 64 * kb, n0 = 32 * nb;
    const int kr = lane >> 3, c4 = lane & 7; float sc[4];
#pragma unroll
    for (int e_ = 0; e_ < 4; ++e_) sc[e_] = 448.0f / fmaxf(__uint_as_float(__hip_atomic_load(F.ctl + CW_WMAX + l * 1024 + n0 + 4 * c4 + e_, RLX_AGENT)), 1e-30f);
#pragma unroll
    for (int i = 0; i < 8; ++i) { const int kk = 8 * i + kr; const f32x4_t v = *(const GAS f32x4_t*)(W + (size_t)(k0 + kk) * 1024 + n0 + 4 * c4);
#pragma unroll
        for (int e_ = 0; e_ < 4; ++e_) scr[kk * 33 + 4 * c4 + e_] = v[e_] * sc[e_]; }
    LDS_WAIT(); asm volatile("" ::: "memory");
#pragma unroll
    for (int j = 0; j < 2; ++j) { const int c = lane + 64 * j, n = c >> 2, part = c & 3; const LAS float* s = scr + (16 * part) * 33 + n;
        v4u o;
#pragma unroll
        for (int q = 0; q < 4; ++q) o[q] = pg8::pk4_fp8(s[(4 * q) * 33], s[(4 * q + 1) * 33], s[(4 * q + 2) * 33], s[(4 * q + 3) * 33]);
        *(GAS v4u*)(WQ + (size_t)(n0 + n) * 4096 + k0 + 16 * part) = o; }
    LDS_WAIT(); asm volatile("" ::: "memory");
}

__device__ __forceinline__ void w1_quant_item(const Args& A, Frame& F, int l, int item, LAS float* scr) {
    const int lane = lane_id();
    const float* W = A.in[22] + (size_t)l * 1024 * 4096; unsigned char* WQ = (unsigned char*)wptr(F, l, WO_1);
    const int kb = item >> 7, nb = item & 127, k0 = 64 * kb, n0 = 32 * nb;
    const int kr = lane >> 3, c4 = lane & 7; float sc[4];
#pragma unroll
    for (int e_ = 0; e_ < 4; ++e_) sc[e_] = 448.0f / fmaxf(__uint_as_float(__hip_atomic_load(F.ctl + CW_WMAX1 + l * 4096 + n0 + 4 * c4 + e_, RLX_AGENT)), 1e-30f);
#pragma unroll
    for (int i = 0; i < 8; ++i) { const int kk = 8 * i + kr; const f32x4_t v = *(const GAS f32x4_t*)(W + (size_t)(k0 + kk) * 4096 + n0 + 4 * c4); const float g = A.in[21][l * 1024 + k0 + kk];
#pragma unroll
        for (int e_ = 0; e_ < 4; ++e_) scr[kk * 33 + 4 * c4 + e_] = v[e_] * g * sc[e_]; }
    LDS_WAIT(); asm volatile("" ::: "memory");
#pragma unroll
    for (int j = 0; j < 2; ++j) { const int c = lane + 64 * j, n = c >> 2, part = c & 3; const LAS float* s = scr + (16 * part) * 33 + n;
        v4u o;
#pragma unroll
        for (int q = 0; q < 4; ++q) o[q] = pg8::pk4_fp8(s[(4 * q) * 33], s[(4 * q + 1) * 33], s[(4 * q + 2) * 33], s[(4 * q + 3) * 33]);
        *(GAS v4u*)(WQ + (size_t)(n0 + n) * 1024 + k0 + 16 * part) = o; }
    LDS_WAIT(); asm volatile("" ::: "memory");
}
__device__ __forceinline__ void hq_phase(Frame& F, const stat_t* ss) {
    const int lane = lane_id();
    const int gw = F.vcu * NWAVES + F.wave, NGW = F.G * NWAVES;
    const bf16* Hb = (const bf16*)(F.ws + WS_HB); unsigned char* HQ = F.ws + WS_HQ;
    for (int m0 = gw * 8; m0 < MVALID; m0 += NGW * 8) {
        v4u hw[8][2]; float r[8];
#pragma unroll
        for (int q = 0; q < 8; ++q) { const GAS v4u* h16 = (const GAS v4u*)(Hb + (size_t)(m0 + q) * DM) + 2 * lane;
            hw[q][0] = h16[0]; hw[q][1] = h16[1];
            r[q] = 8.0f * rsqrtf(stat_get(ss + m0 + q) * (1.0f / 1024.0f) + pg8::RMS_EPS); }
#pragma unroll
        for (int q = 0; q < 8; ++q) { v4u o;
#pragma unroll
            for (int i = 0; i < 2; ++i) { const v4u hv = hw[q][i];
                o[2 * i] = pg8::pk4_fp8(bflo(hv.x) * r[q], bfhi(hv.x) * r[q], bflo(hv.y) * r[q], bfhi(hv.y) * r[q]); o[2 * i + 1] = pg8::pk4_fp8(bflo(hv.z) * r[q], bfhi(hv.z) * r[q], bflo(hv.w) * r[q], bfhi(hv.w) * r[q]); }
            *((GAS v4u*)(HQ + (size_t)(m0 + q) * 1024) + lane) = o; }
    }
}
__device__ __forceinline__ void mixers_naive_phase(const Args& A, Frame& F, int l) {
    LAS float* wl = (LAS float*)(F.lds + RING_OFF + F.wave * 16384);
    if (l == 0) {
        const int gw = F.vcu * NWAVES + F.wave, NGW = F.G * NWAVES;
        for (int it = gw; it < DEPTH * 2048; it += NGW) w2_quant_item(A, F, it >> 11, it & 2047, wl);
        for (int it = gw; it < DEPTH * 2048; it += NGW) w1_quant_item(A, F, it >> 11, it & 2047, wl);
        __syncthreads();
    }
    {
        const int x0 = (int)(xb_xcc_id() & 7u);
        int xq = x0;
        gu32* qbase = F.ctl + CW_Q + 64 * (4 + 8 * l);
        for (;;) {
            unsigned slot_a = (unsigned)(size_t)(F.MISC + 16); asm volatile("" : "+s"(slot_a));
            volatile LAS unsigned* slot = (volatile LAS unsigned*)(size_t)slot_a;
            if (F.wave == 0 && lane_id() == 0) {
                unsigned v = __hip_atomic_fetch_add(qbase + 64 * xq, 1u, RLX_AGENT); int nq = xq;
                if (v >= 68u) {
                    unsigned hd[7];
#pragma unroll
                    for (int q = 0; q < 7; ++q) hd[q] = __hip_atomic_load(qbase + 64 * ((x0 + 1 + q) & 7), RLX_AGENT);
                    nq = -1;
#pragma unroll
                    for (int q = 6; q >= 0; --q) if (hd[q] < 68u) nq = (x0 + 1 + q) & 7;
                }
                slot[0] = v; slot[1] = (unsigned)nq; }
            __syncthreads();
            const int idx = (int)slot[0], nq = (int)slot[1];
            __syncthreads();
            if (idx >= 4 + 64) { if (nq < 0) break; xq = nq; continue; }
            if (idx < 4) { s5_scan_task(A, F, l, 4 * xq + idx); continue; }
            { const int i2 = idx - 4; dsa_unit(A, F, l, 2 * xq + (i2 & 1), 31 - (i2 >> 1)); }
        }
    }
    gu32* head = F.ctl + CW_Q + 64 * l;
    constexpr int N_S5 = 32, N_SB = BATCH * 4 * 64, N_META_Q = 2 * NMETA, TOTAL = N_S5 + N_SB + N_META_Q;
    for (;;) {
        int idx = 0;
        if (lane_id() == 0) idx = (int)__hip_atomic_fetch_add(head, 1u, RLX_AGENT);
        idx = __builtin_amdgcn_readfirstlane(idx);
        if (idx >= TOTAL) break;
        if (idx < N_S5) { s5_naive_item(A, F, l, 0, idx); continue; }
        idx -= N_S5;
        if (idx < N_META_Q) { if (idx < NMETA) dsa_naive_item(A, F, l, MREAL + idx, wl); else sb_naive_item(A, F, l, MREAL + (idx - NMETA), wl); continue; }
        idx -= N_META_Q;
        sb_mfma_unit(A, F, l, (idx & ~63) | (63 - (idx & 63)), (LAS unsigned char*)wl);
    }
}

__device__ __forceinline__ void final_phase(const Args& A, Frame& F) {
    const int lane = lane_id();
    const int gw = F.vcu * NWAVES + F.wave, NGW = F.G * NWAVES;
    const bf16* Hb = (const bf16*)(F.ws + WS_HB); const stat_t* ss = stat_ptr(F, DEPTH, ST_SS1); const float* fg = A.in[24];
    for (int m0 = gw * 8; m0 < MREAL; m0 += NGW * 8) {
        v4u hw[8][2]; float r[8];
#pragma unroll
        for (int q = 0; q < 8; ++q) { const GAS v4u* h16 = (const GAS v4u*)(Hb + (size_t)(m0 + q) * DM) + lane;
            hw[q][0] = h16[0]; hw[q][1] = h16[64];
            r[q] = rsqrtf(stat_get(ss + m0 + q) * (1.0f / 1024.0f) + pg8::RMS_EPS); }
#pragma unroll
        for (int q = 0; q < 8; ++q) { GAS f32x4* o = (GAS f32x4*)(F.out + (size_t)(m0 + q) * DM) + 2 * lane;
#pragma unroll
            for (int jh = 0; jh < 2; ++jh) { const v4u hv = hw[q][jh]; const f32x4 g0 = *((const GAS f32x4*)fg + 2 * lane + 128 * jh), g1 = *((const GAS f32x4*)fg + 2 * lane + 128 * jh + 1);
                o[128 * jh] = (f32x4){bflo(hv.x) * r[q] * g0.x, bfhi(hv.x) * r[q] * g0.y, bflo(hv.y) * r[q] * g0.z, bfhi(hv.y) * r[q] * g0.w};
                o[128 * jh + 1] = (f32x4){bflo(hv.z) * r[q] * g1.x, bfhi(hv.z) * r[q] * g1.y, bflo(hv.w) * r[q] * g1.z, bfhi(hv.w) * r[q] * g1.w}; } }
    }
}


struct MetaArgs { const bf16* A; const bf16* Bt; int N, K; bf16* O; bf16* H; const bf16* Y; const stat_t* ss; stat_t* so; const stat_t* ssb; const stat_t* ssa; const stat_t* ssc; const unsigned* wmax; };
template <int KIND> __device__ __forceinline__ void meta_gemm(Frame& F, const MetaArgs& a, LAS float* red  ) {
    const int lane = lane_id(), w = F.wave, m16 = lane & 15, kg = lane >> 4;
    const int kw = a.K / 8;
    for (int cb = F.vcu; cb < a.N / 16; cb += F.G) {
        f32x4_t acc = (f32x4_t){0.f, 0.f, 0.f, 0.f};
        const bf16* ap = a.A + (size_t)(MREAL + m16) * a.K + w * kw + 8 * kg;
        const bf16* bp = a.Bt + (size_t)(cb * 16 + m16) * a.K + w * kw + 8 * kg;
        constexpr int KW = (KIND == 1 ? 512 : (KIND == 4 ? 4096 : 1024)) / 8, NS = KW / 32, GS = NS < 8 ? NS : 8;
        if constexpr (KIND == 3) {
            const unsigned char* ap8 = (const unsigned char*)a.A + (size_t)(MREAL + m16) * 1024 + w * 128 + 8 * kg;
            const unsigned char* bp8 = (const unsigned char*)a.Bt + (size_t)(cb * 16 + m16) * 1024 + w * 128 + 8 * kg;
            long fa[4], fb[4];
#pragma unroll
            for (int s = 0; s < 4; ++s) { fa[s] = *(const GAS long*)(ap8 + 32 * s); fb[s] = *(const GAS long*)(bp8 + 32 * s); }
#pragma unroll
            for (int s = 0; s < 4; ++s) acc = __builtin_amdgcn_mfma_f32_16x16x32_fp8_fp8(fa[s], fb[s], acc, 0, 0, 0);
        } else if constexpr (KIND == 4) {
            const unsigned char* ap8 = (const unsigned char*)a.A + (size_t)(MREAL + m16) * 4096 + w * 512 + 8 * kg;
            const unsigned char* bp8 = (const unsigned char*)a.Bt + (size_t)(cb * 16 + m16) * 4096 + w * 512 + 8 * kg;
#pragma unroll
            for (int s0 = 0; s0 < 16; s0 += 8) { long fa[8], fb[8];
#pragma unroll
                for (int s = 0; s < 8; ++s) { fa[s] = *(const GAS long*)(ap8 + 32 * (s0 + s)); fb[s] = *(const GAS long*)(bp8 + 32 * (s0 + s)); }
#pragma unroll
                for (int s = 0; s < 8; ++s) acc = __builtin_amdgcn_mfma_f32_16x16x32_fp8_fp8(fa[s], fb[s], acc, 0, 0, 0); }
        } else {
#pragma unroll
        for (int s0 = 0; s0 < NS; s0 += GS) { bf16x8_t fa[GS], fb[GS];
#pragma unroll
            for (int s = 0; s < GS; ++s) { fa[s] = *(const GAS bf16x8_t*)(ap + 32 * (s0 + s)); fb[s] = *(const GAS bf16x8_t*)(bp + 32 * (s0 + s)); }
#pragma unroll
            for (int s = 0; s < GS; ++s) acc = __builtin_amdgcn_mfma_f32_16x16x32_bf16(fa[s], fb[s], acc, 0, 0, 0); }
        }
        *(LAS f32x4_t*)(red + (w * 64 + lane) * 4) = acc;
        __syncthreads();
        if (w == 0) {
            const int col = cb * 16 + m16;
#pragma unroll
            for (int r = 0; r < 4; ++r) { const int row = MREAL + 4 * kg + r; float v = 0.f;
                if (KIND == 2) {
                    const float rb = rsqrtf(stat_get(a.ssb + row) * (1.0f / 512.0f) + pg8::RMS_EPS), ra = rsqrtf(stat_get(a.ssa + row) * (1.0f / 256.0f) + pg8::RMS_EPS), rc = rsqrtf(stat_get(a.ssc + row) * (1.0f / 256.0f) + pg8::RMS_EPS);
#pragma unroll
                    for (int ww = 0; ww < 8; ++ww) v += red[(ww * 64 + lane) * 4 + r] * (ww < 4 ? rb : (ww < 6 ? ra : rc));
                } else {
#pragma unroll
                    for (int ww = 0; ww < 8; ++ww) v += red[(ww * 64 + lane) * 4 + r];
                }
                float sq = 0.f; stat_t* sp = nullptr;
                if (KIND == 0) { v *= rsqrtf(stat_get(a.ss + row) * (1.0f / 1024.0f) + pg8::RMS_EPS); const unsigned wv = f2bf(v); a.O[(size_t)row * NIN + col] = (bf16)wv;
                    if (col >= PC_CKV && col < PC_IK) { const float x = __uint_as_float(wv << 16); sq = x * x; sp = a.so; } }
                else if (KIND == 1) { const float y = bf2f(a.Y[(size_t)row * 512 + col]); const unsigned wv = f2bf(y / (1.0f + __expf(-v))); a.O[(size_t)row * 1024 + col] = (bf16)wv; const float x = __uint_as_float(wv << 16); sq = x * x; sp = a.so; }
                else if (KIND == 2 || KIND == 4) { if (KIND == 4) v *= fmaxf(__uint_as_float(a.wmax[col]), 1e-30f) * (1.0f / (448.0f * pg8::HID_SCALE));
                    const unsigned wv = f2bf(bf2f(a.H[(size_t)row * 1024 + col]) + v); a.H[(size_t)row * 1024 + col] = (bf16)wv; const float x = __uint_as_float(wv << 16); sq = x * x; sp = a.so; }
                else { v *= fmaxf(__uint_as_float(a.wmax[col]), 1e-30f) * (1.0f / (448.0f * 8.0f)); v = fmaxf(v, 0.f); ((unsigned char*)a.O)[(size_t)row * DFF + col] = (unsigned char)(pg8::pk4_fp8(v * v * pg8::HID_SCALE, 0.f, 0.f, 0.f) & 0xffu); }
                if (KIND != 3) { sq += __shfl_xor(sq, 1); sq += __shfl_xor(sq, 2); sq += __shfl_xor(sq, 4); sq += __shfl_xor(sq, 8);
                    if (m16 == 0 && sp != nullptr) pg8::stat_add(sp + row, sq); }
            }
        }
        __syncthreads();
    }
}

#define IN(k) (lo <= (k) && (k) < hi)
#define SEAM(k) do { if (IN(k) && IN((k) + 1)) xcd_barrier(bar, F.wave); } while (0)
__device__ __forceinline__ unsigned char* opaque_ptr(unsigned char* p) { asm volatile("" : "+s"(p)); return p; }
__device__ __forceinline__ stat_t* stat_at(unsigned char* ws, int l, int id) { return (stat_t*)(ws + WS_STATS) + (size_t)(l * ST_PER_LAYER + id) * STAT_STRIDE; }
__device__ __forceinline__ bf16* w_at(unsigned char* ws, int l, size_t off) { return (bf16*)(ws + WS_W + (size_t)l * W_LAYER + off); }
template <int l> __device__ __forceinline__ void layer_phases(const Args& args, Frame& F, const XcdBarrier& bar, int lo, int hi) {
    const int pb = 8 * l;
    if (IN(pb + 1)) {
        unsigned char* ws = opaque_ptr(args.ws);
        { MetaArgs ma{(bf16*)(ws + WS_HB), w_at(ws, l, WO_IN), NIN, DM, (bf16*)(ws + WS_P), nullptr, nullptr, stat_at(ws, l, ST_SS1), stat_at(ws, l, ST_SSKV), nullptr, nullptr, nullptr, nullptr}; meta_gemm<0>(F, ma, (LAS float*)(F.lds + RING_OFF)); }
        pg8::Gemm g{(bf16*)(ws + WS_HB), w_at(ws, l, WO_IN), MREAL, NIN, DM}; pg8::StaticOrder S; S.init(MREAL, NIN, F.G, (int)blockIdx.x);
        pg8::EpiIn E{(bf16*)(ws + WS_P), stat_at(ws, l, ST_SS1), stat_at(ws, l, ST_SSKV), (bf16*)(ws + WS_U)};
        pg8::gemm_phase<pg8::EpiIn, pg8::StaticOrder, true, true>(F.lds + RING_OFF, g, S, E, F.wave);
    } SEAM(pb + 1);
    if (IN(pb + 2)) { mixers_naive_phase(args, F, l); } SEAM(pb + 2);
    if (IN(pb + 3)) {
        unsigned char* ws = opaque_ptr(args.ws);
        pg8::Gemm g{(bf16*)(ws + WS_U), (bf16*)(ws + WS_TZ + (size_t)l * TZ_LAYER), 32 * S5RG, 32 * 512, S5KU}; S5Order S{F.G, (int)blockIdx.x};
        pg8::EpiS5 E{(bf16*)(ws + WS_P), (bf16*)(ws + WS_YG), args.in[15] + l * 512};
        pg8::gemm_phase<pg8::EpiS5, S5Order, true, true>(F.lds + RING_OFF, g, S, E, F.wave);
    } SEAM(pb + 3);
    if (IN(pb + 4)) {
        unsigned char* ws = opaque_ptr(args.ws);
        { MetaArgs ma{(bf16*)(ws + WS_YG), w_at(ws, l, WO_GLU), 512, 512, (bf16*)(ws + WS_YCAT), nullptr, (bf16*)(ws + WS_YG), nullptr, stat_at(ws, l, ST_SSB), nullptr, nullptr, nullptr, nullptr}; meta_gemm<1>(F, ma, (LAS float*)(F.lds + RING_OFF)); }
        pg8::Gemm g{(bf16*)(ws + WS_YG), w_at(ws, l, WO_GLU), MREAL, 512, 512}; pg8::StaticOrder S; S.init(MREAL, 512, F.G, (int)blockIdx.x);
        pg8::EpiGlu E{(bf16*)(ws + WS_YG), (bf16*)(ws + WS_YCAT), stat_at(ws, l, ST_SSB)};
        pg8::gemm_phase<pg8::EpiGlu, pg8::StaticOrder, true, true>(F.lds + RING_OFF, g, S, E, F.wave);
    } SEAM(pb + 4);
    if (IN(pb + 5)) {
        unsigned char* ws = opaque_ptr(args.ws);
        { MetaArgs ma{(bf16*)(ws + WS_YCAT), w_at(ws, l, WO_OUT), DM, DM, nullptr, (bf16*)(ws + WS_HB), nullptr, nullptr, stat_at(ws, l, ST_SS2), stat_at(ws, l, ST_SSB), stat_at(ws, l, ST_SSA), stat_at(ws, l, ST_SSC), nullptr}; meta_gemm<2>(F, ma, (LAS float*)(F.lds + RING_OFF)); }
        pg8::Gemm g{(bf16*)(ws + WS_YCAT), w_at(ws, l, WO_OUT), MREAL, DM, DM}; pg8::StaticOrder S; S.init(MREAL, DM, F.G, (int)blockIdx.x);
        pg8::EpiRes<true> E{(bf16*)(ws + WS_HB), stat_at(ws, l, ST_SS2), stat_at(ws, l, ST_SSB), stat_at(ws, l, ST_SSA), stat_at(ws, l, ST_SSC)};
        pg8::gemm_phase<pg8::EpiRes<true>, pg8::StaticOrder, true, true>(F.lds + RING_OFF, g, S, E, F.wave);
    } SEAM(pb + 5);
    if (IN(pb + 6)) { hq_phase(F, stat_at(opaque_ptr(args.ws), l, ST_SS2)); } SEAM(pb + 6);
    if (IN(pb + 7)) {
        unsigned char* ws = opaque_ptr(args.ws);
        { MetaArgs ma{(bf16*)(ws + WS_HQ), w_at(ws, l, WO_1), DFF, DM, (bf16*)(ws + WS_BIG), nullptr, nullptr, nullptr, nullptr, nullptr, nullptr, nullptr, (const unsigned*)(ws + WS_CTL) + CW_WMAX1 + l * 4096}; meta_gemm<3>(F, ma, (LAS float*)(F.lds + RING_OFF)); }
        pg8::Gemm g{(bf16*)(ws + WS_HQ), w_at(ws, l, WO_1), MREAL, DFF, DM / 2}; pg8::StaticOrder S; S.init(MREAL, DFF, F.G, (int)blockIdx.x);
        pg8::EpiMlp1F8B E{(unsigned char*)(ws + WS_BIG), (const unsigned*)(ws + WS_CTL) + CW_WMAX1 + l * 4096};
        pg8::gemm_phase<pg8::EpiMlp1F8B, pg8::StaticOrder, true, true, true>(F.lds + RING_OFF, g, S, E, F.wave);
    } SEAM(pb + 7);
    if (IN(pb + 8)) {
        unsigned char* ws = opaque_ptr(args.ws);
        { MetaArgs ma{(bf16*)(ws + WS_BIG), w_at(ws, l, WO_2), DM, DFF, nullptr, (bf16*)(ws + WS_HB), nullptr, nullptr, stat_at(ws, l + 1, ST_SS1), nullptr, nullptr, nullptr, (const unsigned*)(ws + WS_CTL) + CW_WMAX + l * 1024}; meta_gemm<4>(F, ma, (LAS float*)(F.lds + RING_OFF)); }
        pg8::Gemm g{(bf16*)(ws + WS_BIG), w_at(ws, l, WO_2), MREAL, DM, DFF / 2}; pg8::StaticOrder S; S.init(MREAL, DM, F.G, (int)blockIdx.x);
        pg8::EpiRes8 E{(bf16*)(ws + WS_HB), stat_at(ws, l + 1, ST_SS1), (const unsigned*)(ws + WS_CTL) + CW_WMAX + l * 1024};
        pg8::gemm_phase<pg8::EpiRes8, pg8::StaticOrder, true, true, true>(F.lds + RING_OFF, g, S, E, F.wave);
    } SEAM(pb + 8);
}
#undef IN
#undef SEAM
constexpr int N_PHASES = 18;
#if defined(__HIP_DEVICE_COMPILE__)
#define MK_NO_PK_F32 __attribute__((target("no-packed-fp32-ops")))
#else
#define MK_NO_PK_F32
#endif
__global__ void __launch_bounds__(NWAVES * 64, 2) MK_NO_PK_F32 hymba_fwd(Args args) {
    extern __shared__ __attribute__((aligned(16))) unsigned char lds[];
    Frame F;
    F.lds = (LAS unsigned char*)lds;
    F.MISC = (volatile LAS unsigned*)(F.lds + MISC_OFF);
    F.wave = __builtin_amdgcn_readfirstlane((int)threadIdx.x >> 6);
    F.G = gridDim.x; { const int bx = blockIdx.x; F.vcu = (F.G % 8 == 0) ? (bx % 8) * (F.G / 8) + bx / 8 : bx; }
    F.out = args.out; F.ws = args.ws;
    F.ctl = (gu32*)(args.ws + WS_CTL);
    for (int u = threadIdx.x; u < (LDS_BYTES - LDSCTL_OFF) / 4; u += NWAVES * 64) ((LAS unsigned*)(F.lds + LDSCTL_OFF))[u] = 0u;
    __syncthreads();
    const int lo = args.ph_lo, hi = args.ph_hi;
    const bool multi = (hi - lo) > 1;
    XcdBarrier bar; bar.bar = (unsigned*)(F.ctl + CW_BAR); bar.x = 0; bar.st = F.MISC + 8;
    if (multi) bar = xcd_barrier_post((unsigned*)(F.ctl + CW_BAR), F.MISC + 8, F.wave);
#define IN(k) (lo <= (k) && (k) < hi)
#define SEAM(k) do { if (IN(k) && IN((k) + 1)) xcd_barrier(bar, F.wave); } while (0)
    if (IN(0)) { p0_prologue(args, F); } SEAM(0);
    layer_phases<0>(args, F, bar, lo, hi);
    layer_phases<1>(args, F, bar, lo, hi);
    if (IN(17)) { final_phase(args, F); }
#undef IN
#undef SEAM
}

#ifndef MK_ONE_LAUNCH
#define MK_ONE_LAUNCH 1
#endif
extern "C" void kernel_launch(void* const* d_in, const int* in_sizes, int n_in, void* d_out, int out_size, void* d_ws, size_t ws_size, hipStream_t stream) {
    static int grid = 0;
    if (grid == 0) {
        if (n_in != 25 || in_sizes[0] != MREAL * DM || out_size != MREAL * DM || ws_size < WS_END2) {
            fprintf(stderr, "kernel_launch: unexpected problem: n_in %d, in0 %d, out %d, ws %zu (need %zu); nothing launched\n", n_in, n_in > 0 ? in_sizes[0] : -1, out_size, ws_size, (size_t)WS_END2); grid = -1; return; }
        int dev = 0, cus = 0, per_cu = 0;
        if (hipGetDevice(&dev) != hipSuccess || hipDeviceGetAttribute(&cus, hipDeviceAttributeMultiprocessorCount, dev) != hipSuccess) { grid = -1; return; }
        if (hipFuncSetAttribute((const void*)hymba_fwd, hipFuncAttributeMaxDynamicSharedMemorySize, LDS_BYTES) != hipSuccess) { fprintf(stderr, "kernel_launch: hipFuncSetAttribute failed\n"); grid = -1; return; }
        if (hipOccupancyMaxActiveBlocksPerMultiprocessor(&per_cu, (const void*)hymba_fwd, NWAVES * 64, LDS_BYTES) != hipSuccess || per_cu < 1)
            fprintf(stderr, "kernel_launch: note: occupancy query reports %d workgroups per CU\n", per_cu);
        (void)hipGetLastError();
        grid = cus;
    }
    if (grid < 0) return;
    if (hipMemsetAsync((char*)d_ws + WS_CTL, 0, CTL_ZERO_BYTES, stream) != hipSuccess) { fprintf(stderr, "kernel_launch: memset failed\n"); return; }
    Args a{};
    for (int i = 0; i < 25; ++i) a.in[i] = (const float*)d_in[i];
    a.out = (float*)d_out; a.ws = (unsigned char*)d_ws;
#if MK_ONE_LAUNCH
    a.ph_lo = 0; a.ph_hi = N_PHASES;
    hipLaunchKernelGGL(hymba_fwd, dim3(grid), dim3(NWAVES * 64), LDS_BYTES, stream, a);
#else
    for (int p = 0; p < N_PHASES; ++p) { a.ph_lo = p; a.ph_hi = p + 1;
        hipLaunchKernelGGL(hymba_fwd, dim3(grid), dim3(NWAVES * 64), LDS_BYTES, stream, a); }
#endif
    const hipError_t le = hipPeekAtLastError();
    if (le != hipSuccess) fprintf(stderr, "kernel_launch: launch failed: %s\n", hipGetErrorName(le));
}
```

```cpp
#include <hip/hip_runtime.h>
#include <cstdio>
#include <cstdint>
namespace pg8 {
#define PG8_LAS __attribute__((address_space(3)))
typedef unsigned short bf16_t;
typedef short bf16x8 __attribute__((ext_vector_type(8)));
typedef float f32x4 __attribute__((ext_vector_type(4)));
typedef unsigned u32x4 __attribute__((ext_vector_type(4)));
constexpr int BM = 256, BK = 64, HALF = 128, HTB = HALF * BK * 2  , STAGE_BYTES = 8 * HTB, NXCD = 8, WGM = 8;

__host__ __device__ __forceinline__ int lds_byte(int r, int c) { const int st = (r >> 4) * 2 + (c >> 5), rr = r & 15, cc = c & 31, ob = rr * 64 + cc * 2; return st * 1024 + (ob ^ (((ob >> 9) & 1) << 5)); }
__host__ __device__ __forceinline__ void stage_rc(int b, int& R, int& C) { const int st = b / 1024, sb = b % 1024, swz = sb ^ (((sb >> 9) & 1) << 5); R = (st >> 1) * 16 + swz / 64; C = (st & 1) * 32 + (swz % 64) / 2; }
__host__ __device__ __forceinline__ int perm32(int rho) { const int n = rho >> 4, i = rho & 15; return 8 * (i >> 2) + 4 * n + (i & 3); }

struct Unit { int pm, pn; };
struct Gemm { const bf16_t* A; const bf16_t* Bt; int M, N, K; };

struct StaticOrder {
    int nM, nN, nwg, G, c;
    __host__ __device__ void init(int M, int N, int G_, int c_) { nM = M / BM; nN = N / BM; nwg = nM * nN; G = G_; c = c_; }
    __host__ __device__ bool next(int i, Unit& u) const {
        const long L = (long)i * G + c; if (L >= nwg) return false;
        int wgid = (int)L; { const int q = nwg / NXCD, r = nwg % NXCD, xcd = wgid % NXCD, off = wgid / NXCD; wgid = (xcd < r ? xcd * (q + 1) : r * (q + 1) + (xcd - r) * q) + off; }
        const int nig = WGM * nN, gid = wgid / nig, fm = gid * WGM, gsz = (nM - fm) < WGM ? (nM - fm) : WGM;
        u.pm = fm + ((wgid % nig) % gsz); u.pn = (wgid % nig) / gsz; return true;
    }
    __device__ __forceinline__ void a_ready(const Unit&) const {}
    __device__ __forceinline__ void done(const Unit&) const {}
};

__device__ __forceinline__ unsigned cvt_pk_bf16(float lo, float hi) { unsigned r; asm volatile("v_cvt_pk_bf16_f32 %0, %1, %2" : "=v"(r) : "v"(lo), "v"(hi)); return r; }
typedef float f32x2 __attribute__((ext_vector_type(2)));
#define PG8_GAS __attribute__((address_space(1)))
constexpr float RMS_EPS = 1e-6f;
__device__ __forceinline__ float bf_lo(unsigned w) { return __uint_as_float(w << 16); }
__device__ __forceinline__ float bf_hi(unsigned w) { return __uint_as_float(w & 0xffff0000u); }
typedef unsigned long long stat_t;
__device__ __forceinline__ void stat_add(stat_t* p, float q) { atomicAdd(p, (stat_t)((double)q * 4294967296.0)); }
__device__ __forceinline__ float stat_get(const stat_t* p) { const stat_t v = *p; return (float)(unsigned)(v >> 32) + (float)(unsigned)v * 2.3283064365386963e-10f; }
__device__ __forceinline__ float stat_val(stat_t s) { return (float)((double)s * (1.0 / 4294967296.0)); }
__device__ __forceinline__ float quad_sum(float q) { q += __shfl_xor(q, 16); q += __shfl_xor(q, 32); return q; }

struct EpiIn {
    static constexpr bool PERM = true, AFTER_DRAIN = false; static constexpr int MIDT = 0, MIDT2 = 0;
    bf16_t* O; const stat_t* ss; stat_t* sskv; bf16_t* U;
    __device__ __forceinline__ void operator()(const f32x4 (&acc)[2][2][4][2], const Unit& u, int wr, int wc, int fr, int fq) const {
        const int row0 = u.pm * BM + wr * 64 + fr, col0 = u.pn * BM + wc * 32 + 8 * fq;
        stat_t sv[2][4];
#pragma unroll
        for (int ai = 0; ai < 2; ++ai)
#pragma unroll
            for (int m = 0; m < 4; ++m) sv[ai][m] = *(const PG8_GAS stat_t*)(ss + row0 + ai * HALF + m * 16);
#pragma unroll
        for (int ai = 0; ai < 2; ++ai)
#pragma unroll
            for (int m = 0; m < 4; ++m) { const int row = row0 + ai * HALF + m * 16; const float r = rsqrtf(stat_val(sv[ai][m]) * (1.0f / 1024.0f) + RMS_EPS);
                bf16_t* rowp = O + (size_t)row * 2048 + col0;
#pragma unroll
                for (int bj = 0; bj < 2; ++bj) { const f32x4 v0 = acc[ai][bj][m][0] * r, v1 = acc[ai][bj][m][1] * r;
                    u32x4 w; w.x = cvt_pk_bf16(v0[0], v0[1]); w.y = cvt_pk_bf16(v0[2], v0[3]); w.z = cvt_pk_bf16(v1[0], v1[1]); w.w = cvt_pk_bf16(v1[2], v1[3]);
                    if (u.pn == 3 || u.pn == 4) {
                        const int gc = col0 + bj * HALF - 768, gg = gc >> 4, t = row & 2047;
                        *(PG8_GAS u32x4*)(U + ((size_t)gg * 1024 + (row >> 11) * 64 + (t >> 5)) * 640 + (t & 31) * 16 + (gc & 15)) = w; }
                    else *(PG8_GAS u32x4*)(rowp + bj * HALF) = w;
                    if (bj == 0 && u.pn == 1) { float q = (bf_lo(w.x) * bf_lo(w.x) + bf_hi(w.x) * bf_hi(w.x)) + (bf_lo(w.y) * bf_lo(w.y) + bf_hi(w.y) * bf_hi(w.y))
                                                      + (bf_lo(w.z) * bf_lo(w.z) + bf_hi(w.z) * bf_hi(w.z)) + (bf_lo(w.w) * bf_lo(w.w) + bf_hi(w.w) * bf_hi(w.w));
                        q = quad_sum(q); if (fq == 0) stat_add(sskv + row, q); } } }
    }
};
struct EpiGlu {
    static constexpr bool PERM = true, AFTER_DRAIN = false; static constexpr int MIDT = 0, MIDT2 = 0;
    const bf16_t* Y; bf16_t* O; stat_t* ssb;
    __device__ __forceinline__ void operator()(const f32x4 (&acc)[2][2][4][2], const Unit& u, int wr, int wc, int fr, int fq) const {
        const int row0 = u.pm * BM + wr * 64 + fr, col0 = u.pn * BM + wc * 32 + 8 * fq;
#pragma unroll
        for (int ai = 0; ai < 2; ++ai) {
            u32x4 yl[4][2];
#pragma unroll
            for (int m = 0; m < 4; ++m) { const int row = row0 + ai * HALF + m * 16; const PG8_GAS u32x4* rp = (const PG8_GAS u32x4*)(Y + (size_t)row * 512 + col0); yl[m][0] = rp[0]; yl[m][1] = rp[HALF / 8]; }
#pragma unroll
            for (int m = 0; m < 4; ++m) { const int row = row0 + ai * HALF + m * 16; float q = 0.f;
#pragma unroll
                for (int bj = 0; bj < 2; ++bj) { const u32x4 y8 = yl[m][bj];
                    const f32x4 g0 = acc[ai][bj][m][0], g1 = acc[ai][bj][m][1];
                    float o[8]; const float yv[8] = {bf_lo(y8.x), bf_hi(y8.x), bf_lo(y8.y), bf_hi(y8.y), bf_lo(y8.z), bf_hi(y8.z), bf_lo(y8.w), bf_hi(y8.w)};
                    const float gv[8] = {g0[0], g0[1], g0[2], g0[3], g1[0], g1[1], g1[2], g1[3]};
#pragma unroll
                    for (int j = 0; j < 8; ++j) o[j] = yv[j] * __builtin_amdgcn_rcpf(1.0f + __expf(-gv[j]));
                    u32x4 w; w.x = cvt_pk_bf16(o[0], o[1]); w.y = cvt_pk_bf16(o[2], o[3]); w.z = cvt_pk_bf16(o[4], o[5]); w.w = cvt_pk_bf16(o[6], o[7]);
                    *(PG8_GAS u32x4*)(O + (size_t)row * 1024 + col0 + bj * HALF) = w;
                    q += (bf_lo(w.x) * bf_lo(w.x) + bf_hi(w.x) * bf_hi(w.x)) + (bf_lo(w.y) * bf_lo(w.y) + bf_hi(w.y) * bf_hi(w.y))
                       + (bf_lo(w.z) * bf_lo(w.z) + bf_hi(w.z) * bf_hi(w.z)) + (bf_lo(w.w) * bf_lo(w.w) + bf_hi(w.w) * bf_hi(w.w)); }
                q = quad_sum(q); if (fq == 0) stat_add(ssb + row, q); } }
    }
};
template <bool OUT> struct EpiRes {
    static constexpr bool PERM = true, AFTER_DRAIN = false; static constexpr int MIDT = OUT ? 8 : 0, MIDT2 = OUT ? 12 : 0;
    bf16_t* H; stat_t* ssn; const stat_t* ssb; const stat_t* ssa; const stat_t* ssc;
    __device__ __forceinline__ void mid(f32x4 (&acc)[2][2][4][2], const Unit& u, int wr, int fr, int t) const {
        const stat_t* sn = (t == MIDT) ? ssb : ssa; const stat_t* sd = (t == MIDT) ? ssa : ssc;
        const float wn = (t == MIDT) ? (1.0f / 512.0f) : (1.0f / 256.0f);
        stat_t vn[2][4], vd[2][4];
#pragma unroll
        for (int ai = 0; ai < 2; ++ai)
#pragma unroll
            for (int m = 0; m < 4; ++m) { const int row = u.pm * BM + ai * HALF + wr * 64 + m * 16 + fr; vn[ai][m] = *(const PG8_GAS stat_t*)(sn + row); vd[ai][m] = *(const PG8_GAS stat_t*)(sd + row); }
#pragma unroll
        for (int ai = 0; ai < 2; ++ai)
#pragma unroll
            for (int m = 0; m < 4; ++m) {
                const float xn = stat_val(vn[ai][m]) * wn + RMS_EPS, xd = stat_val(vd[ai][m]) * (1.0f / 256.0f) + RMS_EPS;
                const float f = __builtin_amdgcn_sqrtf(xd * __builtin_amdgcn_rcpf(xn));
#pragma unroll
                for (int bj = 0; bj < 2; ++bj)
#pragma unroll
                    for (int n = 0; n < 2; ++n) acc[ai][bj][m][n] *= f; }
    }
    __device__ __forceinline__ void operator()(const f32x4 (&acc)[2][2][4][2], const Unit& u, int wr, int wc, int fr, int fq) const {
        const int row0 = u.pm * BM + wr * 64 + fr, col0 = u.pn * BM + wc * 32 + 8 * fq;
#pragma unroll
        for (int ai = 0; ai < 2; ++ai) {
            u32x4 h8[4][2]; stat_t sc[4];
#pragma unroll
            for (int m = 0; m < 4; ++m) { const int row = row0 + ai * HALF + m * 16; const PG8_GAS u32x4* rp = (const PG8_GAS u32x4*)(H + (size_t)row * 1024 + col0);
                h8[m][0] = rp[0]; h8[m][1] = rp[HALF / 8]; if (OUT) sc[m] = *(const PG8_GAS stat_t*)(ssc + row); }
#pragma unroll
            for (int m = 0; m < 4; ++m) { const int row = row0 + ai * HALF + m * 16; float q = 0.f; PG8_GAS u32x4* wp = (PG8_GAS u32x4*)(H + (size_t)row * 1024 + col0);
                float post = 1.0f; if (OUT) post = rsqrtf(stat_val(sc[m]) * (1.0f / 256.0f) + RMS_EPS);
#pragma unroll
                for (int bj = 0; bj < 2; ++bj) { const u32x4 hv = h8[m][bj];
                    const f32x4 a0 = acc[ai][bj][m][0] * post, a1 = acc[ai][bj][m][1] * post;
                    u32x4 w; w.x = cvt_pk_bf16(bf_lo(hv.x) + a0[0], bf_hi(hv.x) + a0[1]); w.y = cvt_pk_bf16(bf_lo(hv.y) + a0[2], bf_hi(hv.y) + a0[3]);
                    w.z = cvt_pk_bf16(bf_lo(hv.z) + a1[0], bf_hi(hv.z) + a1[1]); w.w = cvt_pk_bf16(bf_lo(hv.w) + a1[2], bf_hi(hv.w) + a1[3]);
                    wp[bj * (HALF / 8)] = w;
                    q += (bf_lo(w.x) * bf_lo(w.x) + bf_hi(w.x) * bf_hi(w.x)) + (bf_lo(w.y) * bf_lo(w.y) + bf_hi(w.y) * bf_hi(w.y))
                       + (bf_lo(w.z) * bf_lo(w.z) + bf_hi(w.z) * bf_hi(w.z)) + (bf_lo(w.w) * bf_lo(w.w) + bf_hi(w.w) * bf_hi(w.w)); }
                q = quad_sum(q); if (fq == 0) stat_add(ssn + row, q); } }
    }
};
struct EpiMlp1 {
    static constexpr bool PERM = true, AFTER_DRAIN = false; static constexpr int MIDT = 0, MIDT2 = 0;
    bf16_t* O; const stat_t* ss;
    __device__ __forceinline__ void operator()(const f32x4 (&acc)[2][2][4][2], const Unit& u, int wr, int wc, int fr, int fq) const {
        const int row0 = u.pm * BM + wr * 64 + fr, col0 = u.pn * BM + wc * 32 + 8 * fq;
#pragma unroll
        for (int ai = 0; ai < 2; ++ai)
#pragma unroll
            for (int m = 0; m < 4; ++m) { const int row = row0 + ai * HALF + m * 16; const float r = rsqrtf(stat_get(ss + row) * (1.0f / 1024.0f) + RMS_EPS);
                bf16_t* rowp = O + (size_t)row * 4096 + col0;
#pragma unroll
                for (int bj = 0; bj < 2; ++bj) { f32x4 v0 = acc[ai][bj][m][0] * r, v1 = acc[ai][bj][m][1] * r;
#pragma unroll
                    for (int j = 0; j < 4; ++j) { const float a = fmaxf(v0[j], 0.f), b = fmaxf(v1[j], 0.f); v0[j] = a * a; v1[j] = b * b; }
                    u32x4 w; w.x = cvt_pk_bf16(v0[0], v0[1]); w.y = cvt_pk_bf16(v0[2], v0[3]); w.z = cvt_pk_bf16(v1[0], v1[1]); w.w = cvt_pk_bf16(v1[2], v1[3]);
                    *(u32x4*)(rowp + bj * HALF) = w; } }
    }
};
__device__ __forceinline__ float relu_i(float x) { const int i = (int)__builtin_bit_cast(unsigned, x); return __builtin_bit_cast(float, (unsigned)(i > 0 ? i : 0)); }
__device__ __forceinline__ unsigned pk4_fp8(float a, float b, float c, float d) {
    a = __builtin_amdgcn_fmed3f(a, -448.f, 448.f); b = __builtin_amdgcn_fmed3f(b, -448.f, 448.f); c = __builtin_amdgcn_fmed3f(c, -448.f, 448.f); d = __builtin_amdgcn_fmed3f(d, -448.f, 448.f);
    int w = 0; w = __builtin_amdgcn_cvt_pk_fp8_f32(a, b, w, false); w = __builtin_amdgcn_cvt_pk_fp8_f32(c, d, w, true); return (unsigned)w;
}
constexpr float HID_SCALE = 0.25f; static_assert(HID_SCALE == 0.25f, "EpiMlp1F8B folds sqrt(HID_SCALE) = 0.5 into its column scales");
struct EpiMlp1F8 {
    static constexpr bool PERM = true, AFTER_DRAIN = false; static constexpr int MIDT = 0, MIDT2 = 0;
    unsigned char* O; const stat_t* ss;
    __device__ __forceinline__ void operator()(const f32x4 (&acc)[2][2][4][2], const Unit& u, int wr, int wc, int fr, int fq) const {
        typedef unsigned u32x2v __attribute__((ext_vector_type(2)));
        const int row0 = u.pm * BM + wr * 64 + fr, col0 = u.pn * BM + wc * 32 + 8 * fq;
#pragma unroll
        for (int ai = 0; ai < 2; ++ai)
#pragma unroll
            for (int m = 0; m < 4; ++m) { const int row = row0 + ai * HALF + m * 16; const float r = rsqrtf(stat_get(ss + row) * (1.0f / 1024.0f) + RMS_EPS);
                unsigned char* rowp = O + (size_t)row * 4096 + col0;
#pragma unroll
                for (int bj = 0; bj < 2; ++bj) { f32x4 v0 = acc[ai][bj][m][0] * r, v1 = acc[ai][bj][m][1] * r;
#pragma unroll
                    for (int j = 0; j < 4; ++j) { const float a = fmaxf(v0[j], 0.f), b = fmaxf(v1[j], 0.f); v0[j] = a * a * HID_SCALE; v1[j] = b * b * HID_SCALE; }
                    u32x2v w; w.x = pk4_fp8(v0[0], v0[1], v0[2], v0[3]); w.y = pk4_fp8(v1[0], v1[1], v1[2], v1[3]);
                    *(u32x2v*)(rowp + bj * HALF) = w; } }
    }
};
struct EpiMlp1F8B {
    static constexpr bool PERM = true, AFTER_DRAIN = false; static constexpr int MIDT = 0, MIDT2 = 0;
    unsigned char* O; const unsigned* wmax;
    __device__ __forceinline__ void operator()(const f32x4 (&acc)[2][2][4][2], const Unit& u, int wr, int wc, int fr, int fq) const {
        const int row0 = u.pm * BM + wr * 64 + fr, col0 = u.pn * BM + wc * 32 + 8 * fq;
        f32x4 cs[2][2];
#pragma unroll
        for (int bj = 0; bj < 2; ++bj)
#pragma unroll
            for (int n = 0; n < 2; ++n) { const u32x4 wm = *(const PG8_GAS u32x4*)(wmax + col0 + bj * HALF + 4 * n);
                cs[bj][n] = (f32x4){fmaxf(__uint_as_float(wm.x), 1e-30f), fmaxf(__uint_as_float(wm.y), 1e-30f), fmaxf(__uint_as_float(wm.z), 1e-30f), fmaxf(__uint_as_float(wm.w), 1e-30f)} * (0.5f / (448.0f * 8.0f)); }
        const bool odd = (fq & 1) != 0;
#pragma unroll
        for (int ai = 0; ai < 2; ++ai)
#pragma unroll
            for (int mp = 0; mp < 4; mp += 2) {
#pragma unroll
                for (int bj = 0; bj < 2; ++bj) { unsigned wa[2][2];
#pragma unroll
                    for (int q = 0; q < 2; ++q) { f32x4 v0 = acc[ai][bj][mp + q][0] * cs[bj][0], v1 = acc[ai][bj][mp + q][1] * cs[bj][1];
#pragma unroll
                        for (int j = 0; j < 4; ++j) { const float a = relu_i(v0[j]), b = relu_i(v1[j]); v0[j] = a * a; v1[j] = b * b; }
                        wa[q][0] = pk4_fp8(v0[0], v0[1], v0[2], v0[3]); wa[q][1] = pk4_fp8(v1[0], v1[1], v1[2], v1[3]); }
                    const unsigned s0 = odd ? wa[0][0] : wa[1][0], s1 = odd ? wa[0][1] : wa[1][1];
                    const unsigned r0 = (unsigned)__shfl_xor((int)s0, 16), r1 = (unsigned)__shfl_xor((int)s1, 16);
                    u32x4 o; if (odd) { o.x = r0; o.y = r1; o.z = wa[1][0]; o.w = wa[1][1]; } else { o.x = wa[0][0]; o.y = wa[0][1]; o.z = r0; o.w = r1; }
                    const int row = row0 + ai * HALF + (mp + (odd ? 1 : 0)) * 16;
                    *(PG8_GAS u32x4*)(O + (size_t)row * 4096 + (col0 & ~15) + bj * HALF) = o; } }
    }
};
struct EpiRes8 {
    static constexpr bool PERM = true, AFTER_DRAIN = false; static constexpr int MIDT = 0, MIDT2 = 0;
    bf16_t* H; stat_t* ssn; const unsigned* wmax;
    __device__ __forceinline__ void operator()(const f32x4 (&acc)[2][2][4][2], const Unit& u, int wr, int wc, int fr, int fq) const {
        const int row0 = u.pm * BM + wr * 64 + fr, col0 = u.pn * BM + wc * 32 + 8 * fq;
        f32x4 cs[2][2];
#pragma unroll
        for (int bj = 0; bj < 2; ++bj)
#pragma unroll
            for (int n = 0; n < 2; ++n) { const u32x4 wm = *(const u32x4*)(wmax + col0 + bj * HALF + 4 * n);
                cs[bj][n] = (f32x4){fmaxf(__uint_as_float(wm.x), 1e-30f), fmaxf(__uint_as_float(wm.y), 1e-30f), fmaxf(__uint_as_float(wm.z), 1e-30f), fmaxf(__uint_as_float(wm.w), 1e-30f)} * (1.0f / (448.0f * HID_SCALE)); }
#pragma unroll
        for (int ai = 0; ai < 2; ++ai) {
            u32x4 h8[4][2];
#pragma unroll
            for (int m = 0; m < 4; ++m) { const int row = row0 + ai * HALF + m * 16; const PG8_GAS u32x4* rp = (const PG8_GAS u32x4*)(H + (size_t)row * 1024 + col0); h8[m][0] = rp[0]; h8[m][1] = rp[HALF / 8]; }
#pragma unroll
            for (int m = 0; m < 4; ++m) { const int row = row0 + ai * HALF + m * 16; float q = 0.f; PG8_GAS u32x4* wp = (PG8_GAS u32x4*)(H + (size_t)row * 1024 + col0);
#pragma unroll
                for (int bj = 0; bj < 2; ++bj) { const u32x4 hv = h8[m][bj];
                    const f32x4 a0 = acc[ai][bj][m][0] * cs[bj][0], a1 = acc[ai][bj][m][1] * cs[bj][1];
                    u32x4 w; w.x = cvt_pk_bf16(bf_lo(hv.x) + a0[0], bf_hi(hv.x) + a0[1]); w.y = cvt_pk_bf16(bf_lo(hv.y) + a0[2], bf_hi(hv.y) + a0[3]);
                    w.z = cvt_pk_bf16(bf_lo(hv.z) + a1[0], bf_hi(hv.z) + a1[1]); w.w = cvt_pk_bf16(bf_lo(hv.w) + a1[2], bf_hi(hv.w) + a1[3]);
                    wp[bj * (HALF / 8)] = w;
                    q += (bf_lo(w.x) * bf_lo(w.x) + bf_hi(w.x) * bf_hi(w.x)) + (bf_lo(w.y) * bf_lo(w.y) + bf_hi(w.y) * bf_hi(w.y))
                       + (bf_lo(w.z) * bf_lo(w.z) + bf_hi(w.z) * bf_hi(w.z)) + (bf_lo(w.w) * bf_lo(w.w) + bf_hi(w.w) * bf_hi(w.w)); }
                q = quad_sum(q); if (fq == 0) stat_add(ssn + row, q); } }
    }
};
typedef int v8i_t __attribute__((ext_vector_type(8))); typedef int v4i_t __attribute__((ext_vector_type(4)));
template <class Epi, class Sched, bool ALIGN_EPI = false, bool SP2 = false, bool F8 = false>
__device__ __forceinline__ void gemm_phase(PG8_LAS unsigned char* lds, const Gemm g, const Sched& S, const Epi& E, const int wid_in) {
    int lane_; asm volatile("v_mbcnt_lo_u32_b32 %0, -1, 0\n\tv_mbcnt_hi_u32_b32 %0, -1, %0" : "=v"(lane_)); const int tid_ = wid_in * 64 + lane_;
    const int tid = tid_, wid = wid_in, lane = lane_, wr = wid >> 2, wc = wid & 3, fr = lane & 15, fq = lane >> 4;
    const int K = g.K, nt = K / BK;
    unsigned voffA[2], voffB[2];
#pragma unroll
    for (int i = 0; i < 2; ++i) { int R, C; stage_rc(tid * 16 + i * 8192, R, C); const int Rb = Epi::PERM ? ((R & ~31) + perm32(R & 31)) : R;
        voffA[i] = (unsigned)(R * K + C) * 2u; voffB[i] = (unsigned)(Rb * K + C) * 2u; }
    const size_t kstep = (size_t)(BK * 2);
    const size_t hstep = (size_t)HALF * K * 2;
    const size_t tstep = 2 * hstep;
    const unsigned ldsw = (unsigned)wid * 1024u;
    const int aoff = lds_byte(wr * 64 + fr, fq * 8), boff = lds_byte(wc * 32 + fr, fq * 8);
#define PG8_SA(b, h) (((b) * 2 + (h)) * HTB)
#define PG8_SB(b, h) ((4 + (b) * 2 + (h)) * HTB)
#define PG8_STAGE(bufoff, gbase, voff) do { _Pragma("unroll") for (int _i = 0; _i < 2; ++_i) \
        __builtin_amdgcn_global_load_lds((const unsigned*)((const char*)(gbase) + (voff)[_i]), (PG8_LAS unsigned*)(lds + (bufoff) + ldsw + _i * 8192), 16, 0, 0); } while (0)
#define PG8_LDA(dst, b, h) do { if constexpr (F8) { _Pragma("unroll") for (int m = 0; m < 4; ++m) dst##_8[m] = __builtin_shufflevector(*(const PG8_LAS v4i_t*)(lds + PG8_SA(b, h) + aoff + m * 2048), *(const PG8_LAS v4i_t*)(lds + PG8_SA(b, h) + aoff + m * 2048 + 1024), 0, 1, 2, 3, 4, 5, 6, 7); } \
        else { _Pragma("unroll") for (int m = 0; m < 4; ++m) _Pragma("unroll") for (int k = 0; k < 2; ++k) dst[m][k] = *(const PG8_LAS bf16x8*)(lds + PG8_SA(b, h) + aoff + m * 2048 + k * 1024); } } while (0)
#define PG8_LDB(dst, b, h) do { if constexpr (F8) { _Pragma("unroll") for (int n = 0; n < 2; ++n) dst##_8[n] = __builtin_shufflevector(*(const PG8_LAS v4i_t*)(lds + PG8_SB(b, h) + boff + n * 2048), *(const PG8_LAS v4i_t*)(lds + PG8_SB(b, h) + boff + n * 2048 + 1024), 0, 1, 2, 3, 4, 5, 6, 7); } \
        else { _Pragma("unroll") for (int n = 0; n < 2; ++n) _Pragma("unroll") for (int k = 0; k < 2; ++k) dst[n][k] = *(const PG8_LAS bf16x8*)(lds + PG8_SB(b, h) + boff + n * 2048 + k * 1024); } } while (0)
#define PG8_MMA(ai, bj, At, Bt) do { __builtin_amdgcn_s_setprio(1); \
        if constexpr (F8) { _Pragma("unroll") for (int m = 0; m < 4; ++m) _Pragma("unroll") for (int n = 0; n < 2; ++n) { \
            asm volatile("v_mfma_f32_16x16x128_f8f6f4 %0, %1, %2, %0" : "+v"(acc[ai][bj][m][n]) : "v"(Bt##_8[n]), "v"(At##_8[m])); } } \
        else { _Pragma("unroll") for (int m = 0; m < 4; ++m) _Pragma("unroll") for (int n = 0; n < 2; ++n) _Pragma("unroll") for (int k = 0; k < 2; ++k) \
            acc[ai][bj][m][n] = __builtin_amdgcn_mfma_f32_16x16x32_bf16(Bt[n][k], At[m][k], acc[ai][bj][m][n], 0, 0, 0); } \
        __builtin_amdgcn_s_setprio(0); } while (0)
#define PG8_WAIT_V(n) asm volatile("s_waitcnt vmcnt(" #n ")" ::: "memory")
#define PG8_WAIT_L(n) asm volatile("s_waitcnt lgkmcnt(" #n ")" ::: "memory")
#define PG8_BAR __builtin_amdgcn_s_barrier()
#define PG8_SCHED __builtin_amdgcn_sched_barrier(0)
    Unit cur, nxt; int ui = 0;
    if (!S.next(0, cur)) return;
    f32x4 acc[2][2][4][2];
#pragma unroll
    for (int a = 0; a < 2; ++a)
#pragma unroll
        for (int b = 0; b < 2; ++b)
#pragma unroll
            for (int m = 0; m < 4; ++m)
#pragma unroll
                for (int n = 0; n < 2; ++n) acc[a][b][m][n] = (f32x4){0.f, 0.f, 0.f, 0.f};
    bf16x8 At[4][2], B0[2][2], B1[2][2];
    v8i_t At_8[4], B0_8[2], B1_8[2];
    const char* cA = (const char*)g.A + (size_t)cur.pm * tstep; const char* cB = (const char*)g.Bt + (size_t)cur.pn * tstep;
    S.a_ready(cur);
    if constexpr (SP2) {
        PG8_STAGE(PG8_SB(0, 0), cB, voffB); PG8_STAGE(PG8_SB(0, 1), cB + hstep, voffB); PG8_STAGE(PG8_SA(0, 0), cA, voffA); PG8_STAGE(PG8_SA(0, 1), cA + hstep, voffA);
        if (wr == 1) PG8_BAR;
        PG8_WAIT_V(2); PG8_BAR;
        PG8_STAGE(PG8_SB(1, 0), cB + kstep, voffB); PG8_STAGE(PG8_SA(1, 0), cA + kstep, voffA); PG8_STAGE(PG8_SB(1, 1), cB + hstep + kstep, voffB);
        PG8_WAIT_V(6); PG8_BAR;
    } else {
        PG8_STAGE(PG8_SB(0, 0), cB, voffB); PG8_STAGE(PG8_SA(0, 0), cA, voffA); PG8_STAGE(PG8_SB(0, 1), cB + hstep, voffB); PG8_STAGE(PG8_SA(0, 1), cA + hstep, voffA);
        if (wr == 1) PG8_BAR;
        PG8_WAIT_V(4); PG8_BAR;
        PG8_STAGE(PG8_SB(1, 0), cB + kstep, voffB); PG8_STAGE(PG8_SA(1, 0), cA + kstep, voffA); PG8_STAGE(PG8_SB(1, 1), cB + hstep + kstep, voffB);
        PG8_WAIT_V(6); PG8_BAR;
    }
    for (;;) {
        const bool has_next = S.next(ui + 1, nxt);
        const char* nA = has_next ? (const char*)g.A + (size_t)nxt.pm * tstep : cA; const char* nB = has_next ? (const char*)g.Bt + (size_t)nxt.pn * tstep : cB;
        for (int t = 0; t < nt; t += 2) {
            const bool last = (t == nt - 2);
            const char* a1 = cA + (size_t)(t + 1) * kstep;
            const char* a2 = last ? nA : cA + (size_t)(t + 2) * kstep; const char* b2 = last ? nB : cB + (size_t)(t + 2) * kstep;
            const char* a3 = a2 + kstep; const char* b3 = b2 + kstep;
            if (last && has_next) S.a_ready(nxt);
            if constexpr (SP2) {
            PG8_LDB(B0, 0, 0); PG8_LDB(B1, 0, 1); PG8_SCHED; PG8_LDA(At, 0, 0); PG8_STAGE(PG8_SA(1, 1), a1 + hstep, voffA);
            PG8_WAIT_V(8); PG8_WAIT_L(0); PG8_BAR; PG8_MMA(0, 0, At, B0); PG8_MMA(0, 1, At, B1); PG8_BAR; PG8_SCHED;
            PG8_LDA(At, 0, 1); PG8_STAGE(PG8_SB(0, 0), b2, voffB); PG8_STAGE(PG8_SB(0, 1), b2 + hstep, voffB); PG8_STAGE(PG8_SA(0, 0), a2, voffA);
            PG8_WAIT_V(8); PG8_WAIT_L(0); PG8_BAR; PG8_MMA(1, 0, At, B0); PG8_MMA(1, 1, At, B1); PG8_BAR; PG8_SCHED;
            PG8_LDB(B0, 1, 0); PG8_LDB(B1, 1, 1); PG8_SCHED; PG8_LDA(At, 1, 0); PG8_STAGE(PG8_SA(0, 1), a2 + hstep, voffA);
            PG8_WAIT_V(8); PG8_WAIT_L(0); PG8_BAR; PG8_MMA(0, 0, At, B0); PG8_MMA(0, 1, At, B1); PG8_BAR; PG8_SCHED;
            PG8_LDA(At, 1, 1); PG8_STAGE(PG8_SB(1, 0), b3, voffB); PG8_STAGE(PG8_SB(1, 1), b3 + hstep, voffB); PG8_STAGE(PG8_SA(1, 0), a3, voffA);
            PG8_WAIT_V(8); PG8_WAIT_L(0); PG8_BAR; PG8_MMA(1, 0, At, B0); PG8_MMA(1, 1, At, B1); PG8_BAR; PG8_SCHED;
            } else {
            PG8_LDB(B0, 0, 0); PG8_SCHED; PG8_LDA(At, 0, 0); PG8_STAGE(PG8_SA(1, 1), a1 + hstep, voffA);
            PG8_WAIT_L(8); PG8_BAR; PG8_WAIT_L(0); PG8_MMA(0, 0, At, B0); PG8_BAR; PG8_SCHED;
            PG8_LDB(B1, 0, 1); PG8_STAGE(PG8_SB(0, 0), b2, voffB);
            PG8_BAR; PG8_WAIT_L(0); PG8_MMA(0, 1, At, B1); PG8_BAR;
            PG8_LDA(At, 0, 1); PG8_STAGE(PG8_SA(0, 0), a2, voffA);
            PG8_BAR; PG8_WAIT_L(0); PG8_MMA(1, 0, At, B0); PG8_BAR; PG8_SCHED;
            PG8_STAGE(PG8_SB(0, 1), b2 + hstep, voffB);
            PG8_WAIT_V(6); PG8_BAR; PG8_MMA(1, 1, At, B1); PG8_BAR;
            PG8_LDB(B0, 1, 0); PG8_SCHED; PG8_LDA(At, 1, 0); PG8_STAGE(PG8_SA(0, 1), a2 + hstep, voffA);
            PG8_WAIT_L(8); PG8_BAR; PG8_WAIT_L(0); PG8_MMA(0, 0, At, B0); PG8_BAR; PG8_SCHED;
            PG8_LDB(B1, 1, 1); PG8_STAGE(PG8_SB(1, 0), b3, voffB);
            PG8_BAR; PG8_WAIT_L(0); PG8_MMA(0, 1, At, B1); PG8_BAR;
            PG8_LDA(At, 1, 1); PG8_STAGE(PG8_SA(1, 0), a3, voffA);
            PG8_BAR; PG8_WAIT_L(0); PG8_MMA(1, 0, At, B0); PG8_BAR; PG8_SCHED;
            PG8_STAGE(PG8_SB(1, 1), b3 + hstep, voffB);
            PG8_WAIT_V(6); PG8_BAR; PG8_MMA(1, 1, At, B1); PG8_BAR;
            }
            if constexpr (Epi::MIDT > 0) { if (t + 2 == Epi::MIDT || t + 2 == Epi::MIDT2) { int l2_; asm volatile("v_mbcnt_lo_u32_b32 %0, -1, 0\n\tv_mbcnt_hi_u32_b32 %0, -1, %0" : "=v"(l2_)); E.mid(acc, cur, wr, l2_ & 15, t + 2); } }
        }
        if constexpr (F8) asm volatile("s_nop 15\n\ts_nop 15" ::: "memory");
        if constexpr (ALIGN_EPI) { if (wr == 0) PG8_BAR; }
        if constexpr (!Epi::AFTER_DRAIN) { int l2_; asm volatile("v_mbcnt_lo_u32_b32 %0, -1, 0\n\tv_mbcnt_hi_u32_b32 %0, -1, %0" : "=v"(l2_));
            E(acc, cur, wr, wc, l2_ & 15, l2_ >> 4); S.done(cur); }
        if (!has_next) break;
#pragma unroll
        for (int a = 0; a < 2; ++a)
#pragma unroll
            for (int b = 0; b < 2; ++b)
#pragma unroll
                for (int m = 0; m < 4; ++m)
#pragma unroll
                    for (int n = 0; n < 2; ++n) acc[a][b][m][n] = (f32x4){0.f, 0.f, 0.f, 0.f};
        cur = nxt; cA = nA; cB = nB; ++ui;
        if constexpr (ALIGN_EPI) { if (wr == 1) PG8_BAR; }
    }
    PG8_WAIT_V(0);
    if constexpr (!ALIGN_EPI) { if (wr == 0) PG8_BAR; }
    PG8_BAR;
    if constexpr (Epi::AFTER_DRAIN) { E.fused(acc, cur, wr, wc, fr, fq, lds, wid, lane); S.done(cur); }
#undef PG8_SA
#undef PG8_SB
#undef PG8_STAGE
#undef PG8_LDA
#undef PG8_LDB
#undef PG8_MMA
#undef PG8_WAIT_V
#undef PG8_WAIT_L
#undef PG8_BAR
#undef PG8_SCHED
}
}

constexpr int NWAVES = 8;
constexpr int BATCH = 16, SEQ = 2048, DM = 1024, DEPTH = 2, NMETA = 16, DFF = 4096;
constexpr int MROWS = 33024;
constexpr int MREAL = BATCH * SEQ, MVALID = MREAL + NMETA;
constexpr int NIN_SRC = 1988, NIN = 2048;
constexpr int PC_QA = 0, PC_CKV = 256, PC_IK = 384, PC_IW = 448, PC_IQ = 512, PC_UB = 768, PC_QC = 1280, PC_KC = 1536, PC_VC = 1792;
constexpr int YC_B = 0, YC_A = 512, YC_C = 768;
constexpr int TOPK = 256;

constexpr size_t MiB = 1u << 20;
constexpr size_t WS_CTL = 0;
constexpr size_t WS_STATS = 1 * MiB, CTL_ZERO_BYTES = 5 * MiB;
constexpr size_t STAT_STRIDE = 33024;
enum StatId { ST_SS1 = 0, ST_SSKV = 1, ST_SSB = 2, ST_SS2 = 3, ST_SSA = 4, ST_SSC = 5, ST_PER_LAYER = 6 };
constexpr size_t WS_W = 6 * MiB;
constexpr size_t W_LAYER = 23 * MiB, WO_IN = 0, WO_GLU = 4 * MiB, WO_OUT = 5 * MiB, WO_1 = 7 * MiB, WO_2 = 15 * MiB;
constexpr size_t WS_HB = 52 * MiB;
constexpr size_t WS_BIG = 118 * MiB;
constexpr size_t WS_P = WS_BIG, WS_YCAT = WS_BIG + 130 * MiB, WS_YG = WS_BIG + 196 * MiB;
constexpr size_t WS_END = 376 * MiB;
constexpr size_t WS_WUKF = 497 * MiB - 512 * 1024, WS_WUVF = WS_WUKF + 128 * 1024;
static_assert(WS_STATS + (2 * ST_PER_LAYER + 1) * STAT_STRIDE * 8 <= CTL_ZERO_BYTES && CTL_ZERO_BYTES <= WS_W && WS_W + 2 * W_LAYER <= WS_HB && WS_HB + (size_t)MROWS * 1024 * 2 <= WS_BIG && WS_P + (size_t)MROWS * 2048 * 2 <= WS_YCAT && WS_YCAT + (size_t)MROWS * 1024 * 2 <= WS_YG
              && WS_YG + (size_t)MROWS * 512 * 2 <= WS_BIG + (size_t)MROWS * 4096 * 2 && WS_BIG + (size_t)MROWS * 4096 * 2 <= WS_END, "d_ws map");
constexpr int CW_TMO = 0, CW_CODE = 1;
constexpr int CW_BAR = 4096;
constexpr int CW_WMAX1 = 65536 + 2048;
constexpr int CW_WMAX = 65536;
constexpr int CW_Q = 16384;

constexpr int RING_OFF = 0, RING_BYTES = 131072;
constexpr int LDSCTL_OFF = RING_BYTES, MISC_OFF = LDSCTL_OFF + 320;
constexpr int LDS_BYTES = 147456;

#define GAS __attribute__((address_space(1)))
#define LAS __attribute__((address_space(3)))
typedef unsigned short bf16;
typedef unsigned v4u __attribute__((ext_vector_type(4)));
typedef float f32x4 __attribute__((ext_vector_type(4)));
typedef GAS unsigned gu32;
#define RLX_AGENT __ATOMIC_RELAXED, __HIP_MEMORY_SCOPE_AGENT
#define LDS_WAIT() asm volatile("s_waitcnt lgkmcnt(0)" ::: "memory")
#define VM_WAIT() asm volatile("s_waitcnt vmcnt(0)" ::: "memory")
__device__ __forceinline__ unsigned f2bf(float f) { unsigned u = __builtin_bit_cast(unsigned, f); return (u + 0x7fffu + ((u >> 16) & 1u)) >> 16; }
__device__ __forceinline__ unsigned pk2(float lo, float hi) { return f2bf(lo) | (f2bf(hi) << 16); }
__device__ __forceinline__ float bf2f(bf16 v) { return __uint_as_float((unsigned)v << 16); }
__device__ __forceinline__ float bflo(unsigned w) { return __uint_as_float(w << 16); }
__device__ __forceinline__ float bfhi(unsigned w) { return __uint_as_float(w & 0xffff0000u); }

__device__ __forceinline__ int lane_id() { int l; asm volatile("v_mbcnt_lo_u32_b32 %0, -1, 0\n\tv_mbcnt_hi_u32_b32 %0, -1, %0" : "=v"(l)); return l; }
#define XB_TMO      128
#define XB_XCNT(j)  (256  + 64 * (j))
#define XB_XSUB(j)  (1280 + 64 * (j))
#define XB_XGEN(j)  (2304 + 64 * (j))
#define XB_TOP      3328
#define XB_TOPGEN   3392
#define XCD_BAR_WORDS 3456
#define XB_SPIN_CAP (1u << 21)

__device__ __forceinline__ unsigned xb_ld(unsigned* p)              { return __hip_atomic_load(p, __ATOMIC_RELAXED, __HIP_MEMORY_SCOPE_AGENT); }
__device__ __forceinline__ unsigned xb_add(unsigned* p, unsigned v) { return __hip_atomic_fetch_add(p, v, __ATOMIC_RELAXED, __HIP_MEMORY_SCOPE_AGENT); }
__device__ __forceinline__ unsigned xb_xcc_id() { return (unsigned)__builtin_amdgcn_s_getreg((3 << 11) | 20) & 0xFu; }
#define XB_SPIN(cond, bar) do { unsigned _sp = 0; while (cond) { __builtin_amdgcn_s_sleep(1); \
    if ((++_sp & 255u) == 0u) { if (xb_ld(&(bar)[XB_TMO])) break; if (_sp > XB_SPIN_CAP) { atomicAdd(&(bar)[XB_TMO], 1u); break; } } } } while (0)

struct XcdBarrier { unsigned* bar; unsigned x; volatile LAS unsigned* st; };
__device__ __forceinline__ XcdBarrier xcd_barrier_post(unsigned* bar, volatile LAS unsigned* st, int wave) {
    XcdBarrier b; b.bar = bar; b.x = xb_xcc_id(); b.st = st;
    if (wave == 0 && lane_id() == 0) (void)xb_add(&bar[XB_XCNT(b.x)], 1u);
    return b;
}
__device__ __forceinline__ void xcd_barrier_complete(unsigned* bar, unsigned x, unsigned& nloc, unsigned& nx) {
    const unsigned G = gridDim.x * gridDim.y * gridDim.z;
    unsigned sum, cnt, mine, sp = 0u;
    for (;;) {
        sum = 0u; cnt = 0u; mine = 0u;
#pragma unroll
        for (unsigned j = 0; j < 16; ++j) { const unsigned c = xb_ld(&bar[XB_XCNT(j)]); sum += c; cnt += (c > 0u) ? 1u : 0u; mine = (j == x) ? c : mine; }
        if (sum == G) break;
        __builtin_amdgcn_s_sleep(1);
        if ((++sp & 255u) == 0u) { if (xb_ld(&bar[XB_TMO])) break; if (sp > XB_SPIN_CAP) { atomicAdd(&bar[XB_TMO], 1u); break; } }
    }
    nloc = mine > 0u ? mine : 1u; nx = cnt > 0u ? cnt : 1u;
}
__device__ __forceinline__ void xcd_barrier(const XcdBarrier& b, int wave) {
    asm volatile("s_waitcnt vmcnt(0)" ::: "memory");
    __syncthreads();
    if (wave == 0 && lane_id() == 0) {
        unsigned* bar = b.bar;
        __builtin_amdgcn_s_waitcnt(0);
        unsigned nloc = b.st[0], nx = b.st[1];
        if (nloc == 0u) { xcd_barrier_complete(bar, b.x, nloc, nx); b.st[0] = nloc; b.st[1] = nx; }
        const unsigned old = xb_add(&bar[XB_XSUB(b.x)], 1u);
        const unsigned gen = old / nloc;
        if (old + 1u == (gen + 1u) * nloc) {
            __builtin_amdgcn_fence(__ATOMIC_RELEASE, "agent");
            asm volatile("s_waitcnt vmcnt(0)" ::: "memory");
            const unsigned og = xb_add(&bar[XB_TOP], 1u);
            const unsigned tg = og / nx;
            if (og + 1u == (tg + 1u) * nx) xb_add(&bar[XB_TOPGEN], 1u);
            else XB_SPIN(xb_ld(&bar[XB_TOPGEN]) == tg, bar);
            __builtin_amdgcn_fence(__ATOMIC_ACQUIRE, "agent");
            xb_add(&bar[XB_XGEN(b.x)], 1u);
            asm volatile("s_waitcnt vmcnt(0)" ::: "memory");
        } else {
            XB_SPIN(xb_ld(&bar[XB_XGEN(b.x)]) == gen, bar);
            __builtin_amdgcn_fence(__ATOMIC_ACQUIRE, "agent");
            asm volatile("s_waitcnt vmcnt(0)" ::: "memory");
        }
    }
    __syncthreads();
}


struct Args { const float* in[25]; float* out; unsigned char* ws; int ph_lo, ph_hi; };
struct Frame {
    LAS unsigned char* lds;
    volatile LAS unsigned* MISC;
    gu32* ctl;
    int wave;
    int vcu, G;
    float* out; unsigned char* ws;
};
using pg8::stat_t; using pg8::stat_get;
__device__ __forceinline__ stat_t* stat_ptr(Frame& F, int l, int id) { return (stat_t*)(F.ws + WS_STATS) + (size_t)(l * ST_PER_LAYER + id) * STAT_STRIDE; }
__device__ __forceinline__ bf16* wptr(Frame& F, int l, size_t off) { return (bf16*)(F.ws + WS_W + (size_t)l * W_LAYER + off); }
__device__ __forceinline__ float wave_sum(float v) {
#pragma unroll
    for (int o = 1; o < 64; o <<= 1) v += __shfl_xor(v, o);
    return v;
}
__device__ __forceinline__ float wave_max(float v) {
#pragma unroll
    for (int o = 1; o < 64; o <<= 1) v = fmaxf(v, __shfl_xor(v, o));
    return v;
}
__device__ __forceinline__ int key_row(int b, int kp) { return kp < NMETA ? MREAL + kp : b * SEQ + (kp - NMETA); }

__device__ __forceinline__ int win_srccol(int n) {
    if (n < 384) return n;
    if (n < 448) return 640 + (n - 384);
    if (n < 452) return 704 + (n - 448);
    if (n < 512) return -1;
    if (n < 768) return 384 + (n - 512);
    if (n < 1280) return 708 + (n - 768);
    return 1220 + (n - 1280);
}
__device__ __forceinline__ void p0_transpose_item(const Args& A, Frame& F, int l, int mat, int item, LAS float* scr) {
    const int lane = lane_id();
    int N, K, ldw; const float* W; bf16* WT;
    if (mat == 0) { N = 2048; K = 1024; ldw = NIN_SRC; W = A.in[4] + (size_t)l * 1024 * NIN_SRC; WT = wptr(F, l, WO_IN); }
    else if (mat == 1) { N = 512; K = 512; ldw = 512; W = A.in[16] + (size_t)l * 512 * 512; WT = wptr(F, l, WO_GLU); }
    else if (mat == 2) { N = 1024; K = 1024; ldw = 1024; W = A.in[20] + (size_t)l * 1024 * 1024; WT = wptr(F, l, WO_OUT); }
    else if (mat == 3) { N = 4096; K = 1024; ldw = 4096; W = A.in[22] + (size_t)l * 1024 * 4096; WT = wptr(F, l, WO_1); }
    else { N = 1024; K = 4096; ldw = 1024; W = A.in[23] + (size_t)l * 4096 * 1024; WT = wptr(F, l, WO_2); }
    if (mat == 3) {
        const int nblk = N / 32, kb = item / nblk, nb = item % nblk, k0 = 64 * kb, n0 = 32 * nb, kr = lane >> 3, c4 = lane & 7; float m[4] = {0.f, 0.f, 0.f, 0.f};
#pragma unroll
        for (int i = 0; i < 8; ++i) { const int kk = k0 + 8 * i + kr; const pg8::f32x4 v = *(const GAS pg8::f32x4*)(W + (size_t)kk * ldw + n0 + 4 * c4); const float g = A.in[21][l * 1024 + kk];
#pragma unroll
            for (int e_ = 0; e_ < 4; ++e_) m[e_] = fmaxf(m[e_], fabsf(v[e_] * g)); }
#pragma unroll
        for (int e_ = 0; e_ < 4; ++e_) { m[e_] = fmaxf(m[e_], __shfl_xor(m[e_], 8)); m[e_] = fmaxf(m[e_], __shfl_xor(m[e_], 16)); m[e_] = fmaxf(m[e_], __shfl_xor(m[e_], 32)); }
        if (lane < 8) {
#pragma unroll
            for (int e_ = 0; e_ < 4; ++e_) atomicMax((unsigned*)(F.ctl + CW_WMAX1 + l * 4096 + n0 + 4 * c4 + e_), __float_as_uint(m[e_])); }
        return; }
    if (mat == 4) {
        const int nblk = N / 32, kb = item / nblk, nb = item % nblk, k0 = 64 * kb, n0 = 32 * nb, kr = lane >> 3, c4 = lane & 7; float m[4] = {0.f, 0.f, 0.f, 0.f};
#pragma unroll
        for (int i = 0; i < 8; ++i) { const pg8::f32x4 v = *(const GAS pg8::f32x4*)(W + (size_t)(k0 + 8 * i + kr) * ldw + n0 + 4 * c4);
#pragma unroll
            for (int e_ = 0; e_ < 4; ++e_) m[e_] = fmaxf(m[e_], fabsf(v[e_])); }
#pragma unroll
        for (int e_ = 0; e_ < 4; ++e_) { m[e_] = fmaxf(m[e_], __shfl_xor(m[e_], 8)); m[e_] = fmaxf(m[e_], __shfl_xor(m[e_], 16)); m[e_] = fmaxf(m[e_], __shfl_xor(m[e_], 32)); }
        if (lane < 8) {
#pragma unroll
            for (int e_ = 0; e_ < 4; ++e_) atomicMax((unsigned*)(F.ctl + CW_WMAX + l * 1024 + n0 + 4 * c4 + e_), __float_as_uint(m[e_])); }
        return; }
    const int nblk = N / 32, kb = item / nblk, nb = item % nblk, k0 = 64 * kb, n0 = 32 * nb;
    const int kr = lane >> 3, c4 = lane & 7, n = n0 + 4 * c4;
    int sc = n; float cs = 1.f;
    if (mat == 0) { sc = win_srccol(n); if (n >= PC_QC && n < PC_KC) cs = 0.125f; }
#pragma unroll
    for (int i = 0; i < 8; ++i) { const int kk = 8 * i + kr, k = k0 + kk; int ks = k; float g = 1.f;
        if (mat == 0) g = A.in[3][l * 1024 + k];
        else if (mat == 2) { if (k < 512) { ks = 256 + k; g = A.in[18][l * 512 + k]; } else if (k < 768) { ks = k - 512; g = A.in[17][l * 256 + (k - 512)]; } else { ks = k; g = A.in[19][l * 256 + (k - 768)]; } }
        pg8::f32x4 v = (pg8::f32x4){0.f, 0.f, 0.f, 0.f}; if (sc >= 0) v = *(const GAS pg8::f32x4*)(W + (size_t)ks * ldw + sc);
        g *= cs;
#pragma unroll
        for (int e_ = 0; e_ < 4; ++e_) scr[kk * 33 + 4 * c4 + e_] = v[e_] * g; }
    LDS_WAIT(); asm volatile("" ::: "memory");
    const int c = lane & 7;
#pragma unroll
    for (int j = 0; j < 4; ++j) { const int nn = (lane >> 3) + 8 * j; const LAS float* s = scr + (8 * c) * 33 + nn;
        v4u o; o.x = pk2(s[0 * 33], s[1 * 33]); o.y = pk2(s[2 * 33], s[3 * 33]); o.z = pk2(s[4 * 33], s[5 * 33]); o.w = pk2(s[6 * 33], s[7 * 33]);
        *(GAS v4u*)(WT + (size_t)(n0 + nn) * K + k0 + 8 * c) = o; }
    LDS_WAIT(); asm volatile("" ::: "memory");
}
__device__ __forceinline__ void s5_build_item(const Args& A, Frame& F, int l, int kind, int g, int x, LAS float* scr);
__device__ __forceinline__ void p0_prologue(const Args& A, Frame& F) {
    const int lane = lane_id();
    LAS float* scr = (LAS float*)(F.lds + RING_OFF + F.wave * 16384);
    const int gw = F.vcu * NWAVES + F.wave, NGW = F.G * NWAVES;
    constexpr int I0 = 16 * 64, I1 = 8 * 16, I2 = 16 * 32, I3 = 16 * 128, I4 = 64 * 32, IL = I0 + I1 + I2 + I3 + I4;
    for (int it = gw; it < DEPTH * IL; it += NGW) {
        const int l = it / IL; int r = it % IL;
        if (r < I0) { p0_transpose_item(A, F, l, 0, r, scr); continue; } r -= I0;
        if (r < I1) { p0_transpose_item(A, F, l, 1, r, scr); continue; } r -= I1;
        if (r < I2) { p0_transpose_item(A, F, l, 2, r, scr); continue; } r -= I2;
        if (r < I3) { p0_transpose_item(A, F, l, 3, r, scr); continue; } r -= I3;
        p0_transpose_item(A, F, l, 4, r, scr);
    }
    for (int it = gw; it < DEPTH * 3 * 1024; it += NGW) { const int l = it / 3072, r = it % 3072; s5_build_item(A, F, l, r >> 10, (r >> 5) & 31, r & 31, scr); }
    for (int it = gw; it < DEPTH * 4 * 16 * 2; it += NGW) { const int tb_ = it & 1, fr_ = (it >> 1) & 15, h_ = (it >> 5) & 3, l_ = it >> 7; const int r32_ = lane & 31, hi_ = lane >> 5;
        const float* wuk_ = A.in[6] + (size_t)l_ * 128 * 256; const float* wuv_ = A.in[7] + (size_t)l_ * 128 * 256; const float* kvg_ = A.in[5] + l_ * 128;
        float v_[8];
        if (tb_ == 0) { const int c_ = fr_ >> 2, ks_ = fr_ & 3, rank_ = 32 * c_ + r32_; const float sc_ = kvg_[rank_] * 0.125f;
#pragma unroll
            for (int e_ = 0; e_ < 8; ++e_) v_[e_] = wuk_[((size_t)rank_ * 4 + h_) * 64 + ks_ * 16 + hi_ * 8 + e_] * sc_; }
        else { const int c_ = fr_ >> 2, s_ = (fr_ >> 1) & 1, db_ = fr_ & 1, d_ = 32 * db_ + r32_;
#pragma unroll
            for (int j_ = 0; j_ < 8; ++j_) { const int rk_ = 32 * c_ + 16 * s_ + 8 * (j_ >> 2) + 4 * hi_ + (j_ & 3); v_[j_] = wuv_[((size_t)rk_ * 4 + h_) * 64 + d_] * kvg_[rk_]; } }
        v4u o_; o_.x = pk2(v_[0], v_[1]); o_.y = pk2(v_[2], v_[3]); o_.z = pk2(v_[4], v_[5]); o_.w = pk2(v_[6], v_[7]);
        *((GAS v4u*)(F.ws + (tb_ == 0 ? WS_WUKF : WS_WUVF)) + ((size_t)(l_ * 4 + h_) * 16 + fr_) * 64 + lane) = o_; }
    bf16* Hb = (bf16*)(F.ws + WS_HB); stat_t* ss = stat_ptr(F, 0, ST_SS1);
    for (int m0 = gw * 4; m0 < MVALID; m0 += NGW * 4) {
        f32x4 v[4][4];
#pragma unroll
        for (int q = 0; q < 4; ++q) { const int m = m0 + q < MVALID ? m0 + q : MVALID - 1;
            const float* src = m < MREAL ? A.in[0] + (size_t)m * DM : A.in[1] + (size_t)(m - MREAL) * DM; const GAS f32x4* xr = (const GAS f32x4*)src + 2 * lane;
#pragma unroll
            for (int j = 0; j < 4; ++j) v[q][j] = xr[(j >> 1) * 128 + (j & 1)]; }
#pragma unroll
        for (int q = 0; q < 4; ++q) { const int m = m0 + q; if (m < MVALID) {
            GAS v4u* o16 = (GAS v4u*)(Hb + (size_t)m * DM) + lane; float s = 0.f;
#pragma unroll
            for (int jh = 0; jh < 2; ++jh) { v4u o;
#pragma unroll
                for (int i = 0; i < 2; ++i) { const f32x4 vv = v[q][2 * jh + i]; const unsigned w0 = pk2(vv.x, vv.y), w1 = pk2(vv.z, vv.w); o[2 * i] = w0; o[2 * i + 1] = w1;
                    s += (bflo(w0) * bflo(w0) + bfhi(w0) * bfhi(w0)) + (bflo(w1) * bflo(w1) + bfhi(w1) * bfhi(w1)); }
                o16[64 * jh] = o; }
            s = wave_sum(s); if (lane == 0) ss[m] = (stat_t)((double)s * 4294967296.0); } }
    }
}

__device__ __forceinline__ float log_sigmoid_f(float x) { return fminf(x, 0.f) - log1pf(__expf(-fabsf(x))); }
__device__ __forceinline__ float gelu_tanh_f(float x) { const float u = 0.7978845608028654f * (x + 0.044715f * x * x * x); return 0.5f * x * (1.0f + tanhf(u)); }
__device__ __forceinline__ unsigned mono_key(float f) { const unsigned u = __float_as_uint(f); return (u & 0x80000000u) ? ~u : (u | 0x80000000u); }
__device__ __forceinline__ int t5_bucket(int d) {
    if (d < 16) return d;
    const int v = 16 + (int)(logf((float)d / 16.0f) / 2.0794415416798357f * 16.0f);
    return v < 31 ? v : 31;
}

__device__ __forceinline__ void s5_naive_item(const Args& A, Frame& F, int l, int b, int g) {
    const int p = lane_id();
    const bf16* P = (const bf16*)(F.ws + WS_P); bf16* YG = (bf16*)(F.ws + WS_YG);
    const int lg = l * 32 + g;
    const float dt = expf(A.in[10][lg]), lr = A.in[8][lg * 64 + p], li = A.in[9][lg * 64 + p];
    const float mag = expf(lr * dt), ar = mag * cosf(li * dt), ai = mag * sinf(li * dt);
    const float den = lr * lr + li * li, nr = ar - 1.0f, ni = ai;
    const float fr_ = (nr * lr + ni * li) / den, fi_ = (ni * lr - nr * li) / den;
    float Br[16], Bi[16], Cr[16], Ci[16];
#pragma unroll
    for (int c = 0; c < 16; ++c) { const float br = A.in[11][((size_t)lg * 64 + p) * 16 + c], bi = A.in[12][((size_t)lg * 64 + p) * 16 + c];
        Br[c] = fr_ * br - fi_ * bi; Bi[c] = fr_ * bi + fi_ * br;
        Cr[c] = A.in[13][((size_t)lg * 16 + c) * 64 + p]; Ci[c] = A.in[14][((size_t)lg * 16 + c) * 64 + p]; }
    const int myc = ((p >> 5) & 1) * 8 + ((p >> 4) & 1) * 4 + ((p >> 3) & 1) * 2 + ((p >> 2) & 1);
    const float dsk = A.in[15][l * 512 + g * 16 + myc];
    float hr = 0.f, hi = 0.f;
    for (int kp = 0; kp < NMETA; ++kp) {
        const int row = key_row(b, kp);
        const v4u uw = *(const GAS v4u*)(P + (size_t)row * NIN + PC_UB + g * 16 + (p & 1) * 8);
        float u[16];
#pragma unroll
        for (int j = 0; j < 4; ++j) { const unsigned w0 = __builtin_amdgcn_readlane(uw[j], 0), w1 = __builtin_amdgcn_readlane(uw[j], 1);
            u[2 * j] = bflo(w0); u[2 * j + 1] = bfhi(w0); u[8 + 2 * j] = bflo(w1); u[8 + 2 * j + 1] = bfhi(w1); }
        float bur = 0.f, bui = 0.f;
#pragma unroll
        for (int c = 0; c < 16; ++c) { bur += Br[c] * u[c]; bui += Bi[c] * u[c]; }
        const float nhr = ar * hr - ai * hi + bur, nhi = ar * hi + ai * hr + bui; hr = nhr; hi = nhi;
        float v[16];
#pragma unroll
        for (int c = 0; c < 16; ++c) v[c] = Cr[c] * hr - Ci[c] * hi;
#pragma unroll
        for (int i = 0; i < 8; ++i) { const float send = (p & 32) ? v[i] : v[i + 8]; const float keep = (p & 32) ? v[i + 8] : v[i]; v[i] = keep + __shfl_xor(send, 32); }
#pragma unroll
        for (int i = 0; i < 4; ++i) { const float send = (p & 16) ? v[i] : v[i + 4]; const float keep = (p & 16) ? v[i + 4] : v[i]; v[i] = keep + __shfl_xor(send, 16); }
#pragma unroll
        for (int i = 0; i < 2; ++i) { const float send = (p & 8) ? v[i] : v[i + 2]; const float keep = (p & 8) ? v[i + 2] : v[i]; v[i] = keep + __shfl_xor(send, 8); }
        { const float send = (p & 4) ? v[0] : v[1]; const float keep = (p & 4) ? v[1] : v[0]; v[0] = keep + __shfl_xor(send, 4); }
        float y = v[0]; y += __shfl_xor(y, 1); y += __shfl_xor(y, 2);
        float um = u[0];
#pragma unroll
        for (int c = 1; c < 16; ++c) um = (myc == c) ? u[c] : um;
        y = gelu_tanh_f(y + dsk * um);
        if ((p & 3) == 0 && (b == 0 || kp >= NMETA)) YG[(size_t)row * 512 + g * 16 + myc] = (bf16)f2bf(y);
    }
}

__device__ __forceinline__ void dsa_naive_item(const Args& A, Frame& F, int l, int qi, LAS float* wl) {
    const int lane = lane_id();
    const bf16* P = (const bf16*)(F.ws + WS_P); bf16* Ycat = (bf16*)(F.ws + WS_YCAT);
    const stat_t* sskv = stat_ptr(F, l, ST_SSKV);
    LAS float* sc = wl;
    LAS unsigned* hist = (LAS unsigned*)(wl + 2080);
    LAS float* ql = wl + 2336;
    LAS float* qv = wl + 2848;
    LAS int* sel = (LAS int*)(wl + 3104);
    LAS float* ol = wl + 3360;
    int b, n, row;
    if (qi < MREAL) { b = qi >> 11; n = (qi & 2047) + NMETA + 1; row = qi; } else { b = 0; n = (qi - MREAL) + 1; row = qi; }
    const bf16* Pq = P + (size_t)row * NIN;
    LDS_WAIT(); asm volatile("" ::: "memory");
#pragma unroll
    for (int j = 0; j < 4; ++j) qv[lane + 64 * j] = bf2f(Pq[PC_IQ + lane + 64 * j]);
    float iw[4];
#pragma unroll
    for (int h = 0; h < 4; ++h) iw[h] = bf2f(Pq[PC_IW + h]);
    LDS_WAIT(); asm volatile("" ::: "memory");
#pragma unroll 1
    for (int kp = lane; kp < n; kp += 64) {
        const int krow = key_row(b, kp); const GAS v4u* ikp = (const GAS v4u*)(P + (size_t)krow * NIN + PC_IK);
        float d0 = 0.f, d1 = 0.f, d2 = 0.f, d3 = 0.f;
#pragma unroll 2
        for (int c = 0; c < 8; ++c) { const v4u w = ikp[c]; const float k8[8] = {bflo(w.x), bfhi(w.x), bflo(w.y), bfhi(w.y), bflo(w.z), bfhi(w.z), bflo(w.w), bfhi(w.w)};
#pragma unroll
            for (int j = 0; j < 8; ++j) { const float kk = k8[j]; d0 += qv[c * 8 + j] * kk; d1 += qv[64 + c * 8 + j] * kk; d2 += qv[128 + c * 8 + j] * kk; d3 += qv[192 + c * 8 + j] * kk; } }
        float s = iw[0] * fmaxf(d0, 0.f) + iw[1] * fmaxf(d1, 0.f) + iw[2] * fmaxf(d2, 0.f) + iw[3] * fmaxf(d3, 0.f);
        s += 0.0f;
        sc[kp] = s;
    }
    LDS_WAIT(); asm volatile("" ::: "memory");
    const int keff = n < TOPK ? n : TOPK;
    unsigned prefix = 0u; int krem = keff;
#pragma unroll 1
    for (int pass = 0; pass < 4; ++pass) {
        const int shift = 24 - 8 * pass;
#pragma unroll
        for (int j = 0; j < 4; ++j) hist[lane * 4 + j] = 0u;
        LDS_WAIT(); asm volatile("" ::: "memory");
        for (int kp = lane; kp < n; kp += 64) { const unsigned key = mono_key(sc[kp]);
            const bool match = (pass == 0) || ((key >> (shift + 8)) == (prefix >> (shift + 8)));
            if (match) __hip_atomic_fetch_add(&hist[(key >> shift) & 255u], 1u, __ATOMIC_RELAXED, __HIP_MEMORY_SCOPE_WORKGROUP); }
        LDS_WAIT(); asm volatile("" ::: "memory");
        const int c0 = (int)hist[lane * 4 + 0], c1 = (int)hist[lane * 4 + 1], c2 = (int)hist[lane * 4 + 2], c3 = (int)hist[lane * 4 + 3];
        const int tot = c0 + c1 + c2 + c3; int S = tot;
#pragma unroll
        for (int off = 1; off < 64; off <<= 1) { const int t = __shfl_down(S, off); if (lane + off < 64) S += t; }
        const int above = S - tot;
        const bool here = (above < krem) && (S >= krem);
        int bin = 0, newk = 0;
        if (here) { int a = above;
            if (a + c3 >= krem) { bin = 3; newk = krem - a; } else { a += c3;
            if (a + c2 >= krem) { bin = 2; newk = krem - a; } else { a += c2;
            if (a + c1 >= krem) { bin = 1; newk = krem - a; } else { a += c1; bin = 0; newk = krem - a; } } }
            bin += 4 * lane; }
        const unsigned long long mm = __ballot(here); const int src = mm ? (__ffsll((long long)mm) - 1) : 0;
        bin = __shfl(bin, src); krem = __shfl(newk, src);
        prefix |= (unsigned)bin << shift;
        LDS_WAIT(); asm volatile("" ::: "memory");
    }
    const unsigned T = prefix; const int rneed = krem;
    int selbase = 0, eqbase = 0;
    for (int k0 = 0; k0 < n; k0 += 64) { const int kp = k0 + lane; const bool valid = kp < n;
        const unsigned key = valid ? mono_key(sc[valid ? kp : 0]) : 0u;
        const bool gt = valid && key > T, eq = valid && key == T;
        const unsigned long long eqm = __ballot(eq); const unsigned long long lt = (1ull << lane) - 1ull;
        const int eqr = eqbase + __popcll(eqm & lt);
        const bool s = gt || (eq && eqr < rneed);
        const unsigned long long sm = __ballot(s);
        if (s) sel[selbase + __popcll(sm & lt)] = kp;
        selbase += __popcll(sm); eqbase += __popcll(eqm); }
    LDS_WAIT(); asm volatile("" ::: "memory");
#pragma unroll
    for (int j = 0; j < 4; ++j) qv[lane + 64 * j] = bf2f(Pq[PC_QA + lane + 64 * j]);
    LDS_WAIT(); asm volatile("" ::: "memory");
    const float* wuk = A.in[6] + (size_t)l * 128 * 256; const float* wuv = A.in[7] + (size_t)l * 128 * 256; const float* kvg = A.in[5] + l * 128;
#pragma unroll 1
    for (int h = 0; h < 4; ++h)
#pragma unroll 1
        for (int rr = 0; rr < 2; ++rr) { const int r = lane + 64 * rr; const GAS f32x4* wp = (const GAS f32x4*)(wuk + ((size_t)r * 4 + h) * 64); float a = 0.f;
#pragma unroll
            for (int d4 = 0; d4 < 16; ++d4) { const f32x4 w = wp[d4]; a += qv[h * 64 + d4 * 4] * w.x + qv[h * 64 + d4 * 4 + 1] * w.y + qv[h * 64 + d4 * 4 + 2] * w.z + qv[h * 64 + d4 * 4 + 3] * w.w; }
            ql[h * 128 + r] = a * kvg[r] * 0.125f; }
    LDS_WAIT(); asm volatile("" ::: "memory");
    float ya[4];
#pragma unroll 1
    for (int h = 0; h < 4; ++h) {
        float mx = -3.0e38f;
#pragma unroll 1
        for (int j = 0; j < 4; ++j) { const int i = lane + 64 * j;
            if (i < keff) { const int kp = sel[i]; const int krow = key_row(b, kp); const GAS v4u* cp = (const GAS v4u*)(P + (size_t)krow * NIN + PC_CKV); float d = 0.f;
#pragma unroll 4
                for (int c = 0; c < 16; ++c) { const v4u w = cp[c]; const LAS float* q8 = ql + h * 128 + c * 8;
                    d += q8[0] * bflo(w.x) + q8[1] * bfhi(w.x) + q8[2] * bflo(w.y) + q8[3] * bfhi(w.y) + q8[4] * bflo(w.z) + q8[5] * bfhi(w.z) + q8[6] * bflo(w.w) + q8[7] * bfhi(w.w); }
                const float rkv = rsqrtf(stat_get(sskv + krow) * (1.0f / 128.0f) + pg8::RMS_EPS);
                const float lgv = d * rkv + A.in[2][t5_bucket((n - 1) - kp) * 4 + h];
                sc[i] = lgv; sc[256 + i] = rkv; mx = fmaxf(mx, lgv); } }
        mx = wave_max(mx); float sum = 0.f;
        LDS_WAIT(); asm volatile("" ::: "memory");
#pragma unroll 1
        for (int j = 0; j < 4; ++j) { const int i = lane + 64 * j; if (i < keff) { const float e = __expf(sc[i] - mx); sc[i] = e; sum += e; } }
        sum = wave_sum(sum); const float inv = 1.0f / sum;
        LDS_WAIT(); asm volatile("" ::: "memory");
#pragma unroll 1
        for (int j = 0; j < 4; ++j) { const int i = lane + 64 * j; if (i < keff) qv[i] = sc[i] * inv * sc[256 + i]; }
        LDS_WAIT(); asm volatile("" ::: "memory");
        float o0 = 0.f, o1 = 0.f;
#pragma unroll 4
        for (int i = 0; i < keff; ++i) { const int krow = key_row(b, sel[i]); const float pw = qv[i]; const bf16* cp = P + (size_t)krow * NIN + PC_CKV;
            o0 += pw * bf2f(cp[lane]); o1 += pw * bf2f(cp[lane + 64]); }
        ol[lane] = o0 * kvg[lane]; ol[lane + 64] = o1 * kvg[lane + 64];
        LDS_WAIT(); asm volatile("" ::: "memory");
        float a = 0.f;
#pragma unroll 8
        for (int r = 0; r < 128; ++r) a += ol[r] * wuv[((size_t)r * 4 + h) * 64 + lane];
        ya[h] = a;
        LDS_WAIT(); asm volatile("" ::: "memory");
    }
    float ssq = 0.f;
#pragma unroll
    for (int h = 0; h < 4; ++h) { const unsigned w = f2bf(ya[h]); Ycat[(size_t)row * 1024 + YC_A + h * 64 + lane] = (bf16)w; const float v = __uint_as_float(w << 16); ssq += v * v; }
    ssq = wave_sum(ssq); if (lane == 0) pg8::stat_add(stat_ptr(F, l, ST_SSA) + row, ssq);
}

__device__ __forceinline__ void sb_naive_item(const Args& A, Frame& F, int l, int qi, LAS float* wl) {
    const int lane = lane_id();
    const bf16* P = (const bf16*)(F.ws + WS_P); bf16* Ycat = (bf16*)(F.ws + WS_YCAT);
    LAS float* qs = wl;
    LAS float* wbuf = wl + 64;
    LAS int* rbuf = (LAS int*)(wl + 128);
    int b, n, row;
    if (qi < MREAL) { b = qi >> 11; n = (qi & 2047) + NMETA; row = qi; } else { b = 0; n = qi - MREAL; row = qi; }
    const bf16* Pq = P + (size_t)row * NIN;
    float yc[4];
#pragma unroll 1
    for (int h = 0; h < 4; ++h) {
        LDS_WAIT(); asm volatile("" ::: "memory");
        qs[lane] = bf2f(Pq[PC_QC + h * 64 + lane]);
        LDS_WAIT(); asm volatile("" ::: "memory");
        float carry = 0.f, acc = 0.f;
        for (int top = n - 1; top >= 0; top -= 64) {
            const int kp = top - lane; const bool valid = kp >= 0; const int krow = key_row(b, valid ? kp : 0);
            const GAS v4u* kpn = (const GAS v4u*)(P + (size_t)krow * NIN + PC_KC + h * 64); float z = 0.f;
#pragma unroll
            for (int c = 0; c < 8; ++c) { const v4u w = kpn[c]; const LAS float* q8 = qs + c * 8;
                z += q8[0] * bflo(w.x) + q8[1] * bfhi(w.x) + q8[2] * bflo(w.y) + q8[3] * bfhi(w.y) + q8[4] * bflo(w.z) + q8[5] * bfhi(w.z) + q8[6] * bflo(w.w) + q8[7] * bfhi(w.w); }
            const float lk = valid ? log_sigmoid_f(-z) : 0.f;
            float incl = lk;
#pragma unroll
            for (int off = 1; off < 64; off <<= 1) { const float t = __shfl_up(incl, off); if (lane >= off) incl += t; }
            const float later = carry + incl - lk;
            const float w = valid ? __expf(log_sigmoid_f(z) + later) : 0.f;
            carry += __shfl(incl, 63);
            LDS_WAIT(); asm volatile("" ::: "memory");
            wbuf[lane] = w; rbuf[lane] = krow;
            LDS_WAIT(); asm volatile("" ::: "memory");
            const int cnt = top + 1 < 64 ? top + 1 : 64;
            for (int j = 0; j < cnt; ++j) acc += wbuf[j] * bf2f(P[(size_t)rbuf[j] * NIN + PC_VC + h * 64 + lane]);
        }
        yc[h] = acc;
    }
    float ssq = 0.f;
#pragma unroll
    for (int h = 0; h < 4; ++h) { const unsigned w = f2bf(yc[h]); Ycat[(size_t)row * 1024 + YC_C + h * 64 + lane] = (bf16)w; const float v = __uint_as_float(w << 16); ssq += v * v; }
    ssq = wave_sum(ssq); if (lane == 0) pg8::stat_add(stat_ptr(F, l, ST_SSC) + row, ssq);
}


typedef short bf16x8_t __attribute__((ext_vector_type(8)));
typedef short s16x4_t __attribute__((ext_vector_type(4)));
typedef float f32x16_t __attribute__((ext_vector_type(16)));
typedef float f32x2_t __attribute__((ext_vector_type(2)));
typedef __bf16 bf16x2_t __attribute__((ext_vector_type(2)));
typedef short v4i16_t __attribute__((ext_vector_type(4)));
typedef __attribute__((address_space(3))) const char* lds_cptr;
__device__ __forceinline__ s16x4_t vtr(lds_cptr p) { return __builtin_bit_cast(s16x4_t, __builtin_amdgcn_ds_read_tr16_b64_v4i16((__attribute__((address_space(3))) v4i16_t*)p)); }
__device__ __forceinline__ unsigned cvtpk(float lo, float hi) { f32x2_t v = {lo, hi}; bf16x2_t b = __builtin_convertvector(v, bf16x2_t); return __builtin_bit_cast(unsigned, b); }
__device__ __forceinline__ int crow(int r, int hi) { return (r & 3) + 8 * (r >> 2) + 4 * hi; }
__device__ __forceinline__ float relu_bits(float x) { const int i = (int)__float_as_uint(x); return __uint_as_float((unsigned)(i > 0 ? i : 0)); }
#define MFMA32(a, b, c) __builtin_amdgcn_mfma_f32_32x32x16_bf16((a), (b), (c), 0, 0, 0)

__device__ __forceinline__ void sb_mfma_unit(const Args& A, Frame& F, int l, int unit, LAS unsigned char* wl) {
    const int lane = lane_id(), r32 = lane & 31, hi = lane >> 5;
    const int qt = unit & 63, h = (unit >> 6) & 3, b = unit >> 8;
    const bf16* P = (const bf16*)(F.ws + WS_P); bf16* Ycat = (bf16*)(F.ws + WS_YCAT); stat_t* ssc = stat_ptr(F, l, ST_SSC);
    const int qrow0 = b * SEQ + 32 * qt;
    bf16x8_t qr[4];
#pragma unroll
    for (int ks = 0; ks < 4; ++ks) qr[ks] = *(const GAS bf16x8_t*)(P + (size_t)(qrow0 + r32) * NIN + PC_QC + h * 64 + ks * 16 + hi * 8);
    f32x16_t o0, o1;
#pragma unroll
    for (int r = 0; r < 16; ++r) { o0[r] = 0.f; o1[r] = 0.f; }
    float carry = 0.f;
    const int jt = qt >> 1;
    const lds_cptr vp = (lds_cptr)wl + ((lane >> 4) & 1) * 32 + (lane & 3) * 8 + (4 * hi + ((lane & 15) >> 2)) * 64;
    constexpr float LOG2E = 1.4426950408889634f;
    v4u vld[8]; bf16x8_t kf0[4], kf1[4];
#define SB_LOAD_TILE(it_) do { const int itt_ = (it_); const bool meta_ = itt_ < 0; const int kb_ = meta_ ? MREAL : b * SEQ + 64 * itt_; \
        _Pragma("unroll") for (int i = 0; i < 8; ++i) { int kl = (lane >> 3) + 8 * i; if (meta_ && kl > NMETA - 1) kl = NMETA - 1; \
            vld[i] = *(const GAS v4u*)(P + (size_t)(kb_ + kl) * NIN + PC_VC + h * 64 + (lane & 7) * 8); } \
        const int kr0 = (meta_ && r32 > NMETA - 1) ? NMETA - 1 : r32, kr1 = meta_ ? NMETA - 1 : 32 + r32; \
        _Pragma("unroll") for (int ks = 0; ks < 4; ++ks) { kf0[ks] = *(const GAS bf16x8_t*)(P + (size_t)(kb_ + kr0) * NIN + PC_KC + h * 64 + ks * 16 + hi * 8); \
                                                            kf1[ks] = *(const GAS bf16x8_t*)(P + (size_t)(kb_ + kr1) * NIN + PC_KC + h * 64 + ks * 16 + hi * 8); } } while (0)
    SB_LOAD_TILE(jt);
#pragma unroll 1
    for (int it = jt; it >= -1; --it) {
        const bool meta = it < 0;
        f32x16_t p0, p1;
#pragma unroll
        for (int r = 0; r < 16; ++r) { p0[r] = 0.f; p1[r] = 0.f; }
#pragma unroll
        for (int ks = 0; ks < 4; ++ks) { p0 = MFMA32(kf0[ks], qr[ks], p0); p1 = MFMA32(kf1[ks], qr[ks], p1); }
#pragma unroll
        for (int i = 0; i < 8; ++i) *(LAS v4u*)(wl + ((lane & 7) >> 2) * 4096 + ((lane >> 3) + 8 * i) * 64 + (lane & 3) * 16) = vld[i];
        if (it > -1) SB_LOAD_TILE(it - 1);
        const int lim = meta ? NMETA : (it == jt ? 32 * (qt & 1) + r32 : 64);
        float lk0[16], lk1[16];
#pragma unroll
        for (int r = 0; r < 16; ++r) {
            { const float Z = p0[r] * LOG2E; const float L = __builtin_amdgcn_logf(1.0f + __builtin_amdgcn_exp2f(-fabsf(Z))); const float nl = -(relu_bits(Z) + L);
              const bool valid = crow(r, hi) < lim; lk0[r] = valid ? nl : 0.f; p0[r] = valid ? Z + nl : -1.0e30f; }
            { const float Z = p1[r] * LOG2E; const float L = __builtin_amdgcn_logf(1.0f + __builtin_amdgcn_exp2f(-fabsf(Z))); const float nl = -(relu_bits(Z) + L);
              const bool valid = 32 + crow(r, hi) < lim; lk1[r] = valid ? nl : 0.f; p1[r] = valid ? Z + nl : -1.0e30f; }
        }
        float base[8]; float E = carry;
#pragma unroll
        for (int B = 7; B >= 0; --B) {
            const int rb = 4 * (B & 3);
            const float own = (B >> 2) ? ((lk1[rb] + lk1[rb + 1]) + (lk1[rb + 2] + lk1[rb + 3])) : ((lk0[rb] + lk0[rb + 1]) + (lk0[rb + 2] + lk0[rb + 3]));
            const auto rr = __builtin_amdgcn_permlane32_swap(__float_as_uint(own), __float_as_uint(own), false, false);
            const float lo_s = __uint_as_float(rr[0]), hi_s = __uint_as_float(rr[1]);
            base[B] = E + (hi ? 0.f : hi_s);
            E += lo_s + hi_s;
        }
        carry = E;
#pragma unroll
        for (int B = 0; B < 8; ++B) {
            const int rb = 4 * (B & 3);
            if (B >> 2) { const float l3 = base[B], l2 = l3 + lk1[rb + 3], l1 = l2 + lk1[rb + 2], l0 = l1 + lk1[rb + 1];
                p1[rb + 3] = __builtin_amdgcn_exp2f(p1[rb + 3] + l3); p1[rb + 2] = __builtin_amdgcn_exp2f(p1[rb + 2] + l2); p1[rb + 1] = __builtin_amdgcn_exp2f(p1[rb + 1] + l1); p1[rb] = __builtin_amdgcn_exp2f(p1[rb] + l0); }
            else { const float l3 = base[B], l2 = l3 + lk0[rb + 3], l1 = l2 + lk0[rb + 2], l0 = l1 + lk0[rb + 1];
                p0[rb + 3] = __builtin_amdgcn_exp2f(p0[rb + 3] + l3); p0[rb + 2] = __builtin_amdgcn_exp2f(p0[rb + 2] + l2); p0[rb + 1] = __builtin_amdgcn_exp2f(p0[rb + 1] + l1); p0[rb] = __builtin_amdgcn_exp2f(p0[rb] + l0); }
        }
        v4u pw[4];
#pragma unroll
        for (int j = 0; j < 4; ++j) { pw[0][j] = cvtpk(p0[2 * j], p0[2 * j + 1]); pw[1][j] = cvtpk(p0[8 + 2 * j], p0[8 + 2 * j + 1]); pw[2][j] = cvtpk(p1[2 * j], p1[2 * j + 1]); pw[3][j] = cvtpk(p1[8 + 2 * j], p1[8 + 2 * j + 1]); }
#pragma unroll
        for (int ks = 0; ks < 4; ++ks) {
            const s16x4_t a_lo = vtr(vp + ks * 1024), a_hi = vtr(vp + ks * 1024 + 512), b_lo = vtr(vp + 4096 + ks * 1024), b_hi = vtr(vp + 4096 + ks * 1024 + 512);
            const bf16x8_t v0 = (bf16x8_t){a_lo[0], a_lo[1], a_lo[2], a_lo[3], a_hi[0], a_hi[1], a_hi[2], a_hi[3]};
            const bf16x8_t v1 = (bf16x8_t){b_lo[0], b_lo[1], b_lo[2], b_lo[3], b_hi[0], b_hi[1], b_hi[2], b_hi[3]};
            const bf16x8_t pa = __builtin_bit_cast(bf16x8_t, pw[ks]);
            o0 = MFMA32(pa, v0, o0); o1 = MFMA32(pa, v1, o1); }
        if (__all(carry < -160.0f)) break;
    }
    LAS unsigned short* stg = (LAS unsigned short*)(wl + 8192);
#pragma unroll
    for (int r = 0; r < 16; ++r) { stg[crow(r, hi) * 64 + r32] = (unsigned short)f2bf(o0[r]); stg[crow(r, hi) * 64 + 32 + r32] = (unsigned short)f2bf(o1[r]); }
    LDS_WAIT(); asm volatile("" ::: "memory");
#pragma unroll
    for (int i = 0; i < 4; ++i) { const int row = i * 8 + (lane >> 3), ch = lane & 7; const v4u v = *(const LAS v4u*)(stg + row * 64 + ch * 8);
        float q = (bflo(v.x) * bflo(v.x) + bfhi(v.x) * bfhi(v.x)) + (bflo(v.y) * bflo(v.y) + bfhi(v.y) * bfhi(v.y)) + (bflo(v.z) * bflo(v.z) + bfhi(v.z) * bfhi(v.z)) + (bflo(v.w) * bflo(v.w) + bfhi(v.w) * bfhi(v.w));
        q += __shfl_xor(q, 1); q += __shfl_xor(q, 2); q += __shfl_xor(q, 4);
        if (ch == 0) pg8::stat_add(ssc + qrow0 + row, q);
        *(GAS v4u*)(Ycat + (size_t)(qrow0 + row) * 1024 + YC_C + h * 64 + ch * 8) = v; }
    LDS_WAIT(); asm volatile("" ::: "memory");
}

constexpr int DSA_HIST = 0, DSA_HIST_STRIDE = 257;
constexpr int DSA_ZC = 65792, DSA_ZC_STRIDE = 36;
constexpr int DSA_MASK = DSA_ZC + 64 * 36 * 4;
constexpr int DSA_Q = DSA_MASK + 64 * 34 * 2 * 4;
constexpr int DSA_BD = DSA_Q + 10 * 64 * 4;
constexpr int DSA_IQ = DSA_BD + 4 * 132 * 4, DSA_IQ_STRIDE = 528;
constexpr int DSA_END = DSA_IQ + 64 * DSA_IQ_STRIDE;
static_assert(DSA_END <= RING_BYTES, "DSA LDS map");
constexpr int DSA_CAP = 32;
constexpr unsigned KEY_ZERO = 0x80000000u;

__device__ __forceinline__ constexpr int crow0(int r) { return (r & 3) + 8 * (r >> 2); }
__device__ __forceinline__ unsigned off_a(unsigned row, unsigned ch) { return 2048u * (row >> 3) + 512u * (ch >> 2) + 64u * (row & 7) + 16u * ((ch & 3) ^ ((row >> 2) & 3)); }

__device__ __forceinline__ void dsa_scores(f32x16_t& s0, f32x16_t& s1, const bf16x8_t (&ikf)[2][4], const LAS unsigned char* iqrow, const float (&iw)[4]) {
#pragma unroll
    for (int r = 0; r < 16; ++r) { s0[r] = 0.f; s1[r] = 0.f; }
#pragma unroll
    for (int hp = 0; hp < 4; hp += 2) {
        f32x16_t a0, a1, b0, b1;
#pragma unroll
        for (int r = 0; r < 16; ++r) { a0[r] = 0.f; a1[r] = 0.f; b0[r] = 0.f; b1[r] = 0.f; }
#pragma unroll
        for (int ks = 0; ks < 4; ++ks) { const bf16x8_t qa = *(const LAS bf16x8_t*)(iqrow + hp * 128 + ks * 32), qb = *(const LAS bf16x8_t*)(iqrow + (hp + 1) * 128 + ks * 32);
            a0 = MFMA32(ikf[0][ks], qa, a0); a1 = MFMA32(ikf[1][ks], qa, a1); b0 = MFMA32(ikf[0][ks], qb, b0); b1 = MFMA32(ikf[1][ks], qb, b1); }
#pragma unroll
        for (int r = 0; r < 16; ++r) { s0[r] += iw[hp] * relu_bits(a0[r]); s1[r] += iw[hp] * relu_bits(a1[r]); }
#pragma unroll
        for (int r = 0; r < 16; ++r) { s0[r] += iw[hp + 1] * relu_bits(b0[r]); s1[r] += iw[hp + 1] * relu_bits(b1[r]); }
        __builtin_amdgcn_sched_barrier(0);
    }
}
__device__ __forceinline__ void dsa_load_ik(bf16x8_t (&ikf)[2][4], const bf16* P, int b, int j, int r32, int hi) {
    const int row0 = j == 0 ? MREAL + (r32 < NMETA ? r32 : NMETA - 1) : b * SEQ + 64 * (j - 1) + r32;
    const int row1 = j == 0 ? MREAL + NMETA - 1 : b * SEQ + 64 * (j - 1) + 32 + r32;
#pragma unroll
    for (int ks = 0; ks < 4; ++ks) { ikf[0][ks] = *(const GAS bf16x8_t*)(P + (size_t)row0 * NIN + PC_IK + ks * 16 + hi * 8);
                                     ikf[1][ks] = *(const GAS bf16x8_t*)(P + (size_t)row1 * NIN + PC_IK + ks * 16 + hi * 8); }
}


template <bool P0, bool EDGE>
__device__ __forceinline__ void dsa_hist_tile(const f32x16_t& s0, const f32x16_t& s1, LAS unsigned* hrow, const int shift, const unsigned psh, const int limh, unsigned& zcount) {
#pragma unroll
    for (int r = 0; r < 16; ++r) {
#pragma unroll
        for (int hf = 0; hf < 2; ++hf) {
            float sv = hf ? s1[r] : s0[r]; asm volatile("" : "+v"(sv) :: "memory");
            const unsigned u = __float_as_uint(sv);
            const unsigned key = u ^ ((unsigned)((int)u >> 31) | 0x80000000u);
            unsigned bin;
            if (P0) { bin = key >> 24;
                if (EDGE) { const bool valid = (32 * hf + crow0(r)) < limh; bin = valid ? bin : 256u; zcount += (valid && key == KEY_ZERO) ? 1u : 0u; }
                else zcount += (key == KEY_ZERO) ? 1u : 0u; }
            else { const unsigned d = (key >> shift) & 255u; bool m = (key >> (shift + 8)) == psh; if (EDGE) m = m && ((32 * hf + crow0(r)) < limh); bin = m ? d : 256u; }
            __hip_atomic_fetch_add(hrow + bin, 1u, __ATOMIC_RELAXED, __HIP_MEMORY_SCOPE_WORKGROUP);
        }
        if ((r & 1) == 1) asm volatile("" ::: "memory");
    }
}

__device__ __forceinline__ void dsa_unit(const Args& A, Frame& F, int l, int b, int qt) {
    const int lane = lane_id(), r32 = lane & 31, hi = lane >> 5, w = F.wave;
    LAS unsigned char* L = F.lds + RING_OFF;
    LAS unsigned* hist = (LAS unsigned*)(L + DSA_HIST); LAS unsigned* zc = (LAS unsigned*)(L + DSA_ZC); LAS unsigned* maskw = (LAS unsigned*)(L + DSA_MASK);
    LAS unsigned* qT = (LAS unsigned*)(L + DSA_Q); LAS unsigned* qK = qT + 64; LAS unsigned* qM = qT + 128; LAS unsigned* qJ = qT + 192; LAS unsigned* qR = qT + 256; LAS unsigned* qF = qT + 320; LAS unsigned* qT2 = qT + 384; LAS unsigned* qJ2 = qT + 448; LAS unsigned* qR2 = qT + 512; LAS unsigned* qC = qT + 576;
    LAS float* bd = (LAS float*)(L + DSA_BD);
    const bf16* P = (const bf16*)(F.ws + WS_P); bf16* Ycat = (bf16*)(F.ws + WS_YCAT);
    const int nt = qt + 2;
    const int t0 = 64 * qt, qrow0 = b * SEQ + t0;
    const int tid = w * 64 + lane;
    for (int i = tid; i < (DSA_MASK - DSA_HIST) / 4; i += 512) hist[i] = 0u;
    for (int i = tid; i < 4 * 132; i += 512) { const int h = i / 132, d = i % 132; bd[i] = A.in[2][t5_bucket(d) * 4 + h] * 1.4426950408889634f; }
    if (tid < 64) qF[tid] = 0u;
    {
        const int qh = w & 1, ts = w >> 1;
        const int ql = 32 * qh + r32;
        float iw[4];
        { const bf16* Pq = P + (size_t)(qrow0 + ql) * NIN;
#pragma unroll
          for (int h = 0; h < 4; ++h) iw[h] = bf2f(Pq[PC_IW + h]); }
#pragma unroll
        for (int i = 0; i < 4; ++i) { const int cidx = tid + 512 * i, row = cidx >> 5, ch = cidx & 31;
            *(LAS v4u*)(L + DSA_IQ + row * DSA_IQ_STRIDE + ch * 16) = *(const GAS v4u*)(P + (size_t)(qrow0 + row) * NIN + PC_IQ + ch * 8); }
        const LAS unsigned char* iqrow = L + DSA_IQ + ql * DSA_IQ_STRIDE + hi * 16;
        const int nq = NMETA + t0 + ql + 1;
        unsigned pref = 0u, Tq = 0u, candlim = 0u; int jstar = 1000, rprime = 0; bool fast = false;
        __syncthreads();
#pragma unroll 1
        for (int pass = 0; pass < 6; ++pass) {
            if (pass == 4) { if (qF[0] == 0u) continue; }
            const int shift = 24 - 8 * pass;
            bf16x8_t ikf[2][4];
            if (ts < nt) dsa_load_ik(ikf, P, b, ts, r32, hi);
#pragma unroll 1
            for (int j = ts; j < nt; j += 4) {
                f32x16_t s0, s1;
                dsa_scores(s0, s1, ikf, iqrow, iw);
                if (j + 4 < nt) dsa_load_ik(ikf, P, b, j + 4, r32, hi);
                const int lim = (j == 0) ? NMETA : ((j == nt - 1) ? ql + 1 : 64);
                const int limh = lim - 4 * hi;
                if (pass < 4) {
                    LAS unsigned* hrow = hist + ql * DSA_HIST_STRIDE;
                    const bool edge = (j == 0) || (j == nt - 1);
                    if (pass == 0) { unsigned zcount = 0u;
                        if (edge) dsa_hist_tile<true, true>(s0, s1, hrow, 24, 0u, limh, zcount); else dsa_hist_tile<true, false>(s0, s1, hrow, 24, 0u, limh, zcount);
                        __hip_atomic_fetch_add(zc + ql * DSA_ZC_STRIDE + j, zcount, __ATOMIC_RELAXED, __HIP_MEMORY_SCOPE_WORKGROUP);
                    } else { unsigned zdummy = 0u; const unsigned psh = pref >> (shift + 8);
                        if (edge) dsa_hist_tile<false, true>(s0, s1, hrow, shift, psh, limh, zdummy); else dsa_hist_tile<false, false>(s0, s1, hrow, shift, psh, limh, zdummy); }
                } else if (pass == 4) {
                    LAS unsigned* zrow = zc + ql * DSA_ZC_STRIDE;
#pragma unroll
                    for (int r = 0; r < 16; ++r) {
#pragma unroll
                        for (int hf = 0; hf < 2; ++hf) { const float s = (hf ? s1[r] : s0[r]); const unsigned key = mono_key(s);
                            const unsigned zs = ((32 * hf + crow0(r)) < limh && key == Tq) ? (unsigned)j : 35u; __hip_atomic_fetch_add(zrow + zs, 1u, __ATOMIC_RELAXED, __HIP_MEMORY_SCOPE_WORKGROUP); }
                        if ((r & 3) == 3) asm volatile("" ::: "memory"); }
                } else {
                    unsigned sel0 = 0u, sel1 = 0u;
                    LAS unsigned* lrow = hist + ql * DSA_HIST_STRIDE;
                    const unsigned posb = 64u * (unsigned)j + 4u * (unsigned)hi;
#define DSA_CAND(key_, kidx_) do { const unsigned slot_ = __hip_atomic_fetch_add(lrow, 1u, __ATOMIC_RELAXED, __HIP_MEMORY_SCOPE_WORKGROUP); \
                        if (slot_ < (unsigned)DSA_CAP) { lrow[1 + 2 * slot_] = (key_); lrow[2 + 2 * slot_] = posb + (unsigned)(kidx_); } } while (0)
                    if (!__any(j == jstar)) {
                        const unsigned Tj = (j < jstar) ? Tq : Tq + 1u;
                        if ((j == 0) || (j == nt - 1)) {
#pragma unroll
                            for (int r = 15; r >= 0; --r) {
                                { float sv = s0[r]; asm volatile("" : "+v"(sv) :: "memory"); const unsigned u = __float_as_uint(sv); const unsigned key = u ^ ((unsigned)((int)u >> 31) | 0x80000000u);
                                  sel0 = sel0 * 2u + ((key >= Tj && crow0(r) < limh) ? 1u : 0u); if ((key ^ Tq) < candlim && crow0(r) < limh) DSA_CAND(key, crow0(r)); }
                                { float sv = s1[r]; asm volatile("" : "+v"(sv) :: "memory"); const unsigned u = __float_as_uint(sv); const unsigned key = u ^ ((unsigned)((int)u >> 31) | 0x80000000u);
                                  sel1 = sel1 * 2u + ((key >= Tj && (32 + crow0(r)) < limh) ? 1u : 0u); if ((key ^ Tq) < candlim && (32 + crow0(r)) < limh) DSA_CAND(key, 32 + crow0(r)); } }
                        } else {
#pragma unroll
                            for (int r = 15; r >= 0; --r) {
                                { float sv = s0[r]; asm volatile("" : "+v"(sv) :: "memory"); const unsigned u = __float_as_uint(sv); const unsigned key = u ^ ((unsigned)((int)u >> 31) | 0x80000000u);
                                  sel0 = sel0 * 2u + ((key >= Tj) ? 1u : 0u); if ((key ^ Tq) < candlim) DSA_CAND(key, crow0(r)); }
                                { float sv = s1[r]; asm volatile("" : "+v"(sv) :: "memory"); const unsigned u = __float_as_uint(sv); const unsigned key = u ^ ((unsigned)((int)u >> 31) | 0x80000000u);
                                  sel1 = sel1 * 2u + ((key >= Tj) ? 1u : 0u); if ((key ^ Tq) < candlim) DSA_CAND(key, 32 + crow0(r)); } }
                        }
                    } else {
                    unsigned e0 = 0u, e1 = 0u, g0 = 0u, g1 = 0u;
#pragma unroll
                    for (int r = 15; r >= 0; --r) {
                        { const unsigned key = mono_key(s0[r]); const bool valid = crow0(r) < limh; e0 = e0 * 2u + ((valid && key == Tq) ? 1u : 0u); g0 = g0 * 2u + ((valid && key > Tq) ? 1u : 0u); }
                        { const unsigned key = mono_key(s1[r]); const bool valid = (32 + crow0(r)) < limh; e1 = e1 * 2u + ((valid && key == Tq) ? 1u : 0u); g1 = g1 * 2u + ((valid && key > Tq) ? 1u : 0u); } }
                    unsigned t0m = 0u, t1m = 0u;
                    if (j < jstar) { t0m = e0; t1m = e1; }
                    {
                        int E = 0; unsigned r0m = 0u, r1m = 0u;
#pragma unroll
                        for (int B = 0; B < 8; ++B) { const int rb = 4 * (B & 3); const unsigned em = (B >> 2) ? e1 : e0;
                            const int own = __popc((em >> rb) & 15u);
                            const auto rr = __builtin_amdgcn_permlane32_swap((unsigned)own, (unsigned)own, false, false);
                            const int lo_s = (int)rr[0], hi_s = (int)rr[1];
                            int rk = E + (hi ? lo_s : 0);
#pragma unroll
                            for (int i = 0; i < 4; ++i) { const bool isq = (em >> (rb + i)) & 1u; if (isq && rk < rprime) { if (B >> 2) r1m |= 1u << (rb + i); else r0m |= 1u << (rb + i); } rk += isq ? 1 : 0; }
                            E += lo_s + hi_s; }
                        if (j == jstar) { t0m = r0m; t1m = r1m; }
                    }
                    sel0 = g0 | t0m; sel1 = g1 | t1m;
                    if (__any(candlim != 0u)) {
#pragma unroll
                        for (int r = 0; r < 16; ++r) {
                            { float sv = s0[r]; asm volatile("" : "+v"(sv) :: "memory"); const unsigned key = mono_key(sv); if ((key ^ Tq) < candlim && crow0(r) < limh) DSA_CAND(key, crow0(r)); }
                            { float sv = s1[r]; asm volatile("" : "+v"(sv) :: "memory"); const unsigned key = mono_key(sv); if ((key ^ Tq) < candlim && (32 + crow0(r)) < limh) DSA_CAND(key, 32 + crow0(r)); } }
                    }
                    }
                    unsigned w0 = ((sel0 & 0xfu) | ((sel0 & 0xf0u) << 4) | ((sel0 & 0xf00u) << 8) | ((sel0 & 0xf000u) << 12)) << (4 * hi);
                    unsigned w1 = ((sel1 & 0xfu) | ((sel1 & 0xf0u) << 4) | ((sel1 & 0xf00u) << 8) | ((sel1 & 0xf000u) << 12)) << (4 * hi);
                    { const auto rr = __builtin_amdgcn_permlane32_swap(w0, w0, false, false); w0 = rr[0] | rr[1]; }
                    { const auto rr = __builtin_amdgcn_permlane32_swap(w1, w1, false, false); w1 = rr[0] | rr[1]; }
                    if (hi == 0) { maskw[(ql * 34 + j) * 2] = w0; maskw[(ql * 34 + j) * 2 + 1] = w1; }
                }
            }
            if (pass == 5) {
                if (fast) {
                    __syncthreads();
#pragma unroll 1
                    for (int it = 0; it < 4; ++it) { const int q = 8 * w + 2 * it + hi, i = r32;
                        const LAS unsigned* lr = hist + q * DSA_HIST_STRIDE; const unsigned c0 = lr[0]; const int cnt = (int)(c0 < (unsigned)DSA_CAP ? c0 : (unsigned)DSA_CAP); const int kr = (int)qK[q];
                        unsigned mk = 0u, mp = 0u; if (i < cnt) { mk = lr[1 + 2 * i]; mp = lr[2 + 2 * i]; }
                        int rank = 0;
#pragma unroll 1
                        for (int jj = 0; jj < DSA_CAP; ++jj) { if (!__any(jj < cnt)) break;
                            const unsigned kj = lr[1 + 2 * jj], pj = lr[2 + 2 * jj]; rank += (jj < cnt && (kj > mk || (kj == mk && pj < mp))) ? 1 : 0; }
                        if (i < cnt && rank < kr) __hip_atomic_fetch_or(maskw + (q * 34 + (int)(mp >> 6)) * 2 + (int)((mp >> 5) & 1u), 1u << (mp & 31u), __ATOMIC_RELAXED, __HIP_MEMORY_SCOPE_WORKGROUP); }
                }
                break; }
            __syncthreads();
            if (pass < 4) {
                const int qi = lane >> 3, part = lane & 7, q = 8 * w + qi; LAS unsigned* hr = hist + q * DSA_HIST_STRIDE + 32 * part;
                const int nqq = NMETA + t0 + q + 1; const int krem = (pass == 0) ? (nqq < TOPK ? nqq : TOPK) : (int)qK[q];
                int c[32]; int tot = 0;
#pragma unroll
                for (int i = 0; i < 32; ++i) { c[i] = (int)hr[i]; tot += c[i]; }
#pragma unroll
                for (int i = 0; i < 32; ++i) hr[i] = 0u;
                int S = tot;
#pragma unroll
                for (int off = 1; off < 8; off <<= 1) { const int t = __shfl_down(S, off); if (part + off < 8) S += t; }
                const int above = S - tot; const bool here = (above < krem) && (S >= krem);
                int a = above, bin = 0, newk = 0, cb = 0; bool done = false;
#pragma unroll
                for (int i = 31; i >= 0; --i) { const bool f = !done && (a + c[i] >= krem); bin = f ? i : bin; newk = f ? krem - a : newk; cb = f ? c[i] : cb; done = done || f; a += done ? 0 : c[i]; }
                if (here) { const unsigned np = ((pass == 0) ? 0u : qT[q]) | ((unsigned)(bin + 32 * part) << shift); qT[q] = np; qK[q] = (unsigned)newk; qM[q] = (unsigned)cb;
                    if (pass == 3 && cb > newk && np != KEY_ZERO) qF[0] = 1u;
                    if (pass == 1) {
                        if (cb <= DSA_CAP) { qT2[q] = np | 0xffffu; qJ2[q] = 0xffffffffu; qR2[q] = 0u; qC[q] = 0x10000u; }
                        else if (np == KEY_ZERO) { const LAS unsigned* zr = zc + q * DSA_ZC_STRIDE; int acc = 0, js = 1000, rp = 0;
#pragma unroll 1
                            for (int jj = 0; jj < nt; ++jj) { const int cz = (int)zr[jj]; if (js == 1000 && acc + cz >= newk) { js = jj; rp = newk - acc; } acc += cz; }
                            if (acc == cb) { qT2[q] = KEY_ZERO; qJ2[q] = (unsigned)js; qR2[q] = (unsigned)rp; qC[q] = 0u; } else qF[1] = 1u; }
                        else qF[1] = 1u; } }
            }
            if (pass == 3 || pass == 4) {
                __syncthreads();
                const bool generic = qF[0] != 0u;
                if (pass == 4 || !generic) {
#pragma unroll 1
                    for (int i = 0; i < 8; ++i) { const int q = 8 * w + i; const int m = (int)qM[q], rn = (int)qK[q];
                        int js = 1000, rp = 0;
                        if (m > rn) { const int c = lane < nt ? (int)zc[q * DSA_ZC_STRIDE + lane] : 0; int inc = c;
#pragma unroll
                            for (int off = 1; off < 64; off <<= 1) { const int t = __shfl_up(inc, off); if (lane >= off) inc += t; }
                            const bool here = (inc >= rn) && (inc - c < rn);
                            const unsigned long long mm = __ballot(here); const int src = mm ? (__ffsll((long long)mm) - 1) : 0;
                            js = src; rp = rn - __shfl(inc - c, src); }
                        if (lane == 0) { qJ[q] = (unsigned)js; qR[q] = (unsigned)rp; } }
                } else {
                    for (int i = tid; i < 64 * DSA_ZC_STRIDE; i += 512) zc[i] = 0u;
                }
            }
            __syncthreads();
            pref = qT[ql]; Tq = pref; jstar = (int)qJ[ql]; rprime = (int)qR[ql];
            if (pass == 1 && qF[1] == 0u) { fast = true; Tq = qT2[ql]; jstar = (int)qJ2[ql]; rprime = (int)qR2[ql]; candlim = qC[ql]; pass = 4; }
        }
    }
    __syncthreads();
    {
        const int h = w & 3, qh2 = w >> 2, ql = 32 * qh2 + r32;
        const stat_t* sskv = stat_ptr(F, l, ST_SSKV);
        LAS unsigned short* QL = (LAS unsigned short*)(L + w * 8192);
        {
            bf16x8_t qaf[4];
#pragma unroll
            for (int ks = 0; ks < 4; ++ks) qaf[ks] = *(const GAS bf16x8_t*)(P + (size_t)(qrow0 + ql) * NIN + PC_QA + h * 64 + ks * 16 + hi * 8);
#pragma unroll 1
            for (int c = 0; c < 4; ++c) {
                f32x16_t d;
#pragma unroll
                for (int r = 0; r < 16; ++r) d[r] = 0.f;
                const GAS bf16x8_t* wf = (const GAS bf16x8_t*)(F.ws + WS_WUKF) + ((size_t)(l * 4 + h) * 16 + 4 * c) * 64 + lane;
#pragma unroll
                for (int ks = 0; ks < 4; ++ks) d = MFMA32(wf[64 * ks], qaf[ks], d);
#pragma unroll
                for (int r = 0; r < 16; ++r) QL[r32 * 128 + 32 * c + crow(r, hi)] = (unsigned short)f2bf(d[r]); }
        }
        LDS_WAIT(); asm volatile("" ::: "memory");
        bf16x8_t qlf[8];
#pragma unroll
        for (int s = 0; s < 8; ++s) qlf[s] = *(const LAS bf16x8_t*)(QL + r32 * 128 + 16 * s + 8 * hi);
        LDS_WAIT(); asm volatile("" ::: "memory");
        __syncthreads();
        LAS unsigned char* ckb = L;
        LAS float* rkb = (LAS float*)(L + DSA_IQ);
#define DSA_DMA(j_, buf_) do { const int jj_ = (j_); const int row_ = 8 * w + ((lane >> 2) & 7); \
            const int grow_ = jj_ == 0 ? MREAL + (row_ < NMETA ? row_ : NMETA - 1) : b * SEQ + 64 * (jj_ - 1) + row_; \
            const bf16* gp_ = P + (size_t)grow_ * NIN + PC_CKV + (4 * (lane >> 5) + ((lane & 3) ^ ((row_ >> 2) & 3))) * 8; \
            __builtin_amdgcn_global_load_lds((const unsigned*)gp_, (LAS unsigned*)(ckb + (buf_) * 16384 + 2048 * w), 16, 0, 0); \
            __builtin_amdgcn_global_load_lds((const unsigned*)(gp_ + 64), (LAS unsigned*)(ckb + (buf_) * 16384 + 2048 * w + 1024), 16, 0, 0); } while (0)
        DSA_DMA(0, 0); if (1 < nt) DSA_DMA(1, 1);
        for (int i = tid; i < nt * 64; i += 512) { const int jj_ = i >> 6, kk_ = i & 63; const int grow_ = jj_ == 0 ? MREAL + (kk_ < NMETA ? kk_ : NMETA - 1) : b * SEQ + 64 * (jj_ - 1) + kk_;
            const float rks_ = rsqrtf(stat_get(sskv + grow_) * (1.0f / 128.0f) + pg8::RMS_EPS); rkb[jj_ * 128 + kk_] = rks_; rkb[jj_ * 128 + 64 + kk_] = rks_ * 1.4426950408889634f; }
        asm volatile("s_waitcnt vmcnt(0)" ::: "memory");
        __syncthreads();
        f32x16_t oT[4];
#pragma unroll
        for (int c = 0; c < 4; ++c)
#pragma unroll
            for (int r = 0; r < 16; ++r) oT[c][r] = 0.f;
        float mrun = -1.0e30f, lrun = 0.f;
        constexpr float LOG2E = 1.4426950408889634f;
        const float bfar = bd[h * 132 + 128]; const LAS float* bdh = bd + h * 132;
        const unsigned xr = (r32 >> 2) & 3u, rowpart = 2048u * (r32 >> 3) + 64u * (r32 & 7);
        const unsigned rrA = rowpart + 16u * ((unsigned)hi ^ xr), rrB = rowpart + 16u * (((unsigned)hi ^ xr) ^ 2u);
        const unsigned yb = 2u * ((lane >> 4) & 1) + ((lane & 3) >> 1), trpart = 64u * (4u * hi + ((lane & 15) >> 2)) + 8u * (lane & 1);
        const unsigned trA = trpart + 16u * (yb ^ (unsigned)hi), trB = trpart + 16u * (yb ^ (unsigned)hi ^ 2u);
        if (qh2 == 0) __builtin_amdgcn_s_setprio(2);
#pragma unroll 1
        for (int j0 = 0; j0 < nt; j0 += 2) {
            if (j0 + 2 < nt) DSA_DMA(j0 + 2, (j0 + 2) & 3);
            if (j0 + 3 < nt) DSA_DMA(j0 + 3, (j0 + 3) & 3);
#pragma unroll
            for (int jj = 0; jj < 2; ++jj) { const int j = j0 + jj; if (j >= nt) break;
            const LAS unsigned char* tb = ckb + (j & 3) * 16384; const LAS float* rk = rkb + j * 128;
            f32x16_t p0, p1;
#pragma unroll
            for (int r = 0; r < 16; ++r) { p0[r] = 0.f; p1[r] = 0.f; }
            { const LAS unsigned char* ra = tb + rrA; const LAS unsigned char* rb_ = tb + rrB;
              bf16x8_t a0 = *(const LAS bf16x8_t*)(ra), a1 = *(const LAS bf16x8_t*)(ra + 8192);
#pragma unroll
              for (int s = 0; s < 8; ++s) { bf16x8_t n0 = a0, n1 = a1;
                if (s < 7) { const LAS unsigned char* bp = ((s + 1) & 1) ? rb_ : ra; n0 = *(const LAS bf16x8_t*)(bp + 512 * ((s + 1) >> 1)); n1 = *(const LAS bf16x8_t*)(bp + 512 * ((s + 1) >> 1) + 8192); }
                p0 = MFMA32(a0, qlf[s], p0); p1 = MFMA32(a1, qlf[s], p1); a0 = n0; a1 = n1; } }
            const unsigned mw0 = maskw[(ql * 34 + j) * 2] >> (4 * hi), mw1 = maskw[(ql * 34 + j) * 2 + 1] >> (4 * hi);
            const int dbase = ((j == 0) ? (NMETA + t0 + ql) : (t0 + ql - 64 * (j - 1))) - 4 * hi;
            const bool nearb = __any((dbase - 63) < 128);
            const LAS float* rkh = rk + 4 * hi;
            float mx = -INFINITY;
            const unsigned NINF = 0xff800000u;
#define DSA_LOGITS(NEAR_) \
            _Pragma("unroll") for (int g = 0; g < 4; ++g) {        \
                const f32x4 ka = *(const LAS f32x4*)(rkh + 64 + 8 * g), kb = *(const LAS f32x4*)(rkh + 64 + 32 + 8 * g);        \
                _Pragma("unroll") for (int i = 0; i < 4; ++i) { const int r = 4 * g + i, c0 = 8 * g + i; \
                    float x0 = p0[r], x1 = p1[r]; asm volatile("" : "+v"(x0), "+v"(x1) :: "memory");        \
                    float b0 = bfar, b1 = bfar; \
                    if (NEAR_) { int d0 = dbase - c0; d0 = d0 < 0 ? 0 : (d0 > 128 ? 128 : d0); int d1 = dbase - 32 - c0; d1 = d1 < 0 ? 0 : (d1 > 128 ? 128 : d1); b0 = bdh[d0]; b1 = bdh[d1]; } \
                    const unsigned v0 = __float_as_uint(fmaf(x0, ka[i], b0)), v1 = __float_as_uint(fmaf(x1, kb[i], b1)); \
                    const unsigned m0 = (unsigned)(((int)(mw0 << (31 - c0))) >> 31), m1 = (unsigned)(((int)(mw1 << (31 - c0))) >> 31);        \
                    const float y0 = __uint_as_float((m0 & v0) | (~m0 & NINF)), y1 = __uint_as_float((m1 & v1) | (~m1 & NINF)); \
                    p0[r] = y0; p1[r] = y1; asm("v_max3_f32 %0, %1, %2, %3" : "=v"(mx) : "v"(mx), "v"(y0), "v"(y1)); } }
            if (nearb) { DSA_LOGITS(true) } else { DSA_LOGITS(false) }
#undef DSA_LOGITS
            { const auto rr = __builtin_amdgcn_permlane32_swap(__float_as_uint(mx), __float_as_uint(mx), false, false); mx = fmaxf(__uint_as_float(rr[0]), __uint_as_float(rr[1])); }
            const float mnew = fmaxf(mrun, mx);
            const float scl = __builtin_amdgcn_exp2f(mrun - mnew);
            if (__any(mnew > mrun)) {
#pragma unroll
                for (int c = 0; c < 4; ++c)
#pragma unroll
                    for (int r = 0; r < 16; ++r) oT[c][r] *= scl;
            }
            mrun = mnew; f32x2_t psv = (f32x2_t){0.f, 0.f}; const f32x2_t mv = (f32x2_t){mnew, mnew};
#pragma unroll
            for (int g = 0; g < 4; ++g) {
                const f32x4 ka = *(const LAS f32x4*)(rkh + 8 * g), kb = *(const LAS f32x4*)(rkh + 32 + 8 * g);
#pragma unroll
                for (int i = 0; i < 4; i += 2) { const int r = 4 * g + i;
                    f32x2_t xa = (f32x2_t){p0[r], p0[r + 1]}, xb = (f32x2_t){p1[r], p1[r + 1]}; asm volatile("" : "+v"(xa), "+v"(xb) :: "memory");
                    xa = xa - mv; xb = xb - mv;
                    const f32x2_t ea = (f32x2_t){__builtin_amdgcn_exp2f(xa.x), __builtin_amdgcn_exp2f(xa.y)}, eb = (f32x2_t){__builtin_amdgcn_exp2f(xb.x), __builtin_amdgcn_exp2f(xb.y)};
                    psv = psv + ea; psv = psv + eb;
                    const f32x2_t wa = ea * (f32x2_t){ka[i], ka[i + 1]}, wb = eb * (f32x2_t){kb[i], kb[i + 1]};
                    p0[r] = wa.x; p0[r + 1] = wa.y; p1[r] = wb.x; p1[r + 1] = wb.y; } }
            float ps = psv.x + psv.y;
            { const auto rr = __builtin_amdgcn_permlane32_swap(__float_as_uint(ps), __float_as_uint(ps), false, false); ps = __uint_as_float(rr[0]) + __uint_as_float(rr[1]); }
            lrun = lrun * scl + ps;
            v4u pw[4];
#pragma unroll
            for (int i = 0; i < 4; ++i) { pw[0][i] = cvtpk(p0[2 * i], p0[2 * i + 1]); pw[1][i] = cvtpk(p0[8 + 2 * i], p0[8 + 2 * i + 1]); pw[2][i] = cvtpk(p1[2 * i], p1[2 * i + 1]); pw[3][i] = cvtpk(p1[8 + 2 * i], p1[8 + 2 * i + 1]); }
            { const lds_cptr t0p = (lds_cptr)(tb + trA), t1p = (lds_cptr)(tb + trB);
              s16x4_t lo = vtr(t0p), hh = vtr(t1p + 2048);
#pragma unroll
              for (int i = 0; i < 16; ++i) { const int ks = i >> 2, c = i & 3;
                s16x4_t lo2 = lo, hh2 = hh;
                if (i < 15) { const int ks2 = (i + 1) >> 2, c2 = (i + 1) & 3; lo2 = vtr(t0p + 4096 * ks2 + 512 * c2); hh2 = vtr(t1p + 4096 * ks2 + 2048 + 512 * c2); }
                const bf16x8_t av = (bf16x8_t){lo[0], lo[1], lo[2], lo[3], hh[0], hh[1], hh[2], hh[3]};
                oT[c] = MFMA32(av, __builtin_bit_cast(bf16x8_t, pw[ks]), oT[c]);
                lo = lo2; hh = hh2; } }
            }
            asm volatile("s_waitcnt vmcnt(0)" ::: "memory");
            __syncthreads();
        }
        __builtin_amdgcn_s_setprio(0);
        { const int lane = lane_id(), r32 = lane & 31, hi = lane >> 5;
        const float linv = 1.0f / lrun;
        f32x16_t ot[2];
#pragma unroll
        for (int db = 0; db < 2; ++db)
#pragma unroll
            for (int r = 0; r < 16; ++r) ot[db][r] = 0.f;
#pragma unroll
        for (int c = 0; c < 4; ++c) {
#pragma unroll
            for (int s = 0; s < 2; ++s) {
                v4u pk;
#pragma unroll
                for (int i = 0; i < 4; ++i) pk[i] = cvtpk(oT[c][8 * s + 2 * i] * linv, oT[c][8 * s + 2 * i + 1] * linv);
                const bf16x8_t bfrag = __builtin_bit_cast(bf16x8_t, pk);
#pragma unroll
                for (int db = 0; db < 2; ++db) {
                    const bf16x8_t wa = *((const GAS bf16x8_t*)(F.ws + WS_WUVF) + ((size_t)(l * 4 + h) * 16 + 4 * c + 2 * s + db) * 64 + lane);
                    ot[db] = MFMA32(wa, bfrag, ot[db]); } } }
        LAS unsigned short* stg = (LAS unsigned short*)(L + 36864 + w * 4096);
#pragma unroll
        for (int db = 0; db < 2; ++db)
#pragma unroll
            for (int r = 0; r < 16; ++r) stg[r32 * 64 + 32 * db + crow(r, hi)] = (unsigned short)f2bf(ot[db][r]);
        LDS_WAIT(); asm volatile("" ::: "memory");
        stat_t* ssa = stat_ptr(F, l, ST_SSA);
#pragma unroll
        for (int i = 0; i < 4; ++i) { const int row = i * 8 + (lane >> 3), ch = lane & 7; const v4u v = *(const LAS v4u*)(stg + row * 64 + ch * 8);
            float q = (bflo(v.x) * bflo(v.x) + bfhi(v.x) * bfhi(v.x)) + (bflo(v.y) * bflo(v.y) + bfhi(v.y) * bfhi(v.y)) + (bflo(v.z) * bflo(v.z) + bfhi(v.z) * bfhi(v.z)) + (bflo(v.w) * bflo(v.w) + bfhi(v.w) * bfhi(v.w));
            q += __shfl_xor(q, 1); q += __shfl_xor(q, 2); q += __shfl_xor(q, 4);
            if (ch == 0) pg8::stat_add(ssa + qrow0 + 32 * qh2 + row, q);
            *(GAS v4u*)(Ycat + (size_t)(qrow0 + 32 * qh2 + row) * 1024 + YC_A + h * 64 + ch * 8) = v; }
        LDS_WAIT(); asm volatile("" ::: "memory");
        }
    }
    __syncthreads();
}


constexpr int S5T = 32, S5NC = SEQ / S5T, S5RG = BATCH * S5NC, S5KU = 640;
constexpr size_t WS_U = 376 * MiB, WS_TZ = 416 * MiB, TZ_LAYER = 20 * MiB, WS_MG = 456 * MiB, MG_LAYER = 4 * MiB, WS_HQ = 464 * MiB, WS_END2 = 497 * MiB;
static_assert(WS_HQ + (size_t)MROWS * 1024 <= WS_WUKF && WS_WUVF + 128 * 1024 <= WS_END2 && WS_END2 <= 512 * MiB, "HQ buffer / fragment tables");
static_assert((size_t)32 * S5RG * S5KU * 2 <= WS_TZ - WS_U && (size_t)32 * 512 * S5KU * 2 <= TZ_LAYER && (size_t)32 * 128 * 512 * 2 <= MG_LAYER, "S5 buffers");

struct S5P { float lrdt, lidt, fr, fi; };
__device__ __forceinline__ S5P s5_params(const Args& A, int lg, int p) {
    const float dt = expf(A.in[10][lg]), lr = A.in[8][lg * 64 + p], li = A.in[9][lg * 64 + p];
    const float mag = expf(lr * dt), ar = mag * cosf(li * dt), ai = mag * sinf(li * dt);
    const float den = lr * lr + li * li, nr = ar - 1.0f, ni = ai;
    S5P o; o.lrdt = lr * dt; o.lidt = li * dt; o.fr = (nr * lr + ni * li) / den; o.fi = (ni * lr - nr * li) / den; return o;
}
__device__ __forceinline__ void s5_apow(const S5P& q, int n, float& re, float& im) { const float m = expf(q.lrdt * (float)n); re = m * cosf(q.lidt * (float)n); im = m * sinf(q.lidt * (float)n); }

__device__ __forceinline__ void s5_build_item(const Args& A, Frame& F, int l, int kind, int g, int x, LAS float* scr) {
    const int lane = lane_id(), lg = l * 32 + g, p = lane;
    bf16* TZ = (bf16*)(F.ws + WS_TZ + (size_t)l * TZ_LAYER) + (size_t)g * 512 * S5KU;
    bf16* MG = (bf16*)(F.ws + WS_MG + (size_t)l * MG_LAYER) + (size_t)g * 128 * 512;
    const S5P q = s5_params(A, lg, p);
    if (kind == 0) {
        const int d = x;
        float pr, pi; s5_apow(q, d, pr, pi);
        LDS_WAIT(); asm volatile("" ::: "memory");
#pragma unroll
        for (int ch = 0; ch < 16; ++ch) { const float br = A.in[11][((size_t)lg * 64 + p) * 16 + ch], bi = A.in[12][((size_t)lg * 64 + p) * 16 + ch];
            const float b1r = q.fr * br - q.fi * bi, b1i = q.fr * bi + q.fi * br;
            scr[p * 34 + ch] = pr * b1r - pi * b1i; scr[p * 34 + 16 + ch] = pr * b1i + pi * b1r; }
        LDS_WAIT(); asm volatile("" ::: "memory");
        const int ch = lane >> 2, c4 = 4 * (lane & 3); float k0 = 0.f, k1 = 0.f, k2 = 0.f, k3 = 0.f;
#pragma unroll 16
        for (int pp = 0; pp < 64; ++pp) { const float cr = A.in[13][((size_t)lg * 16 + ch) * 64 + pp], ci = A.in[14][((size_t)lg * 16 + ch) * 64 + pp]; const LAS float* xr = scr + pp * 34 + c4; const LAS float* xi = xr + 16;
            k0 += cr * xr[0] - ci * xi[0]; k1 += cr * xr[1] - ci * xi[1]; k2 += cr * xr[2] - ci * xi[2]; k3 += cr * xr[3] - ci * xi[3]; }
        const unsigned long long kv = (unsigned long long)pk2(k0, k1) | ((unsigned long long)pk2(k2, k3) << 32);
        for (int tau = d; tau < S5T; ++tau) *(GAS unsigned long long*)(TZ + (size_t)(tau * 16 + ch) * S5KU + (tau - d) * 16 + c4) = kv;
        if (d > 0) for (int tau = 0; tau + d < S5T; ++tau) *(GAS unsigned long long*)(TZ + (size_t)(tau * 16 + ch) * S5KU + (tau + d) * 16 + c4) = 0ull;
        LDS_WAIT(); asm volatile("" ::: "memory");
    } else if (kind == 1) {
        const int tau = x; float pr, pi; s5_apow(q, tau + 1, pr, pi);
#pragma unroll 4
        for (int ch = 0; ch < 16; ++ch) { const float cr = A.in[13][((size_t)lg * 16 + ch) * 64 + p], ci = A.in[14][((size_t)lg * 16 + ch) * 64 + p];
            const float wr_ = cr * pr - ci * pi, wi_ = cr * pi + ci * pr;
            bf16* rowp = TZ + (size_t)(tau * 16 + ch) * S5KU + 512;
            rowp[p] = (bf16)f2bf(wr_); rowp[64 + p] = (bf16)f2bf(-wi_); }
    } else {
        const int sg = x; float pr, pi; s5_apow(q, S5T - 1 - sg, pr, pi);
        unsigned wre[8], wim[8];
#pragma unroll
        for (int c2 = 0; c2 < 8; ++c2) { float vr[2], vi[2];
#pragma unroll
            for (int e = 0; e < 2; ++e) { const int ch = 2 * c2 + e; const float br = A.in[11][((size_t)lg * 64 + p) * 16 + ch], bi = A.in[12][((size_t)lg * 64 + p) * 16 + ch];
                const float b1r = q.fr * br - q.fi * bi, b1i = q.fr * bi + q.fi * br; vr[e] = pr * b1r - pi * b1i; vi[e] = pr * b1i + pi * b1r; }
            wre[c2] = pk2(vr[0], vr[1]); wim[c2] = pk2(vi[0], vi[1]); }
        GAS v4u* r0 = (GAS v4u*)(MG + (size_t)(2 * p) * 512 + sg * 16); GAS v4u* r1 = (GAS v4u*)(MG + (size_t)(2 * p + 1) * 512 + sg * 16);
        r0[0] = (v4u){wre[0], wre[1], wre[2], wre[3]}; r0[1] = (v4u){wre[4], wre[5], wre[6], wre[7]};
        r1[0] = (v4u){wim[0], wim[1], wim[2], wim[3]}; r1[1] = (v4u){wim[4], wim[5], wim[6], wim[7]};
    }
}

typedef float f32x4_t __attribute__((ext_vector_type(4)));
__device__ __forceinline__ void s5_scan_task(const Args& A, Frame& F, int l, int g) {
    const int lane = lane_id(), w = F.wave, bcol = lane & 15, kg = lane >> 4, lg = l * 32 + g;
    const bf16* P = (const bf16*)(F.ws + WS_P);
    bf16* U = (bf16*)(F.ws + WS_U) + (size_t)g * S5RG * S5KU;
    const bf16* MG = (const bf16*)(F.ws + WS_MG + (size_t)l * MG_LAYER) + (size_t)g * 128 * 512;
    LAS unsigned char* ring = F.lds + RING_OFF;
    asm volatile("s_waitcnt vmcnt(0)" ::: "memory");
    __syncthreads();
#define S5_DMA(k_) do { const int kk_ = (k_); _Pragma("unroll") for (int i_ = 0; i_ < 2; ++i_) { const int r_ = 2 * w + i_; \
        __builtin_amdgcn_global_load_lds((const unsigned*)(U + (size_t)(r_ * S5NC + kk_) * S5KU + 8 * (lane ^ r_)), (LAS unsigned*)(ring + (kk_ & 7) * 16384 + r_ * 1024), 16, 0, 0); } } while (0)
#pragma unroll
    for (int k0 = 0; k0 < 7; ++k0) S5_DMA(k0);
    bf16x8_t af[16];
#pragma unroll
    for (int ks = 0; ks < 16; ++ks) af[ks] = *(const GAS bf16x8_t*)(MG + (size_t)(16 * w + bcol) * 512 + 32 * ks + 8 * kg);
    const int pA = 8 * w + 2 * kg;
    float aTr[2], aTi[2];
#pragma unroll
    for (int e = 0; e < 2; ++e) { const S5P q = s5_params(A, lg, pA + e); s5_apow(q, S5T, aTr[e], aTi[e]); }
    f32x4_t h;
    {
        f32x4_t s = (f32x4_t){0.f, 0.f, 0.f, 0.f};
#pragma unroll
        for (int ks = 0; ks < 16; ++ks) { const int sg = 2 * ks + (kg >> 1);
            if (sg >= 16) { const bf16x8_t bfm = *(const GAS bf16x8_t*)(P + (size_t)(MREAL + sg - 16) * NIN + PC_UB + g * 16 + 8 * (kg & 1)); s = __builtin_amdgcn_mfma_f32_16x16x32_bf16(af[ks], bfm, s, 0, 0, 0); } }
        h = s;
        bf16* hp = U + (size_t)(bcol * S5NC) * S5KU + 512 + pA;
        *(GAS unsigned*)hp = pk2(h[0], h[2]); *(GAS unsigned*)(hp + 64) = pk2(h[1], h[3]);
    }
    const unsigned lbase = (unsigned)bcol * 1024u + 16u * (unsigned)((kg ^ bcol) & 3), bc2 = (unsigned)bcol >> 2;
#pragma unroll 1
    for (int c = 0; c < S5NC - 1; ++c) {
        if (c <= S5NC - 2 - 6) asm volatile("s_waitcnt vmcnt(12)" ::: "memory"); else asm volatile("s_waitcnt vmcnt(0)" ::: "memory");
        __syncthreads();
        if (c + 7 <= S5NC - 2) S5_DMA(c + 7);
        const LAS unsigned char* bufp = ring + (c & 7) * 16384 + lbase;
        f32x4_t s4[4];
#pragma unroll
        for (int j = 0; j < 4; ++j) s4[j] = (f32x4_t){0.f, 0.f, 0.f, 0.f};
#pragma unroll
        for (int m = 0; m < 4; ++m)
#pragma unroll
            for (int j = 0; j < 4; ++j) { const bf16x8_t bfr = *(const LAS bf16x8_t*)(bufp + 256 * m + 64u * ((unsigned)j ^ bc2)); s4[j] = __builtin_amdgcn_mfma_f32_16x16x32_bf16(af[4 * m + j], bfr, s4[j], 0, 0, 0); }
        const f32x4_t s = (s4[0] + s4[1]) + (s4[2] + s4[3]);
        { const float r0 = aTr[0] * h[0] - aTi[0] * h[1] + s[0], i0 = aTr[0] * h[1] + aTi[0] * h[0] + s[1], r1 = aTr[1] * h[2] - aTi[1] * h[3] + s[2], i1 = aTr[1] * h[3] + aTi[1] * h[2] + s[3];
          h = (f32x4_t){r0, i0, r1, i1}; }
        bf16* hp = U + (size_t)(bcol * S5NC + (c + 1)) * S5KU + 512 + pA;
        *(GAS unsigned*)hp = pk2(h[0], h[2]); *(GAS unsigned*)(hp + 64) = pk2(h[1], h[3]);
    }
#undef S5_DMA
    __syncthreads();
}

struct S5Order {
    int G, c;
    __device__ __forceinline__ bool next(int i, pg8::Unit& u) const { const int L = i * G + c; if (L >= 256) return false; const int g = L >> 3, wi = L & 7; u.pm = 4 * g + (wi >> 1); u.pn = 2 * g + (wi & 1); return true; }
    __device__ __forceinline__ void a_ready(const pg8::Unit&) const {}
    __device__ __forceinline__ void done(const pg8::Unit&) const {}
};
namespace pg8 {
struct EpiS5 {
    static constexpr bool PERM = true, AFTER_DRAIN = false; static constexpr int MIDT = 0, MIDT2 = 0;
    const bf16_t* Pm; bf16_t* YG; const float* dsk;
    __device__ __forceinline__ void operator()(const f32x4 (&acc)[2][2][4][2], const Unit& u, int wr, int wc, int fr, int fq) const {
        const int g = u.pm >> 2, rg0 = (u.pm & 3) * BM + wr * 64 + fr, cg0 = (u.pn & 1) * BM + wc * 32 + 8 * fq;
        const int colq = g * 16 + (cg0 & 15);
        const f32x4 d0 = *(const PG8_GAS f32x4*)(dsk + colq), d1 = *(const PG8_GAS f32x4*)(dsk + colq + 4);
#pragma unroll
        for (int ai = 0; ai < 2; ++ai) {
            u32x4 ul[4][2];
#pragma unroll
            for (int m = 0; m < 4; ++m) { const int rg = rg0 + ai * HALF + m * 16, b = rg >> 6, c = rg & 63;
#pragma unroll
                for (int bj = 0; bj < 2; ++bj) { const int cg = cg0 + bj * HALF, tau = cg >> 4, ch = cg & 15; const size_t row = (size_t)b * 2048 + c * 32 + tau; const int col = g * 16 + ch;
                    ul[m][bj] = *(const PG8_GAS u32x4*)(Pm + ((size_t)g * 1024 + rg) * 640 + cg); (void)row; (void)col; } }
#pragma unroll
            for (int m = 0; m < 4; ++m) { const int rg = rg0 + ai * HALF + m * 16, b = rg >> 6, c = rg & 63;
#pragma unroll
                for (int bj = 0; bj < 2; ++bj) { const int cg = cg0 + bj * HALF, tau = cg >> 4, ch = cg & 15; const size_t row = (size_t)b * 2048 + c * 32 + tau; const int col = g * 16 + ch;
                    const u32x4 u8 = ul[m][bj];
                    const f32x4 a0 = acc[ai][bj][m][0], a1 = acc[ai][bj][m][1];
                    float y[8] = {a0[0] + d0[0] * bf_lo(u8.x), a0[1] + d0[1] * bf_hi(u8.x), a0[2] + d0[2] * bf_lo(u8.y), a0[3] + d0[3] * bf_hi(u8.y),
                                  a1[0] + d1[0] * bf_lo(u8.z), a1[1] + d1[1] * bf_hi(u8.z), a1[2] + d1[2] * bf_lo(u8.w), a1[3] + d1[3] * bf_hi(u8.w)};
#pragma unroll
                    for (int j = 0; j < 8; ++j) { const float x = y[j], t = fminf(0.7978845608028654f * (x + 0.044715f * x * x * x), 15.0f); const float e = __expf(2.0f * t); y[j] = x * (1.0f - __builtin_amdgcn_rcpf(e + 1.0f)); }
                    u32x4 w; w.x = cvt_pk_bf16(y[0], y[1]); w.y = cvt_pk_bf16(y[2], y[3]); w.z = cvt_pk_bf16(y[4], y[5]); w.w = cvt_pk_bf16(y[6], y[7]);
                    *(PG8_GAS u32x4*)(YG + row * 512 + col) = w; } } }
    }
};
}


__device__ __forceinline__ void w2_quant_item(const Args& A, Frame& F, int l, int item, LAS float* scr) {
    const int lane = lane_id();
    const float* W = A.in[23] + (size_t)l * 4096 * 1024; unsigned char* WQ = (unsigned char*)wptr(F, l, WO_2);
    const int kb = item >> 5, nb = item & 31, k0 = 64 * kb, n0 = 32 * nb;
    const int kr = lane >> 3, c4 = lane & 7; float sc[4];
#pragma unroll
    for (int e_ = 0; e_ < 4; ++e_) sc[e_] = 448.0f / fmaxf(__uint_as_float(__hip_atomic_load(F.ctl + CW_WMAX + l * 1024 + n0 + 4 * c4 + e_, RLX_AGENT)), 1e-30f);
#pragma unroll
    for (int i = 0; i < 8; ++i) { const int kk = 8 * i + kr; const f32x4_t v = *(const GAS f32x4_t*)(W + (size_t)(k0 + kk) * 1024 + n0 + 4 * c4);
#pragma unroll
        for (int e_ = 0; e_ < 4; ++e_) scr[kk * 33 + 4 * c4 + e_] = v[e_] * sc[e_]; }
    LDS_WAIT(); asm volatile("" ::: "memory");
#pragma unroll
    for (int j = 0; j < 2; ++j) { const int c = lane + 64 * j, n = c >> 2, part = c & 3; const LAS float* s = scr + (16 * part) * 33 + n;
        v4u o;
#pragma unroll
        for (int q = 0; q < 4; ++q) o[q] = pg8::pk4_fp8(s[(4 * q) * 33], s[(4 * q + 1) * 33], s[(4 * q + 2) * 33], s[(4 * q + 3) * 33]);
        *(GAS v4u*)(WQ + (size_t)(n0 + n) * 4096 + k0 + 16 * part) = o; }
    LDS_WAIT(); asm volatile("" ::: "memory");
}

__device__ __forceinline__ void w1_quant_item(const Args& A, Frame& F, int l, int item, LAS float* scr) {
    const int lane = lane_id();
    const float* W = A.in[22] + (size_t)l * 1024 * 4096; unsigned char* WQ = (unsigned char*)wptr(F, l, WO_1);
    const int kb = item >> 7, nb = item & 127, k0 = 64 * kb, n0 = 32 * nb;
    const int kr = lane >> 3, c4 = lane & 7; float sc[4];
#pragma unroll
    for (int e_ = 0; e_ < 4; ++e_) sc[e_] = 448.0f / fmaxf(__uint_as_float(__hip_atomic_load(F.ctl + CW_WMAX1 + l * 4096 + n0 + 4 * c4 + e_, RLX_AGENT)), 1e-30f);
#pragma unroll
    for (int i = 0; i < 8; ++i) { const int kk = 8 * i + kr; const f32x4_t v = *(const GAS f32x4_t*)(W + (size_t)(k0 + kk) * 4096 + n0 + 4 * c4); const float g = A.in[21][l * 1024 + k0 + kk];
#pragma unroll
        for (int e_ = 0; e_ < 4; ++e_) scr[kk * 33 + 4 * c4 + e_] = v[e_] * g * sc[e_]; }
    LDS_WAIT(); asm volatile("" ::: "memory");
#pragma unroll
    for (int j = 0; j < 2; ++j) { const int c = lane + 64 * j, n = c >> 2, part = c & 3; const LAS float* s = scr + (16 * part) * 33 + n;
        v4u o;
#pragma unroll
        for (int q = 0; q < 4; ++q) o[q] = pg8::pk4_fp8(s[(4 * q) * 33], s[(4 * q + 1) * 33], s[(4 * q + 2) * 33], s[(4 * q + 3) * 33]);
        *(GAS v4u*)(WQ + (size_t)(n0 + n) * 1024 + k0 + 16 * part) = o; }
    LDS_WAIT(); asm volatile("" ::: "memory");
}
__device__ __forceinline__ void hq_phase(Frame& F, const stat_t* ss) {
    const int lane = lane_id();
    const int gw = F.vcu * NWAVES + F.wave, NGW = F.G * NWAVES;
    const bf16* Hb = (const bf16*)(F.ws + WS_HB); unsigned char* HQ = F.ws + WS_HQ;
    for (int m0 = gw * 4; m0 < MVALID; m0 += NGW * 4) {
        v4u hw[4][2]; float r[4];
#pragma unroll
        for (int q = 0; q < 4; ++q) { const GAS v4u* h16 = (const GAS v4u*)(Hb + (size_t)(m0 + q) * DM) + 2 * lane;
            hw[q][0] = h16[0]; hw[q][1] = h16[1];
            r[q] = 8.0f * rsqrtf(stat_get(ss + m0 + q) * (1.0f / 1024.0f) + pg8::RMS_EPS); }
#pragma unroll
        for (int q = 0; q < 4; ++q) { v4u o;
#pragma unroll
            for (int i = 0; i < 2; ++i) { const v4u hv = hw[q][i];
                o[2 * i] = pg8::pk4_fp8(bflo(hv.x) * r[q], bfhi(hv.x) * r[q], bflo(hv.y) * r[q], bfhi(hv.y) * r[q]); o[2 * i + 1] = pg8::pk4_fp8(bflo(hv.z) * r[q], bfhi(hv.z) * r[q], bflo(hv.w) * r[q], bfhi(hv.w) * r[q]); }
            *((GAS v4u*)(HQ + (size_t)(m0 + q) * 1024) + lane) = o; }
    }
}
__device__ __forceinline__ void mixers_naive_phase(const Args& A, Frame& F, int l) {
    LAS float* wl = (LAS float*)(F.lds + RING_OFF + F.wave * 16384);
    if (l == 0) {
        const int gw = F.vcu * NWAVES + F.wave, NGW = F.G * NWAVES;
        for (int it = gw; it < DEPTH * 2048; it += NGW) w2_quant_item(A, F, it >> 11, it & 2047, wl);
        for (int it = gw; it < DEPTH * 2048; it += NGW) w1_quant_item(A, F, it >> 11, it & 2047, wl);
        __syncthreads();
    }
    {
        const int x0 = (int)(xb_xcc_id() & 7u);
        int xq = x0;
        gu32* qbase = F.ctl + CW_Q + 64 * (4 + 8 * l);
        for (;;) {
            unsigned slot_a = (unsigned)(size_t)(F.MISC + 16); asm volatile("" : "+s"(slot_a));
            volatile LAS unsigned* slot = (volatile LAS unsigned*)(size_t)slot_a;
            if (F.wave == 0 && lane_id() == 0) {
                unsigned v = __hip_atomic_fetch_add(qbase + 64 * xq, 1u, RLX_AGENT); int nq = xq;
                if (v >= 68u) {
                    unsigned hd[7];
#pragma unroll
                    for (int q = 0; q < 7; ++q) hd[q] = __hip_atomic_load(qbase + 64 * ((x0 + 1 + q) & 7), RLX_AGENT);
                    nq = -1;
#pragma unroll
                    for (int q = 6; q >= 0; --q) if (hd[q] < 68u) nq = (x0 + 1 + q) & 7;
                }
                slot[0] = v; slot[1] = (unsigned)nq; }
            __syncthreads();
            const int idx = (int)slot[0], nq = (int)slot[1];
            __syncthreads();
            if (idx >= 4 + 64) { if (nq < 0) break; xq = nq; continue; }
            if (idx < 4) { s5_scan_task(A, F, l, 4 * xq + idx); continue; }
            { const int i2 = idx - 4; dsa_unit(A, F, l, 2 * xq + (i2 & 1), 31 - (i2 >> 1)); }
        }
    }
    gu32* head = F.ctl + CW_Q + 64 * l;
    constexpr int N_S5 = 32, N_SB = BATCH * 4 * 64, N_META_Q = 2 * NMETA, TOTAL = N_S5 + N_SB + N_META_Q;
    for (;;) {
        int idx = 0;
        if (lane_id() == 0) idx = (int)__hip_atomic_fetch_add(head, 1u, RLX_AGENT);
        idx = __builtin_amdgcn_readfirstlane(idx);
        if (idx >= TOTAL) break;
        if (idx < N_S5) { s5_naive_item(A, F, l, 0, idx); continue; }
        idx -= N_S5;
        if (idx < N_META_Q) { if (idx < NMETA) dsa_naive_item(A, F, l, MREAL + idx, wl); else sb_naive_item(A, F, l, MREAL + (idx - NMETA), wl); continue; }
        idx -= N_META_Q;
        sb_mfma_unit(A, F, l, (idx & ~63) | (63 - (idx & 63)), (LAS unsigned char*)wl);
    }
}

__device__ __forceinline__ void final_phase(const Args& A, Frame& F) {
    const int lane = lane_id();
    const int gw = F.vcu * NWAVES + F.wave, NGW = F.G * NWAVES;
    const bf16* Hb = (const bf16*)(F.ws + WS_HB); const stat_t* ss = stat_ptr(F, DEPTH, ST_SS1); const float* fg = A.in[24];
    for (int m0 = gw * 4; m0 < MREAL; m0 += NGW * 4) {
        v4u hw[4][2]; float r[4];
#pragma unroll
        for (int q = 0; q < 4; ++q) { const GAS v4u* h16 = (const GAS v4u*)(Hb + (size_t)(m0 + q) * DM) + lane;
            hw[q][0] = h16[0]; hw[q][1] = h16[64];
            r[q] = rsqrtf(stat_get(ss + m0 + q) * (1.0f / 1024.0f) + pg8::RMS_EPS); }
#pragma unroll
        for (int q = 0; q < 4; ++q) { GAS f32x4* o = (GAS f32x4*)(F.out + (size_t)(m0 + q) * DM) + 2 * lane;
#pragma unroll
            for (int jh = 0; jh < 2; ++jh) { const v4u hv = hw[q][jh]; const f32x4 g0 = *((const GAS f32x4*)fg + 2 * lane + 128 * jh), g1 = *((const GAS f32x4*)fg + 2 * lane + 128 * jh + 1);
                o[128 * jh] = (f32x4){bflo(hv.x) * r[q] * g0.x, bfhi(hv.x) * r[q] * g0.y, bflo(hv.y) * r[q] * g0.z, bfhi(hv.y) * r[q] * g0.w};
                o[128 * jh + 1] = (f32x4){bflo(hv.z) * r[q] * g1.x, bfhi(hv.z) * r[q] * g1.y, bflo(hv.w) * r[q] * g1.z, bfhi(hv.w) * r[q] * g1.w}; } }
    }
}


struct MetaArgs { const bf16* A; const bf16* Bt; int N, K; bf16* O; bf16* H; const bf16* Y; const stat_t* ss; stat_t* so; const stat_t* ssb; const stat_t* ssa; const stat_t* ssc; const unsigned* wmax; };
template <int KIND> __device__ __forceinline__ void meta_gemm(Frame& F, const MetaArgs& a, LAS float* red  ) {
    const int lane = lane_id(), w = F.wave, m16 = lane & 15, kg = lane >> 4;
    const int kw = a.K / 8;
    for (int cb = F.vcu; cb < a.N / 16; cb += F.G) {
        f32x4_t acc = (f32x4_t){0.f, 0.f, 0.f, 0.f};
        const bf16* ap = a.A + (size_t)(MREAL + m16) * a.K + w * kw + 8 * kg;
        const bf16* bp = a.Bt + (size_t)(cb * 16 + m16) * a.K + w * kw + 8 * kg;
        constexpr int KW = (KIND == 1 ? 512 : (KIND == 4 ? 4096 : 1024)) / 8, NS = KW / 32, GS = NS < 8 ? NS : 8;
        if constexpr (KIND == 3) {
            const unsigned char* ap8 = (const unsigned char*)a.A + (size_t)(MREAL + m16) * 1024 + w * 128 + 8 * kg;
            const unsigned char* bp8 = (const unsigned char*)a.Bt + (size_t)(cb * 16 + m16) * 1024 + w * 128 + 8 * kg;
            long fa[4], fb[4];
#pragma unroll
            for (int s = 0; s < 4; ++s) { fa[s] = *(const GAS long*)(ap8 + 32 * s); fb[s] = *(const GAS long*)(bp8 + 32 * s); }
#pragma unroll
            for (int s = 0; s < 4; ++s) acc = __builtin_amdgcn_mfma_f32_16x16x32_fp8_fp8(fa[s], fb[s], acc, 0, 0, 0);
        } else if constexpr (KIND == 4) {
            const unsigned char* ap8 = (const unsigned char*)a.A + (size_t)(MREAL + m16) * 4096 + w * 512 + 8 * kg;
            const unsigned char* bp8 = (const unsigned char*)a.Bt + (size_t)(cb * 16 + m16) * 4096 + w * 512 + 8 * kg;
#pragma unroll
            for (int s0 = 0; s0 < 16; s0 += 8) { long fa[8], fb[8];
#pragma unroll
                for (int s = 0; s < 8; ++s) { fa[s] = *(const GAS long*)(ap8 + 32 * (s0 + s)); fb[s] = *(const GAS long*)(bp8 + 32 * (s0 + s)); }
#pragma unroll
                for (int s = 0; s < 8; ++s) acc = __builtin_amdgcn_mfma_f32_16x16x32_fp8_fp8(fa[s], fb[s], acc, 0, 0, 0); }
        } else {
#pragma unroll
        for (int s0 = 0; s0 < NS; s0 += GS) { bf16x8_t fa[GS], fb[GS];
#pragma unroll
            for (int s = 0; s < GS; ++s) { fa[s] = *(const GAS bf16x8_t*)(ap + 32 * (s0 + s)); fb[s] = *(const GAS bf16x8_t*)(bp + 32 * (s0 + s)); }
#pragma unroll
            for (int s = 0; s < GS; ++s) acc = __builtin_amdgcn_mfma_f32_16x16x32_bf16(fa[s], fb[s], acc, 0, 0, 0); }
        }
        *(LAS f32x4_t*)(red + (w * 64 + lane) * 4) = acc;
        __syncthreads();
        if (w == 0) {
            const int col = cb * 16 + m16;
#pragma unroll
            for (int r = 0; r < 4; ++r) { const int row = MREAL + 4 * kg + r; float v = 0.f;
                if (KIND == 2) {
                    const float rb = rsqrtf(stat_get(a.ssb + row) * (1.0f / 512.0f) + pg8::RMS_EPS), ra = rsqrtf(stat_get(a.ssa + row) * (1.0f / 256.0f) + pg8::RMS_EPS), rc = rsqrtf(stat_get(a.ssc + row) * (1.0f / 256.0f) + pg8::RMS_EPS);
#pragma unroll
                    for (int ww = 0; ww < 8; ++ww) v += red[(ww * 64 + lane) * 4 + r] * (ww < 4 ? rb : (ww < 6 ? ra : rc));
                } else {
#pragma unroll
                    for (int ww = 0; ww < 8; ++ww) v += red[(ww * 64 + lane) * 4 + r];
                }
                float sq = 0.f; stat_t* sp = nullptr;
                if (KIND == 0) { v *= rsqrtf(stat_get(a.ss + row) * (1.0f / 1024.0f) + pg8::RMS_EPS); const unsigned wv = f2bf(v); a.O[(size_t)row * NIN + col] = (bf16)wv;
                    if (col >= PC_CKV && col < PC_IK) { const float x = __uint_as_float(wv << 16); sq = x * x; sp = a.so; } }
                else if (KIND == 1) { const float y = bf2f(a.Y[(size_t)row * 512 + col]); const unsigned wv = f2bf(y / (1.0f + __expf(-v))); a.O[(size_t)row * 1024 + col] = (bf16)wv; const float x = __uint_as_float(wv << 16); sq = x * x; sp = a.so; }
                else if (KIND == 2 || KIND == 4) { if (KIND == 4) v *= fmaxf(__uint_as_float(a.wmax[col]), 1e-30f) * (1.0f / (448.0f * pg8::HID_SCALE));
                    const unsigned wv = f2bf(bf2f(a.H[(size_t)row * 1024 + col]) + v); a.H[(size_t)row * 1024 + col] = (bf16)wv; const float x = __uint_as_float(wv << 16); sq = x * x; sp = a.so; }
                else { v *= fmaxf(__uint_as_float(a.wmax[col]), 1e-30f) * (1.0f / (448.0f * 8.0f)); v = fmaxf(v, 0.f); ((unsigned char*)a.O)[(size_t)row * DFF + col] = (unsigned char)(pg8::pk4_fp8(v * v * pg8::HID_SCALE, 0.f, 0.f, 0.f) & 0xffu); }
                if (KIND != 3) { sq += __shfl_xor(sq, 1); sq += __shfl_xor(sq, 2); sq += __shfl_xor(sq, 4); sq += __shfl_xor(sq, 8);
                    if (m16 == 0 && sp != nullptr) pg8::stat_add(sp + row, sq); }
            }
        }
        __syncthreads();
    }
}

#define IN(k) (lo <= (k) && (k) < hi)
#define SEAM(k) do { if (IN(k) && IN((k) + 1)) xcd_barrier(bar, F.wave); } while (0)
__device__ __forceinline__ unsigned char* opaque_ptr(unsigned char* p) { asm volatile("" : "+s"(p)); return p; }
__device__ __forceinline__ stat_t* stat_at(unsigned char* ws, int l, int id) { return (stat_t*)(ws + WS_STATS) + (size_t)(l * ST_PER_LAYER + id) * STAT_STRIDE; }
__device__ __forceinline__ bf16* w_at(unsigned char* ws, int l, size_t off) { return (bf16*)(ws + WS_W + (size_t)l * W_LAYER + off); }
template <int l> __device__ __forceinline__ void layer_phases(const Args& args, Frame& F, const XcdBarrier& bar, int lo, int hi) {
    const int pb = 8 * l;
    if (IN(pb + 1)) {
        unsigned char* ws = opaque_ptr(args.ws);
        { MetaArgs ma{(bf16*)(ws + WS_HB), w_at(ws, l, WO_IN), NIN, DM, (bf16*)(ws + WS_P), nullptr, nullptr, stat_at(ws, l, ST_SS1), stat_at(ws, l, ST_SSKV), nullptr, nullptr, nullptr, nullptr}; meta_gemm<0>(F, ma, (LAS float*)(F.lds + RING_OFF)); }
        pg8::Gemm g{(bf16*)(ws + WS_HB), w_at(ws, l, WO_IN), MREAL, NIN, DM}; pg8::StaticOrder S; S.init(MREAL, NIN, F.G, (int)blockIdx.x);
        pg8::EpiIn E{(bf16*)(ws + WS_P), stat_at(ws, l, ST_SS1), stat_at(ws, l, ST_SSKV), (bf16*)(ws + WS_U)};
        pg8::gemm_phase<pg8::EpiIn, pg8::StaticOrder, true, true>(F.lds + RING_OFF, g, S, E, F.wave);
    } SEAM(pb + 1);
    if (IN(pb + 2)) { mixers_naive_phase(args, F, l); } SEAM(pb + 2);
    if (IN(pb + 3)) {
        unsigned char* ws = opaque_ptr(args.ws);
        pg8::Gemm g{(bf16*)(ws + WS_U), (bf16*)(ws + WS_TZ + (size_t)l * TZ_LAYER), 32 * S5RG, 32 * 512, S5KU}; S5Order S{F.G, (int)blockIdx.x};
        pg8::EpiS5 E{(bf16*)(ws + WS_U), (bf16*)(ws + WS_YG), args.in[15] + l * 512};
        pg8::gemm_phase<pg8::EpiS5, S5Order, true, true>(F.lds + RING_OFF, g, S, E, F.wave);
    } SEAM(pb + 3);
    if (IN(pb + 4)) {
        unsigned char* ws = opaque_ptr(args.ws);
        { MetaArgs ma{(bf16*)(ws + WS_YG), w_at(ws, l, WO_GLU), 512, 512, (bf16*)(ws + WS_YCAT), nullptr, (bf16*)(ws + WS_YG), nullptr, stat_at(ws, l, ST_SSB), nullptr, nullptr, nullptr, nullptr}; meta_gemm<1>(F, ma, (LAS float*)(F.lds + RING_OFF)); }
        pg8::Gemm g{(bf16*)(ws + WS_YG), w_at(ws, l, WO_GLU), MREAL, 512, 512}; pg8::StaticOrder S; S.init(MREAL, 512, F.G, (int)blockIdx.x);
        pg8::EpiGlu E{(bf16*)(ws + WS_YG), (bf16*)(ws + WS_YCAT), stat_at(ws, l, ST_SSB)};
        pg8::gemm_phase<pg8::EpiGlu, pg8::StaticOrder, true, true>(F.lds + RING_OFF, g, S, E, F.wave);
    } SEAM(pb + 4);
    if (IN(pb + 5)) {
        unsigned char* ws = opaque_ptr(args.ws);
        { MetaArgs ma{(bf16*)(ws + WS_YCAT), w_at(ws, l, WO_OUT), DM, DM, nullptr, (bf16*)(ws + WS_HB), nullptr, nullptr, stat_at(ws, l, ST_SS2), stat_at(ws, l, ST_SSB), stat_at(ws, l, ST_SSA), stat_at(ws, l, ST_SSC), nullptr}; meta_gemm<2>(F, ma, (LAS float*)(F.lds + RING_OFF)); }
        pg8::Gemm g{(bf16*)(ws + WS_YCAT), w_at(ws, l, WO_OUT), MREAL, DM, DM}; pg8::StaticOrder S; S.init(MREAL, DM, F.G, (int)blockIdx.x);
        pg8::EpiRes<true> E{(bf16*)(ws + WS_HB), stat_at(ws, l, ST_SS2), stat_at(ws, l, ST_SSB), stat_at(ws, l, ST_SSA), stat_at(ws, l, ST_SSC)};
        pg8::gemm_phase<pg8::EpiRes<true>, pg8::StaticOrder, true, true>(F.lds + RING_OFF, g, S, E, F.wave);
    } SEAM(pb + 5);
    if (IN(pb + 6)) { hq_phase(F, stat_at(opaque_ptr(args.ws), l, ST_SS2)); } SEAM(pb + 6);
    if (IN(pb + 7)) {
        unsigned char* ws = opaque_ptr(args.ws);
        { MetaArgs ma{(bf16*)(ws + WS_HQ), w_at(ws, l, WO_1), DFF, DM, (bf16*)(ws + WS_BIG), nullptr, nullptr, nullptr, nullptr, nullptr, nullptr, nullptr, (const unsigned*)(ws + WS_CTL) + CW_WMAX1 + l * 4096}; meta_gemm<3>(F, ma, (LAS float*)(F.lds + RING_OFF)); }
        pg8::Gemm g{(bf16*)(ws + WS_HQ), w_at(ws, l, WO_1), MREAL, DFF, DM / 2}; pg8::StaticOrder S; S.init(MREAL, DFF, F.G, (int)blockIdx.x);
        pg8::EpiMlp1F8B E{(unsigned char*)(ws + WS_BIG), (const unsigned*)(ws + WS_CTL) + CW_WMAX1 + l * 4096};
        pg8::gemm_phase<pg8::EpiMlp1F8B, pg8::StaticOrder, true, true, true>(F.lds + RING_OFF, g, S, E, F.wave);
    } SEAM(pb + 7);
    if (IN(pb + 8)) {
        unsigned char* ws = opaque_ptr(args.ws);
        { MetaArgs ma{(bf16*)(ws + WS_BIG), w_at(ws, l, WO_2), DM, DFF, nullptr, (bf16*)(ws + WS_HB), nullptr, nullptr, stat_at(ws, l + 1, ST_SS1), nullptr, nullptr, nullptr, (const unsigned*)(ws + WS_CTL) + CW_WMAX + l * 1024}; meta_gemm<4>(F, ma, (LAS float*)(F.lds + RING_OFF)); }
        pg8::Gemm g{(bf16*)(ws + WS_BIG), w_at(ws, l, WO_2), MREAL, DM, DFF / 2}; pg8::StaticOrder S; S.init(MREAL, DM, F.G, (int)blockIdx.x);
        pg8::EpiRes8 E{(bf16*)(ws + WS_HB), stat_at(ws, l + 1, ST_SS1), (const unsigned*)(ws + WS_CTL) + CW_WMAX + l * 1024};
        pg8::gemm_phase<pg8::EpiRes8, pg8::StaticOrder, true, true, true>(F.lds + RING_OFF, g, S, E, F.wave);
    } SEAM(pb + 8);
}
#undef IN
#undef SEAM
constexpr int N_PHASES = 18;
#if defined(__HIP_DEVICE_COMPILE__)
#define MK_NO_PK_F32 __attribute__((target("no-packed-fp32-ops")))
#else
#define MK_NO_PK_F32
#endif
__global__ void __launch_bounds__(NWAVES * 64, 2) MK_NO_PK_F32 hymba_fwd(Args args) {
    extern __shared__ __attribute__((aligned(16))) unsigned char lds[];
    Frame F;
    F.lds = (LAS unsigned char*)lds;
    F.MISC = (volatile LAS unsigned*)(F.lds + MISC_OFF);
    F.wave = __builtin_amdgcn_readfirstlane((int)threadIdx.x >> 6);
    F.G = gridDim.x; { const int bx = blockIdx.x; F.vcu = (F.G % 8 == 0) ? (bx % 8) * (F.G / 8) + bx / 8 : bx; }
    F.out = args.out; F.ws = args.ws;
    F.ctl = (gu32*)(args.ws + WS_CTL);
    for (int u = threadIdx.x; u < (LDS_BYTES - LDSCTL_OFF) / 4; u += NWAVES * 64) ((LAS unsigned*)(F.lds + LDSCTL_OFF))[u] = 0u;
    __syncthreads();
    const int lo = args.ph_lo, hi = args.ph_hi;
    const bool multi = (hi - lo) > 1;
    XcdBarrier bar; bar.bar = (unsigned*)(F.ctl + CW_BAR); bar.x = 0; bar.st = F.MISC + 8;
    if (multi) bar = xcd_barrier_post((unsigned*)(F.ctl + CW_BAR), F.MISC + 8, F.wave);
#define IN(k) (lo <= (k) && (k) < hi)
#define SEAM(k) do { if (IN(k) && IN((k) + 1)) xcd_barrier(bar, F.wave); } while (0)
    if (IN(0)) { p0_prologue(args, F); } SEAM(0);
    layer_phases<0>(args, F, bar, lo, hi);
    layer_phases<1>(args, F, bar, lo, hi);
    if (IN(17)) { final_phase(args, F); }
#undef IN
#undef SEAM
}

#ifndef MK_ONE_LAUNCH
#define MK_ONE_LAUNCH 1
#endif
extern "C" void kernel_launch(void* const* d_in, const int* in_sizes, int n_in, void* d_out, int out_size, void* d_ws, size_t ws_size, hipStream_t stream) {
    static int grid = 0;
    if (grid == 0) {
        if (n_in != 25 || in_sizes[0] != MREAL * DM || out_size != MREAL * DM || ws_size < WS_END2) {
            fprintf(stderr, "kernel_launch: unexpected problem: n_in %d, in0 %d, out %d, ws %zu (need %zu); nothing launched\n", n_in, n_in > 0 ? in_sizes[0] : -1, out_size, ws_size, (size_t)WS_END2); grid = -1; return; }
        int dev = 0, cus = 0, per_cu = 0;
        if (hipGetDevice(&dev) != hipSuccess || hipDeviceGetAttribute(&cus, hipDeviceAttributeMultiprocessorCount, dev) != hipSuccess) { grid = -1; return; }
        if (hipFuncSetAttribute((const void*)hymba_fwd, hipFuncAttributeMaxDynamicSharedMemorySize, LDS_BYTES) != hipSuccess) { fprintf(stderr, "kernel_launch: hipFuncSetAttribute failed\n"); grid = -1; return; }
        if (hipOccupancyMaxActiveBlocksPerMultiprocessor(&per_cu, (const void*)hymba_fwd, NWAVES * 64, LDS_BYTES) != hipSuccess || per_cu < 1)
            fprintf(stderr, "kernel_launch: note: occupancy query reports %d workgroups per CU\n", per_cu);
        (void)hipGetLastError();
        grid = cus;
    }
    if (grid < 0) return;
    if (hipMemsetAsync((char*)d_ws + WS_CTL, 0, CTL_ZERO_BYTES, stream) != hipSuccess) { fprintf(stderr, "kernel_launch: memset failed\n"); return; }
    Args a{};
    for (int i = 0; i < 25; ++i) a.in[i] = (const float*)d_in[i];
    a.out = (float*)d_out; a.ws = (unsigned char*)d_ws;
#if MK_ONE_LAUNCH
    a.ph_lo = 0; a.ph_hi = N_PHASES;
    hipLaunchKernelGGL(hymba_fwd, dim3(grid), dim3(NWAVES * 64), LDS_BYTES, stream, a);
#else
    for (int p = 0; p < N_PHASES; ++p) { a.ph_lo = p; a.ph_hi = p + 1;
        hipLaunchKernelGGL(hymba_fwd, dim3(grid), dim3(NWAVES * 64), LDS_BYTES, stream, a); }
#endif
    const hipError_t le = hipPeekAtLastError();
    if (le != hipSuccess) fprintf(stderr, "kernel_launch: launch failed: %s\n", hipGetErrorName(le));
}
```

```cpp
#include <hip/hip_runtime.h>
#include <cstdio>
#include <cstdint>
namespace pg8 {
#define PG8_LAS __attribute__((address_space(3)))
typedef unsigned short bf16_t;
typedef short bf16x8 __attribute__((ext_vector_type(8)));
typedef float f32x4 __attribute__((ext_vector_type(4)));
typedef unsigned u32x4 __attribute__((ext_vector_type(4)));
constexpr int BM = 256, BK = 64, HALF = 128, HTB = HALF * BK * 2  , STAGE_BYTES = 8 * HTB, NXCD = 8, WGM = 8;

__host__ __device__ __forceinline__ int lds_byte(int r, int c) { const int st = (r >> 4) * 2 + (c >> 5), rr = r & 15, cc = c & 31, ob = rr * 64 + cc * 2; return st * 1024 + (ob ^ (((ob >> 9) & 1) << 5)); }
__host__ __device__ __forceinline__ void stage_rc(int b, int& R, int& C) { const int st = b / 1024, sb = b % 1024, swz = sb ^ (((sb >> 9) & 1) << 5); R = (st >> 1) * 16 + swz / 64; C = (st & 1) * 32 + (swz % 64) / 2; }
__host__ __device__ __forceinline__ int perm32(int rho) { const int n = rho >> 4, i = rho & 15; return 8 * (i >> 2) + 4 * n + (i & 3); }

struct Unit { int pm, pn; };
struct Gemm { const bf16_t* A; const bf16_t* Bt; int M, N, K; };

struct StaticOrder {
    int nM, nN, nwg, G, c;
    __host__ __device__ void init(int M, int N, int G_, int c_) { nM = M / BM; nN = N / BM; nwg = nM * nN; G = G_; c = c_; }
    __host__ __device__ bool next(int i, Unit& u) const {
        const long L = (long)i * G + c; if (L >= nwg) return false;
        int wgid = (int)L; { const int q = nwg / NXCD, r = nwg % NXCD, xcd = wgid % NXCD, off = wgid / NXCD; wgid = (xcd < r ? xcd * (q + 1) : r * (q + 1) + (xcd - r) * q) + off; }
        const int nig = WGM * nN, gid = wgid / nig, fm = gid * WGM, gsz = (nM - fm) < WGM ? (nM - fm) : WGM;
        u.pm = fm + ((wgid % nig) % gsz); u.pn = (wgid % nig) / gsz; return true;
    }
    __device__ __forceinline__ void a_ready(const Unit&) const {}
    __device__ __forceinline__ void done(const Unit&) const {}
};

__device__ __forceinline__ unsigned cvt_pk_bf16(float lo, float hi) { unsigned r; asm volatile("v_cvt_pk_bf16_f32 %0, %1, %2" : "=v"(r) : "v"(lo), "v"(hi)); return r; }
typedef float f32x2 __attribute__((ext_vector_type(2)));
#define PG8_GAS __attribute__((address_space(1)))
constexpr float RMS_EPS = 1e-6f;
__device__ __forceinline__ float bf_lo(unsigned w) { return __uint_as_float(w << 16); }
__device__ __forceinline__ float bf_hi(unsigned w) { return __uint_as_float(w & 0xffff0000u); }
typedef unsigned long long stat_t;
__device__ __forceinline__ void stat_add(stat_t* p, float q) { atomicAdd(p, (stat_t)((double)q * 4294967296.0)); }
__device__ __forceinline__ float stat_get(const stat_t* p) { const stat_t v = *p; return (float)(unsigned)(v >> 32) + (float)(unsigned)v * 2.3283064365386963e-10f; }
__device__ __forceinline__ float stat_val(stat_t s) { return (float)((double)s * (1.0 / 4294967296.0)); }
__device__ __forceinline__ float quad_sum(float q) { q += __shfl_xor(q, 16); q += __shfl_xor(q, 32); return q; }

struct EpiIn {
    static constexpr bool PERM = true, AFTER_DRAIN = false; static constexpr int MIDT = 0, MIDT2 = 0;
    bf16_t* O; const stat_t* ss; stat_t* sskv; bf16_t* U;
    __device__ __forceinline__ void operator()(const f32x4 (&acc)[2][2][4][2], const Unit& u, int wr, int wc, int fr, int fq) const {
        const int row0 = u.pm * BM + wr * 64 + fr, col0 = u.pn * BM + wc * 32 + 8 * fq;
        stat_t sv[2][4];
#pragma unroll
        for (int ai = 0; ai < 2; ++ai)
#pragma unroll
            for (int m = 0; m < 4; ++m) sv[ai][m] = *(const PG8_GAS stat_t*)(ss + row0 + ai * HALF + m * 16);
#pragma unroll
        for (int ai = 0; ai < 2; ++ai)
#pragma unroll
            for (int m = 0; m < 4; ++m) { const int row = row0 + ai * HALF + m * 16; const float r = rsqrtf(stat_val(sv[ai][m]) * (1.0f / 1024.0f) + RMS_EPS);
                bf16_t* rowp = O + (size_t)row * 2048 + col0;
#pragma unroll
                for (int bj = 0; bj < 2; ++bj) { const f32x4 v0 = acc[ai][bj][m][0] * r, v1 = acc[ai][bj][m][1] * r;
                    u32x4 w; w.x = cvt_pk_bf16(v0[0], v0[1]); w.y = cvt_pk_bf16(v0[2], v0[3]); w.z = cvt_pk_bf16(v1[0], v1[1]); w.w = cvt_pk_bf16(v1[2], v1[3]);
                    if (u.pn == 3 || u.pn == 4) {
                        const int gc = col0 + bj * HALF - 768, gg = gc >> 4, t = row & 2047;
                        *(PG8_GAS u32x4*)(U + ((size_t)gg * 1024 + (row >> 11) * 64 + (t >> 5)) * 640 + (t & 31) * 16 + (gc & 15)) = w; }
                    else *(PG8_GAS u32x4*)(rowp + bj * HALF) = w;
                    if (bj == 0 && u.pn == 1) { float q = (bf_lo(w.x) * bf_lo(w.x) + bf_hi(w.x) * bf_hi(w.x)) + (bf_lo(w.y) * bf_lo(w.y) + bf_hi(w.y) * bf_hi(w.y))
                                                      + (bf_lo(w.z) * bf_lo(w.z) + bf_hi(w.z) * bf_hi(w.z)) + (bf_lo(w.w) * bf_lo(w.w) + bf_hi(w.w) * bf_hi(w.w));
                        q = quad_sum(q); if (fq == 0) stat_add(sskv + row, q); } } }
    }
};
struct EpiGlu {
    static constexpr bool PERM = true, AFTER_DRAIN = false; static constexpr int MIDT = 0, MIDT2 = 0;
    const bf16_t* Y; bf16_t* O; stat_t* ssb;
    __device__ __forceinline__ void operator()(const f32x4 (&acc)[2][2][4][2], const Unit& u, int wr, int wc, int fr, int fq) const {
        const int row0 = u.pm * BM + wr * 64 + fr, col0 = u.pn * BM + wc * 32 + 8 * fq;
#pragma unroll
        for (int ai = 0; ai < 2; ++ai) {
            u32x4 yl[4][2];
#pragma unroll
            for (int m = 0; m < 4; ++m) { const int row = row0 + ai * HALF + m * 16; const PG8_GAS u32x4* rp = (const PG8_GAS u32x4*)(Y + (size_t)row * 512 + col0); yl[m][0] = rp[0]; yl[m][1] = rp[HALF / 8]; }
#pragma unroll
            for (int m = 0; m < 4; ++m) { const int row = row0 + ai * HALF + m * 16; float q = 0.f;
#pragma unroll
                for (int bj = 0; bj < 2; ++bj) { const u32x4 y8 = yl[m][bj];
                    const f32x4 g0 = acc[ai][bj][m][0], g1 = acc[ai][bj][m][1];
                    float o[8]; const float yv[8] = {bf_lo(y8.x), bf_hi(y8.x), bf_lo(y8.y), bf_hi(y8.y), bf_lo(y8.z), bf_hi(y8.z), bf_lo(y8.w), bf_hi(y8.w)};
                    const float gv[8] = {g0[0], g0[1], g0[2], g0[3], g1[0], g1[1], g1[2], g1[3]};
#pragma unroll
                    for (int j = 0; j < 8; ++j) o[j] = yv[j] * __builtin_amdgcn_rcpf(1.0f + __expf(-gv[j]));
                    u32x4 w; w.x = cvt_pk_bf16(o[0], o[1]); w.y = cvt_pk_bf16(o[2], o[3]); w.z = cvt_pk_bf16(o[4], o[5]); w.w = cvt_pk_bf16(o[6], o[7]);
                    *(PG8_GAS u32x4*)(O + (size_t)row * 1024 + col0 + bj * HALF) = w;
                    q += (bf_lo(w.x) * bf_lo(w.x) + bf_hi(w.x) * bf_hi(w.x)) + (bf_lo(w.y) * bf_lo(w.y) + bf_hi(w.y) * bf_hi(w.y))
                       + (bf_lo(w.z) * bf_lo(w.z) + bf_hi(w.z) * bf_hi(w.z)) + (bf_lo(w.w) * bf_lo(w.w) + bf_hi(w.w) * bf_hi(w.w)); }
                q = quad_sum(q); if (fq == 0) stat_add(ssb + row, q); } }
    }
};
template <bool OUT> struct EpiRes {
    static constexpr bool PERM = true, AFTER_DRAIN = false; static constexpr int MIDT = OUT ? 8 : 0, MIDT2 = OUT ? 12 : 0;
    bf16_t* H; stat_t* ssn; const stat_t* ssb; const stat_t* ssa; const stat_t* ssc;
    __device__ __forceinline__ void mid(f32x4 (&acc)[2][2][4][2], const Unit& u, int wr, int fr, int t) const {
        const stat_t* sn = (t == MIDT) ? ssb : ssa; const stat_t* sd = (t == MIDT) ? ssa : ssc;
        const float wn = (t == MIDT) ? (1.0f / 512.0f) : (1.0f / 256.0f);
        stat_t vn[2][4], vd[2][4];
#pragma unroll
        for (int ai = 0; ai < 2; ++ai)
#pragma unroll
            for (int m = 0; m < 4; ++m) { const int row = u.pm * BM + ai * HALF + wr * 64 + m * 16 + fr; vn[ai][m] = *(const PG8_GAS stat_t*)(sn + row); vd[ai][m] = *(const PG8_GAS stat_t*)(sd + row); }
#pragma unroll
        for (int ai = 0; ai < 2; ++ai)
#pragma unroll
            for (int m = 0; m < 4; ++m) {
                const float xn = stat_val(vn[ai][m]) * wn + RMS_EPS, xd = stat_val(vd[ai][m]) * (1.0f / 256.0f) + RMS_EPS;
                const float f = __builtin_amdgcn_sqrtf(xd * __builtin_amdgcn_rcpf(xn));
#pragma unroll
                for (int bj = 0; bj < 2; ++bj)
#pragma unroll
                    for (int n = 0; n < 2; ++n) acc[ai][bj][m][n] *= f; }
    }
    __device__ __forceinline__ void operator()(const f32x4 (&acc)[2][2][4][2], const Unit& u, int wr, int wc, int fr, int fq) const {
        const int row0 = u.pm * BM + wr * 64 + fr, col0 = u.pn * BM + wc * 32 + 8 * fq;
#pragma unroll
        for (int ai = 0; ai < 2; ++ai) {
            u32x4 h8[4][2]; stat_t sc[4];
#pragma unroll
            for (int m = 0; m < 4; ++m) { const int row = row0 + ai * HALF + m * 16; const PG8_GAS u32x4* rp = (const PG8_GAS u32x4*)(H + (size_t)row * 1024 + col0);
                h8[m][0] = rp[0]; h8[m][1] = rp[HALF / 8]; if (OUT) sc[m] = *(const PG8_GAS stat_t*)(ssc + row); }
#pragma unroll
            for (int m = 0; m < 4; ++m) { const int row = row0 + ai * HALF + m * 16; float q = 0.f; PG8_GAS u32x4* wp = (PG8_GAS u32x4*)(H + (size_t)row * 1024 + col0);
                float post = 1.0f; if (OUT) post = rsqrtf(stat_val(sc[m]) * (1.0f / 256.0f) + RMS_EPS);
#pragma unroll
                for (int bj = 0; bj < 2; ++bj) { const u32x4 hv = h8[m][bj];
                    const f32x4 a0 = acc[ai][bj][m][0] * post, a1 = acc[ai][bj][m][1] * post;
                    u32x4 w; w.x = cvt_pk_bf16(bf_lo(hv.x) + a0[0], bf_hi(hv.x) + a0[1]); w.y = cvt_pk_bf16(bf_lo(hv.y) + a0[2], bf_hi(hv.y) + a0[3]);
                    w.z = cvt_pk_bf16(bf_lo(hv.z) + a1[0], bf_hi(hv.z) + a1[1]); w.w = cvt_pk_bf16(bf_lo(hv.w) + a1[2], bf_hi(hv.w) + a1[3]);
                    wp[bj * (HALF / 8)] = w;
                    q += (bf_lo(w.x) * bf_lo(w.x) + bf_hi(w.x) * bf_hi(w.x)) + (bf_lo(w.y) * bf_lo(w.y) + bf_hi(w.y) * bf_hi(w.y))
                       + (bf_lo(w.z) * bf_lo(w.z) + bf_hi(w.z) * bf_hi(w.z)) + (bf_lo(w.w) * bf_lo(w.w) + bf_hi(w.w) * bf_hi(w.w)); }
                q = quad_sum(q); if (fq == 0) stat_add(ssn + row, q); } }
    }
};
struct EpiMlp1 {
    static constexpr bool PERM = true, AFTER_DRAIN = false; static constexpr int MIDT = 0, MIDT2 = 0;
    bf16_t* O; const stat_t* ss;
    __device__ __forceinline__ void operator()(const f32x4 (&acc)[2][2][4][2], const Unit& u, int wr, int wc, int fr, int fq) const {
        const int row0 = u.pm * BM + wr * 64 + fr, col0 = u.pn * BM + wc * 32 + 8 * fq;
#pragma unroll
        for (int ai = 0; ai < 2; ++ai)
#pragma unroll
            for (int m = 0; m < 4; ++m) { const int row = row0 + ai * HALF + m * 16; const float r = rsqrtf(stat_get(ss + row) * (1.0f / 1024.0f) + RMS_EPS);
                bf16_t* rowp = O + (size_t)row * 4096 + col0;
#pragma unroll
                for (int bj = 0; bj < 2; ++bj) { f32x4 v0 = acc[ai][bj][m][0] * r, v1 = acc[ai][bj][m][1] * r;
#pragma unroll
                    for (int j = 0; j < 4; ++j) { const float a = fmaxf(v0[j], 0.f), b = fmaxf(v1[j], 0.f); v0[j] = a * a; v1[j] = b * b; }
                    u32x4 w; w.x = cvt_pk_bf16(v0[0], v0[1]); w.y = cvt_pk_bf16(v0[2], v0[3]); w.z = cvt_pk_bf16(v1[0], v1[1]); w.w = cvt_pk_bf16(v1[2], v1[3]);
                    *(u32x4*)(rowp + bj * HALF) = w; } }
    }
};
__device__ __forceinline__ float relu_i(float x) { const int i = (int)__builtin_bit_cast(unsigned, x); return __builtin_bit_cast(float, (unsigned)(i > 0 ? i : 0)); }
__device__ __forceinline__ unsigned pk4_fp8(float a, float b, float c, float d) {
    a = __builtin_amdgcn_fmed3f(a, -448.f, 448.f); b = __builtin_amdgcn_fmed3f(b, -448.f, 448.f); c = __builtin_amdgcn_fmed3f(c, -448.f, 448.f); d = __builtin_amdgcn_fmed3f(d, -448.f, 448.f);
    int w = 0; w = __builtin_amdgcn_cvt_pk_fp8_f32(a, b, w, false); w = __builtin_amdgcn_cvt_pk_fp8_f32(c, d, w, true); return (unsigned)w;
}
constexpr float HID_SCALE = 0.25f; static_assert(HID_SCALE == 0.25f, "EpiMlp1F8B folds sqrt(HID_SCALE) = 0.5 into its column scales");
struct EpiMlp1F8 {
    static constexpr bool PERM = true, AFTER_DRAIN = false; static constexpr int MIDT = 0, MIDT2 = 0;
    unsigned char* O; const stat_t* ss;
    __device__ __forceinline__ void operator()(const f32x4 (&acc)[2][2][4][2], const Unit& u, int wr, int wc, int fr, int fq) const {
        typedef unsigned u32x2v __attribute__((ext_vector_type(2)));
        const int row0 = u.pm * BM + wr * 64 + fr, col0 = u.pn * BM + wc * 32 + 8 * fq;
#pragma unroll
        for (int ai = 0; ai < 2; ++ai)
#pragma unroll
            for (int m = 0; m < 4; ++m) { const int row = row0 + ai * HALF + m * 16; const float r = rsqrtf(stat_get(ss + row) * (1.0f / 1024.0f) + RMS_EPS);
                unsigned char* rowp = O + (size_t)row * 4096 + col0;
#pragma unroll
                for (int bj = 0; bj < 2; ++bj) { f32x4 v0 = acc[ai][bj][m][0] * r, v1 = acc[ai][bj][m][1] * r;
#pragma unroll
                    for (int j = 0; j < 4; ++j) { const float a = fmaxf(v0[j], 0.f), b = fmaxf(v1[j], 0.f); v0[j] = a * a * HID_SCALE; v1[j] = b * b * HID_SCALE; }
                    u32x2v w; w.x = pk4_fp8(v0[0], v0[1], v0[2], v0[3]); w.y = pk4_fp8(v1[0], v1[1], v1[2], v1[3]);
                    *(u32x2v*)(rowp + bj * HALF) = w; } }
    }
};
struct EpiMlp1F8B {
    static constexpr bool PERM = true, AFTER_DRAIN = false; static constexpr int MIDT = 0, MIDT2 = 0;
    unsigned char* O; const unsigned* wmax;
    __device__ __forceinline__ void operator()(const f32x4 (&acc)[2][2][4][2], const Unit& u, int wr, int wc, int fr, int fq) const {
        const int row0 = u.pm * BM + wr * 64 + fr, col0 = u.pn * BM + wc * 32 + 8 * fq;
        f32x4 cs[2][2];
#pragma unroll
        for (int bj = 0; bj < 2; ++bj)
#pragma unroll
            for (int n = 0; n < 2; ++n) { const u32x4 wm = *(const PG8_GAS u32x4*)(wmax + col0 + bj * HALF + 4 * n);
                cs[bj][n] = (f32x4){fmaxf(__uint_as_float(wm.x), 1e-30f), fmaxf(__uint_as_float(wm.y), 1e-30f), fmaxf(__uint_as_float(wm.z), 1e-30f), fmaxf(__uint_as_float(wm.w), 1e-30f)} * (0.5f / (448.0f * 8.0f)); }
        const bool odd = (fq & 1) != 0;
#pragma unroll
        for (int ai = 0; ai < 2; ++ai)
#pragma unroll
            for (int mp = 0; mp < 4; mp += 2) {
#pragma unroll
                for (int bj = 0; bj < 2; ++bj) { unsigned wa[2][2];
#pragma unroll
                    for (int q = 0; q < 2; ++q) { f32x4 v0 = acc[ai][bj][mp + q][0] * cs[bj][0], v1 = acc[ai][bj][mp + q][1] * cs[bj][1];
#pragma unroll
                        for (int j = 0; j < 4; ++j) { const float a = relu_i(v0[j]), b = relu_i(v1[j]); v0[j] = a * a; v1[j] = b * b; }
                        wa[q][0] = pk4_fp8(v0[0], v0[1], v0[2], v0[3]); wa[q][1] = pk4_fp8(v1[0], v1[1], v1[2], v1[3]); }
                    const unsigned s0 = odd ? wa[0][0] : wa[1][0], s1 = odd ? wa[0][1] : wa[1][1];
                    const unsigned r0 = (unsigned)__shfl_xor((int)s0, 16), r1 = (unsigned)__shfl_xor((int)s1, 16);
                    u32x4 o; if (odd) { o.x = r0; o.y = r1; o.z = wa[1][0]; o.w = wa[1][1]; } else { o.x = wa[0][0]; o.y = wa[0][1]; o.z = r0; o.w = r1; }
                    const int row = row0 + ai * HALF + (mp + (odd ? 1 : 0)) * 16;
                    *(PG8_GAS u32x4*)(O + (size_t)row * 4096 + (col0 & ~15) + bj * HALF) = o; } }
    }
};
struct EpiRes8 {
    static constexpr bool PERM = true, AFTER_DRAIN = false; static constexpr int MIDT = 0, MIDT2 = 0;
    bf16_t* H; stat_t* ssn; const unsigned* wmax;
    __device__ __forceinline__ void operator()(const f32x4 (&acc)[2][2][4][2], const Unit& u, int wr, int wc, int fr, int fq) const {
        const int row0 = u.pm * BM + wr * 64 + fr, col0 = u.pn * BM + wc * 32 + 8 * fq;
        f32x4 cs[2][2];
#pragma unroll
        for (int bj = 0; bj < 2; ++bj)
#pragma unroll
            for (int n = 0; n < 2; ++n) { const u32x4 wm = *(const u32x4*)(wmax + col0 + bj * HALF + 4 * n);
                cs[bj][n] = (f32x4){fmaxf(__uint_as_float(wm.x), 1e-30f), fmaxf(__uint_as_float(wm.y), 1e-30f), fmaxf(__uint_as_float(wm.z), 1e-30f), fmaxf(__uint_as_float(wm.w), 1e-30f)} * (1.0f / (448.0f * HID_SCALE)); }
#pragma unroll
        for (int ai = 0; ai < 2; ++ai) {
            u32x4 h8[4][2];
#pragma unroll
            for (int m = 0; m < 4; ++m) { const int row = row0 + ai * HALF + m * 16; const PG8_GAS u32x4* rp = (const PG8_GAS u32x4*)(H + (size_t)row * 1024 + col0); h8[m][0] = rp[0]; h8[m][1] = rp[HALF / 8]; }
#pragma unroll
            for (int m = 0; m < 4; ++m) { const int row = row0 + ai * HALF + m * 16; float q = 0.f; PG8_GAS u32x4* wp = (PG8_GAS u32x4*)(H + (size_t)row * 1024 + col0);
#pragma unroll
                for (int bj = 0; bj < 2; ++bj) { const u32x4 hv = h8[m][bj];
                    const f32x4 a0 = acc[ai][bj][m][0] * cs[bj][0], a1 = acc[ai][bj][m][1] * cs[bj][1];
                    u32x4 w; w.x = cvt_pk_bf16(bf_lo(hv.x) + a0[0], bf_hi(hv.x) + a0[1]); w.y = cvt_pk_bf16(bf_lo(hv.y) + a0[2], bf_hi(hv.y) + a0[3]);
                    w.z = cvt_pk_bf16(bf_lo(hv.z) + a1[0], bf_hi(hv.z) + a1[1]); w.w = cvt_pk_bf16(bf_lo(hv.w) + a1[2], bf_hi(hv.w) + a1[3]);
                    wp[bj * (HALF / 8)] = w;
                    q += (bf_lo(w.x) * bf_lo(w.x) + bf_hi(w.x) * bf_hi(w.x)) + (bf_lo(w.y) * bf_lo(w.y) + bf_hi(w.y) * bf_hi(w.y))
                       + (bf_lo(w.z) * bf_lo(w.z) + bf_hi(w.z) * bf_hi(w.z)) + (bf_lo(w.w) * bf_lo(w.w) + bf_hi(w.w) * bf_hi(w.w)); }
                q = quad_sum(q); if (fq == 0) stat_add(ssn + row, q); } }
    }
};
typedef int v8i_t __attribute__((ext_vector_type(8))); typedef int v4i_t __attribute__((ext_vector_type(4)));
template <class Epi, class Sched, bool ALIGN_EPI = false, bool SP2 = false, bool F8 = false>
__device__ __forceinline__ void gemm_phase(PG8_LAS unsigned char* lds, const Gemm g, const Sched& S, const Epi& E, const int wid_in) {
    int lane_; asm volatile("v_mbcnt_lo_u32_b32 %0, -1, 0\n\tv_mbcnt_hi_u32_b32 %0, -1, %0" : "=v"(lane_)); const int tid_ = wid_in * 64 + lane_;
    const int tid = tid_, wid = wid_in, lane = lane_, wr = wid >> 2, wc = wid & 3, fr = lane & 15, fq = lane >> 4;
    const int K = g.K, nt = K / BK;
    unsigned voffA[2], voffB[2];
#pragma unroll
    for (int i = 0; i < 2; ++i) { int R, C; stage_rc(tid * 16 + i * 8192, R, C); const int Rb = Epi::PERM ? ((R & ~31) + perm32(R & 31)) : R;
        voffA[i] = (unsigned)(R * K + C) * 2u; voffB[i] = (unsigned)(Rb * K + C) * 2u; }
    const size_t kstep = (size_t)(BK * 2);
    const size_t hstep = (size_t)HALF * K * 2;
    const size_t tstep = 2 * hstep;
    const unsigned ldsw = (unsigned)wid * 1024u;
    const int aoff = lds_byte(wr * 64 + fr, fq * 8), boff = lds_byte(wc * 32 + fr, fq * 8);
#define PG8_SA(b, h) (((b) * 2 + (h)) * HTB)
#define PG8_SB(b, h) ((4 + (b) * 2 + (h)) * HTB)
#define PG8_STAGE(bufoff, gbase, voff) do { _Pragma("unroll") for (int _i = 0; _i < 2; ++_i) \
        __builtin_amdgcn_global_load_lds((const unsigned*)((const char*)(gbase) + (voff)[_i]), (PG8_LAS unsigned*)(lds + (bufoff) + ldsw + _i * 8192), 16, 0, 0); } while (0)
#define PG8_LDA(dst, b, h) do { if constexpr (F8) { _Pragma("unroll") for (int m = 0; m < 4; ++m) dst##_8[m] = __builtin_shufflevector(*(const PG8_LAS v4i_t*)(lds + PG8_SA(b, h) + aoff + m * 2048), *(const PG8_LAS v4i_t*)(lds + PG8_SA(b, h) + aoff + m * 2048 + 1024), 0, 1, 2, 3, 4, 5, 6, 7); } \
        else { _Pragma("unroll") for (int m = 0; m < 4; ++m) _Pragma("unroll") for (int k = 0; k < 2; ++k) dst[m][k] = *(const PG8_LAS bf16x8*)(lds + PG8_SA(b, h) + aoff + m * 2048 + k * 1024); } } while (0)
#define PG8_LDB(dst, b, h) do { if constexpr (F8) { _Pragma("unroll") for (int n = 0; n < 2; ++n) dst##_8[n] = __builtin_shufflevector(*(const PG8_LAS v4i_t*)(lds + PG8_SB(b, h) + boff + n * 2048), *(const PG8_LAS v4i_t*)(lds + PG8_SB(b, h) + boff + n * 2048 + 1024), 0, 1, 2, 3, 4, 5, 6, 7); } \
        else { _Pragma("unroll") for (int n = 0; n < 2; ++n) _Pragma("unroll") for (int k = 0; k < 2; ++k) dst[n][k] = *(const PG8_LAS bf16x8*)(lds + PG8_SB(b, h) + boff + n * 2048 + k * 1024); } } while (0)
#define PG8_MMA(ai, bj, At, Bt) do { __builtin_amdgcn_s_setprio(1); \
        if constexpr (F8) { _Pragma("unroll") for (int m = 0; m < 4; ++m) _Pragma("unroll") for (int n = 0; n < 2; ++n) { \
            asm volatile("v_mfma_f32_16x16x128_f8f6f4 %0, %1, %2, %0" : "+v"(acc[ai][bj][m][n]) : "v"(Bt##_8[n]), "v"(At##_8[m])); } } \
        else { _Pragma("unroll") for (int m = 0; m < 4; ++m) _Pragma("unroll") for (int n = 0; n < 2; ++n) _Pragma("unroll") for (int k = 0; k < 2; ++k) \
            acc[ai][bj][m][n] = __builtin_amdgcn_mfma_f32_16x16x32_bf16(Bt[n][k], At[m][k], acc[ai][bj][m][n], 0, 0, 0); } \
        __builtin_amdgcn_s_setprio(0); } while (0)
#define PG8_WAIT_V(n) asm volatile("s_waitcnt vmcnt(" #n ")" ::: "memory")
#define PG8_WAIT_L(n) asm volatile("s_waitcnt lgkmcnt(" #n ")" ::: "memory")
#define PG8_BAR __builtin_amdgcn_s_barrier()
#define PG8_SCHED __builtin_amdgcn_sched_barrier(0)
    Unit cur, nxt; int ui = 0;
    if (!S.next(0, cur)) return;
    f32x4 acc[2][2][4][2];
#pragma unroll
    for (int a = 0; a < 2; ++a)
#pragma unroll
        for (int b = 0; b < 2; ++b)
#pragma unroll
            for (int m = 0; m < 4; ++m)
#pragma unroll
                for (int n = 0; n < 2; ++n) acc[a][b][m][n] = (f32x4){0.f, 0.f, 0.f, 0.f};
    bf16x8 At[4][2], B0[2][2], B1[2][2];
    v8i_t At_8[4], B0_8[2], B1_8[2];
    const char* cA = (const char*)g.A + (size_t)cur.pm * tstep; const char* cB = (const char*)g.Bt + (size_t)cur.pn * tstep;
    S.a_ready(cur);
    if constexpr (SP2) {
        PG8_STAGE(PG8_SB(0, 0), cB, voffB); PG8_STAGE(PG8_SB(0, 1), cB + hstep, voffB); PG8_STAGE(PG8_SA(0, 0), cA, voffA); PG8_STAGE(PG8_SA(0, 1), cA + hstep, voffA);
        if (wr == 1) PG8_BAR;
        PG8_WAIT_V(2); PG8_BAR;
        PG8_STAGE(PG8_SB(1, 0), cB + kstep, voffB); PG8_STAGE(PG8_SA(1, 0), cA + kstep, voffA); PG8_STAGE(PG8_SB(1, 1), cB + hstep + kstep, voffB);
        PG8_WAIT_V(6); PG8_BAR;
    } else {
        PG8_STAGE(PG8_SB(0, 0), cB, voffB); PG8_STAGE(PG8_SA(0, 0), cA, voffA); PG8_STAGE(PG8_SB(0, 1), cB + hstep, voffB); PG8_STAGE(PG8_SA(0, 1), cA + hstep, voffA);
        if (wr == 1) PG8_BAR;
        PG8_WAIT_V(4); PG8_BAR;
        PG8_STAGE(PG8_SB(1, 0), cB + kstep, voffB); PG8_STAGE(PG8_SA(1, 0), cA + kstep, voffA); PG8_STAGE(PG8_SB(1, 1), cB + hstep + kstep, voffB);
        PG8_WAIT_V(6); PG8_BAR;
    }
    for (;;) {
        const bool has_next = S.next(ui + 1, nxt);
        const char* nA = has_next ? (const char*)g.A + (size_t)nxt.pm * tstep : cA; const char* nB = has_next ? (const char*)g.Bt + (size_t)nxt.pn * tstep : cB;
        for (int t = 0; t < nt; t += 2) {
            const bool last = (t == nt - 2);
            const char* a1 = cA + (size_t)(t + 1) * kstep;
            const char* a2 = last ? nA : cA + (size_t)(t + 2) * kstep; const char* b2 = last ? nB : cB + (size_t)(t + 2) * kstep;
            const char* a3 = a2 + kstep; const char* b3 = b2 + kstep;
            if (last && has_next) S.a_ready(nxt);
            if constexpr (SP2) {
            PG8_LDB(B0, 0, 0); PG8_LDB(B1, 0, 1); PG8_SCHED; PG8_LDA(At, 0, 0); PG8_STAGE(PG8_SA(1, 1), a1 + hstep, voffA);
            PG8_WAIT_V(8); PG8_WAIT_L(0); PG8_BAR; PG8_MMA(0, 0, At, B0); PG8_MMA(0, 1, At, B1); PG8_BAR; PG8_SCHED;
            PG8_LDA(At, 0, 1); PG8_STAGE(PG8_SB(0, 0), b2, voffB); PG8_STAGE(PG8_SB(0, 1), b2 + hstep, voffB); PG8_STAGE(PG8_SA(0, 0), a2, voffA);
            PG8_WAIT_V(8); PG8_WAIT_L(0); PG8_BAR; PG8_MMA(1, 0, At, B0); PG8_MMA(1, 1, At, B1); PG8_BAR; PG8_SCHED;
            PG8_LDB(B0, 1, 0); PG8_LDB(B1, 1, 1); PG8_SCHED; PG8_LDA(At, 1, 0); PG8_STAGE(PG8_SA(0, 1), a2 + hstep, voffA);
            PG8_WAIT_V(8); PG8_WAIT_L(0); PG8_BAR; PG8_MMA(0, 0, At, B0); PG8_MMA(0, 1, At, B1); PG8_BAR; PG8_SCHED;
            PG8_LDA(At, 1, 1); PG8_STAGE(PG8_SB(1, 0), b3, voffB); PG8_STAGE(PG8_SB(1, 1), b3 + hstep, voffB); PG8_STAGE(PG8_SA(1, 0), a3, voffA);
            PG8_WAIT_V(8); PG8_WAIT_L(0); PG8_BAR; PG8_MMA(1, 0, At, B0); PG8_MMA(1, 1, At, B1); PG8_BAR; PG8_SCHED;
            } else {
            PG8_LDB(B0, 0, 0); PG8_SCHED; PG8_LDA(At, 0, 0); PG8_STAGE(PG8_SA(1, 1), a1 + hstep, voffA);
            PG8_WAIT_L(8); PG8_BAR; PG8_WAIT_L(0); PG8_MMA(0, 0, At, B0); PG8_BAR; PG8_SCHED;
            PG8_LDB(B1, 0, 1); PG8_STAGE(PG8_SB(0, 0), b2, voffB);
            PG8_BAR; PG8_WAIT_L(0); PG8_MMA(0, 1, At, B1); PG8_BAR;
            PG8_LDA(At, 0, 1); PG8_STAGE(PG8_SA(0, 0), a2, voffA);
            PG8_BAR; PG8_WAIT_L(0); PG8_MMA(1, 0, At, B0); PG8_BAR; PG8_SCHED;
            PG8_STAGE(PG8_SB(0, 1), b2 + hstep, voffB);
            PG8_WAIT_V(6); PG8_BAR; PG8_MMA(1, 1, At, B1); PG8_BAR;
            PG8_LDB(B0, 1, 0); PG8_SCHED; PG8_LDA(At, 1, 0); PG8_STAGE(PG8_SA(0, 1), a2 + hstep, voffA);
            PG8_WAIT_L(8); PG8_BAR; PG8_WAIT_L(0); PG8_MMA(0, 0, At, B0); PG8_BAR; PG8_SCHED;
            PG8_LDB(B1, 1, 1); PG8_STAGE(PG8_SB(1, 0), b3, voffB);
            PG8_BAR; PG8_WAIT_L(0); PG8_MMA(0, 1, At, B1); PG8_BAR;
            PG8_LDA(At, 1, 1); PG8_STAGE(PG8_SA(1, 0), a3, voffA);
            PG8_BAR; PG8_WAIT_L(0); PG8_MMA(1, 0, At, B0); PG8_BAR; PG8_SCHED;
            PG8_STAGE(PG8_SB(1, 1), b3 + hstep, voffB);
            PG8_WAIT_V(6); PG8_BAR; PG8_MMA(1, 1, At, B1); PG8_BAR;
            }
            if constexpr (Epi::MIDT > 0) { if (t + 2 == Epi::MIDT || t + 2 == Epi::MIDT2) { int l2_; asm volatile("v_mbcnt_lo_u32_b32 %0, -1, 0\n\tv_mbcnt_hi_u32_b32 %0, -1, %0" : "=v"(l2_)); E.mid(acc, cur, wr, l2_ & 15, t + 2); } }
        }
        if constexpr (F8) asm volatile("s_nop 15\n\ts_nop 15" ::: "memory");
        if constexpr (ALIGN_EPI) { if (wr == 0) PG8_BAR; }
        if constexpr (!Epi::AFTER_DRAIN) { int l2_; asm volatile("v_mbcnt_lo_u32_b32 %0, -1, 0\n\tv_mbcnt_hi_u32_b32 %0, -1, %0" : "=v"(l2_));
            E(acc, cur, wr, wc, l2_ & 15, l2_ >> 4); S.done(cur); }
        if (!has_next) break;
#pragma unroll
        for (int a = 0; a < 2; ++a)
#pragma unroll
            for (int b = 0; b < 2; ++b)
#pragma unroll
                for (int m = 0; m < 4; ++m)
#pragma unroll
                    for (int n = 0; n < 2; ++n) acc[a][b][m][n] = (f32x4){0.f, 0.f, 0.f, 0.f};
        cur = nxt; cA = nA; cB = nB; ++ui;
        if constexpr (ALIGN_EPI) { if (wr == 1) PG8_BAR; }
    }
    PG8_WAIT_V(0);
    if constexpr (!ALIGN_EPI) { if (wr == 0) PG8_BAR; }
    PG8_BAR;
    if constexpr (Epi::AFTER_DRAIN) { E.fused(acc, cur, wr, wc, fr, fq, lds, wid, lane); S.done(cur); }
#undef PG8_SA
#undef PG8_SB
#undef PG8_STAGE
#undef PG8_LDA
#undef PG8_LDB
#undef PG8_MMA
#undef PG8_WAIT_V
#undef PG8_WAIT_L
#undef PG8_BAR
#undef PG8_SCHED
}
}

constexpr int NWAVES = 8;
constexpr int BATCH = 16, SEQ = 2048, DM = 1024, DEPTH = 2, NMETA = 16, DFF = 4096;
constexpr int MROWS = 33024;
constexpr int MREAL = BATCH * SEQ, MVALID = MREAL + NMETA;
constexpr int NIN_SRC = 1988, NIN = 2048;
constexpr int PC_QA = 0, PC_CKV = 256, PC_IK = 384, PC_IW = 448, PC_IQ = 512, PC_UB = 768, PC_QC = 1280, PC_KC = 1536, PC_VC = 1792;
constexpr int YC_B = 0, YC_A = 512, YC_C = 768;
constexpr int TOPK = 256;

constexpr size_t MiB = 1u << 20;
constexpr size_t WS_CTL = 0;
constexpr size_t WS_STATS = 1 * MiB, CTL_ZERO_BYTES = 5 * MiB;
constexpr size_t STAT_STRIDE = 33024;
enum StatId { ST_SS1 = 0, ST_SSKV = 1, ST_SSB = 2, ST_SS2 = 3, ST_SSA = 4, ST_SSC = 5, ST_PER_LAYER = 6 };
constexpr size_t WS_W = 6 * MiB;
constexpr size_t W_LAYER = 23 * MiB, WO_IN = 0, WO_GLU = 4 * MiB, WO_OUT = 5 * MiB, WO_1 = 7 * MiB, WO_2 = 15 * MiB;
constexpr size_t WS_HB = 52 * MiB;
constexpr size_t WS_BIG = 118 * MiB;
constexpr size_t WS_P = WS_BIG, WS_YCAT = WS_BIG + 130 * MiB, WS_YG = WS_BIG + 196 * MiB;
constexpr size_t WS_END = 376 * MiB;
constexpr size_t WS_WUKF = 497 * MiB - 512 * 1024, WS_WUVF = WS_WUKF + 128 * 1024;
static_assert(WS_STATS + (2 * ST_PER_LAYER + 1) * STAT_STRIDE * 8 <= CTL_ZERO_BYTES && CTL_ZERO_BYTES <= WS_W && WS_W + 2 * W_LAYER <= WS_HB && WS_HB + (size_t)MROWS * 1024 * 2 <= WS_BIG && WS_P + (size_t)MROWS * 2048 * 2 <= WS_YCAT && WS_YCAT + (size_t)MROWS * 1024 * 2 <= WS_YG
              && WS_YG + (size_t)MROWS * 512 * 2 <= WS_BIG + (size_t)MROWS * 4096 * 2 && WS_BIG + (size_t)MROWS * 4096 * 2 <= WS_END, "d_ws map");
constexpr int CW_TMO = 0, CW_CODE = 1;
constexpr int CW_BAR = 4096;
constexpr int CW_WMAX1 = 65536 + 2048;
constexpr int CW_WMAX = 65536;
constexpr int CW_Q = 16384;

constexpr int RING_OFF = 0, RING_BYTES = 131072;
constexpr int LDSCTL_OFF = RING_BYTES, MISC_OFF = LDSCTL_OFF + 320;
constexpr int LDS_BYTES = 147456;

#define GAS __attribute__((address_space(1)))
#define LAS __attribute__((address_space(3)))
typedef unsigned short bf16;
typedef unsigned v4u __attribute__((ext_vector_type(4)));
typedef float f32x4 __attribute__((ext_vector_type(4)));
typedef GAS unsigned gu32;
#define RLX_AGENT __ATOMIC_RELAXED, __HIP_MEMORY_SCOPE_AGENT
#define LDS_WAIT() asm volatile("s_waitcnt lgkmcnt(0)" ::: "memory")
#define VM_WAIT() asm volatile("s_waitcnt vmcnt(0)" ::: "memory")
__device__ __forceinline__ unsigned f2bf(float f) { unsigned u = __builtin_bit_cast(unsigned, f); return (u + 0x7fffu + ((u >> 16) & 1u)) >> 16; }
__device__ __forceinline__ unsigned pk2(float lo, float hi) { return f2bf(lo) | (f2bf(hi) << 16); }
__device__ __forceinline__ float bf2f(bf16 v) { return __uint_as_float((unsigned)v << 16); }
__device__ __forceinline__ float bflo(unsigned w) { return __uint_as_float(w << 16); }
__device__ __forceinline__ float bfhi(unsigned w) { return __uint_as_float(w & 0xffff0000u); }

__device__ __forceinline__ int lane_id() { int l; asm volatile("v_mbcnt_lo_u32_b32 %0, -1, 0\n\tv_mbcnt_hi_u32_b32 %0, -1, %0" : "=v"(l)); return l; }
#define XB_TMO      128
#define XB_XCNT(j)  (256  + 64 * (j))
#define XB_XSUB(j)  (1280 + 64 * (j))
#define XB_XGEN(j)  (2304 + 64 * (j))
#define XB_TOP      3328
#define XB_TOPGEN   3392
#define XCD_BAR_WORDS 3456
#define XB_SPIN_CAP (1u << 21)

__device__ __forceinline__ unsigned xb_ld(unsigned* p)              { return __hip_atomic_load(p, __ATOMIC_RELAXED, __HIP_MEMORY_SCOPE_AGENT); }
__device__ __forceinline__ unsigned xb_add(unsigned* p, unsigned v) { return __hip_atomic_fetch_add(p, v, __ATOMIC_RELAXED, __HIP_MEMORY_SCOPE_AGENT); }
__device__ __forceinline__ unsigned xb_xcc_id() { return (unsigned)__builtin_amdgcn_s_getreg((3 << 11) | 20) & 0xFu; }
#define XB_SPIN(cond, bar) do { unsigned _sp = 0; while (cond) { __builtin_amdgcn_s_sleep(1); \
    if ((++_sp & 255u) == 0u) { if (xb_ld(&(bar)[XB_TMO])) break; if (_sp > XB_SPIN_CAP) { atomicAdd(&(bar)[XB_TMO], 1u); break; } } } } while (0)

struct XcdBarrier { unsigned* bar; unsigned x; volatile LAS unsigned* st; };
__device__ __forceinline__ XcdBarrier xcd_barrier_post(unsigned* bar, volatile LAS unsigned* st, int wave) {
    XcdBarrier b; b.bar = bar; b.x = xb_xcc_id(); b.st = st;
    if (wave == 0 && lane_id() == 0) (void)xb_add(&bar[XB_XCNT(b.x)], 1u);
    return b;
}
__device__ __forceinline__ void xcd_barrier_complete(unsigned* bar, unsigned x, unsigned& nloc, unsigned& nx) {
    const unsigned G = gridDim.x * gridDim.y * gridDim.z;
    unsigned sum, cnt, mine, sp = 0u;
    for (;;) {
        sum = 0u; cnt = 0u; mine = 0u;
#pragma unroll
        for (unsigned j = 0; j < 16; ++j) { const unsigned c = xb_ld(&bar[XB_XCNT(j)]); sum += c; cnt += (c > 0u) ? 1u : 0u; mine = (j == x) ? c : mine; }
        if (sum == G) break;
        __builtin_amdgcn_s_sleep(1);
        if ((++sp & 255u) == 0u) { if (xb_ld(&bar[XB_TMO])) break; if (sp > XB_SPIN_CAP) { atomicAdd(&bar[XB_TMO], 1u); break; } }
    }
    nloc = mine > 0u ? mine : 1u; nx = cnt > 0u ? cnt : 1u;
}
__device__ __forceinline__ void xcd_barrier(const XcdBarrier& b, int wave) {
    asm volatile("s_waitcnt vmcnt(0)" ::: "memory");
    __syncthreads();
    if (wave == 0 && lane_id() == 0) {
        unsigned* bar = b.bar;
        __builtin_amdgcn_s_waitcnt(0);
        unsigned nloc = b.st[0], nx = b.st[1];
        if (nloc == 0u) { xcd_barrier_complete(bar, b.x, nloc, nx); b.st[0] = nloc; b.st[1] = nx; }
        const unsigned old = xb_add(&bar[XB_XSUB(b.x)], 1u);
        const unsigned gen = old / nloc;
        if (old + 1u == (gen + 1u) * nloc) {
            __builtin_amdgcn_fence(__ATOMIC_RELEASE, "agent");
            asm volatile("s_waitcnt vmcnt(0)" ::: "memory");
            const unsigned og = xb_add(&bar[XB_TOP], 1u);
            const unsigned tg = og / nx;
            if (og + 1u == (tg + 1u) * nx) xb_add(&bar[XB_TOPGEN], 1u);
            else XB_SPIN(xb_ld(&bar[XB_TOPGEN]) == tg, bar);
            __builtin_amdgcn_fence(__ATOMIC_ACQUIRE, "agent");
            xb_add(&bar[XB_XGEN(b.x)], 1u);
            asm volatile("s_waitcnt vmcnt(0)" ::: "memory");
        } else {
            XB_SPIN(xb_ld(&bar[XB_XGEN(b.x)]) == gen, bar);
            __builtin_amdgcn_fence(__ATOMIC_ACQUIRE, "agent");
            asm volatile("s_waitcnt vmcnt(0)" ::: "memory");
        }
    }
    __syncthreads();
}


struct Args { const float* in[25]; float* out; unsigned char* ws; int ph_lo, ph_hi; };
struct Frame {
    LAS unsigned char* lds;
    volatile LAS unsigned* MISC;
    gu32* ctl;
    int wave;
    int vcu, G;
    float* out; unsigned char* ws;
};
using pg8::stat_t; using pg8::stat_get;
__device__ __forceinline__ stat_t* stat_ptr(Frame& F, int l, int id) { return (stat_t*)(F.ws + WS_STATS) + (size_t)(l * ST_PER_LAYER + id) * STAT_STRIDE; }
__device__ __forceinline__ bf16* wptr(Frame& F, int l, size_t off) { return (bf16*)(F.ws + WS_W + (size_t)l * W_LAYER + off); }
__device__ __forceinline__ float wave_sum(float v) {
#pragma unroll
    for (int o = 1; o < 64; o <<= 1) v += __shfl_xor(v, o);
    return v;
}
__device__ __forceinline__ float wave_max(float v) {
#pragma unroll
    for (int o = 1; o < 64; o <<= 1) v = fmaxf(v, __shfl_xor(v, o));
    return v;
}
__device__ __forceinline__ int key_row(int b, int kp) { return kp < NMETA ? MREAL + kp : b * SEQ + (kp - NMETA); }

__device__ __forceinline__ int win_srccol(int n) {
    if (n < 384) return n;
    if (n < 448) return 640 + (n - 384);
    if (n < 452) return 704 + (n - 448);
    if (n < 512) return -1;
    if (n < 768) return 384 + (n - 512);
    if (n < 1280) return 708 + (n - 768);
    return 1220 + (n - 1280);
}
__device__ __forceinline__ void p0_transpose_item(const Args& A, Frame& F, int l, int mat, int item, LAS float* scr) {
    const int lane = lane_id();
    int N, K, ldw; const float* W; bf16* WT;
    if (mat == 0) { N = 2048; K = 1024; ldw = NIN_SRC; W = A.in[4] + (size_t)l * 1024 * NIN_SRC; WT = wptr(F, l, WO_IN); }
    else if (mat == 1) { N = 512; K = 512; ldw = 512; W = A.in[16] + (size_t)l * 512 * 512; WT = wptr(F, l, WO_GLU); }
    else if (mat == 2) { N = 1024; K = 1024; ldw = 1024; W = A.in[20] + (size_t)l * 1024 * 1024; WT = wptr(F, l, WO_OUT); }
    else if (mat == 3) { N = 4096; K = 1024; ldw = 4096; W = A.in[22] + (size_t)l * 1024 * 4096; WT = wptr(F, l, WO_1); }
    else { N = 1024; K = 4096; ldw = 1024; W = A.in[23] + (size_t)l * 4096 * 1024; WT = wptr(F, l, WO_2); }
    if (mat == 3) {
        const int nblk = N / 32, kb = item / nblk, nb = item % nblk, k0 = 64 * kb, n0 = 32 * nb, kr = lane >> 3, c4 = lane & 7; float m[4] = {0.f, 0.f, 0.f, 0.f};
#pragma unroll
        for (int i = 0; i < 8; ++i) { const int kk = k0 + 8 * i + kr; const pg8::f32x4 v = *(const GAS pg8::f32x4*)(W + (size_t)kk * ldw + n0 + 4 * c4); const float g = A.in[21][l * 1024 + kk];
#pragma unroll
            for (int e_ = 0; e_ < 4; ++e_) m[e_] = fmaxf(m[e_], fabsf(v[e_] * g)); }
#pragma unroll
        for (int e_ = 0; e_ < 4; ++e_) { m[e_] = fmaxf(m[e_], __shfl_xor(m[e_], 8)); m[e_] = fmaxf(m[e_], __shfl_xor(m[e_], 16)); m[e_] = fmaxf(m[e_], __shfl_xor(m[e_], 32)); }
        if (lane < 8) {
#pragma unroll
            for (int e_ = 0; e_ < 4; ++e_) atomicMax((unsigned*)(F.ctl + CW_WMAX1 + l * 4096 + n0 + 4 * c4 + e_), __float_as_uint(m[e_])); }
        return; }
    if (mat == 4) {
        const int nblk = N / 32, kb = item / nblk, nb = item % nblk, k0 = 64 * kb, n0 = 32 * nb, kr = lane >> 3, c4 = lane & 7; float m[4] = {0.f, 0.f, 0.f, 0.f};
#pragma unroll
        for (int i = 0; i < 8; ++i) { const pg8::f32x4 v = *(const GAS pg8::f32x4*)(W + (size_t)(k0 + 8 * i + kr) * ldw + n0 + 4 * c4);
#pragma unroll
            for (int e_ = 0; e_ < 4; ++e_) m[e_] = fmaxf(m[e_], fabsf(v[e_])); }
#pragma unroll
        for (int e_ = 0; e_ < 4; ++e_) { m[e_] = fmaxf(m[e_], __shfl_xor(m[e_], 8)); m[e_] = fmaxf(m[e_], __shfl_xor(m[e_], 16)); m[e_] = fmaxf(m[e_], __shfl_xor(m[e_], 32)); }
        if (lane < 8) {
#pragma unroll
            for (int e_ = 0; e_ < 4; ++e_) atomicMax((unsigned*)(F.ctl + CW_WMAX + l * 1024 + n0 + 4 * c4 + e_), __float_as_uint(m[e_])); }
        return; }
    const int nblk = N / 32, kb = item / nblk, nb = item % nblk, k0 = 64 * kb, n0 = 32 * nb;
    const int kr = lane >> 3, c4 = lane & 7, n = n0 + 4 * c4;
    int sc = n; float cs = 1.f;
    if (mat == 0) { sc = win_srccol(n); if (n >= PC_QC && n < PC_KC) cs = 0.125f; }
#pragma unroll
    for (int i = 0; i < 8; ++i) { const int kk = 8 * i + kr, k = k0 + kk; int ks = k; float g = 1.f;
        if (mat == 0) g = A.in[3][l * 1024 + k];
        else if (mat == 2) { if (k < 512) { ks = 256 + k; g = A.in[18][l * 512 + k]; } else if (k < 768) { ks = k - 512; g = A.in[17][l * 256 + (k - 512)]; } else { ks = k; g = A.in[19][l * 256 + (k - 768)]; } }
        pg8::f32x4 v = (pg8::f32x4){0.f, 0.f, 0.f, 0.f}; if (sc >= 0) v = *(const GAS pg8::f32x4*)(W + (size_t)ks * ldw + sc);
        g *= cs;
#pragma unroll
        for (int e_ = 0; e_ < 4; ++e_) scr[kk * 33 + 4 * c4 + e_] = v[e_] * g; }
    LDS_WAIT(); asm volatile("" ::: "memory");
    const int c = lane & 7;
#pragma unroll
    for (int j = 0; j < 4; ++j) { const int nn = (lane >> 3) + 8 * j; const LAS float* s = scr + (8 * c) * 33 + nn;
        v4u o; o.x = pk2(s[0 * 33], s[1 * 33]); o.y = pk2(s[2 * 33], s[3 * 33]); o.z = pk2(s[4 * 33], s[5 * 33]); o.w = pk2(s[6 * 33], s[7 * 33]);
        *(GAS v4u*)(WT + (size_t)(n0 + nn) * K + k0 + 8 * c) = o; }
    LDS_WAIT(); asm volatile("" ::: "memory");
}
__device__ __forceinline__ void s5_build_item(const Args& A, Frame& F, int l, int kind, int g, int x, LAS float* scr);
__device__ __forceinline__ void p0_prologue(const Args& A, Frame& F) {
    const int lane = lane_id();
    LAS float* scr = (LAS float*)(F.lds + RING_OFF + F.wave * 16384);
    const int gw = F.vcu * NWAVES + F.wave, NGW = F.G * NWAVES;
    constexpr int I0 = 16 * 64, I1 = 8 * 16, I2 = 16 * 32, I3 = 16 * 128, I4 = 64 * 32, IL = I0 + I1 + I2 + I3 + I4;
    for (int it = gw; it < DEPTH * IL; it += NGW) {
        const int l = it / IL; int r = it % IL;
        if (r < I0) { p0_transpose_item(A, F, l, 0, r, scr); continue; } r -= I0;
        if (r < I1) { p0_transpose_item(A, F, l, 1, r, scr); continue; } r -= I1;
        if (r < I2) { p0_transpose_item(A, F, l, 2, r, scr); continue; } r -= I2;
        if (r < I3) { p0_transpose_item(A, F, l, 3, r, scr); continue; } r -= I3;
        p0_transpose_item(A, F, l, 4, r, scr);
    }
    for (int it = gw; it < DEPTH * 3 * 1024; it += NGW) { const int l = it / 3072, r = it % 3072; s5_build_item(A, F, l, r >> 10, (r >> 5) & 31, r & 31, scr); }
    for (int it = gw; it < DEPTH * 4 * 16 * 2; it += NGW) { const int tb_ = it & 1, fr_ = (it >> 1) & 15, h_ = (it >> 5) & 3, l_ = it >> 7; const int r32_ = lane & 31, hi_ = lane >> 5;
        const float* wuk_ = A.in[6] + (size_t)l_ * 128 * 256; const float* wuv_ = A.in[7] + (size_t)l_ * 128 * 256; const float* kvg_ = A.in[5] + l_ * 128;
        float v_[8];
        if (tb_ == 0) { const int c_ = fr_ >> 2, ks_ = fr_ & 3, rank_ = 32 * c_ + r32_; const float sc_ = kvg_[rank_] * 0.125f;
#pragma unroll
            for (int e_ = 0; e_ < 8; ++e_) v_[e_] = wuk_[((size_t)rank_ * 4 + h_) * 64 + ks_ * 16 + hi_ * 8 + e_] * sc_; }
        else { const int c_ = fr_ >> 2, s_ = (fr_ >> 1) & 1, db_ = fr_ & 1, d_ = 32 * db_ + r32_;
#pragma unroll
            for (int j_ = 0; j_ < 8; ++j_) { const int rk_ = 32 * c_ + 16 * s_ + 8 * (j_ >> 2) + 4 * hi_ + (j_ & 3); v_[j_] = wuv_[((size_t)rk_ * 4 + h_) * 64 + d_] * kvg_[rk_]; } }
        v4u o_; o_.x = pk2(v_[0], v_[1]); o_.y = pk2(v_[2], v_[3]); o_.z = pk2(v_[4], v_[5]); o_.w = pk2(v_[6], v_[7]);
        *((GAS v4u*)(F.ws + (tb_ == 0 ? WS_WUKF : WS_WUVF)) + ((size_t)(l_ * 4 + h_) * 16 + fr_) * 64 + lane) = o_; }
    bf16* Hb = (bf16*)(F.ws + WS_HB); stat_t* ss = stat_ptr(F, 0, ST_SS1);
    for (int m0 = gw * 4; m0 < MVALID; m0 += NGW * 4) {
        f32x4 v[4][4];
#pragma unroll
        for (int q = 0; q < 4; ++q) { const int m = m0 + q < MVALID ? m0 + q : MVALID - 1;
            const float* src = m < MREAL ? A.in[0] + (size_t)m * DM : A.in[1] + (size_t)(m - MREAL) * DM; const GAS f32x4* xr = (const GAS f32x4*)src + 2 * lane;
#pragma unroll
            for (int j = 0; j < 4; ++j) v[q][j] = xr[(j >> 1) * 128 + (j & 1)]; }
#pragma unroll
        for (int q = 0; q < 4; ++q) { const int m = m0 + q; if (m < MVALID) {
            GAS v4u* o16 = (GAS v4u*)(Hb + (size_t)m * DM) + lane; float s = 0.f;
#pragma unroll
            for (int jh = 0; jh < 2; ++jh) { v4u o;
#pragma unroll
                for (int i = 0; i < 2; ++i) { const f32x4 vv = v[q][2 * jh + i]; const unsigned w0 = pk2(vv.x, vv.y), w1 = pk2(vv.z, vv.w); o[2 * i] = w0; o[2 * i + 1] = w1;
                    s += (bflo(w0) * bflo(w0) + bfhi(w0) * bfhi(w0)) + (bflo(w1) * bflo(w1) + bfhi(w1) * bfhi(w1)); }
                o16[64 * jh] = o; }
            s = wave_sum(s); if (lane == 0) ss[m] = (stat_t)((double)s * 4294967296.0); } }
    }
}

__device__ __forceinline__ float log_sigmoid_f(float x) { return fminf(x, 0.f) - log1pf(__expf(-fabsf(x))); }
__device__ __forceinline__ float gelu_tanh_f(float x) { const float u = 0.7978845608028654f * (x + 0.044715f * x * x * x); return 0.5f * x * (1.0f + tanhf(u)); }
__device__ __forceinline__ unsigned mono_key(float f) { const unsigned u = __float_as_uint(f); return (u & 0x80000000u) ? ~u : (u | 0x80000000u); }
__device__ __forceinline__ int t5_bucket(int d) {
    if (d < 16) return d;
    const int v = 16 + (int)(logf((float)d / 16.0f) / 2.0794415416798357f * 16.0f);
    return v < 31 ? v : 31;
}

__device__ __forceinline__ void s5_naive_item(const Args& A, Frame& F, int l, int b, int g) {
    const int p = lane_id();
    const bf16* P = (const bf16*)(F.ws + WS_P); bf16* YG = (bf16*)(F.ws + WS_YG);
    const int lg = l * 32 + g;
    const float dt = expf(A.in[10][lg]), lr = A.in[8][lg * 64 + p], li = A.in[9][lg * 64 + p];
    const float mag = expf(lr * dt), ar = mag * cosf(li * dt), ai = mag * sinf(li * dt);
    const float den = lr * lr + li * li, nr = ar - 1.0f, ni = ai;
    const float fr_ = (nr * lr + ni * li) / den, fi_ = (ni * lr - nr * li) / den;
    float Br[16], Bi[16], Cr[16], Ci[16];
#pragma unroll
    for (int c = 0; c < 16; ++c) { const float br = A.in[11][((size_t)lg * 64 + p) * 16 + c], bi = A.in[12][((size_t)lg * 64 + p) * 16 + c];
        Br[c] = fr_ * br - fi_ * bi; Bi[c] = fr_ * bi + fi_ * br;
        Cr[c] = A.in[13][((size_t)lg * 16 + c) * 64 + p]; Ci[c] = A.in[14][((size_t)lg * 16 + c) * 64 + p]; }
    const int myc = ((p >> 5) & 1) * 8 + ((p >> 4) & 1) * 4 + ((p >> 3) & 1) * 2 + ((p >> 2) & 1);
    const float dsk = A.in[15][l * 512 + g * 16 + myc];
    float hr = 0.f, hi = 0.f;
    for (int kp = 0; kp < NMETA; ++kp) {
        const int row = key_row(b, kp);
        const v4u uw = *(const GAS v4u*)(P + (size_t)row * NIN + PC_UB + g * 16 + (p & 1) * 8);
        float u[16];
#pragma unroll
        for (int j = 0; j < 4; ++j) { const unsigned w0 = __builtin_amdgcn_readlane(uw[j], 0), w1 = __builtin_amdgcn_readlane(uw[j], 1);
            u[2 * j] = bflo(w0); u[2 * j + 1] = bfhi(w0); u[8 + 2 * j] = bflo(w1); u[8 + 2 * j + 1] = bfhi(w1); }
        float bur = 0.f, bui = 0.f;
#pragma unroll
        for (int c = 0; c < 16; ++c) { bur += Br[c] * u[c]; bui += Bi[c] * u[c]; }
        const float nhr = ar * hr - ai * hi + bur, nhi = ar * hi + ai * hr + bui; hr = nhr; hi = nhi;
        float v[16];
#pragma unroll
        for (int c = 0; c < 16; ++c) v[c] = Cr[c] * hr - Ci[c] * hi;
#pragma unroll
        for (int i = 0; i < 8; ++i) { const float send = (p & 32) ? v[i] : v[i + 8]; const float keep = (p & 32) ? v[i + 8] : v[i]; v[i] = keep + __shfl_xor(send, 32); }
#pragma unroll
        for (int i = 0; i < 4; ++i) { const float send = (p & 16) ? v[i] : v[i + 4]; const float keep = (p & 16) ? v[i + 4] : v[i]; v[i] = keep + __shfl_xor(send, 16); }
#pragma unroll
        for (int i = 0; i < 2; ++i) { const float send = (p & 8) ? v[i] : v[i + 2]; const float keep = (p & 8) ? v[i + 2] : v[i]; v[i] = keep + __shfl_xor(send, 8); }
        { const float send = (p & 4) ? v[0] : v[1]; const float keep = (p & 4) ? v[1] : v[0]; v[0] = keep + __shfl_xor(send, 4); }
        float y = v[0]; y += __shfl_xor(y, 1); y += __shfl_xor(y, 2);
        float um = u[0];
#pragma unroll
        for (int c = 1; c < 16; ++c) um = (myc == c) ? u[c] : um;
        y = gelu_tanh_f(y + dsk * um);
        if ((p & 3) == 0 && (b == 0 || kp >= NMETA)) YG[(size_t)row * 512 + g * 16 + myc] = (bf16)f2bf(y);
    }
}

__device__ __forceinline__ void dsa_naive_item(const Args& A, Frame& F, int l, int qi, LAS float* wl) {
    const int lane = lane_id();
    const bf16* P = (const bf16*)(F.ws + WS_P); bf16* Ycat = (bf16*)(F.ws + WS_YCAT);
    const stat_t* sskv = stat_ptr(F, l, ST_SSKV);
    LAS float* sc = wl;
    LAS unsigned* hist = (LAS unsigned*)(wl + 2080);
    LAS float* ql = wl + 2336;
    LAS float* qv = wl + 2848;
    LAS int* sel = (LAS int*)(wl + 3104);
    LAS float* ol = wl + 3360;
    int b, n, row;
    if (qi < MREAL) { b = qi >> 11; n = (qi & 2047) + NMETA + 1; row = qi; } else { b = 0; n = (qi - MREAL) + 1; row = qi; }
    const bf16* Pq = P + (size_t)row * NIN;
    LDS_WAIT(); asm volatile("" ::: "memory");
#pragma unroll
    for (int j = 0; j < 4; ++j) qv[lane + 64 * j] = bf2f(Pq[PC_IQ + lane + 64 * j]);
    float iw[4];
#pragma unroll
    for (int h = 0; h < 4; ++h) iw[h] = bf2f(Pq[PC_IW + h]);
    LDS_WAIT(); asm volatile("" ::: "memory");
#pragma unroll 1
    for (int kp = lane; kp < n; kp += 64) {
        const int krow = key_row(b, kp); const GAS v4u* ikp = (const GAS v4u*)(P + (size_t)krow * NIN + PC_IK);
        float d0 = 0.f, d1 = 0.f, d2 = 0.f, d3 = 0.f;
#pragma unroll 2
        for (int c = 0; c < 8; ++c) { const v4u w = ikp[c]; const float k8[8] = {bflo(w.x), bfhi(w.x), bflo(w.y), bfhi(w.y), bflo(w.z), bfhi(w.z), bflo(w.w), bfhi(w.w)};
#pragma unroll
            for (int j = 0; j < 8; ++j) { const float kk = k8[j]; d0 += qv[c * 8 + j] * kk; d1 += qv[64 + c * 8 + j] * kk; d2 += qv[128 + c * 8 + j] * kk; d3 += qv[192 + c * 8 + j] * kk; } }
        float s = iw[0] * fmaxf(d0, 0.f) + iw[1] * fmaxf(d1, 0.f) + iw[2] * fmaxf(d2, 0.f) + iw[3] * fmaxf(d3, 0.f);
        s += 0.0f;
        sc[kp] = s;
    }
    LDS_WAIT(); asm volatile("" ::: "memory");
    const int keff = n < TOPK ? n : TOPK;
    unsigned prefix = 0u; int krem = keff;
#pragma unroll 1
    for (int pass = 0; pass < 4; ++pass) {
        const int shift = 24 - 8 * pass;
#pragma unroll
        for (int j = 0; j < 4; ++j) hist[lane * 4 + j] = 0u;
        LDS_WAIT(); asm volatile("" ::: "memory");
        for (int kp = lane; kp < n; kp += 64) { const unsigned key = mono_key(sc[kp]);
            const bool match = (pass == 0) || ((key >> (shift + 8)) == (prefix >> (shift + 8)));
            if (match) __hip_atomic_fetch_add(&hist[(key >> shift) & 255u], 1u, __ATOMIC_RELAXED, __HIP_MEMORY_SCOPE_WORKGROUP); }
        LDS_WAIT(); asm volatile("" ::: "memory");
        const int c0 = (int)hist[lane * 4 + 0], c1 = (int)hist[lane * 4 + 1], c2 = (int)hist[lane * 4 + 2], c3 = (int)hist[lane * 4 + 3];
        const int tot = c0 + c1 + c2 + c3; int S = tot;
#pragma unroll
        for (int off = 1; off < 64; off <<= 1) { const int t = __shfl_down(S, off); if (lane + off < 64) S += t; }
        const int above = S - tot;
        const bool here = (above < krem) && (S >= krem);
        int bin = 0, newk = 0;
        if (here) { int a = above;
            if (a + c3 >= krem) { bin = 3; newk = krem - a; } else { a += c3;
            if (a + c2 >= krem) { bin = 2; newk = krem - a; } else { a += c2;
            if (a + c1 >= krem) { bin = 1; newk = krem - a; } else { a += c1; bin = 0; newk = krem - a; } } }
            bin += 4 * lane; }
        const unsigned long long mm = __ballot(here); const int src = mm ? (__ffsll((long long)mm) - 1) : 0;
        bin = __shfl(bin, src); krem = __shfl(newk, src);
        prefix |= (unsigned)bin << shift;
        LDS_WAIT(); asm volatile("" ::: "memory");
    }
    const unsigned T = prefix; const int rneed = krem;
    int selbase = 0, eqbase = 0;
    for (int k0 = 0; k0 < n; k0 += 64) { const int kp = k0 + lane; const bool valid = kp < n;
        const unsigned key = valid ? mono_key(sc[valid ? kp : 0]) : 0u;
        const bool gt = valid && key > T, eq = valid && key == T;
        const unsigned long long eqm = __ballot(eq); const unsigned long long lt = (1ull << lane) - 1ull;
        const int eqr = eqbase + __popcll(eqm & lt);
        const bool s = gt || (eq && eqr < rneed);
        const unsigned long long sm = __ballot(s);
        if (s) sel[selbase + __popcll(sm & lt)] = kp;
        selbase += __popcll(sm); eqbase += __popcll(eqm); }
    LDS_WAIT(); asm volatile("" ::: "memory");
#pragma unroll
    for (int j = 0; j < 4; ++j) qv[lane + 64 * j] = bf2f(Pq[PC_QA + lane + 64 * j]);
    LDS_WAIT(); asm volatile("" ::: "memory");
    const float* wuk = A.in[6] + (size_t)l * 128 * 256; const float* wuv = A.in[7] + (size_t)l * 128 * 256; const float* kvg = A.in[5] + l * 128;
#pragma unroll 1
    for (int h = 0; h < 4; ++h)
#pragma unroll 1
        for (int rr = 0; rr < 2; ++rr) { const int r = lane + 64 * rr; const GAS f32x4* wp = (const GAS f32x4*)(wuk + ((size_t)r * 4 + h) * 64); float a = 0.f;
#pragma unroll
            for (int d4 = 0; d4 < 16; ++d4) { const f32x4 w = wp[d4]; a += qv[h * 64 + d4 * 4] * w.x + qv[h * 64 + d4 * 4 + 1] * w.y + qv[h * 64 + d4 * 4 + 2] * w.z + qv[h * 64 + d4 * 4 + 3] * w.w; }
            ql[h * 128 + r] = a * kvg[r] * 0.125f; }
    LDS_WAIT(); asm volatile("" ::: "memory");
    float ya[4];
#pragma unroll 1
    for (int h = 0; h < 4; ++h) {
        float mx = -3.0e38f;
#pragma unroll 1
        for (int j = 0; j < 4; ++j) { const int i = lane + 64 * j;
            if (i < keff) { const int kp = sel[i]; const int krow = key_row(b, kp); const GAS v4u* cp = (const GAS v4u*)(P + (size_t)krow * NIN + PC_CKV); float d = 0.f;
#pragma unroll 4
                for (int c = 0; c < 16; ++c) { const v4u w = cp[c]; const LAS float* q8 = ql + h * 128 + c * 8;
                    d += q8[0] * bflo(w.x) + q8[1] * bfhi(w.x) + q8[2] * bflo(w.y) + q8[3] * bfhi(w.y) + q8[4] * bflo(w.z) + q8[5] * bfhi(w.z) + q8[6] * bflo(w.w) + q8[7] * bfhi(w.w); }
                const float rkv = rsqrtf(stat_get(sskv + krow) * (1.0f / 128.0f) + pg8::RMS_EPS);
                const float lgv = d * rkv + A.in[2][t5_bucket((n - 1) - kp) * 4 + h];
                sc[i] = lgv; sc[256 + i] = rkv; mx = fmaxf(mx, lgv); } }
        mx = wave_max(mx); float sum = 0.f;
        LDS_WAIT(); asm volatile("" ::: "memory");
#pragma unroll 1
        for (int j = 0; j < 4; ++j) { const int i = lane + 64 * j; if (i < keff) { const float e = __expf(sc[i] - mx); sc[i] = e; sum += e; } }
        sum = wave_sum(sum); const float inv = 1.0f / sum;
        LDS_WAIT(); asm volatile("" ::: "memory");
#pragma unroll 1
        for (int j = 0; j < 4; ++j) { const int i = lane + 64 * j; if (i < keff) qv[i] = sc[i] * inv * sc[256 + i]; }
        LDS_WAIT(); asm volatile("" ::: "memory");
        float o0 = 0.f, o1 = 0.f;
#pragma unroll 4
        for (int i = 0; i < keff; ++i) { const int krow = key_row(b, sel[i]); const float pw = qv[i]; const bf16* cp = P + (size_t)krow * NIN + PC_CKV;
            o0 += pw * bf2f(cp[lane]); o1 += pw * bf2f(cp[lane + 64]); }
        ol[lane] = o0 * kvg[lane]; ol[lane + 64] = o1 * kvg[lane + 64];
        LDS_WAIT(); asm volatile("" ::: "memory");
        float a = 0.f;
#pragma unroll 8
        for (int r = 0; r < 128; ++r) a += ol[r] * wuv[((size_t)r * 4 + h) * 64 + lane];
        ya[h] = a;
        LDS_WAIT(); asm volatile("" ::: "memory");
    }
    float ssq = 0.f;
#pragma unroll
    for (int h = 0; h < 4; ++h) { const unsigned w = f2bf(ya[h]); Ycat[(size_t)row * 1024 + YC_A + h * 64 + lane] = (bf16)w; const float v = __uint_as_float(w << 16); ssq += v * v; }
    ssq = wave_sum(ssq); if (lane == 0) pg8::stat_add(stat_ptr(F, l, ST_SSA) + row, ssq);
}

__device__ __forceinline__ void sb_naive_item(const Args& A, Frame& F, int l, int qi, LAS float* wl) {
    const int lane = lane_id();
    const bf16* P = (const bf16*)(F.ws + WS_P); bf16* Ycat = (bf16*)(F.ws + WS_YCAT);
    LAS float* qs = wl;
    LAS float* wbuf = wl + 64;
    LAS int* rbuf = (LAS int*)(wl + 128);
    int b, n, row;
    if (qi < MREAL) { b = qi >> 11; n = (qi & 2047) + NMETA; row = qi; } else { b = 0; n = qi - MREAL; row = qi; }
    const bf16* Pq = P + (size_t)row * NIN;
    float yc[4];
#pragma unroll 1
    for (int h = 0; h < 4; ++h) {
        LDS_WAIT(); asm volatile("" ::: "memory");
        qs[lane] = bf2f(Pq[PC_QC + h * 64 + lane]);
        LDS_WAIT(); asm volatile("" ::: "memory");
        float carry = 0.f, acc = 0.f;
        for (int top = n - 1; top >= 0; top -= 64) {
            const int kp = top - lane; const bool valid = kp >= 0; const int krow = key_row(b, valid ? kp : 0);
            const GAS v4u* kpn = (const GAS v4u*)(P + (size_t)krow * NIN + PC_KC + h * 64); float z = 0.f;
#pragma unroll
            for (int c = 0; c < 8; ++c) { const v4u w = kpn[c]; const LAS float* q8 = qs + c * 8;
                z += q8[0] * bflo(w.x) + q8[1] * bfhi(w.x) + q8[2] * bflo(w.y) + q8[3] * bfhi(w.y) + q8[4] * bflo(w.z) + q8[5] * bfhi(w.z) + q8[6] * bflo(w.w) + q8[7] * bfhi(w.w); }
            const float lk = valid ? log_sigmoid_f(-z) : 0.f;
            float incl = lk;
#pragma unroll
            for (int off = 1; off < 64; off <<= 1) { const float t = __shfl_up(incl, off); if (lane >= off) incl += t; }
            const float later = carry + incl - lk;
            const float w = valid ? __expf(log_sigmoid_f(z) + later) : 0.f;
            carry += __shfl(incl, 63);
            LDS_WAIT(); asm volatile("" ::: "memory");
            wbuf[lane] = w; rbuf[lane] = krow;
            LDS_WAIT(); asm volatile("" ::: "memory");
            const int cnt = top + 1 < 64 ? top + 1 : 64;
            for (int j = 0; j < cnt; ++j) acc += wbuf[j] * bf2f(P[(size_t)rbuf[j] * NIN + PC_VC + h * 64 + lane]);
        }
        yc[h] = acc;
    }
    float ssq = 0.f;
#pragma unroll
    for (int h = 0; h < 4; ++h) { const unsigned w = f2bf(yc[h]); Ycat[(size_t)row * 1024 + YC_C + h * 64 + lane] = (bf16)w; const float v = __uint_as_float(w << 16); ssq += v * v; }
    ssq = wave_sum(ssq); if (lane == 0) pg8::stat_add(stat_ptr(F, l, ST_SSC) + row, ssq);
}


typedef short bf16x8_t __attribute__((ext_vector_type(8)));
typedef short s16x4_t __attribute__((ext_vector_type(4)));
typedef float f32x16_t __attribute__((ext_vector_type(16)));
typedef float f32x2_t __attribute__((ext_vector_type(2)));
typedef __bf16 bf16x2_t __attribute__((ext_vector_type(2)));
typedef short v4i16_t __attribute__((ext_vector_type(4)));
typedef __attribute__((address_space(3))) const char* lds_cptr;
__device__ __forceinline__ s16x4_t vtr(lds_cptr p) { return __builtin_bit_cast(s16x4_t, __builtin_amdgcn_ds_read_tr16_b64_v4i16((__attribute__((address_space(3))) v4i16_t*)p)); }
__device__ __forceinline__ unsigned cvtpk(float lo, float hi) { f32x2_t v = {lo, hi}; bf16x2_t b = __builtin_convertvector(v, bf16x2_t); return __builtin_bit_cast(unsigned, b); }
__device__ __forceinline__ int crow(int r, int hi) { return (r & 3) + 8 * (r >> 2) + 4 * hi; }
__device__ __forceinline__ float relu_bits(float x) { const int i = (int)__float_as_uint(x); return __uint_as_float((unsigned)(i > 0 ? i : 0)); }
#define MFMA32(a, b, c) __builtin_amdgcn_mfma_f32_32x32x16_bf16((a), (b), (c), 0, 0, 0)

__device__ __forceinline__ void sb_mfma_unit(const Args& A, Frame& F, int l, int unit, LAS unsigned char* wl) {
    const int lane = lane_id(), r32 = lane & 31, hi = lane >> 5;
    const int qt = unit & 63, h = (unit >> 6) & 3, b = unit >> 8;
    const bf16* P = (const bf16*)(F.ws + WS_P); bf16* Ycat = (bf16*)(F.ws + WS_YCAT); stat_t* ssc = stat_ptr(F, l, ST_SSC);
    const int qrow0 = b * SEQ + 32 * qt;
    bf16x8_t qr[4];
#pragma unroll
    for (int ks = 0; ks < 4; ++ks) qr[ks] = *(const GAS bf16x8_t*)(P + (size_t)(qrow0 + r32) * NIN + PC_QC + h * 64 + ks * 16 + hi * 8);
    f32x16_t o0, o1;
#pragma unroll
    for (int r = 0; r < 16; ++r) { o0[r] = 0.f; o1[r] = 0.f; }
    float carry = 0.f;
    const int jt = qt >> 1;
    const lds_cptr vp = (lds_cptr)wl + ((lane >> 4) & 1) * 32 + (lane & 3) * 8 + (4 * hi + ((lane & 15) >> 2)) * 64;
    constexpr float LOG2E = 1.4426950408889634f;
    v4u vld[8]; bf16x8_t kf0[4], kf1[4];
#define SB_LOAD_TILE(it_) do { const int itt_ = (it_); const bool meta_ = itt_ < 0; const int kb_ = meta_ ? MREAL : b * SEQ + 64 * itt_; \
        _Pragma("unroll") for (int i = 0; i < 8; ++i) { int kl = (lane >> 3) + 8 * i; if (meta_ && kl > NMETA - 1) kl = NMETA - 1; \
            vld[i] = *(const GAS v4u*)(P + (size_t)(kb_ + kl) * NIN + PC_VC + h * 64 + (lane & 7) * 8); } \
        const int kr0 = (meta_ && r32 > NMETA - 1) ? NMETA - 1 : r32, kr1 = meta_ ? NMETA - 1 : 32 + r32; \
        _Pragma("unroll") for (int ks = 0; ks < 4; ++ks) { kf0[ks] = *(const GAS bf16x8_t*)(P + (size_t)(kb_ + kr0) * NIN + PC_KC + h * 64 + ks * 16 + hi * 8); \
                                                            kf1[ks] = *(const GAS bf16x8_t*)(P + (size_t)(kb_ + kr1) * NIN + PC_KC + h * 64 + ks * 16 + hi * 8); } } while (0)
    SB_LOAD_TILE(jt);
#pragma unroll 1
    for (int it = jt; it >= -1; --it) {
        const bool meta = it < 0;
        f32x16_t p0, p1;
#pragma unroll
        for (int r = 0; r < 16; ++r) { p0[r] = 0.f; p1[r] = 0.f; }
#pragma unroll
        for (int ks = 0; ks < 4; ++ks) { p0 = MFMA32(kf0[ks], qr[ks], p0); p1 = MFMA32(kf1[ks], qr[ks], p1); }
#pragma unroll
        for (int i = 0; i < 8; ++i) *(LAS v4u*)(wl + ((lane & 7) >> 2) * 4096 + ((lane >> 3) + 8 * i) * 64 + (lane & 3) * 16) = vld[i];
        if (it > -1) SB_LOAD_TILE(it - 1);
        const int lim = meta ? NMETA : (it == jt ? 32 * (qt & 1) + r32 : 64);
        float lk0[16], lk1[16];
#pragma unroll
        for (int r = 0; r < 16; ++r) {
            { const float Z = p0[r] * LOG2E; const float L = __builtin_amdgcn_logf(1.0f + __builtin_amdgcn_exp2f(-fabsf(Z))); const float nl = -(relu_bits(Z) + L);
              const bool valid = crow(r, hi) < lim; lk0[r] = valid ? nl : 0.f; p0[r] = valid ? Z + nl : -1.0e30f; }
            { const float Z = p1[r] * LOG2E; const float L = __builtin_amdgcn_logf(1.0f + __builtin_amdgcn_exp2f(-fabsf(Z))); const float nl = -(relu_bits(Z) + L);
              const bool valid = 32 + crow(r, hi) < lim; lk1[r] = valid ? nl : 0.f; p1[r] = valid ? Z + nl : -1.0e30f; }
        }
        float base[8]; float E = carry;
#pragma unroll
        for (int B = 7; B >= 0; --B) {
            const int rb = 4 * (B & 3);
            const float own = (B >> 2) ? ((lk1[rb] + lk1[rb + 1]) + (lk1[rb + 2] + lk1[rb + 3])) : ((lk0[rb] + lk0[rb + 1]) + (lk0[rb + 2] + lk0[rb + 3]));
            const auto rr = __builtin_amdgcn_permlane32_swap(__float_as_uint(own), __float_as_uint(own), false, false);
            const float lo_s = __uint_as_float(rr[0]), hi_s = __uint_as_float(rr[1]);
            base[B] = E + (hi ? 0.f : hi_s);
            E += lo_s + hi_s;
        }
        carry = E;
#pragma unroll
        for (int B = 0; B < 8; ++B) {
            const int rb = 4 * (B & 3);
            if (B >> 2) { const float l3 = base[B], l2 = l3 + lk1[rb + 3], l1 = l2 + lk1[rb + 2], l0 = l1 + lk1[rb + 1];
                p1[rb + 3] = __builtin_amdgcn_exp2f(p1[rb + 3] + l3); p1[rb + 2] = __builtin_amdgcn_exp2f(p1[rb + 2] + l2); p1[rb + 1] = __builtin_amdgcn_exp2f(p1[rb + 1] + l1); p1[rb] = __builtin_amdgcn_exp2f(p1[rb] + l0); }
            else { const float l3 = base[B], l2 = l3 + lk0[rb + 3], l1 = l2 + lk0[rb + 2], l0 = l1 + lk0[rb + 1];
                p0[rb + 3] = __builtin_amdgcn_exp2f(p0[rb + 3] + l3); p0[rb + 2] = __builtin_amdgcn_exp2f(p0[rb + 2] + l2); p0[rb + 1] = __builtin_amdgcn_exp2f(p0[rb + 1] + l1); p0[rb] = __builtin_amdgcn_exp2f(p0[rb] + l0); }
        }
        v4u pw[4];
#pragma unroll
        for (int j = 0; j < 4; ++j) { pw[0][j] = cvtpk(p0[2 * j], p0[2 * j + 1]); pw[1][j] = cvtpk(p0[8 + 2 * j], p0[8 + 2 * j + 1]); pw[2][j] = cvtpk(p1[2 * j], p1[2 * j + 1]); pw[3][j] = cvtpk(p1[8 + 2 * j], p1[8 + 2 * j + 1]); }
#pragma unroll
        for (int ks = 0; ks < 4; ++ks) {
            const s16x4_t a_lo = vtr(vp + ks * 1024), a_hi = vtr(vp + ks * 1024 + 512), b_lo = vtr(vp + 4096 + ks * 1024), b_hi = vtr(vp + 4096 + ks * 1024 + 512);
            const bf16x8_t v0 = (bf16x8_t){a_lo[0], a_lo[1], a_lo[2], a_lo[3], a_hi[0], a_hi[1], a_hi[2], a_hi[3]};
            const bf16x8_t v1 = (bf16x8_t){b_lo[0], b_lo[1], b_lo[2], b_lo[3], b_hi[0], b_hi[1], b_hi[2], b_hi[3]};
            const bf16x8_t pa = __builtin_bit_cast(bf16x8_t, pw[ks]);
            o0 = MFMA32(pa, v0, o0); o1 = MFMA32(pa, v1, o1); }
        if (__all(carry < -160.0f)) break;
    }
    LAS unsigned short* stg = (LAS unsigned short*)(wl + 8192);
#pragma unroll
    for (int r = 0; r < 16; ++r) { stg[crow(r, hi) * 64 + r32] = (unsigned short)f2bf(o0[r]); stg[crow(r, hi) * 64 + 32 + r32] = (unsigned short)f2bf(o1[r]); }
    LDS_WAIT(); asm volatile("" ::: "memory");
#pragma unroll
    for (int i = 0; i < 4; ++i) { const int row = i * 8 + (lane >> 3), ch = lane & 7; const v4u v = *(const LAS v4u*)(stg + row * 64 + ch * 8);
        float q = (bflo(v.x) * bflo(v.x) + bfhi(v.x) * bfhi(v.x)) + (bflo(v.y) * bflo(v.y) + bfhi(v.y) * bfhi(v.y)) + (bflo(v.z) * bflo(v.z) + bfhi(v.z) * bfhi(v.z)) + (bflo(v.w) * bflo(v.w) + bfhi(v.w) * bfhi(v.w));
        q += __shfl_xor(q, 1); q += __shfl_xor(q, 2); q += __shfl_xor(q, 4);
        if (ch == 0) pg8::stat_add(ssc + qrow0 + row, q);
        *(GAS v4u*)(Ycat + (size_t)(qrow0 + row) * 1024 + YC_C + h * 64 + ch * 8) = v; }
    LDS_WAIT(); asm volatile("" ::: "memory");
}

constexpr int DSA_HIST = 0, DSA_HIST_STRIDE = 257;
constexpr int DSA_ZC = 65792, DSA_ZC_STRIDE = 36;
constexpr int DSA_MASK = DSA_ZC + 64 * 36 * 4;
constexpr int DSA_Q = DSA_MASK + 64 * 34 * 2 * 4;
constexpr int DSA_BD = DSA_Q + 10 * 64 * 4;
constexpr int DSA_IQ = DSA_BD + 4 * 132 * 4, DSA_IQ_STRIDE = 528;
constexpr int DSA_END = DSA_IQ + 64 * DSA_IQ_STRIDE;
static_assert(DSA_END <= RING_BYTES, "DSA LDS map");
constexpr int DSA_CAP = 32;
constexpr unsigned KEY_ZERO = 0x80000000u;

__device__ __forceinline__ constexpr int crow0(int r) { return (r & 3) + 8 * (r >> 2); }
__device__ __forceinline__ unsigned off_a(unsigned row, unsigned ch) { return 2048u * (row >> 3) + 512u * (ch >> 2) + 64u * (row & 7) + 16u * ((ch & 3) ^ ((row >> 2) & 3)); }

__device__ __forceinline__ void dsa_scores(f32x16_t& s0, f32x16_t& s1, const bf16x8_t (&ikf)[2][4], const LAS unsigned char* iqrow, const float (&iw)[4]) {
#pragma unroll
    for (int r = 0; r < 16; ++r) { s0[r] = 0.f; s1[r] = 0.f; }
#pragma unroll
    for (int hp = 0; hp < 4; hp += 2) {
        f32x16_t a0, a1, b0, b1;
#pragma unroll
        for (int r = 0; r < 16; ++r) { a0[r] = 0.f; a1[r] = 0.f; b0[r] = 0.f; b1[r] = 0.f; }
#pragma unroll
        for (int ks = 0; ks < 4; ++ks) { const bf16x8_t qa = *(const LAS bf16x8_t*)(iqrow + hp * 128 + ks * 32), qb = *(const LAS bf16x8_t*)(iqrow + (hp + 1) * 128 + ks * 32);
            a0 = MFMA32(ikf[0][ks], qa, a0); a1 = MFMA32(ikf[1][ks], qa, a1); b0 = MFMA32(ikf[0][ks], qb, b0); b1 = MFMA32(ikf[1][ks], qb, b1); }
#pragma unroll
        for (int r = 0; r < 16; ++r) { s0[r] += iw[hp] * relu_bits(a0[r]); s1[r] += iw[hp] * relu_bits(a1[r]); }
#pragma unroll
        for (int r = 0; r < 16; ++r) { s0[r] += iw[hp + 1] * relu_bits(b0[r]); s1[r] += iw[hp + 1] * relu_bits(b1[r]); }
        __builtin_amdgcn_sched_barrier(0);
    }
}
__device__ __forceinline__ void dsa_load_ik(bf16x8_t (&ikf)[2][4], const bf16* P, int b, int j, int r32, int hi) {
    const int row0 = j == 0 ? MREAL + (r32 < NMETA ? r32 : NMETA - 1) : b * SEQ + 64 * (j - 1) + r32;
    const int row1 = j == 0 ? MREAL + NMETA - 1 : b * SEQ + 64 * (j - 1) + 32 + r32;
#pragma unroll
    for (int ks = 0; ks < 4; ++ks) { ikf[0][ks] = *(const GAS bf16x8_t*)(P + (size_t)row0 * NIN + PC_IK + ks * 16 + hi * 8);
                                     ikf[1][ks] = *(const GAS bf16x8_t*)(P + (size_t)row1 * NIN + PC_IK + ks * 16 + hi * 8); }
}


template <bool P0, bool EDGE>
__device__ __forceinline__ void dsa_hist_tile(const f32x16_t& s0, const f32x16_t& s1, LAS unsigned* hrow, const int shift, const unsigned psh, const int limh, unsigned& zcount) {
#pragma unroll
    for (int r = 0; r < 16; ++r) {
#pragma unroll
        for (int hf = 0; hf < 2; ++hf) {
            float sv = hf ? s1[r] : s0[r]; asm volatile("" : "+v"(sv) :: "memory");
            const unsigned u = __float_as_uint(sv);
            const unsigned key = u ^ ((unsigned)((int)u >> 31) | 0x80000000u);
            unsigned bin;
            if (P0) { bin = key >> 24;
                if (EDGE) { const bool valid = (32 * hf + crow0(r)) < limh; bin = valid ? bin : 256u; zcount += (valid && key == KEY_ZERO) ? 1u : 0u; }
                else zcount += (key == KEY_ZERO) ? 1u : 0u; }
            else { const unsigned d = (key >> shift) & 255u; bool m = (key >> (shift + 8)) == psh; if (EDGE) m = m && ((32 * hf + crow0(r)) < limh); bin = m ? d : 256u; }
            __hip_atomic_fetch_add(hrow + bin, 1u, __ATOMIC_RELAXED, __HIP_MEMORY_SCOPE_WORKGROUP);
        }
        if ((r & 1) == 1) asm volatile("" ::: "memory");
    }
}

__device__ __forceinline__ void dsa_unit(const Args& A, Frame& F, int l, int b, int qt) {
    const int lane = lane_id(), r32 = lane & 31, hi = lane >> 5, w = F.wave;
    LAS unsigned char* L = F.lds + RING_OFF;
    LAS unsigned* hist = (LAS unsigned*)(L + DSA_HIST); LAS unsigned* zc = (LAS unsigned*)(L + DSA_ZC); LAS unsigned* maskw = (LAS unsigned*)(L + DSA_MASK);
    LAS unsigned* qT = (LAS unsigned*)(L + DSA_Q); LAS unsigned* qK = qT + 64; LAS unsigned* qM = qT + 128; LAS unsigned* qJ = qT + 192; LAS unsigned* qR = qT + 256; LAS unsigned* qF = qT + 320; LAS unsigned* qT2 = qT + 384; LAS unsigned* qJ2 = qT + 448; LAS unsigned* qR2 = qT + 512; LAS unsigned* qC = qT + 576;
    LAS float* bd = (LAS float*)(L + DSA_BD);
    const bf16* P = (const bf16*)(F.ws + WS_P); bf16* Ycat = (bf16*)(F.ws + WS_YCAT);
    const int nt = qt + 2;
    const int t0 = 64 * qt, qrow0 = b * SEQ + t0;
    const int tid = w * 64 + lane;
    for (int i = tid; i < (DSA_MASK - DSA_HIST) / 4; i += 512) hist[i] = 0u;
    for (int i = tid; i < 4 * 132; i += 512) { const int h = i / 132, d = i % 132; bd[i] = A.in[2][t5_bucket(d) * 4 + h] * 1.4426950408889634f; }
    if (tid < 64) qF[tid] = 0u;
    {
        const int qh = w & 1, ts = w >> 1;
        const int ql = 32 * qh + r32;
        float iw[4];
        { const bf16* Pq = P + (size_t)(qrow0 + ql) * NIN;
#pragma unroll
          for (int h = 0; h < 4; ++h) iw[h] = bf2f(Pq[PC_IW + h]); }
#pragma unroll
        for (int i = 0; i < 4; ++i) { const int cidx = tid + 512 * i, row = cidx >> 5, ch = cidx & 31;
            *(LAS v4u*)(L + DSA_IQ + row * DSA_IQ_STRIDE + ch * 16) = *(const GAS v4u*)(P + (size_t)(qrow0 + row) * NIN + PC_IQ + ch * 8); }
        const LAS unsigned char* iqrow = L + DSA_IQ + ql * DSA_IQ_STRIDE + hi * 16;
        const int nq = NMETA + t0 + ql + 1;
        unsigned pref = 0u, Tq = 0u, candlim = 0u; int jstar = 1000, rprime = 0; bool fast = false;
        __syncthreads();
        bf16x8_t ikf[2][4];
        if (ts < nt) dsa_load_ik(ikf, P, b, ts, r32, hi);
#pragma unroll 1
        for (int pass = 0; pass < 6; ++pass) {
            if (pass == 4) { if (qF[0] == 0u) continue; }
            const int shift = 24 - 8 * pass;
#pragma unroll 1
            for (int j = ts; j < nt; j += 4) {
                f32x16_t s0, s1;
                dsa_scores(s0, s1, ikf, iqrow, iw);
                if (j + 4 < nt) dsa_load_ik(ikf, P, b, j + 4, r32, hi);
                else if (pass < 5) dsa_load_ik(ikf, P, b, ts, r32, hi);
                const int lim = (j == 0) ? NMETA : ((j == nt - 1) ? ql + 1 : 64);
                const int limh = lim - 4 * hi;
                if (pass < 4) {
                    LAS unsigned* hrow = hist + ql * DSA_HIST_STRIDE;
                    const bool edge = (j == 0) || (j == nt - 1);
                    if (pass == 0) { unsigned zcount = 0u;
                        if (edge) dsa_hist_tile<true, true>(s0, s1, hrow, 24, 0u, limh, zcount); else dsa_hist_tile<true, false>(s0, s1, hrow, 24, 0u, limh, zcount);
                        __hip_atomic_fetch_add(zc + ql * DSA_ZC_STRIDE + j, zcount, __ATOMIC_RELAXED, __HIP_MEMORY_SCOPE_WORKGROUP);
                    } else { unsigned zdummy = 0u; const unsigned psh = pref >> (shift + 8);
                        if (edge) dsa_hist_tile<false, true>(s0, s1, hrow, shift, psh, limh, zdummy); else dsa_hist_tile<false, false>(s0, s1, hrow, shift, psh, limh, zdummy); }
                } else if (pass == 4) {
                    LAS unsigned* zrow = zc + ql * DSA_ZC_STRIDE;
#pragma unroll
                    for (int r = 0; r < 16; ++r) {
#pragma unroll
                        for (int hf = 0; hf < 2; ++hf) { const float s = (hf ? s1[r] : s0[r]); const unsigned key = mono_key(s);
                            const unsigned zs = ((32 * hf + crow0(r)) < limh && key == Tq) ? (unsigned)j : 35u; __hip_atomic_fetch_add(zrow + zs, 1u, __ATOMIC_RELAXED, __HIP_MEMORY_SCOPE_WORKGROUP); }
                        if ((r & 3) == 3) asm volatile("" ::: "memory"); }
                } else {
                    unsigned sel0 = 0u, sel1 = 0u;
                    LAS unsigned* lrow = hist + ql * DSA_HIST_STRIDE;
                    const unsigned posb = 64u * (unsigned)j + 4u * (unsigned)hi;
#define DSA_CAND(key_, kidx_) do { const unsigned slot_ = __hip_atomic_fetch_add(lrow, 1u, __ATOMIC_RELAXED, __HIP_MEMORY_SCOPE_WORKGROUP); \
                        if (slot_ < (unsigned)DSA_CAP) { lrow[1 + 2 * slot_] = (key_); lrow[2 + 2 * slot_] = posb + (unsigned)(kidx_); } } while (0)
                    if (!__any(j == jstar)) {
                        const unsigned Tj = (j < jstar) ? Tq : Tq + 1u;
                        if ((j == 0) || (j == nt - 1)) {
#pragma unroll
                            for (int r = 15; r >= 0; --r) {
                                { float sv = s0[r]; asm volatile("" : "+v"(sv) :: "memory"); const unsigned u = __float_as_uint(sv); const unsigned key = u ^ ((unsigned)((int)u >> 31) | 0x80000000u);
                                  sel0 = sel0 * 2u + ((key >= Tj && crow0(r) < limh) ? 1u : 0u); if ((key ^ Tq) < candlim && crow0(r) < limh) DSA_CAND(key, crow0(r)); }
                                { float sv = s1[r]; asm volatile("" : "+v"(sv) :: "memory"); const unsigned u = __float_as_uint(sv); const unsigned key = u ^ ((unsigned)((int)u >> 31) | 0x80000000u);
                                  sel1 = sel1 * 2u + ((key >= Tj && (32 + crow0(r)) < limh) ? 1u : 0u); if ((key ^ Tq) < candlim && (32 + crow0(r)) < limh) DSA_CAND(key, 32 + crow0(r)); } }
                        } else {
#pragma unroll
                            for (int r = 15; r >= 0; --r) {
                                { float sv = s0[r]; asm volatile("" : "+v"(sv) :: "memory"); const unsigned u = __float_as_uint(sv); const unsigned key = u ^ ((unsigned)((int)u >> 31) | 0x80000000u);
                                  sel0 = sel0 * 2u + ((key >= Tj) ? 1u : 0u); if ((key ^ Tq) < candlim) DSA_CAND(key, crow0(r)); }
                                { float sv = s1[r]; asm volatile("" : "+v"(sv) :: "memory"); const unsigned u = __float_as_uint(sv); const unsigned key = u ^ ((unsigned)((int)u >> 31) | 0x80000000u);
                                  sel1 = sel1 * 2u + ((key >= Tj) ? 1u : 0u); if ((key ^ Tq) < candlim) DSA_CAND(key, 32 + crow0(r)); } }
                        }
                    } else {
                    unsigned e0 = 0u, e1 = 0u, g0 = 0u, g1 = 0u;
#pragma unroll
                    for (int r = 15; r >= 0; --r) {
                        { const unsigned key = mono_key(s0[r]); const bool valid = crow0(r) < limh; e0 = e0 * 2u + ((valid && key == Tq) ? 1u : 0u); g0 = g0 * 2u + ((valid && key > Tq) ? 1u : 0u); }
                        { const unsigned key = mono_key(s1[r]); const bool valid = (32 + crow0(r)) < limh; e1 = e1 * 2u + ((valid && key == Tq) ? 1u : 0u); g1 = g1 * 2u + ((valid && key > Tq) ? 1u : 0u); } }
                    unsigned t0m = 0u, t1m = 0u;
                    if (j < jstar) { t0m = e0; t1m = e1; }
                    {
                        int E = 0; unsigned r0m = 0u, r1m = 0u;
#pragma unroll
                        for (int B = 0; B < 8; ++B) { const int rb = 4 * (B & 3); const unsigned em = (B >> 2) ? e1 : e0;
                            const int own = __popc((em >> rb) & 15u);
                            const auto rr = __builtin_amdgcn_permlane32_swap((unsigned)own, (unsigned)own, false, false);
                            const int lo_s = (int)rr[0], hi_s = (int)rr[1];
                            int rk = E + (hi ? lo_s : 0);
#pragma unroll
                            for (int i = 0; i < 4; ++i) { const bool isq = (em >> (rb + i)) & 1u; if (isq && rk < rprime) { if (B >> 2) r1m |= 1u << (rb + i); else r0m |= 1u << (rb + i); } rk += isq ? 1 : 0; }
                            E += lo_s + hi_s; }
                        if (j == jstar) { t0m = r0m; t1m = r1m; }
                    }
                    sel0 = g0 | t0m; sel1 = g1 | t1m;
                    if (__any(candlim != 0u)) {
#pragma unroll
                        for (int r = 0; r < 16; ++r) {
                            { float sv = s0[r]; asm volatile("" : "+v"(sv) :: "memory"); const unsigned key = mono_key(sv); if ((key ^ Tq) < candlim && crow0(r) < limh) DSA_CAND(key, crow0(r)); }
                            { float sv = s1[r]; asm volatile("" : "+v"(sv) :: "memory"); const unsigned key = mono_key(sv); if ((key ^ Tq) < candlim && (32 + crow0(r)) < limh) DSA_CAND(key, 32 + crow0(r)); } }
                    }
                    }
                    unsigned w0 = ((sel0 & 0xfu) | ((sel0 & 0xf0u) << 4) | ((sel0 & 0xf00u) << 8) | ((sel0 & 0xf000u) << 12)) << (4 * hi);
                    unsigned w1 = ((sel1 & 0xfu) | ((sel1 & 0xf0u) << 4) | ((sel1 & 0xf00u) << 8) | ((sel1 & 0xf000u) << 12)) << (4 * hi);
                    { const auto rr = __builtin_amdgcn_permlane32_swap(w0, w0, false, false); w0 = rr[0] | rr[1]; }
                    { const auto rr = __builtin_amdgcn_permlane32_swap(w1, w1, false, false); w1 = rr[0] | rr[1]; }
                    if (hi == 0) { maskw[(ql * 34 + j) * 2] = w0; maskw[(ql * 34 + j) * 2 + 1] = w1; }
                }
            }
            if (pass == 5) {
                if (fast) {
                    __syncthreads();
#pragma unroll 1
                    for (int it = 0; it < 4; ++it) { const int q = 8 * w + 2 * it + hi, i = r32;
                        const LAS unsigned* lr = hist + q * DSA_HIST_STRIDE; const unsigned c0 = lr[0]; const int cnt = (int)(c0 < (unsigned)DSA_CAP ? c0 : (unsigned)DSA_CAP); const int kr = (int)qK[q];
                        unsigned mk = 0u, mp = 0u; if (i < cnt) { mk = lr[1 + 2 * i]; mp = lr[2 + 2 * i]; }
                        int rank = 0;
#pragma unroll 1
                        for (int jj = 0; jj < DSA_CAP; ++jj) { if (!__any(jj < cnt)) break;
                            const unsigned kj = lr[1 + 2 * jj], pj = lr[2 + 2 * jj]; rank += (jj < cnt && (kj > mk || (kj == mk && pj < mp))) ? 1 : 0; }
                        if (i < cnt && rank < kr) __hip_atomic_fetch_or(maskw + (q * 34 + (int)(mp >> 6)) * 2 + (int)((mp >> 5) & 1u), 1u << (mp & 31u), __ATOMIC_RELAXED, __HIP_MEMORY_SCOPE_WORKGROUP); }
                }
                break; }
            __syncthreads();
            if (pass < 4) {
                const int qi = lane >> 3, part = lane & 7, q = 8 * w + qi; LAS unsigned* hr = hist + q * DSA_HIST_STRIDE + 32 * part;
                const int nqq = NMETA + t0 + q + 1; const int krem = (pass == 0) ? (nqq < TOPK ? nqq : TOPK) : (int)qK[q];
                int c[32]; int tot = 0;
#pragma unroll
                for (int i = 0; i < 32; ++i) { c[i] = (int)hr[i]; tot += c[i]; }
#pragma unroll
                for (int i = 0; i < 32; ++i) hr[i] = 0u;
                int S = tot;
#pragma unroll
                for (int off = 1; off < 8; off <<= 1) { const int t = __shfl_down(S, off); if (part + off < 8) S += t; }
                const int above = S - tot; const bool here = (above < krem) && (S >= krem);
                int a = above, bin = 0, newk = 0, cb = 0; bool done = false;
#pragma unroll
                for (int i = 31; i >= 0; --i) { const bool f = !done && (a + c[i] >= krem); bin = f ? i : bin; newk = f ? krem - a : newk; cb = f ? c[i] : cb; done = done || f; a += done ? 0 : c[i]; }
                if (here) { const unsigned np = ((pass == 0) ? 0u : qT[q]) | ((unsigned)(bin + 32 * part) << shift); qT[q] = np; qK[q] = (unsigned)newk; qM[q] = (unsigned)cb;
                    if (pass == 3 && cb > newk && np != KEY_ZERO) qF[0] = 1u;
                    if (pass == 1) {
                        if (cb <= DSA_CAP) { qT2[q] = np | 0xffffu; qJ2[q] = 0xffffffffu; qR2[q] = 0u; qC[q] = 0x10000u; }
                        else if (np == KEY_ZERO) { const LAS unsigned* zr = zc + q * DSA_ZC_STRIDE; int acc = 0, js = 1000, rp = 0;
#pragma unroll 1
                            for (int jj = 0; jj < nt; ++jj) { const int cz = (int)zr[jj]; if (js == 1000 && acc + cz >= newk) { js = jj; rp = newk - acc; } acc += cz; }
                            if (acc == cb) { qT2[q] = KEY_ZERO; qJ2[q] = (unsigned)js; qR2[q] = (unsigned)rp; qC[q] = 0u; } else qF[1] = 1u; }
                        else qF[1] = 1u; } }
            }
            if (pass == 3 || pass == 4) {
                __syncthreads();
                const bool generic = qF[0] != 0u;
                if (pass == 4 || !generic) {
#pragma unroll 1
                    for (int i = 0; i < 8; ++i) { const int q = 8 * w + i; const int m = (int)qM[q], rn = (int)qK[q];
                        int js = 1000, rp = 0;
                        if (m > rn) { const int c = lane < nt ? (int)zc[q * DSA_ZC_STRIDE + lane] : 0; int inc = c;
#pragma unroll
                            for (int off = 1; off < 64; off <<= 1) { const int t = __shfl_up(inc, off); if (lane >= off) inc += t; }
                            const bool here = (inc >= rn) && (inc - c < rn);
                            const unsigned long long mm = __ballot(here); const int src = mm ? (__ffsll((long long)mm) - 1) : 0;
                            js = src; rp = rn - __shfl(inc - c, src); }
                        if (lane == 0) { qJ[q] = (unsigned)js; qR[q] = (unsigned)rp; } }
                } else {
                    for (int i = tid; i < 64 * DSA_ZC_STRIDE; i += 512) zc[i] = 0u;
                }
            }
            __syncthreads();
            pref = qT[ql]; Tq = pref; jstar = (int)qJ[ql]; rprime = (int)qR[ql];
            if (pass == 1 && qF[1] == 0u) { fast = true; Tq = qT2[ql]; jstar = (int)qJ2[ql]; rprime = (int)qR2[ql]; candlim = qC[ql]; pass = 4; }
        }
    }
    __syncthreads();
    {
        const int h = w & 3, qh2 = w >> 2, ql = 32 * qh2 + r32;
        const stat_t* sskv = stat_ptr(F, l, ST_SSKV);
        LAS unsigned short* QL = (LAS unsigned short*)(L + w * 8192);
        {
            bf16x8_t qaf[4];
#pragma unroll
            for (int ks = 0; ks < 4; ++ks) qaf[ks] = *(const GAS bf16x8_t*)(P + (size_t)(qrow0 + ql) * NIN + PC_QA + h * 64 + ks * 16 + hi * 8);
#pragma unroll 1
            for (int c = 0; c < 4; ++c) {
                f32x16_t d;
#pragma unroll
                for (int r = 0; r < 16; ++r) d[r] = 0.f;
                const GAS bf16x8_t* wf = (const GAS bf16x8_t*)(F.ws + WS_WUKF) + ((size_t)(l * 4 + h) * 16 + 4 * c) * 64 + lane;
#pragma unroll
                for (int ks = 0; ks < 4; ++ks) d = MFMA32(wf[64 * ks], qaf[ks], d);
#pragma unroll
                for (int r = 0; r < 16; ++r) QL[r32 * 128 + 32 * c + crow(r, hi)] = (unsigned short)f2bf(d[r]); }
        }
        LDS_WAIT(); asm volatile("" ::: "memory");
        bf16x8_t qlf[8];
#pragma unroll
        for (int s = 0; s < 8; ++s) qlf[s] = *(const LAS bf16x8_t*)(QL + r32 * 128 + 16 * s + 8 * hi);
        LDS_WAIT(); asm volatile("" ::: "memory");
        __syncthreads();
        LAS unsigned char* ckb = L;
        LAS float* rkb = (LAS float*)(L + DSA_IQ);
#define DSA_DMA(j_, buf_) do { const int jj_ = (j_); const int row_ = 8 * w + ((lane >> 2) & 7); \
            const int grow_ = jj_ == 0 ? MREAL + (row_ < NMETA ? row_ : NMETA - 1) : b * SEQ + 64 * (jj_ - 1) + row_; \
            const bf16* gp_ = P + (size_t)grow_ * NIN + PC_CKV + (4 * (lane >> 5) + ((lane & 3) ^ ((row_ >> 2) & 3))) * 8; \
            __builtin_amdgcn_global_load_lds((const unsigned*)gp_, (LAS unsigned*)(ckb + (buf_) * 16384 + 2048 * w), 16, 0, 0); \
            __builtin_amdgcn_global_load_lds((const unsigned*)(gp_ + 64), (LAS unsigned*)(ckb + (buf_) * 16384 + 2048 * w + 1024), 16, 0, 0); } while (0)
        DSA_DMA(0, 0); if (1 < nt) DSA_DMA(1, 1);
        for (int i = tid; i < nt * 64; i += 512) { const int jj_ = i >> 6, kk_ = i & 63; const int grow_ = jj_ == 0 ? MREAL + (kk_ < NMETA ? kk_ : NMETA - 1) : b * SEQ + 64 * (jj_ - 1) + kk_;
            const float rks_ = rsqrtf(stat_get(sskv + grow_) * (1.0f / 128.0f) + pg8::RMS_EPS); rkb[jj_ * 128 + kk_] = rks_; rkb[jj_ * 128 + 64 + kk_] = rks_ * 1.4426950408889634f; }
        asm volatile("s_waitcnt vmcnt(0)" ::: "memory");
        __syncthreads();
        f32x16_t oT[4];
#pragma unroll
        for (int c = 0; c < 4; ++c)
#pragma unroll
            for (int r = 0; r < 16; ++r) oT[c][r] = 0.f;
        float mrun = -1.0e30f, lrun = 0.f;
        constexpr float LOG2E = 1.4426950408889634f;
        const float bfar = bd[h * 132 + 128]; const LAS float* bdh = bd + h * 132;
        const unsigned xr = (r32 >> 2) & 3u, rowpart = 2048u * (r32 >> 3) + 64u * (r32 & 7);
        const unsigned rrA = rowpart + 16u * ((unsigned)hi ^ xr), rrB = rowpart + 16u * (((unsigned)hi ^ xr) ^ 2u);
        const unsigned yb = 2u * ((lane >> 4) & 1) + ((lane & 3) >> 1), trpart = 64u * (4u * hi + ((lane & 15) >> 2)) + 8u * (lane & 1);
        const unsigned trA = trpart + 16u * (yb ^ (unsigned)hi), trB = trpart + 16u * (yb ^ (unsigned)hi ^ 2u);
        if (qh2 == 0) __builtin_amdgcn_s_setprio(2);
#pragma unroll 1
        for (int j0 = 0; j0 < nt; j0 += 2) {
            if (j0 + 2 < nt) DSA_DMA(j0 + 2, (j0 + 2) & 3);
            if (j0 + 3 < nt) DSA_DMA(j0 + 3, (j0 + 3) & 3);
#pragma unroll
            for (int jj = 0; jj < 2; ++jj) { const int j = j0 + jj; if (j >= nt) break;
            const LAS unsigned char* tb = ckb + (j & 3) * 16384; const LAS float* rk = rkb + j * 128;
            f32x16_t p0, p1;
#pragma unroll
            for (int r = 0; r < 16; ++r) { p0[r] = 0.f; p1[r] = 0.f; }
            { const LAS unsigned char* ra = tb + rrA; const LAS unsigned char* rb_ = tb + rrB;
              bf16x8_t a0 = *(const LAS bf16x8_t*)(ra), a1 = *(const LAS bf16x8_t*)(ra + 8192);
#pragma unroll
              for (int s = 0; s < 8; ++s) { bf16x8_t n0 = a0, n1 = a1;
                if (s < 7) { const LAS unsigned char* bp = ((s + 1) & 1) ? rb_ : ra; n0 = *(const LAS bf16x8_t*)(bp + 512 * ((s + 1) >> 1)); n1 = *(const LAS bf16x8_t*)(bp + 512 * ((s + 1) >> 1) + 8192); }
                p0 = MFMA32(a0, qlf[s], p0); p1 = MFMA32(a1, qlf[s], p1); a0 = n0; a1 = n1; } }
            const unsigned mw0 = maskw[(ql * 34 + j) * 2] >> (4 * hi), mw1 = maskw[(ql * 34 + j) * 2 + 1] >> (4 * hi);
            const int dbase = ((j == 0) ? (NMETA + t0 + ql) : (t0 + ql - 64 * (j - 1))) - 4 * hi;
            const bool nearb = __any((dbase - 63) < 128);
            const LAS float* rkh = rk + 4 * hi;
            float mx = -INFINITY;
            const unsigned NINF = 0xff800000u;
#define DSA_LOGITS(NEAR_) \
            _Pragma("unroll") for (int g = 0; g < 4; ++g) {        \
                const f32x4 ka = *(const LAS f32x4*)(rkh + 64 + 8 * g), kb = *(const LAS f32x4*)(rkh + 64 + 32 + 8 * g);        \
                _Pragma("unroll") for (int i = 0; i < 4; ++i) { const int r = 4 * g + i, c0 = 8 * g + i; \
                    float x0 = p0[r], x1 = p1[r]; asm volatile("" : "+v"(x0), "+v"(x1) :: "memory");        \
                    float b0 = bfar, b1 = bfar; \
                    if (NEAR_) { int d0 = dbase - c0; d0 = d0 < 0 ? 0 : (d0 > 128 ? 128 : d0); int d1 = dbase - 32 - c0; d1 = d1 < 0 ? 0 : (d1 > 128 ? 128 : d1); b0 = bdh[d0]; b1 = bdh[d1]; } \
                    const unsigned v0 = __float_as_uint(fmaf(x0, ka[i], b0)), v1 = __float_as_uint(fmaf(x1, kb[i], b1)); \
                    const unsigned m0 = (unsigned)(((int)(mw0 << (31 - c0))) >> 31), m1 = (unsigned)(((int)(mw1 << (31 - c0))) >> 31);        \
                    const float y0 = __uint_as_float((m0 & v0) | (~m0 & NINF)), y1 = __uint_as_float((m1 & v1) | (~m1 & NINF)); \
                    p0[r] = y0; p1[r] = y1; asm("v_max3_f32 %0, %1, %2, %3" : "=v"(mx) : "v"(mx), "v"(y0), "v"(y1)); } }
            if (nearb) { DSA_LOGITS(true) } else { DSA_LOGITS(false) }
#undef DSA_LOGITS
            { const auto rr = __builtin_amdgcn_permlane32_swap(__float_as_uint(mx), __float_as_uint(mx), false, false); mx = fmaxf(__uint_as_float(rr[0]), __uint_as_float(rr[1])); }
            const float mnew = fmaxf(mrun, mx);
            const float scl = __builtin_amdgcn_exp2f(mrun - mnew);
            if (__any(mnew > mrun)) {
#pragma unroll
                for (int c = 0; c < 4; ++c)
#pragma unroll
                    for (int r = 0; r < 16; ++r) oT[c][r] *= scl;
            }
            mrun = mnew; f32x2_t psv = (f32x2_t){0.f, 0.f}; const f32x2_t mv = (f32x2_t){mnew, mnew};
#pragma unroll
            for (int g = 0; g < 4; ++g) {
                const f32x4 ka = *(const LAS f32x4*)(rkh + 8 * g), kb = *(const LAS f32x4*)(rkh + 32 + 8 * g);
#pragma unroll
                for (int i = 0; i < 4; i += 2) { const int r = 4 * g + i;
                    f32x2_t xa = (f32x2_t){p0[r], p0[r + 1]}, xb = (f32x2_t){p1[r], p1[r + 1]}; asm volatile("" : "+v"(xa), "+v"(xb) :: "memory");
                    xa = xa - mv; xb = xb - mv;
                    const f32x2_t ea = (f32x2_t){__builtin_amdgcn_exp2f(xa.x), __builtin_amdgcn_exp2f(xa.y)}, eb = (f32x2_t){__builtin_amdgcn_exp2f(xb.x), __builtin_amdgcn_exp2f(xb.y)};
                    psv = psv + ea; psv = psv + eb;
                    const f32x2_t wa = ea * (f32x2_t){ka[i], ka[i + 1]}, wb = eb * (f32x2_t){kb[i], kb[i + 1]};
                    p0[r] = wa.x; p0[r + 1] = wa.y; p1[r] = wb.x; p1[r + 1] = wb.y; } }
            float ps = psv.x + psv.y;
            { const auto rr = __builtin_amdgcn_permlane32_swap(__float_as_uint(ps), __float_as_uint(ps), false, false); ps = __uint_as_float(rr[0]) + __uint_as_float(rr[1]); }
            lrun = lrun * scl + ps;
            v4u pw[4];
#pragma unroll
            for (int i = 0; i < 4; ++i) { pw[0][i] = cvtpk(p0[2 * i], p0[2 * i + 1]); pw[1][i] = cvtpk(p0[8 + 2 * i], p0[8 + 2 * i + 1]); pw[2][i] = cvtpk(p1[2 * i], p1[2 * i + 1]); pw[3][i] = cvtpk(p1[8 + 2 * i], p1[8 + 2 * i + 1]); }
            { const lds_cptr t0p = (lds_cptr)(tb + trA), t1p = (lds_cptr)(tb + trB);
              s16x4_t lo = vtr(t0p), hh = vtr(t1p + 2048);
#pragma unroll
              for (int i = 0; i < 16; ++i) { const int ks = i >> 2, c = i & 3;
                s16x4_t lo2 = lo, hh2 = hh;
                if (i < 15) { const int ks2 = (i + 1) >> 2, c2 = (i + 1) & 3; lo2 = vtr(t0p + 4096 * ks2 + 512 * c2); hh2 = vtr(t1p + 4096 * ks2 + 2048 + 512 * c2); }
                const bf16x8_t av = (bf16x8_t){lo[0], lo[1], lo[2], lo[3], hh[0], hh[1], hh[2], hh[3]};
                oT[c] = MFMA32(av, __builtin_bit_cast(bf16x8_t, pw[ks]), oT[c]);
                lo = lo2; hh = hh2; } }
            }
            asm volatile("s_waitcnt vmcnt(0)" ::: "memory");
            __syncthreads();
        }
        __builtin_amdgcn_s_setprio(0);
        { const int lane = lane_id(), r32 = lane & 31, hi = lane >> 5;
        const float linv = 1.0f / lrun;
        f32x16_t ot[2];
#pragma unroll
        for (int db = 0; db < 2; ++db)
#pragma unroll
            for (int r = 0; r < 16; ++r) ot[db][r] = 0.f;
#pragma unroll
        for (int c = 0; c < 4; ++c) {
#pragma unroll
            for (int s = 0; s < 2; ++s) {
                v4u pk;
#pragma unroll
                for (int i = 0; i < 4; ++i) pk[i] = cvtpk(oT[c][8 * s + 2 * i] * linv, oT[c][8 * s + 2 * i + 1] * linv);
                const bf16x8_t bfrag = __builtin_bit_cast(bf16x8_t, pk);
#pragma unroll
                for (int db = 0; db < 2; ++db) {
                    const bf16x8_t wa = *((const GAS bf16x8_t*)(F.ws + WS_WUVF) + ((size_t)(l * 4 + h) * 16 + 4 * c + 2 * s + db) * 64 + lane);
                    ot[db] = MFMA32(wa, bfrag, ot[db]); } } }
        LAS unsigned short* stg = (LAS unsigned short*)(L + 36864 + w * 4096);
#pragma unroll
        for (int db = 0; db < 2; ++db)
#pragma unroll
            for (int r = 0; r < 16; ++r) stg[r32 * 64 + 32 * db + crow(r, hi)] = (unsigned short)f2bf(ot[db][r]);
        LDS_WAIT(); asm volatile("" ::: "memory");
        stat_t* ssa = stat_ptr(F, l, ST_SSA);
#pragma unroll
        for (int i = 0; i < 4; ++i) { const int row = i * 8 + (lane >> 3), ch = lane & 7; const v4u v = *(const LAS v4u*)(stg + row * 64 + ch * 8);
            float q = (bflo(v.x) * bflo(v.x) + bfhi(v.x) * bfhi(v.x)) + (bflo(v.y) * bflo(v.y) + bfhi(v.y) * bfhi(v.y)) + (bflo(v.z) * bflo(v.z) + bfhi(v.z) * bfhi(v.z)) + (bflo(v.w) * bflo(v.w) + bfhi(v.w) * bfhi(v.w));
            q += __shfl_xor(q, 1); q += __shfl_xor(q, 2); q += __shfl_xor(q, 4);
            if (ch == 0) pg8::stat_add(ssa + qrow0 + 32 * qh2 + row, q);
            *(GAS v4u*)(Ycat + (size_t)(qrow0 + 32 * qh2 + row) * 1024 + YC_A + h * 64 + ch * 8) = v; }
        LDS_WAIT(); asm volatile("" ::: "memory");
        }
    }
    __syncthreads();
}


constexpr int S5T = 32, S5NC = SEQ / S5T, S5RG = BATCH * S5NC, S5KU = 640;
constexpr size_t WS_U = 376 * MiB, WS_TZ = 416 * MiB, TZ_LAYER = 20 * MiB, WS_MG = 456 * MiB, MG_LAYER = 4 * MiB, WS_HQ = 464 * MiB, WS_END2 = 497 * MiB;
static_assert(WS_HQ + (size_t)MROWS * 1024 <= WS_WUKF && WS_WUVF + 128 * 1024 <= WS_END2 && WS_END2 <= 512 * MiB, "HQ buffer / fragment tables");
static_assert((size_t)32 * S5RG * S5KU * 2 <= WS_TZ - WS_U && (size_t)32 * 512 * S5KU * 2 <= TZ_LAYER && (size_t)32 * 128 * 512 * 2 <= MG_LAYER, "S5 buffers");

struct S5P { float lrdt, lidt, fr, fi; };
__device__ __forceinline__ S5P s5_params(const Args& A, int lg, int p) {
    const float dt = expf(A.in[10][lg]), lr = A.in[8][lg * 64 + p], li = A.in[9][lg * 64 + p];
    const float mag = expf(lr * dt), ar = mag * cosf(li * dt), ai = mag * sinf(li * dt);
    const float den = lr * lr + li * li, nr = ar - 1.0f, ni = ai;
    S5P o; o.lrdt = lr * dt; o.lidt = li * dt; o.fr = (nr * lr + ni * li) / den; o.fi = (ni * lr - nr * li) / den; return o;
}
__device__ __forceinline__ void s5_apow(const S5P& q, int n, float& re, float& im) { const float m = expf(q.lrdt * (float)n); re = m * cosf(q.lidt * (float)n); im = m * sinf(q.lidt * (float)n); }

__device__ __forceinline__ void s5_build_item(const Args& A, Frame& F, int l, int kind, int g, int x, LAS float* scr) {
    const int lane = lane_id(), lg = l * 32 + g, p = lane;
    bf16* TZ = (bf16*)(F.ws + WS_TZ + (size_t)l * TZ_LAYER) + (size_t)g * 512 * S5KU;
    bf16* MG = (bf16*)(F.ws + WS_MG + (size_t)l * MG_LAYER) + (size_t)g * 128 * 512;
    const S5P q = s5_params(A, lg, p);
    if (kind == 0) {
        const int d = x;
        float pr, pi; s5_apow(q, d, pr, pi);
        LDS_WAIT(); asm volatile("" ::: "memory");
#pragma unroll
        for (int ch = 0; ch < 16; ++ch) { const float br = A.in[11][((size_t)lg * 64 + p) * 16 + ch], bi = A.in[12][((size_t)lg * 64 + p) * 16 + ch];
            const float b1r = q.fr * br - q.fi * bi, b1i = q.fr * bi + q.fi * br;
            scr[p * 34 + ch] = pr * b1r - pi * b1i; scr[p * 34 + 16 + ch] = pr * b1i + pi * b1r; }
        LDS_WAIT(); asm volatile("" ::: "memory");
        const int ch = lane >> 2, c4 = 4 * (lane & 3); float k0 = 0.f, k1 = 0.f, k2 = 0.f, k3 = 0.f;
#pragma unroll 16
        for (int pp = 0; pp < 64; ++pp) { const float cr = A.in[13][((size_t)lg * 16 + ch) * 64 + pp], ci = A.in[14][((size_t)lg * 16 + ch) * 64 + pp]; const LAS float* xr = scr + pp * 34 + c4; const LAS float* xi = xr + 16;
            k0 += cr * xr[0] - ci * xi[0]; k1 += cr * xr[1] - ci * xi[1]; k2 += cr * xr[2] - ci * xi[2]; k3 += cr * xr[3] - ci * xi[3]; }
        const unsigned long long kv = (unsigned long long)pk2(k0, k1) | ((unsigned long long)pk2(k2, k3) << 32);
        for (int tau = d; tau < S5T; ++tau) *(GAS unsigned long long*)(TZ + (size_t)(tau * 16 + ch) * S5KU + (tau - d) * 16 + c4) = kv;
        if (d > 0) for (int tau = 0; tau + d < S5T; ++tau) *(GAS unsigned long long*)(TZ + (size_t)(tau * 16 + ch) * S5KU + (tau + d) * 16 + c4) = 0ull;
        LDS_WAIT(); asm volatile("" ::: "memory");
    } else if (kind == 1) {
        const int tau = x; float pr, pi; s5_apow(q, tau + 1, pr, pi);
#pragma unroll 4
        for (int ch = 0; ch < 16; ++ch) { const float cr = A.in[13][((size_t)lg * 16 + ch) * 64 + p], ci = A.in[14][((size_t)lg * 16 + ch) * 64 + p];
            const float wr_ = cr * pr - ci * pi, wi_ = cr * pi + ci * pr;
            bf16* rowp = TZ + (size_t)(tau * 16 + ch) * S5KU + 512;
            rowp[p] = (bf16)f2bf(wr_); rowp[64 + p] = (bf16)f2bf(-wi_); }
    } else {
        const int sg = x; float pr, pi; s5_apow(q, S5T - 1 - sg, pr, pi);
        unsigned wre[8], wim[8];
#pragma unroll
        for (int c2 = 0; c2 < 8; ++c2) { float vr[2], vi[2];
#pragma unroll
            for (int e = 0; e < 2; ++e) { const int ch = 2 * c2 + e; const float br = A.in[11][((size_t)lg * 64 + p) * 16 + ch], bi = A.in[12][((size_t)lg * 64 + p) * 16 + ch];
                const float b1r = q.fr * br - q.fi * bi, b1i = q.fr * bi + q.fi * br; vr[e] = pr * b1r - pi * b1i; vi[e] = pr * b1i + pi * b1r; }
            wre[c2] = pk2(vr[0], vr[1]); wim[c2] = pk2(vi[0], vi[1]); }
        GAS v4u* r0 = (GAS v4u*)(MG + (size_t)(2 * p) * 512 + sg * 16); GAS v4u* r1 = (GAS v4u*)(MG + (size_t)(2 * p + 1) * 512 + sg * 16);
        r0[0] = (v4u){wre[0], wre[1], wre[2], wre[3]}; r0[1] = (v4u){wre[4], wre[5], wre[6], wre[7]};
        r1[0] = (v4u){wim[0], wim[1], wim[2], wim[3]}; r1[1] = (v4u){wim[4], wim[5], wim[6], wim[7]};
    }
}

typedef float f32x4_t __attribute__((ext_vector_type(4)));
__device__ __forceinline__ void s5_scan_task(const Args& A, Frame& F, int l, int g) {
    const int lane = lane_id(), w = F.wave, bcol = lane & 15, kg = lane >> 4, lg = l * 32 + g;
    const bf16* P = (const bf16*)(F.ws + WS_P);
    bf16* U = (bf16*)(F.ws + WS_U) + (size_t)g * S5RG * S5KU;
    const bf16* MG = (const bf16*)(F.ws + WS_MG + (size_t)l * MG_LAYER) + (size_t)g * 128 * 512;
    LAS unsigned char* ring = F.lds + RING_OFF;
    asm volatile("s_waitcnt vmcnt(0)" ::: "memory");
    __syncthreads();
#define S5_DMA(k_) do { const int kk_ = (k_); _Pragma("unroll") for (int i_ = 0; i_ < 2; ++i_) { const int r_ = 2 * w + i_; \
        __builtin_amdgcn_global_load_lds((const unsigned*)(U + (size_t)(r_ * S5NC + kk_) * S5KU + 8 * (lane ^ r_)), (LAS unsigned*)(ring + (kk_ & 7) * 16384 + r_ * 1024), 16, 0, 0); } } while (0)
#pragma unroll
    for (int k0 = 0; k0 < 7; ++k0) S5_DMA(k0);
    bf16x8_t af[16];
#pragma unroll
    for (int ks = 0; ks < 16; ++ks) af[ks] = *(const GAS bf16x8_t*)(MG + (size_t)(16 * w + bcol) * 512 + 32 * ks + 8 * kg);
    const int pA = 8 * w + 2 * kg;
    float aTr[2], aTi[2];
#pragma unroll
    for (int e = 0; e < 2; ++e) { const S5P q = s5_params(A, lg, pA + e); s5_apow(q, S5T, aTr[e], aTi[e]); }
    f32x4_t h;
    {
        f32x4_t s = (f32x4_t){0.f, 0.f, 0.f, 0.f};
#pragma unroll
        for (int ks = 0; ks < 16; ++ks) { const int sg = 2 * ks + (kg >> 1);
            if (sg >= 16) { const bf16x8_t bfm = *(const GAS bf16x8_t*)(P + (size_t)(MREAL + sg - 16) * NIN + PC_UB + g * 16 + 8 * (kg & 1)); s = __builtin_amdgcn_mfma_f32_16x16x32_bf16(af[ks], bfm, s, 0, 0, 0); } }
        h = s;
        bf16* hp = U + (size_t)(bcol * S5NC) * S5KU + 512 + pA;
        *(GAS unsigned*)hp = pk2(h[0], h[2]); *(GAS unsigned*)(hp + 64) = pk2(h[1], h[3]);
    }
    const unsigned lbase = (unsigned)bcol * 1024u + 16u * (unsigned)((kg ^ bcol) & 3), bc2 = (unsigned)bcol >> 2;
#pragma unroll 1
    for (int c = 0; c < S5NC - 1; ++c) {
        if (c <= S5NC - 2 - 6) asm volatile("s_waitcnt vmcnt(12)" ::: "memory"); else asm volatile("s_waitcnt vmcnt(0)" ::: "memory");
        __syncthreads();
        if (c + 7 <= S5NC - 2) S5_DMA(c + 7);
        const LAS unsigned char* bufp = ring + (c & 7) * 16384 + lbase;
        f32x4_t s4[4];
#pragma unroll
        for (int j = 0; j < 4; ++j) s4[j] = (f32x4_t){0.f, 0.f, 0.f, 0.f};
#pragma unroll
        for (int m = 0; m < 4; ++m)
#pragma unroll
            for (int j = 0; j < 4; ++j) { const bf16x8_t bfr = *(const LAS bf16x8_t*)(bufp + 256 * m + 64u * ((unsigned)j ^ bc2)); s4[j] = __builtin_amdgcn_mfma_f32_16x16x32_bf16(af[4 * m + j], bfr, s4[j], 0, 0, 0); }
        const f32x4_t s = (s4[0] + s4[1]) + (s4[2] + s4[3]);
        { const float r0 = aTr[0] * h[0] - aTi[0] * h[1] + s[0], i0 = aTr[0] * h[1] + aTi[0] * h[0] + s[1], r1 = aTr[1] * h[2] - aTi[1] * h[3] + s[2], i1 = aTr[1] * h[3] + aTi[1] * h[2] + s[3];
          h = (f32x4_t){r0, i0, r1, i1}; }
        bf16* hp = U + (size_t)(bcol * S5NC + (c + 1)) * S5KU + 512 + pA;
        *(GAS unsigned*)hp = pk2(h[0], h[2]); *(GAS unsigned*)(hp + 64) = pk2(h[1], h[3]);
    }
#undef S5_DMA
    __syncthreads();
}

struct S5Order {
    int G, c;
    __device__ __forceinline__ bool next(int i, pg8::Unit& u) const { const int L = i * G + c; if (L >= 256) return false; const int g = L >> 3, wi = L & 7; u.pm = 4 * g + (wi >> 1); u.pn = 2 * g + (wi & 1); return true; }
    __device__ __forceinline__ void a_ready(const pg8::Unit&) const {}
    __device__ __forceinline__ void done(const pg8::Unit&) const {}
};
namespace pg8 {
struct EpiS5 {
    static constexpr bool PERM = true, AFTER_DRAIN = false; static constexpr int MIDT = 0, MIDT2 = 0;
    const bf16_t* Pm; bf16_t* YG; const float* dsk;
    __device__ __forceinline__ void operator()(const f32x4 (&acc)[2][2][4][2], const Unit& u, int wr, int wc, int fr, int fq) const {
        const int g = u.pm >> 2, rg0 = (u.pm & 3) * BM + wr * 64 + fr, cg0 = (u.pn & 1) * BM + wc * 32 + 8 * fq;
        const int colq = g * 16 + (cg0 & 15);
        const f32x4 d0 = *(const PG8_GAS f32x4*)(dsk + colq), d1 = *(const PG8_GAS f32x4*)(dsk + colq + 4);
#pragma unroll
        for (int ai = 0; ai < 2; ++ai) {
            u32x4 ul[4][2];
#pragma unroll
            for (int m = 0; m < 4; ++m) { const int rg = rg0 + ai * HALF + m * 16, b = rg >> 6, c = rg & 63;
#pragma unroll
                for (int bj = 0; bj < 2; ++bj) { const int cg = cg0 + bj * HALF, tau = cg >> 4, ch = cg & 15; const size_t row = (size_t)b * 2048 + c * 32 + tau; const int col = g * 16 + ch;
                    ul[m][bj] = *(const PG8_GAS u32x4*)(Pm + ((size_t)g * 1024 + rg) * 640 + cg); (void)row; (void)col; } }
#pragma unroll
            for (int m = 0; m < 4; ++m) { const int rg = rg0 + ai * HALF + m * 16, b = rg >> 6, c = rg & 63;
#pragma unroll
                for (int bj = 0; bj < 2; ++bj) { const int cg = cg0 + bj * HALF, tau = cg >> 4, ch = cg & 15; const size_t row = (size_t)b * 2048 + c * 32 + tau; const int col = g * 16 + ch;
                    const u32x4 u8 = ul[m][bj];
                    const f32x4 a0 = acc[ai][bj][m][0], a1 = acc[ai][bj][m][1];
                    float y[8] = {a0[0] + d0[0] * bf_lo(u8.x), a0[1] + d0[1] * bf_hi(u8.x), a0[2] + d0[2] * bf_lo(u8.y), a0[3] + d0[3] * bf_hi(u8.y),
                                  a1[0] + d1[0] * bf_lo(u8.z), a1[1] + d1[1] * bf_hi(u8.z), a1[2] + d1[2] * bf_lo(u8.w), a1[3] + d1[3] * bf_hi(u8.w)};
#pragma unroll
                    for (int j = 0; j < 8; ++j) { const float x = y[j], t = fminf(0.7978845608028654f * (x + 0.044715f * x * x * x), 15.0f); const float e = __expf(2.0f * t); y[j] = x * (1.0f - __builtin_amdgcn_rcpf(e + 1.0f)); }
                    u32x4 w; w.x = cvt_pk_bf16(y[0], y[1]); w.y = cvt_pk_bf16(y[2], y[3]); w.z = cvt_pk_bf16(y[4], y[5]); w.w = cvt_pk_bf16(y[6], y[7]);
                    *(PG8_GAS u32x4*)(YG + row * 512 + col) = w; } } }
    }
};
}


__device__ __forceinline__ void w2_quant_item(const Args& A, Frame& F, int l, int item, LAS float* scr) {
    const int lane = lane_id();
    const float* W = A.in[23] + (size_t)l * 4096 * 1024; unsigned char* WQ = (unsigned char*)wptr(F, l, WO_2);
    const int kb = item >> 5, nb = item & 31, k0 = 64 * kb, n0 = 32 * nb;
    const int kr = lane >> 3, c4 = lane & 7; float sc[4];
#pragma unroll
    for (int e_ = 0; e_ < 4; ++e_) sc[e_] = 448.0f / fmaxf(__uint_as_float(__hip_atomic_load(F.ctl + CW_WMAX + l * 1024 + n0 + 4 * c4 + e_, RLX_AGENT)), 1e-30f);
#pragma unroll
    for (int i = 0; i < 8; ++i) { const int kk = 8 * i + kr; const f32x4_t v = *(const GAS f32x4_t*)(W + (size_t)(k0 + kk) * 1024 + n0 + 4 * c4);
#pragma unroll
        for (int e_ = 0; e_ < 4; ++e_) scr[kk * 33 + 4 * c4 + e_] = v[e_] * sc[e_]; }
    LDS_WAIT(); asm volatile("" ::: "memory");
#pragma unroll
    for (int j = 0; j < 2; ++j) { const int c = lane + 64 * j, n = c >> 2, part = c & 3; const LAS float* s = scr + (16 * part) * 33 + n;
        v4u o;
#pragma unroll
        for (int q = 0; q < 4; ++q) o[q] = pg8::pk4_fp8(s[(4 * q) * 33], s[(4 * q + 1) * 33], s[(4 * q + 2) * 33], s[(4 * q + 3) * 33]);
        *(GAS v4u*)(WQ + (size_t)(n0 + n) * 4096 + k0 + 16 * part) = o; }
    LDS_WAIT(); asm volatile("" ::: "memory");
}

__device__ __forceinline__ void w1_quant_item(const Args& A, Frame& F, int l, int item, LAS float* scr) {
    const int lane = lane_id();
    const float* W = A.in[22] + (size_t)l * 1024 * 4096; unsigned char* WQ = (unsigned char*)wptr(F, l, WO_1);
    const int kb = item >> 7, nb = item & 127, k0 = 64 * kb, n0 = 32 * nb;
    const int kr = lane >> 3, c4 = lane & 7; float sc[4];
#pragma unroll
    for (int e_ = 0; e_ < 4; ++e_) sc[e_] = 448.0f / fmaxf(__uint_as_float(__hip_atomic_load(F.ctl + CW_WMAX1 + l * 4096 + n0 + 4 * c4 + e_, RLX_AGENT)), 1e-30f);
#pragma unroll
    for (int i = 0; i < 8; ++i) { const int kk = 8 * i + kr; const f32x4_t v = *(const GAS f32x4_t*)(W + (size_t)(k0 + kk) * 4096 + n0 + 4 * c4); const float g = A.in[21][l * 1024 + k0 + kk];
#pragma unroll
        for (int e_ = 0; e_ < 4; ++e_) scr[kk * 33 + 4 * c4 + e_] = v[e_] * g * sc[e_]; }
    LDS_WAIT(); asm volatile("" ::: "memory");
#pragma unroll
    for (int j = 0; j < 2; ++j) { const int c = lane + 64 * j, n = c >> 2, part = c & 3; const LAS float* s = scr + (16 * part) * 33 + n;
        v4u o;
#pragma unroll
        for (int q = 0; q < 4; ++q) o[q] = pg8::pk4_fp8(s[(4 * q) * 33], s[(4 * q + 1) * 33], s[(4 * q + 2) * 33], s[(4 * q + 3) * 33]);
        *(GAS v4u*)(WQ + (size_t)(n0 + n) * 1024 + k0 + 16 * part) = o; }
    LDS_WAIT(); asm volatile("" ::: "memory");
}
__device__ __forceinline__ void hq_phase(Frame& F, const stat_t* ss) {
    const int lane = lane_id();
    const int gw = F.vcu * NWAVES + F.wave, NGW = F.G * NWAVES;
    const bf16* Hb = (const bf16*)(F.ws + WS_HB); unsigned char* HQ = F.ws + WS_HQ;
    for (int m0 = gw * 4; m0 < MVALID; m0 += NGW * 4) {
        v4u hw[4][2]; float r[4];
#pragma unroll
        for (int q = 0; q < 4; ++q) { const GAS v4u* h16 = (const GAS v4u*)(Hb + (size_t)(m0 + q) * DM) + 2 * lane;
            hw[q][0] = h16[0]; hw[q][1] = h16[1];
            r[q] = 8.0f * rsqrtf(stat_get(ss + m0 + q) * (1.0f / 1024.0f) + pg8::RMS_EPS); }
#pragma unroll
        for (int q = 0; q < 4; ++q) { v4u o;
#pragma unroll
            for (int i = 0; i < 2; ++i) { const v4u hv = hw[q][i];
                o[2 * i] = pg8::pk4_fp8(bflo(hv.x) * r[q], bfhi(hv.x) * r[q], bflo(hv.y) * r[q], bfhi(hv.y) * r[q]); o[2 * i + 1] = pg8::pk4_fp8(bflo(hv.z) * r[q], bfhi(hv.z) * r[q], bflo(hv.w) * r[q], bfhi(hv.w) * r[q]); }
            *((GAS v4u*)(HQ + (size_t)(m0 + q) * 1024) + lane) = o; }
    }
}
__device__ __forceinline__ void mixers_naive_phase(const Args& A, Frame& F, int l) {
    LAS float* wl = (LAS float*)(F.lds + RING_OFF + F.wave * 16384);
    if (l == 0) {
        const int gw = F.vcu * NWAVES + F.wave, NGW = F.G * NWAVES;
        for (int it = gw; it < DEPTH * 2048; it += NGW) w2_quant_item(A, F, it >> 11, it & 2047, wl);
        for (int it = gw; it < DEPTH * 2048; it += NGW) w1_quant_item(A, F, it >> 11, it & 2047, wl);
        __syncthreads();
    }
    {
        const int x0 = (int)(xb_xcc_id() & 7u);
        int xq = x0;
        gu32* qbase = F.ctl + CW_Q + 64 * (4 + 8 * l);
        for (;;) {
            unsigned slot_a = (unsigned)(size_t)(F.MISC + 16); asm volatile("" : "+s"(slot_a));
            volatile LAS unsigned* slot = (volatile LAS unsigned*)(size_t)slot_a;
            if (F.wave == 0 && lane_id() == 0) {
                unsigned v = __hip_atomic_fetch_add(qbase + 64 * xq, 1u, RLX_AGENT); int nq = xq;
                if (v >= 68u) {
                    unsigned hd[7];
#pragma unroll
                    for (int q = 0; q < 7; ++q) hd[q] = __hip_atomic_load(qbase + 64 * ((x0 + 1 + q) & 7), RLX_AGENT);
                    nq = -1;
#pragma unroll
                    for (int q = 6; q >= 0; --q) if (hd[q] < 68u) nq = (x0 + 1 + q) & 7;
                }
                slot[0] = v; slot[1] = (unsigned)nq; }
            __syncthreads();
            const int idx = (int)slot[0], nq = (int)slot[1];
            __syncthreads();
            if (idx >= 4 + 64) { if (nq < 0) break; xq = nq; continue; }
            if (idx < 4) { s5_scan_task(A, F, l, 4 * xq + idx); continue; }
            { const int i2 = idx - 4; dsa_unit(A, F, l, 2 * xq + (i2 & 1), 31 - (i2 >> 1)); }
        }
    }
    gu32* head = F.ctl + CW_Q + 64 * l;
    constexpr int N_S5 = 32, N_SB = BATCH * 4 * 64, N_META_Q = 2 * NMETA, TOTAL = N_S5 + N_SB + N_META_Q;
    for (;;) {
        int idx = 0;
        if (lane_id() == 0) idx = (int)__hip_atomic_fetch_add(head, 1u, RLX_AGENT);
        idx = __builtin_amdgcn_readfirstlane(idx);
        if (idx >= TOTAL) break;
        if (idx < N_S5) { s5_naive_item(A, F, l, 0, idx); continue; }
        idx -= N_S5;
        if (idx < N_META_Q) { if (idx < NMETA) dsa_naive_item(A, F, l, MREAL + idx, wl); else sb_naive_item(A, F, l, MREAL + (idx - NMETA), wl); continue; }
        idx -= N_META_Q;
        sb_mfma_unit(A, F, l, (idx & ~63) | (63 - (idx & 63)), (LAS unsigned char*)wl);
    }
}

__device__ __forceinline__ void final_phase(const Args& A, Frame& F) {
    const int lane = lane_id();
    const int gw = F.vcu * NWAVES + F.wave, NGW = F.G * NWAVES;
    const bf16* Hb = (const bf16*)(F.ws + WS_HB); const stat_t* ss = stat_ptr(F, DEPTH, ST_SS1); const float* fg = A.in[24];
    for (int m0 = gw * 4; m0 < MREAL; m0 += NGW * 4) {
        v4u hw[4][2]; float r[4];
#pragma unroll
        for (int q = 0; q < 4; ++q) { const GAS v4u* h16 = (const GAS v4u*)(Hb + (size_t)(m0 + q) * DM) + lane;
            hw[q][0] = h16[0]; hw[q][1] = h16[64];
            r[q] = rsqrtf(stat_get(ss + m0 + q) * (1.0f / 1024.0f) + pg8::RMS_EPS); }
#pragma unroll
        for (int q = 0; q < 4; ++q) { GAS f32x4* o = (GAS f32x4*)(F.out + (size_t)(m0 + q) * DM) + 2 * lane;
#pragma unroll
            for (int jh = 0; jh < 2; ++jh) { const v4u hv = hw[q][jh]; const f32x4 g0 = *((const GAS f32x4*)fg + 2 * lane + 128 * jh), g1 = *((const GAS f32x4*)fg + 2 * lane + 128 * jh + 1);
                o[128 * jh] = (f32x4){bflo(hv.x) * r[q] * g0.x, bfhi(hv.x) * r[q] * g0.y, bflo(hv.y) * r[q] * g0.z, bfhi(hv.y) * r[q] * g0.w};
                o[128 * jh + 1] = (f32x4){bflo(hv.z) * r[q] * g1.x, bfhi(hv.z) * r[q] * g1.y, bflo(hv.w) * r[q] * g1.z, bfhi(hv.w) * r[q] * g1.w}; } }
    }
}


struct MetaArgs { const bf16* A; const bf16* Bt; int N, K; bf16* O; bf16* H; const bf16* Y; const stat_t* ss; stat_t* so; const stat_t* ssb; const stat_t* ssa; const stat_t* ssc; const unsigned* wmax; };
template <int KIND> __device__ __forceinline__ void meta_gemm(Frame& F, const MetaArgs& a, LAS float* red  ) {
    const int lane = lane_id(), w = F.wave, m16 = lane & 15, kg = lane >> 4;
    const int kw = a.K / 8;
    for (int cb = F.vcu; cb < a.N / 16; cb += F.G) {
        f32x4_t acc = (f32x4_t){0.f, 0.f, 0.f, 0.f};
        const bf16* ap = a.A + (size_t)(MREAL + m16) * a.K + w * kw + 8 * kg;
        const bf16* bp = a.Bt + (size_t)(cb * 16 + m16) * a.K + w * kw + 8 * kg;
        constexpr int KW = (KIND == 1 ? 512 : (KIND == 4 ? 4096 : 1024)) / 8, NS = KW / 32, GS = NS < 8 ? NS : 8;
        if constexpr (KIND == 3) {
            const unsigned char* ap8 = (const unsigned char*)a.A + (size_t)(MREAL + m16) * 1024 + w * 128 + 8 * kg;
            const unsigned char* bp8 = (const unsigned char*)a.Bt + (size_t)(cb * 16 + m16) * 1024 + w * 128 + 8 * kg;
            long fa[4], fb[4];
#pragma unroll
            for (int s = 0; s < 4; ++s) { fa[s] = *(const GAS long*)(ap8 + 32 * s); fb[s] = *(const GAS long*)(bp8 + 32 * s); }
#pragma unroll
            for (int s = 0; s < 4; ++s) acc = __builtin_amdgcn_mfma_f32_16x16x32_fp8_fp8(fa[s], fb[s], acc, 0, 0, 0);
        } else if constexpr (KIND == 4) {
            const unsigned char* ap8 = (const unsigned char*)a.A + (size_t)(MREAL + m16) * 4096 + w * 512 + 8 * kg;
            const unsigned char* bp8 = (const unsigned char*)a.Bt + (size_t)(cb * 16 + m16) * 4096 + w * 512 + 8 * kg;
#pragma unroll
            for (int s0 = 0; s0 < 16; s0 += 8) { long fa[8], fb[8];
#pragma unroll
                for (int s = 0; s < 8; ++s) { fa[s] = *(const GAS long*)(ap8 + 32 * (s0 + s)); fb[s] = *(const GAS long*)(bp8 + 32 * (s0 + s)); }
#pragma unroll
                for (int s = 0; s < 8; ++s) acc = __builtin_amdgcn_mfma_f32_16x16x32_fp8_fp8(fa[s], fb[s], acc, 0, 0, 0); }
        } else {
#pragma unroll
        for (int s0 = 0; s0 < NS; s0 += GS) { bf16x8_t fa[GS], fb[GS];
#pragma unroll
            for (int s = 0; s < GS; ++s) { fa[s] = *(const GAS bf16x8_t*)(ap + 32 * (s0 + s)); fb[s] = *(const GAS bf16x8_t*)(bp + 32 * (s0 + s)); }
#pragma unroll
            for (int s = 0; s < GS; ++s) acc = __builtin_amdgcn_mfma_f32_16x16x32_bf16(fa[s], fb[s], acc, 0, 0, 0); }
        }
        *(LAS f32x4_t*)(red + (w * 64 + lane) * 4) = acc;
        __syncthreads();
        if (w == 0) {
            const int col = cb * 16 + m16;
#pragma unroll
            for (int r = 0; r < 4; ++r) { const int row = MREAL + 4 * kg + r; float v = 0.f;
                if (KIND == 2) {
                    const float rb = rsqrtf(stat_get(a.ssb + row) * (1.0f / 512.0f) + pg8::RMS_EPS), ra = rsqrtf(stat_get(a.ssa + row) * (1.0f / 256.0f) + pg8::RMS_EPS), rc = rsqrtf(stat_get(a.ssc + row) * (1.0f / 256.0f) + pg8::RMS_EPS);
#pragma unroll
                    for (int ww = 0; ww < 8; ++ww) v += red[(ww * 64 + lane) * 4 + r] * (ww < 4 ? rb : (ww < 6 ? ra : rc));
                } else {
#pragma unroll
                    for (int ww = 0; ww < 8; ++ww) v += red[(ww * 64 + lane) * 4 + r];
                }
                float sq = 0.f; stat_t* sp = nullptr;
                if (KIND == 0) { v *= rsqrtf(stat_get(a.ss + row) * (1.0f / 1024.0f) + pg8::RMS_EPS); const unsigned wv = f2bf(v); a.O[(size_t)row * NIN + col] = (bf16)wv;
                    if (col >= PC_CKV && col < PC_IK) { const float x = __uint_as_float(wv << 16); sq = x * x; sp = a.so; } }
                else if (KIND == 1) { const float y = bf2f(a.Y[(size_t)row * 512 + col]); const unsigned wv = f2bf(y / (1.0f + __expf(-v))); a.O[(size_t)row * 1024 + col] = (bf16)wv; const float x = __uint_as_float(wv << 16); sq = x * x; sp = a.so; }
                else if (KIND == 2 || KIND == 4) { if (KIND == 4) v *= fmaxf(__uint_as_float(a.wmax[col]), 1e-30f) * (1.0f / (448.0f * pg8::HID_SCALE));
                    const unsigned wv = f2bf(bf2f(a.H[(size_t)row * 1024 + col]) + v); a.H[(size_t)row * 1024 + col] = (bf16)wv; const float x = __uint_as_float(wv << 16); sq = x * x; sp = a.so; }
                else { v *= fmaxf(__uint_as_float(a.wmax[col]), 1e-30f) * (1.0f / (448.0f * 8.0f)); v = fmaxf(v, 0.f); ((unsigned char*)a.O)[(size_t)row * DFF + col] = (unsigned char)(pg8::pk4_fp8(v * v * pg8::HID_SCALE, 0.f, 0.f, 0.f) & 0xffu); }
                if (KIND != 3) { sq += __shfl_xor(sq, 1); sq += __shfl_xor(sq, 2); sq += __shfl_xor(sq, 4); sq += __shfl_xor(sq, 8);
                    if (m16 == 0 && sp != nullptr) pg8::stat_add(sp + row, sq); }
            }
        }
        __syncthreads();
    }
}

#define IN(k) (lo <= (k) && (k) < hi)
#define SEAM(k) do { if (IN(k) && IN((k) + 1)) xcd_barrier(bar, F.wave); } while (0)
__device__ __forceinline__ unsigned char* opaque_ptr(unsigned char* p) { asm volatile("" : "+s"(p)); return p; }
__device__ __forceinline__ stat_t* stat_at(unsigned char* ws, int l, int id) { return (stat_t*)(ws + WS_STATS) + (size_t)(l * ST_PER_LAYER + id) * STAT_STRIDE; }
__device__ __forceinline__ bf16* w_at(unsigned char* ws, int l, size_t off) { return (bf16*)(ws + WS_W + (size_t)l * W_LAYER + off); }
template <int l> __device__ __forceinline__ void layer_phases(const Args& args, Frame& F, const XcdBarrier& bar, int lo, int hi) {
    const int pb = 8 * l;
    if (IN(pb + 1)) {
        unsigned char* ws = opaque_ptr(args.ws);
        { MetaArgs ma{(bf16*)(ws + WS_HB), w_at(ws, l, WO_IN), NIN, DM, (bf16*)(ws + WS_P), nullptr, nullptr, stat_at(ws, l, ST_SS1), stat_at(ws, l, ST_SSKV), nullptr, nullptr, nullptr, nullptr}; meta_gemm<0>(F, ma, (LAS float*)(F.lds + RING_OFF)); }
        pg8::Gemm g{(bf16*)(ws + WS_HB), w_at(ws, l, WO_IN), MREAL, NIN, DM}; pg8::StaticOrder S; S.init(MREAL, NIN, F.G, (int)blockIdx.x);
        pg8::EpiIn E{(bf16*)(ws + WS_P), stat_at(ws, l, ST_SS1), stat_at(ws, l, ST_SSKV), (bf16*)(ws + WS_U)};
        pg8::gemm_phase<pg8::EpiIn, pg8::StaticOrder, true, true>(F.lds + RING_OFF, g, S, E, F.wave);
    } SEAM(pb + 1);
    if (IN(pb + 2)) { mixers_naive_phase(args, F, l); } SEAM(pb + 2);
    if (IN(pb + 3)) {
        unsigned char* ws = opaque_ptr(args.ws);
        pg8::Gemm g{(bf16*)(ws + WS_U), (bf16*)(ws + WS_TZ + (size_t)l * TZ_LAYER), 32 * S5RG, 32 * 512, S5KU}; S5Order S{F.G, (int)blockIdx.x};
        pg8::EpiS5 E{(bf16*)(ws + WS_U), (bf16*)(ws + WS_YG), args.in[15] + l * 512};
        pg8::gemm_phase<pg8::EpiS5, S5Order, true, true>(F.lds + RING_OFF, g, S, E, F.wave);
    } SEAM(pb + 3);
    if (IN(pb + 4)) {
        unsigned char* ws = opaque_ptr(args.ws);
        { MetaArgs ma{(bf16*)(ws + WS_YG), w_at(ws, l, WO_GLU), 512, 512, (bf16*)(ws + WS_YCAT), nullptr, (bf16*)(ws + WS_YG), nullptr, stat_at(ws, l, ST_SSB), nullptr, nullptr, nullptr, nullptr}; meta_gemm<1>(F, ma, (LAS float*)(F.lds + RING_OFF)); }
        pg8::Gemm g{(bf16*)(ws + WS_YG), w_at(ws, l, WO_GLU), MREAL, 512, 512}; pg8::StaticOrder S; S.init(MREAL, 512, F.G, (int)blockIdx.x);
        pg8::EpiGlu E{(bf16*)(ws + WS_YG), (bf16*)(ws + WS_YCAT), stat_at(ws, l, ST_SSB)};
        pg8::gemm_phase<pg8::EpiGlu, pg8::StaticOrder, true, true>(F.lds + RING_OFF, g, S, E, F.wave);
    } SEAM(pb + 4);
    if (IN(pb + 5)) {
        unsigned char* ws = opaque_ptr(args.ws);
        { MetaArgs ma{(bf16*)(ws + WS_YCAT), w_at(ws, l, WO_OUT), DM, DM, nullptr, (bf16*)(ws + WS_HB), nullptr, nullptr, stat_at(ws, l, ST_SS2), stat_at(ws, l, ST_SSB), stat_at(ws, l, ST_SSA), stat_at(ws, l, ST_SSC), nullptr}; meta_gemm<2>(F, ma, (LAS float*)(F.lds + RING_OFF)); }
        pg8::Gemm g{(bf16*)(ws + WS_YCAT), w_at(ws, l, WO_OUT), MREAL, DM, DM}; pg8::StaticOrder S; S.init(MREAL, DM, F.G, (int)blockIdx.x);
        pg8::EpiRes<true> E{(bf16*)(ws + WS_HB), stat_at(ws, l, ST_SS2), stat_at(ws, l, ST_SSB), stat_at(ws, l, ST_SSA), stat_at(ws, l, ST_SSC)};
        pg8::gemm_phase<pg8::EpiRes<true>, pg8::StaticOrder, true, true>(F.lds + RING_OFF, g, S, E, F.wave);
    } SEAM(pb + 5);
    if (IN(pb + 6)) { hq_phase(F, stat_at(opaque_ptr(args.ws), l, ST_SS2)); } SEAM(pb + 6);
    if (IN(pb + 7)) {
        unsigned char* ws = opaque_ptr(args.ws);
        { MetaArgs ma{(bf16*)(ws + WS_HQ), w_at(ws, l, WO_1), DFF, DM, (bf16*)(ws + WS_BIG), nullptr, nullptr, nullptr, nullptr, nullptr, nullptr, nullptr, (const unsigned*)(ws + WS_CTL) + CW_WMAX1 + l * 4096}; meta_gemm<3>(F, ma, (LAS float*)(F.lds + RING_OFF)); }
        pg8::Gemm g{(bf16*)(ws + WS_HQ), w_at(ws, l, WO_1), MREAL, DFF, DM / 2}; pg8::StaticOrder S; S.init(MREAL, DFF, F.G, (int)blockIdx.x);
        pg8::EpiMlp1F8B E{(unsigned char*)(ws + WS_BIG), (const unsigned*)(ws + WS_CTL) + CW_WMAX1 + l * 4096};
        pg8::gemm_phase<pg8::EpiMlp1F8B, pg8::StaticOrder, true, true, true>(F.lds + RING_OFF, g, S, E, F.wave);
    } SEAM(pb + 7);
    if (IN(pb + 8)) {
        unsigned char* ws = opaque_ptr(args.ws);
        { MetaArgs ma{(bf16*)(ws + WS_BIG), w_at(ws, l, WO_2), DM, DFF, nullptr, (bf16*)(ws + WS_HB), nullptr, nullptr, stat_at(ws, l + 1, ST_SS1), nullptr, nullptr, nullptr, (const unsigned*)(ws + WS_CTL) + CW_WMAX + l * 1024}; meta_gemm<4>(F, ma, (LAS float*)(F.lds + RING_OFF)); }
        pg8::Gemm g{(bf16*)(ws + WS_BIG), w_at(ws, l, WO_2), MREAL, DM, DFF / 2}; pg8::StaticOrder S; S.init(MREAL, DM, F.G, (int)blockIdx.x);
        pg8::EpiRes8 E{(bf16*)(ws + WS_HB), stat_at(ws, l + 1, ST_SS1), (const unsigned*)(ws + WS_CTL) + CW_WMAX + l * 1024};
        pg8::gemm_phase<pg8::EpiRes8, pg8::StaticOrder, true, true, true>(F.lds + RING_OFF, g, S, E, F.wave);
    } SEAM(pb + 8);
}
#undef IN
#undef SEAM
constexpr int N_PHASES = 18;
#if defined(__HIP_DEVICE_COMPILE__)
#define MK_NO_PK_F32 __attribute__((target("no-packed-fp32-ops")))
#else
#define MK_NO_PK_F32
#endif
__global__ void __launch_bounds__(NWAVES * 64, 2) MK_NO_PK_F32 hymba_fwd(Args args) {
    extern __shared__ __attribute__((aligned(16))) unsigned char lds[];
    Frame F;
    F.lds = (LAS unsigned char*)lds;
    F.MISC = (volatile LAS unsigned*)(F.lds + MISC_OFF);
    F.wave = __builtin_amdgcn_readfirstlane((int)threadIdx.x >> 6);
    F.G = gridDim.x; { const int bx = blockIdx.x; F.vcu = (F.G % 8 == 0) ? (bx % 8) * (F.G / 8) + bx / 8 : bx; }
    F.out = args.out; F.ws = args.ws;
    F.ctl = (gu32*)(args.ws + WS_CTL);
    for (int u = threadIdx.x; u < (LDS_BYTES - LDSCTL_OFF) / 4; u += NWAVES * 64) ((LAS unsigned*)(F.lds + LDSCTL_OFF))[u] = 0u;
    __syncthreads();
    const int lo = args.ph_lo, hi = args.ph_hi;
    const bool multi = (hi - lo) > 1;
    XcdBarrier bar; bar.bar = (unsigned*)(F.ctl + CW_BAR); bar.x = 0; bar.st = F.MISC + 8;
    if (multi) bar = xcd_barrier_post((unsigned*)(F.ctl + CW_BAR), F.MISC + 8, F.wave);
#define IN(k) (lo <= (k) && (k) < hi)
#define SEAM(k) do { if (IN(k) && IN((k) + 1)) xcd_barrier(bar, F.wave); } while (0)
    if (IN(0)) { p0_prologue(args, F); } SEAM(0);
    layer_phases<0>(args, F, bar, lo, hi);
    layer_phases<1>(args, F, bar, lo, hi);
    if (IN(17)) { final_phase(args, F); }
#undef IN
#undef SEAM
}

#ifndef MK_ONE_LAUNCH
#define MK_ONE_LAUNCH 1
#endif
extern "C" void kernel_launch(void* const* d_in, const int* in_sizes, int n_in, void* d_out, int out_size, void* d_ws, size_t ws_size, hipStream_t stream) {
    static int grid = 0;
    if (grid == 0) {
        if (n_in != 25 || in_sizes[0] != MREAL * DM || out_size != MREAL * DM || ws_size < WS_END2) {
            fprintf(stderr, "kernel_launch: unexpected problem: n_in %d, in0 %d, out %d, ws %zu (need %zu); nothing launched\n", n_in, n_in > 0 ? in_sizes[0] : -1, out_size, ws_size, (size_t)WS_END2); grid = -1; return; }
        int dev = 0, cus = 0, per_cu = 0;
        if (hipGetDevice(&dev) != hipSuccess || hipDeviceGetAttribute(&cus, hipDeviceAttributeMultiprocessorCount, dev) != hipSuccess) { grid = -1; return; }
        if (hipFuncSetAttribute((const void*)hymba_fwd, hipFuncAttributeMaxDynamicSharedMemorySize, LDS_BYTES) != hipSuccess) { fprintf(stderr, "kernel_launch: hipFuncSetAttribute failed\n"); grid = -1; return; }
        if (hipOccupancyMaxActiveBlocksPerMultiprocessor(&per_cu, (const void*)hymba_fwd, NWAVES * 64, LDS_BYTES) != hipSuccess || per_cu < 1)
            fprintf(stderr, "kernel_launch: note: occupancy query reports %d workgroups per CU\n", per_cu);
        (void)hipGetLastError();
        grid = cus;
    }
    if (grid < 0) return;
    if (hipMemsetAsync((char*)d_ws + WS_CTL, 0, CTL_ZERO_BYTES, stream) != hipSuccess) { fprintf(stderr, "kernel_launch: memset failed\n"); return; }
    Args a{};
    for (int i = 0; i < 25; ++i) a.in[i] = (const float*)d_in[i];
    a.out = (float*)d_out; a.ws = (unsigned char*)d_ws;
#if MK_ONE_LAUNCH
    a.ph_lo = 0; a.ph_hi = N_PHASES;
    hipLaunchKernelGGL(hymba_fwd, dim3(grid), dim3(NWAVES * 64), LDS_BYTES, stream, a);
#else
    for (int p = 0; p < N_PHASES; ++p) { a.ph_lo = p; a.ph_hi = p + 1;
        hipLaunchKernelGGL(hymba_fwd, dim3(grid), dim3(NWAVES * 64), LDS_BYTES, stream, a); }
#endif
    const hipError_t le = hipPeekAtLastError();
    if (le != hipSuccess) fprintf(stderr, "kernel_launch: launch failed: %s\n", hipGetErrorName(le));
}
```

```cpp
#include <hip/hip_runtime.h>
#include <cstdio>
#include <cstdint>
namespace pg8 {
#define PG8_LAS __attribute__((address_space(3)))
typedef unsigned short bf16_t;
typedef short bf16x8 __attribute__((ext_vector_type(8)));
typedef float f32x4 __attribute__((ext_vector_type(4)));
typedef unsigned u32x4 __attribute__((ext_vector_type(4)));
constexpr int BM = 256, BK = 64, HALF = 128, HTB = HALF * BK * 2  , STAGE_BYTES = 8 * HTB, NXCD = 8, WGM = 8;

__host__ __device__ __forceinline__ int lds_byte(int r, int c) { const int st = (r >> 4) * 2 + (c >> 5), rr = r & 15, cc = c & 31, ob = rr * 64 + cc * 2; return st * 1024 + (ob ^ (((ob >> 9) & 1) << 5)); }
__host__ __device__ __forceinline__ void stage_rc(int b, int& R, int& C) { const int st = b / 1024, sb = b % 1024, swz = sb ^ (((sb >> 9) & 1) << 5); R = (st >> 1) * 16 + swz / 64; C = (st & 1) * 32 + (swz % 64) / 2; }
__host__ __device__ __forceinline__ int perm32(int rho) { const int n = rho >> 4, i = rho & 15; return 8 * (i >> 2) + 4 * n + (i & 3); }

struct Unit { int pm, pn; };
struct Gemm { const bf16_t* A; const bf16_t* Bt; int M, N, K; };

struct StaticOrder {
    int nM, nN, nwg, G, c;
    __host__ __device__ void init(int M, int N, int G_, int c_) { nM = M / BM; nN = N / BM; nwg = nM * nN; G = G_; c = c_; }
    __host__ __device__ bool next(int i, Unit& u) const {
        const long L = (long)i * G + c; if (L >= nwg) return false;
        int wgid = (int)L; { const int q = nwg / NXCD, r = nwg % NXCD, xcd = wgid % NXCD, off = wgid / NXCD; wgid = (xcd < r ? xcd * (q + 1) : r * (q + 1) + (xcd - r) * q) + off; }
        const int nig = WGM * nN, gid = wgid / nig, fm = gid * WGM, gsz = (nM - fm) < WGM ? (nM - fm) : WGM;
        u.pm = fm + ((wgid % nig) % gsz); u.pn = (wgid % nig) / gsz; return true;
    }
    __device__ __forceinline__ void a_ready(const Unit&) const {}
    __device__ __forceinline__ void done(const Unit&) const {}
};

__device__ __forceinline__ unsigned cvt_pk_bf16(float lo, float hi) { unsigned r; asm volatile("v_cvt_pk_bf16_f32 %0, %1, %2" : "=v"(r) : "v"(lo), "v"(hi)); return r; }
typedef float f32x2 __attribute__((ext_vector_type(2)));
#define PG8_GAS __attribute__((address_space(1)))
constexpr float RMS_EPS = 1e-6f;
__device__ __forceinline__ float bf_lo(unsigned w) { return __uint_as_float(w << 16); }
__device__ __forceinline__ float bf_hi(unsigned w) { return __uint_as_float(w & 0xffff0000u); }
typedef unsigned long long stat_t;
__device__ __forceinline__ void stat_add(stat_t* p, float q) { atomicAdd(p, (stat_t)((double)q * 4294967296.0)); }
__device__ __forceinline__ float stat_get(const stat_t* p) { const stat_t v = *p; return (float)(unsigned)(v >> 32) + (float)(unsigned)v * 2.3283064365386963e-10f; }
__device__ __forceinline__ float stat_val(stat_t s) { return (float)((double)s * (1.0 / 4294967296.0)); }
__device__ __forceinline__ float quad_sum(float q) { q += __shfl_xor(q, 16); q += __shfl_xor(q, 32); return q; }

struct EpiIn {
    static constexpr bool PERM = true, AFTER_DRAIN = false; static constexpr int MIDT = 0, MIDT2 = 0;
    bf16_t* O; const stat_t* ss; stat_t* sskv; bf16_t* U;
    __device__ __forceinline__ void operator()(const f32x4 (&acc)[2][2][4][2], const Unit& u, int wr, int wc, int fr, int fq) const {
        const int row0 = u.pm * BM + wr * 64 + fr, col0 = u.pn * BM + wc * 32 + 8 * fq;
        stat_t sv[2][4];
#pragma unroll
        for (int ai = 0; ai < 2; ++ai)
#pragma unroll
            for (int m = 0; m < 4; ++m) sv[ai][m] = *(const PG8_GAS stat_t*)(ss + row0 + ai * HALF + m * 16);
#pragma unroll
        for (int ai = 0; ai < 2; ++ai)
#pragma unroll
            for (int m = 0; m < 4; ++m) { const int row = row0 + ai * HALF + m * 16; const float r = rsqrtf(stat_val(sv[ai][m]) * (1.0f / 1024.0f) + RMS_EPS);
                bf16_t* rowp = O + (size_t)row * 2048 + col0;
#pragma unroll
                for (int bj = 0; bj < 2; ++bj) { const f32x4 v0 = acc[ai][bj][m][0] * r, v1 = acc[ai][bj][m][1] * r;
                    u32x4 w; w.x = cvt_pk_bf16(v0[0], v0[1]); w.y = cvt_pk_bf16(v0[2], v0[3]); w.z = cvt_pk_bf16(v1[0], v1[1]); w.w = cvt_pk_bf16(v1[2], v1[3]);
                    if (u.pn == 3 || u.pn == 4) {
                        const int gc = col0 + bj * HALF - 768, gg = gc >> 4, t = row & 2047;
                        *(PG8_GAS u32x4*)(U + ((size_t)gg * 1024 + (row >> 11) * 64 + (t >> 5)) * 640 + (t & 31) * 16 + (gc & 15)) = w; }
                    else *(PG8_GAS u32x4*)(rowp + bj * HALF) = w;
                    if (bj == 0 && u.pn == 1) { float q = (bf_lo(w.x) * bf_lo(w.x) + bf_hi(w.x) * bf_hi(w.x)) + (bf_lo(w.y) * bf_lo(w.y) + bf_hi(w.y) * bf_hi(w.y))
                                                      + (bf_lo(w.z) * bf_lo(w.z) + bf_hi(w.z) * bf_hi(w.z)) + (bf_lo(w.w) * bf_lo(w.w) + bf_hi(w.w) * bf_hi(w.w));
                        q = quad_sum(q); if (fq == 0) stat_add(sskv + row, q); } } }
    }
};
struct EpiGlu {
    static constexpr bool PERM = true, AFTER_DRAIN = false; static constexpr int MIDT = 0, MIDT2 = 0;
    const bf16_t* Y; bf16_t* O; stat_t* ssb;
    __device__ __forceinline__ void operator()(const f32x4 (&acc)[2][2][4][2], const Unit& u, int wr, int wc, int fr, int fq) const {
        const int row0 = u.pm * BM + wr * 64 + fr, col0 = u.pn * BM + wc * 32 + 8 * fq;
#pragma unroll
        for (int ai = 0; ai < 2; ++ai) {
            u32x4 yl[4][2];
#pragma unroll
            for (int m = 0; m < 4; ++m) { const int row = row0 + ai * HALF + m * 16; const PG8_GAS u32x4* rp = (const PG8_GAS u32x4*)(Y + (size_t)row * 512 + col0); yl[m][0] = rp[0]; yl[m][1] = rp[HALF / 8]; }
#pragma unroll
            for (int m = 0; m < 4; ++m) { const int row = row0 + ai * HALF + m * 16; float q = 0.f;
#pragma unroll
                for (int bj = 0; bj < 2; ++bj) { const u32x4 y8 = yl[m][bj];
                    const f32x4 g0 = acc[ai][bj][m][0], g1 = acc[ai][bj][m][1];
                    float o[8]; const float yv[8] = {bf_lo(y8.x), bf_hi(y8.x), bf_lo(y8.y), bf_hi(y8.y), bf_lo(y8.z), bf_hi(y8.z), bf_lo(y8.w), bf_hi(y8.w)};
                    const float gv[8] = {g0[0], g0[1], g0[2], g0[3], g1[0], g1[1], g1[2], g1[3]};
#pragma unroll
                    for (int j = 0; j < 8; ++j) o[j] = yv[j] * __builtin_amdgcn_rcpf(1.0f + __expf(-gv[j]));
                    u32x4 w; w.x = cvt_pk_bf16(o[0], o[1]); w.y = cvt_pk_bf16(o[2], o[3]); w.z = cvt_pk_bf16(o[4], o[5]); w.w = cvt_pk_bf16(o[6], o[7]);
                    *(PG8_GAS u32x4*)(O + (size_t)row * 1024 + col0 + bj * HALF) = w;
                    q += (bf_lo(w.x) * bf_lo(w.x) + bf_hi(w.x) * bf_hi(w.x)) + (bf_lo(w.y) * bf_lo(w.y) + bf_hi(w.y) * bf_hi(w.y))
                       + (bf_lo(w.z) * bf_lo(w.z) + bf_hi(w.z) * bf_hi(w.z)) + (bf_lo(w.w) * bf_lo(w.w) + bf_hi(w.w) * bf_hi(w.w)); }
                q = quad_sum(q); if (fq == 0) stat_add(ssb + row, q); } }
    }
};
template <bool OUT> struct EpiRes {
    static constexpr bool PERM = true, AFTER_DRAIN = false; static constexpr int MIDT = OUT ? 8 : 0, MIDT2 = OUT ? 12 : 0;
    bf16_t* H; stat_t* ssn; const stat_t* ssb; const stat_t* ssa; const stat_t* ssc;
    __device__ __forceinline__ void mid(f32x4 (&acc)[2][2][4][2], const Unit& u, int wr, int fr, int t) const {
        const stat_t* sn = (t == MIDT) ? ssb : ssa; const stat_t* sd = (t == MIDT) ? ssa : ssc;
        const float wn = (t == MIDT) ? (1.0f / 512.0f) : (1.0f / 256.0f);
        stat_t vn[2][4], vd[2][4];
#pragma unroll
        for (int ai = 0; ai < 2; ++ai)
#pragma unroll
            for (int m = 0; m < 4; ++m) { const int row = u.pm * BM + ai * HALF + wr * 64 + m * 16 + fr; vn[ai][m] = *(const PG8_GAS stat_t*)(sn + row); vd[ai][m] = *(const PG8_GAS stat_t*)(sd + row); }
#pragma unroll
        for (int ai = 0; ai < 2; ++ai)
#pragma unroll
            for (int m = 0; m < 4; ++m) {
                const float xn = stat_val(vn[ai][m]) * wn + RMS_EPS, xd = stat_val(vd[ai][m]) * (1.0f / 256.0f) + RMS_EPS;
                const float f = __builtin_amdgcn_sqrtf(xd * __builtin_amdgcn_rcpf(xn));
#pragma unroll
                for (int bj = 0; bj < 2; ++bj)
#pragma unroll
                    for (int n = 0; n < 2; ++n) acc[ai][bj][m][n] *= f; }
    }
    __device__ __forceinline__ void operator()(const f32x4 (&acc)[2][2][4][2], const Unit& u, int wr, int wc, int fr, int fq) const {
        const int row0 = u.pm * BM + wr * 64 + fr, col0 = u.pn * BM + wc * 32 + 8 * fq;
#pragma unroll
        for (int ai = 0; ai < 2; ++ai) {
            u32x4 h8[4][2]; stat_t sc[4];
#pragma unroll
            for (int m = 0; m < 4; ++m) { const int row = row0 + ai * HALF + m * 16; const PG8_GAS u32x4* rp = (const PG8_GAS u32x4*)(H + (size_t)row * 1024 + col0);
                h8[m][0] = rp[0]; h8[m][1] = rp[HALF / 8]; if (OUT) sc[m] = *(const PG8_GAS stat_t*)(ssc + row); }
#pragma unroll
            for (int m = 0; m < 4; ++m) { const int row = row0 + ai * HALF + m * 16; float q = 0.f; PG8_GAS u32x4* wp = (PG8_GAS u32x4*)(H + (size_t)row * 1024 + col0);
                float post = 1.0f; if (OUT) post = rsqrtf(stat_val(sc[m]) * (1.0f / 256.0f) + RMS_EPS);
#pragma unroll
                for (int bj = 0; bj < 2; ++bj) { const u32x4 hv = h8[m][bj];
                    const f32x4 a0 = acc[ai][bj][m][0] * post, a1 = acc[ai][bj][m][1] * post;
                    u32x4 w; w.x = cvt_pk_bf16(bf_lo(hv.x) + a0[0], bf_hi(hv.x) + a0[1]); w.y = cvt_pk_bf16(bf_lo(hv.y) + a0[2], bf_hi(hv.y) + a0[3]);
                    w.z = cvt_pk_bf16(bf_lo(hv.z) + a1[0], bf_hi(hv.z) + a1[1]); w.w = cvt_pk_bf16(bf_lo(hv.w) + a1[2], bf_hi(hv.w) + a1[3]);
                    wp[bj * (HALF / 8)] = w;
                    q += (bf_lo(w.x) * bf_lo(w.x) + bf_hi(w.x) * bf_hi(w.x)) + (bf_lo(w.y) * bf_lo(w.y) + bf_hi(w.y) * bf_hi(w.y))
                       + (bf_lo(w.z) * bf_lo(w.z) + bf_hi(w.z) * bf_hi(w.z)) + (bf_lo(w.w) * bf_lo(w.w) + bf_hi(w.w) * bf_hi(w.w)); }
                q = quad_sum(q); if (fq == 0) stat_add(ssn + row, q); } }
    }
};
struct EpiMlp1 {
    static constexpr bool PERM = true, AFTER_DRAIN = false; static constexpr int MIDT = 0, MIDT2 = 0;
    bf16_t* O; const stat_t* ss;
    __device__ __forceinline__ void operator()(const f32x4 (&acc)[2][2][4][2], const Unit& u, int wr, int wc, int fr, int fq) const {
        const int row0 = u.pm * BM + wr * 64 + fr, col0 = u.pn * BM + wc * 32 + 8 * fq;
#pragma unroll
        for (int ai = 0; ai < 2; ++ai)
#pragma unroll
            for (int m = 0; m < 4; ++m) { const int row = row0 + ai * HALF + m * 16; const float r = rsqrtf(stat_get(ss + row) * (1.0f / 1024.0f) + RMS_EPS);
                bf16_t* rowp = O + (size_t)row * 4096 + col0;
#pragma unroll
                for (int bj = 0; bj < 2; ++bj) { f32x4 v0 = acc[ai][bj][m][0] * r, v1 = acc[ai][bj][m][1] * r;
#pragma unroll
                    for (int j = 0; j < 4; ++j) { const float a = fmaxf(v0[j], 0.f), b = fmaxf(v1[j], 0.f); v0[j] = a * a; v1[j] = b * b; }
                    u32x4 w; w.x = cvt_pk_bf16(v0[0], v0[1]); w.y = cvt_pk_bf16(v0[2], v0[3]); w.z = cvt_pk_bf16(v1[0], v1[1]); w.w = cvt_pk_bf16(v1[2], v1[3]);
                    *(u32x4*)(rowp + bj * HALF) = w; } }
    }
};
__device__ __forceinline__ float relu_i(float x) { const int i = (int)__builtin_bit_cast(unsigned, x); return __builtin_bit_cast(float, (unsigned)(i > 0 ? i : 0)); }
__device__ __forceinline__ unsigned pk4_fp8(float a, float b, float c, float d) {
    a = __builtin_amdgcn_fmed3f(a, -448.f, 448.f); b = __builtin_amdgcn_fmed3f(b, -448.f, 448.f); c = __builtin_amdgcn_fmed3f(c, -448.f, 448.f); d = __builtin_amdgcn_fmed3f(d, -448.f, 448.f);
    int w = 0; w = __builtin_amdgcn_cvt_pk_fp8_f32(a, b, w, false); w = __builtin_amdgcn_cvt_pk_fp8_f32(c, d, w, true); return (unsigned)w;
}
constexpr float HID_SCALE = 0.25f; static_assert(HID_SCALE == 0.25f, "EpiMlp1F8B folds sqrt(HID_SCALE) = 0.5 into its column scales");
struct EpiMlp1F8 {
    static constexpr bool PERM = true, AFTER_DRAIN = false; static constexpr int MIDT = 0, MIDT2 = 0;
    unsigned char* O; const stat_t* ss;
    __device__ __forceinline__ void operator()(const f32x4 (&acc)[2][2][4][2], const Unit& u, int wr, int wc, int fr, int fq) const {
        typedef unsigned u32x2v __attribute__((ext_vector_type(2)));
        const int row0 = u.pm * BM + wr * 64 + fr, col0 = u.pn * BM + wc * 32 + 8 * fq;
#pragma unroll
        for (int ai = 0; ai < 2; ++ai)
#pragma unroll
            for (int m = 0; m < 4; ++m) { const int row = row0 + ai * HALF + m * 16; const float r = rsqrtf(stat_get(ss + row) * (1.0f / 1024.0f) + RMS_EPS);
                unsigned char* rowp = O + (size_t)row * 4096 + col0;
#pragma unroll
                for (int bj = 0; bj < 2; ++bj) { f32x4 v0 = acc[ai][bj][m][0] * r, v1 = acc[ai][bj][m][1] * r;
#pragma unroll
                    for (int j = 0; j < 4; ++j) { const float a = fmaxf(v0[j], 0.f), b = fmaxf(v1[j], 0.f); v0[j] = a * a * HID_SCALE; v1[j] = b * b * HID_SCALE; }
                    u32x2v w; w.x = pk4_fp8(v0[0], v0[1], v0[2], v0[3]); w.y = pk4_fp8(v1[0], v1[1], v1[2], v1[3]);
                    *(u32x2v*)(rowp + bj * HALF) = w; } }
    }
};
struct EpiMlp1F8B {
    static constexpr bool PERM = true, AFTER_DRAIN = false; static constexpr int MIDT = 0, MIDT2 = 0;
    unsigned char* O; const unsigned* wmax;
    __device__ __forceinline__ void operator()(const f32x4 (&acc)[2][2][4][2], const Unit& u, int wr, int wc, int fr, int fq) const {
        const int row0 = u.pm * BM + wr * 64 + fr, col0 = u.pn * BM + wc * 32 + 8 * fq;
        f32x4 cs[2][2];
#pragma unroll
        for (int bj = 0; bj < 2; ++bj)
#pragma unroll
            for (int n = 0; n < 2; ++n) { const u32x4 wm = *(const PG8_GAS u32x4*)(wmax + col0 + bj * HALF + 4 * n);
                cs[bj][n] = (f32x4){fmaxf(__uint_as_float(wm.x), 1e-30f), fmaxf(__uint_as_float(wm.y), 1e-30f), fmaxf(__uint_as_float(wm.z), 1e-30f), fmaxf(__uint_as_float(wm.w), 1e-30f)} * (0.5f / (448.0f * 8.0f)); }
        const bool odd = (fq & 1) != 0;
#pragma unroll
        for (int ai = 0; ai < 2; ++ai)
#pragma unroll
            for (int mp = 0; mp < 4; mp += 2) {
#pragma unroll
                for (int bj = 0; bj < 2; ++bj) { unsigned wa[2][2];
#pragma unroll
                    for (int q = 0; q < 2; ++q) { f32x4 v0 = acc[ai][bj][mp + q][0] * cs[bj][0], v1 = acc[ai][bj][mp + q][1] * cs[bj][1];
#pragma unroll
                        for (int j = 0; j < 4; ++j) { const float a = relu_i(v0[j]), b = relu_i(v1[j]); v0[j] = a * a; v1[j] = b * b; }
                        wa[q][0] = pk4_fp8(v0[0], v0[1], v0[2], v0[3]); wa[q][1] = pk4_fp8(v1[0], v1[1], v1[2], v1[3]); }
                    const unsigned s0 = odd ? wa[0][0] : wa[1][0], s1 = odd ? wa[0][1] : wa[1][1];
                    const unsigned r0 = (unsigned)__shfl_xor((int)s0, 16), r1 = (unsigned)__shfl_xor((int)s1, 16);
                    u32x4 o; if (odd) { o.x = r0; o.y = r1; o.z = wa[1][0]; o.w = wa[1][1]; } else { o.x = wa[0][0]; o.y = wa[0][1]; o.z = r0; o.w = r1; }
                    const int row = row0 + ai * HALF + (mp + (odd ? 1 : 0)) * 16;
                    *(PG8_GAS u32x4*)(O + (size_t)row * 4096 + (col0 & ~15) + bj * HALF) = o; } }
    }
};
struct EpiRes8 {
    static constexpr bool PERM = true, AFTER_DRAIN = false; static constexpr int MIDT = 0, MIDT2 = 0;
    bf16_t* H; stat_t* ssn; const unsigned* wmax;
    __device__ __forceinline__ void operator()(const f32x4 (&acc)[2][2][4][2], const Unit& u, int wr, int wc, int fr, int fq) const {
        const int row0 = u.pm * BM + wr * 64 + fr, col0 = u.pn * BM + wc * 32 + 8 * fq;
        f32x4 cs[2][2];
#pragma unroll
        for (int bj = 0; bj < 2; ++bj)
#pragma unroll
            for (int n = 0; n < 2; ++n) { const u32x4 wm = *(const u32x4*)(wmax + col0 + bj * HALF + 4 * n);
                cs[bj][n] = (f32x4){fmaxf(__uint_as_float(wm.x), 1e-30f), fmaxf(__uint_as_float(wm.y), 1e-30f), fmaxf(__uint_as_float(wm.z), 1e-30f), fmaxf(__uint_as_float(wm.w), 1e-30f)} * (1.0f / (448.0f * HID_SCALE)); }
#pragma unroll
        for (int ai = 0; ai < 2; ++ai) {
            u32x4 h8[4][2];
#pragma unroll
            for (int m = 0; m < 4; ++m) { const int row = row0 + ai * HALF + m * 16; const PG8_GAS u32x4* rp = (const PG8_GAS u32x4*)(H + (size_t)row * 1024 + col0); h8[m][0] = rp[0]; h8[m][1] = rp[HALF / 8]; }
#pragma unroll
            for (int m = 0; m < 4; ++m) { const int row = row0 + ai * HALF + m * 16; float q = 0.f; PG8_GAS u32x4* wp = (PG8_GAS u32x4*)(H + (size_t)row * 1024 + col0);
#pragma unroll
                for (int bj = 0; bj < 2; ++bj) { const u32x4 hv = h8[m][bj];
                    const f32x4 a0 = acc[ai][bj][m][0] * cs[bj][0], a1 = acc[ai][bj][m][1] * cs[bj][1];
                    u32x4 w; w.x = cvt_pk_bf16(bf_lo(hv.x) + a0[0], bf_hi(hv.x) + a0[1]); w.y = cvt_pk_bf16(bf_lo(hv.y) + a0[2], bf_hi(hv.y) + a0[3]);
                    w.z = cvt_pk_bf16(bf_lo(hv.z) + a1[0], bf_hi(hv.z) + a1[1]); w.w = cvt_pk_bf16(bf_lo(hv.w) + a1[2], bf_hi(hv.w) + a1[3]);
                    wp[bj * (HALF / 8)] = w;
                    q += (bf_lo(w.x) * bf_lo(w.x) + bf_hi(w.x) * bf_hi(w.x)) + (bf_lo(w.y) * bf_lo(w.y) + bf_hi(w.y) * bf_hi(w.y))
                       + (bf_lo(w.z) * bf_lo(w.z) + bf_hi(w.z) * bf_hi(w.z)) + (bf_lo(w.w) * bf_lo(w.w) + bf_hi(w.w) * bf_hi(w.w)); }
                q = quad_sum(q); if (fq == 0) stat_add(ssn + row, q); } }
    }
};
typedef int v8i_t __attribute__((ext_vector_type(8))); typedef int v4i_t __attribute__((ext_vector_type(4)));
template <class Epi, class Sched, bool ALIGN_EPI = false, bool SP2 = false, bool F8 = false>
__device__ __forceinline__ void gemm_phase(PG8_LAS unsigned char* lds, const Gemm g, const Sched& S, const Epi& E, const int wid_in) {
    int lane_; asm volatile("v_mbcnt_lo_u32_b32 %0, -1, 0\n\tv_mbcnt_hi_u32_b32 %0, -1, %0" : "=v"(lane_)); const int tid_ = wid_in * 64 + lane_;
    const int tid = tid_, wid = wid_in, lane = lane_, wr = wid >> 2, wc = wid & 3, fr = lane & 15, fq = lane >> 4;
    const int K = g.K, nt = K / BK;
    unsigned voffA[2], voffB[2];
#pragma unroll
    for (int i = 0; i < 2; ++i) { int R, C; stage_rc(tid * 16 + i * 8192, R, C); const int Rb = Epi::PERM ? ((R & ~31) + perm32(R & 31)) : R;
        voffA[i] = (unsigned)(R * K + C) * 2u; voffB[i] = (unsigned)(Rb * K + C) * 2u; }
    const size_t kstep = (size_t)(BK * 2);
    const size_t hstep = (size_t)HALF * K * 2;
    const size_t tstep = 2 * hstep;
    const unsigned ldsw = (unsigned)wid * 1024u;
    const int aoff = lds_byte(wr * 64 + fr, fq * 8), boff = lds_byte(wc * 32 + fr, fq * 8);
#define PG8_SA(b, h) (((b) * 2 + (h)) * HTB)
#define PG8_SB(b, h) ((4 + (b) * 2 + (h)) * HTB)
#define PG8_STAGE(bufoff, gbase, voff) do { _Pragma("unroll") for (int _i = 0; _i < 2; ++_i) \
        __builtin_amdgcn_global_load_lds((const unsigned*)((const char*)(gbase) + (voff)[_i]), (PG8_LAS unsigned*)(lds + (bufoff) + ldsw + _i * 8192), 16, 0, 0); } while (0)
#define PG8_LDA(dst, b, h) do { if constexpr (F8) { _Pragma("unroll") for (int m = 0; m < 4; ++m) dst##_8[m] = __builtin_shufflevector(*(const PG8_LAS v4i_t*)(lds + PG8_SA(b, h) + aoff + m * 2048), *(const PG8_LAS v4i_t*)(lds + PG8_SA(b, h) + aoff + m * 2048 + 1024), 0, 1, 2, 3, 4, 5, 6, 7); } \
        else { _Pragma("unroll") for (int m = 0; m < 4; ++m) _Pragma("unroll") for (int k = 0; k < 2; ++k) dst[m][k] = *(const PG8_LAS bf16x8*)(lds + PG8_SA(b, h) + aoff + m * 2048 + k * 1024); } } while (0)
#define PG8_LDB(dst, b, h) do { if constexpr (F8) { _Pragma("unroll") for (int n = 0; n < 2; ++n) dst##_8[n] = __builtin_shufflevector(*(const PG8_LAS v4i_t*)(lds + PG8_SB(b, h) + boff + n * 2048), *(const PG8_LAS v4i_t*)(lds + PG8_SB(b, h) + boff + n * 2048 + 1024), 0, 1, 2, 3, 4, 5, 6, 7); } \
        else { _Pragma("unroll") for (int n = 0; n < 2; ++n) _Pragma("unroll") for (int k = 0; k < 2; ++k) dst[n][k] = *(const PG8_LAS bf16x8*)(lds + PG8_SB(b, h) + boff + n * 2048 + k * 1024); } } while (0)
#define PG8_MMA(ai, bj, At, Bt) do { __builtin_amdgcn_s_setprio(1); \
        if constexpr (F8) { _Pragma("unroll") for (int m = 0; m < 4; ++m) _Pragma("unroll") for (int n = 0; n < 2; ++n) { \
            asm volatile("v_mfma_f32_16x16x128_f8f6f4 %0, %1, %2, %0" : "+v"(acc[ai][bj][m][n]) : "v"(Bt##_8[n]), "v"(At##_8[m])); } } \
        else { _Pragma("unroll") for (int m = 0; m < 4; ++m) _Pragma("unroll") for (int n = 0; n < 2; ++n) _Pragma("unroll") for (int k = 0; k < 2; ++k) \
            acc[ai][bj][m][n] = __builtin_amdgcn_mfma_f32_16x16x32_bf16(Bt[n][k], At[m][k], acc[ai][bj][m][n], 0, 0, 0); } \
        __builtin_amdgcn_s_setprio(0); } while (0)
#define PG8_WAIT_V(n) asm volatile("s_waitcnt vmcnt(" #n ")" ::: "memory")
#define PG8_WAIT_L(n) asm volatile("s_waitcnt lgkmcnt(" #n ")" ::: "memory")
#define PG8_BAR __builtin_amdgcn_s_barrier()
#define PG8_SCHED __builtin_amdgcn_sched_barrier(0)
    Unit cur, nxt; int ui = 0;
    if (!S.next(0, cur)) return;
    f32x4 acc[2][2][4][2];
#pragma unroll
    for (int a = 0; a < 2; ++a)
#pragma unroll
        for (int b = 0; b < 2; ++b)
#pragma unroll
            for (int m = 0; m < 4; ++m)
#pragma unroll
                for (int n = 0; n < 2; ++n) acc[a][b][m][n] = (f32x4){0.f, 0.f, 0.f, 0.f};
    bf16x8 At[4][2], B0[2][2], B1[2][2];
    v8i_t At_8[4], B0_8[2], B1_8[2];
    const char* cA = (const char*)g.A + (size_t)cur.pm * tstep; const char* cB = (const char*)g.Bt + (size_t)cur.pn * tstep;
    S.a_ready(cur);
    if constexpr (SP2) {
        PG8_STAGE(PG8_SB(0, 0), cB, voffB); PG8_STAGE(PG8_SB(0, 1), cB + hstep, voffB); PG8_STAGE(PG8_SA(0, 0), cA, voffA); PG8_STAGE(PG8_SA(0, 1), cA + hstep, voffA);
        if (wr == 1) PG8_BAR;
        PG8_WAIT_V(2); PG8_BAR;
        PG8_STAGE(PG8_SB(1, 0), cB + kstep, voffB); PG8_STAGE(PG8_SA(1, 0), cA + kstep, voffA); PG8_STAGE(PG8_SB(1, 1), cB + hstep + kstep, voffB);
        PG8_WAIT_V(6); PG8_BAR;
    } else {
        PG8_STAGE(PG8_SB(0, 0), cB, voffB); PG8_STAGE(PG8_SA(0, 0), cA, voffA); PG8_STAGE(PG8_SB(0, 1), cB + hstep, voffB); PG8_STAGE(PG8_SA(0, 1), cA + hstep, voffA);
        if (wr == 1) PG8_BAR;
        PG8_WAIT_V(4); PG8_BAR;
        PG8_STAGE(PG8_SB(1, 0), cB + kstep, voffB); PG8_STAGE(PG8_SA(1, 0), cA + kstep, voffA); PG8_STAGE(PG8_SB(1, 1), cB + hstep + kstep, voffB);
        PG8_WAIT_V(6); PG8_BAR;
    }
    for (;;) {
        const bool has_next = S.next(ui + 1, nxt);
        const char* nA = has_next ? (const char*)g.A + (size_t)nxt.pm * tstep : cA; const char* nB = has_next ? (const char*)g.Bt + (size_t)nxt.pn * tstep : cB;
        for (int t = 0; t < nt; t += 2) {
            const bool last = (t == nt - 2);
            const char* a1 = cA + (size_t)(t + 1) * kstep;
            const char* a2 = last ? nA : cA + (size_t)(t + 2) * kstep; const char* b2 = last ? nB : cB + (size_t)(t + 2) * kstep;
            const char* a3 = a2 + kstep; const char* b3 = b2 + kstep;
            if (last && has_next) S.a_ready(nxt);
            if constexpr (SP2) {
            PG8_LDB(B0, 0, 0); PG8_LDB(B1, 0, 1); PG8_SCHED; PG8_LDA(At, 0, 0); PG8_STAGE(PG8_SA(1, 1), a1 + hstep, voffA);
            PG8_WAIT_V(8); PG8_WAIT_L(0); PG8_BAR; PG8_MMA(0, 0, At, B0); PG8_MMA(0, 1, At, B1); PG8_BAR; PG8_SCHED;
            PG8_LDA(At, 0, 1); PG8_STAGE(PG8_SB(0, 0), b2, voffB); PG8_STAGE(PG8_SB(0, 1), b2 + hstep, voffB); PG8_STAGE(PG8_SA(0, 0), a2, voffA);
            PG8_WAIT_V(8); PG8_WAIT_L(0); PG8_BAR; PG8_MMA(1, 0, At, B0); PG8_MMA(1, 1, At, B1); PG8_BAR; PG8_SCHED;
            PG8_LDB(B0, 1, 0); PG8_LDB(B1, 1, 1); PG8_SCHED; PG8_LDA(At, 1, 0); PG8_STAGE(PG8_SA(0, 1), a2 + hstep, voffA);
            PG8_WAIT_V(8); PG8_WAIT_L(0); PG8_BAR; PG8_MMA(0, 0, At, B0); PG8_MMA(0, 1, At, B1); PG8_BAR; PG8_SCHED;
            PG8_LDA(At, 1, 1); PG8_STAGE(PG8_SB(1, 0), b3, voffB); PG8_STAGE(PG8_SB(1, 1), b3 + hstep, voffB); PG8_STAGE(PG8_SA(1, 0), a3, voffA);
            PG8_WAIT_V(8); PG8_WAIT_L(0); PG8_BAR; PG8_MMA(1, 0, At, B0); PG8_MMA(1, 1, At, B1); PG8_BAR; PG8_SCHED;
            } else {
            PG8_LDB(B0, 0, 0); PG8_SCHED; PG8_LDA(At, 0, 0); PG8_STAGE(PG8_SA(1, 1), a1 + hstep, voffA);
            PG8_WAIT_L(8); PG8_BAR; PG8_WAIT_L(0); PG8_MMA(0, 0, At, B0); PG8_BAR; PG8_SCHED;
            PG8_LDB(B1, 0, 1); PG8_STAGE(PG8_SB(0, 0), b2, voffB);
            PG8_BAR; PG8_WAIT_L(0); PG8_MMA(0, 1, At, B1); PG8_BAR;
            PG8_LDA(At, 0, 1); PG8_STAGE(PG8_SA(0, 0), a2, voffA);
            PG8_BAR; PG8_WAIT_L(0); PG8_MMA(1, 0, At, B0); PG8_BAR; PG8_SCHED;
            PG8_STAGE(PG8_SB(0, 1), b2 + hstep, voffB);
            PG8_WAIT_V(6); PG8_BAR; PG8_MMA(1, 1, At, B1); PG8_BAR;
            PG8_LDB(B0, 1, 0); PG8_SCHED; PG8_LDA(At, 1, 0); PG8_STAGE(PG8_SA(0, 1), a2 + hstep, voffA);
            PG8_WAIT_L(8); PG8_BAR; PG8_WAIT_L(0); PG8_MMA(0, 0, At, B0); PG8_BAR; PG8_SCHED;
            PG8_LDB(B1, 1, 1); PG8_STAGE(PG8_SB(1, 0), b3, voffB);
            PG8_BAR; PG8_WAIT_L(0); PG8_MMA(0, 1, At, B1); PG8_BAR;
            PG8_LDA(At, 1, 1); PG8_STAGE(PG8_SA(1, 0), a3, voffA);
            PG8_BAR; PG8_WAIT_L(0); PG8_MMA(1, 0, At, B0); PG8_BAR; PG8_SCHED;
            PG8_STAGE(PG8_SB(1, 1), b3 + hstep, voffB);
            PG8_WAIT_V(6); PG8_BAR; PG8_MMA(1, 1, At, B1); PG8_BAR;
            }
            if constexpr (Epi::MIDT > 0) { if (t + 2 == Epi::MIDT || t + 2 == Epi::MIDT2) { int l2_; asm volatile("v_mbcnt_lo_u32_b32 %0, -1, 0\n\tv_mbcnt_hi_u32_b32 %0, -1, %0" : "=v"(l2_)); E.mid(acc, cur, wr, l2_ & 15, t + 2); } }
        }
        if constexpr (F8) asm volatile("s_nop 15\n\ts_nop 15" ::: "memory");
        if constexpr (ALIGN_EPI) { if (wr == 0) PG8_BAR; }
        if constexpr (!Epi::AFTER_DRAIN) { int l2_; asm volatile("v_mbcnt_lo_u32_b32 %0, -1, 0\n\tv_mbcnt_hi_u32_b32 %0, -1, %0" : "=v"(l2_));
            E(acc, cur, wr, wc, l2_ & 15, l2_ >> 4); S.done(cur); }
        if (!has_next) break;
#pragma unroll
        for (int a = 0; a < 2; ++a)
#pragma unroll
            for (int b = 0; b < 2; ++b)
#pragma unroll
                for (int m = 0; m < 4; ++m)
#pragma unroll
                    for (int n = 0; n < 2; ++n) acc[a][b][m][n] = (f32x4){0.f, 0.f, 0.f, 0.f};
        cur = nxt; cA = nA; cB = nB; ++ui;
        if constexpr (ALIGN_EPI) { if (wr == 1) PG8_BAR; }
    }
    PG8_WAIT_V(0);
    if constexpr (!ALIGN_EPI) { if (wr == 0) PG8_BAR; }
    PG8_BAR;
    if constexpr (Epi::AFTER_DRAIN) { E.fused(acc, cur, wr, wc, fr, fq, lds, wid, lane); S.done(cur); }
#undef PG8_SA
#undef PG8_SB
#undef PG8_STAGE
#undef PG8_LDA
#undef PG8_LDB
#undef PG8_MMA
#undef PG8_WAIT_V
#undef PG8_WAIT_L
#undef PG8_BAR
#undef PG8_SCHED
}
}

constexpr int NWAVES = 8;
constexpr int BATCH = 16, SEQ = 2048, DM = 1024, DEPTH = 2, NMETA = 16, DFF = 4096;
constexpr int MROWS = 33024;
constexpr int MREAL = BATCH * SEQ, MVALID = MREAL + NMETA;
constexpr int NIN_SRC = 1988, NIN = 2048;
constexpr int PC_QA = 0, PC_CKV = 256, PC_IK = 384, PC_IW = 448, PC_IQ = 512, PC_UB = 768, PC_QC = 1280, PC_KC = 1536, PC_VC = 1792;
constexpr int YC_B = 0, YC_A = 512, YC_C = 768;
constexpr int TOPK = 256;

constexpr size_t MiB = 1u << 20;
constexpr size_t WS_CTL = 0;
constexpr size_t WS_STATS = 1 * MiB, CTL_ZERO_BYTES = 5 * MiB;
constexpr size_t STAT_STRIDE = 33024;
enum StatId { ST_SS1 = 0, ST_SSKV = 1, ST_SSB = 2, ST_SS2 = 3, ST_SSA = 4, ST_SSC = 5, ST_PER_LAYER = 6 };
constexpr size_t WS_W = 6 * MiB;
constexpr size_t W_LAYER = 23 * MiB, WO_IN = 0, WO_GLU = 4 * MiB, WO_OUT = 5 * MiB, WO_1 = 7 * MiB, WO_2 = 15 * MiB;
constexpr size_t WS_HB = 52 * MiB;
constexpr size_t WS_BIG = 118 * MiB;
constexpr size_t WS_P = WS_BIG, WS_YCAT = WS_BIG + 130 * MiB, WS_YG = WS_BIG + 196 * MiB;
constexpr size_t WS_END = 376 * MiB;
constexpr size_t WS_WUKF = 497 * MiB - 512 * 1024, WS_WUVF = WS_WUKF + 128 * 1024;
static_assert(WS_STATS + (2 * ST_PER_LAYER + 1) * STAT_STRIDE * 8 <= CTL_ZERO_BYTES && CTL_ZERO_BYTES <= WS_W && WS_W + 2 * W_LAYER <= WS_HB && WS_HB + (size_t)MROWS * 1024 * 2 <= WS_BIG && WS_P + (size_t)MROWS * 2048 * 2 <= WS_YCAT && WS_YCAT + (size_t)MROWS * 1024 * 2 <= WS_YG
              && WS_YG + (size_t)MROWS * 512 * 2 <= WS_BIG + (size_t)MROWS * 4096 * 2 && WS_BIG + (size_t)MROWS * 4096 * 2 <= WS_END, "d_ws map");
constexpr int CW_TMO = 0, CW_CODE = 1;
constexpr int CW_BAR = 4096;
constexpr int CW_WMAX1 = 65536 + 2048;
constexpr int CW_WMAX = 65536;
constexpr int CW_SF = 120000;
constexpr int CW_Q = 16384;

constexpr int RING_OFF = 0, RING_BYTES = 131072;
constexpr int LDSCTL_OFF = RING_BYTES, MISC_OFF = LDSCTL_OFF + 320;
constexpr int LDS_BYTES = 147456;

#define GAS __attribute__((address_space(1)))
#define LAS __attribute__((address_space(3)))
typedef unsigned short bf16;
typedef unsigned v4u __attribute__((ext_vector_type(4)));
typedef float f32x4 __attribute__((ext_vector_type(4)));
typedef GAS unsigned gu32;
#define RLX_AGENT __ATOMIC_RELAXED, __HIP_MEMORY_SCOPE_AGENT
#define LDS_WAIT() asm volatile("s_waitcnt lgkmcnt(0)" ::: "memory")
#define VM_WAIT() asm volatile("s_waitcnt vmcnt(0)" ::: "memory")
__device__ __forceinline__ unsigned f2bf(float f) { unsigned u = __builtin_bit_cast(unsigned, f); return (u + 0x7fffu + ((u >> 16) & 1u)) >> 16; }
__device__ __forceinline__ unsigned pk2(float lo, float hi) { return f2bf(lo) | (f2bf(hi) << 16); }
__device__ __forceinline__ float bf2f(bf16 v) { return __uint_as_float((unsigned)v << 16); }
__device__ __forceinline__ float bflo(unsigned w) { return __uint_as_float(w << 16); }
__device__ __forceinline__ float bfhi(unsigned w) { return __uint_as_float(w & 0xffff0000u); }

__device__ __forceinline__ int lane_id() { int l; asm volatile("v_mbcnt_lo_u32_b32 %0, -1, 0\n\tv_mbcnt_hi_u32_b32 %0, -1, %0" : "=v"(l)); return l; }
#define XB_TMO      128
#define XB_XCNT(j)  (256  + 64 * (j))
#define XB_XSUB(j)  (1280 + 64 * (j))
#define XB_XGEN(j)  (2304 + 64 * (j))
#define XB_TOP      3328
#define XB_TOPGEN   3392
#define XCD_BAR_WORDS 3456
#define XB_SPIN_CAP (1u << 21)

__device__ __forceinline__ unsigned xb_ld(unsigned* p)              { return __hip_atomic_load(p, __ATOMIC_RELAXED, __HIP_MEMORY_SCOPE_AGENT); }
__device__ __forceinline__ unsigned xb_add(unsigned* p, unsigned v) { return __hip_atomic_fetch_add(p, v, __ATOMIC_RELAXED, __HIP_MEMORY_SCOPE_AGENT); }
__device__ __forceinline__ unsigned xb_xcc_id() { return (unsigned)__builtin_amdgcn_s_getreg((3 << 11) | 20) & 0xFu; }
#define XB_SPIN(cond, bar) do { unsigned _sp = 0; while (cond) { __builtin_amdgcn_s_sleep(1); \
    if ((++_sp & 255u) == 0u) { if (xb_ld(&(bar)[XB_TMO])) break; if (_sp > XB_SPIN_CAP) { atomicAdd(&(bar)[XB_TMO], 1u); break; } } } } while (0)

struct XcdBarrier { unsigned* bar; unsigned x; volatile LAS unsigned* st; };
__device__ __forceinline__ XcdBarrier xcd_barrier_post(unsigned* bar, volatile LAS unsigned* st, int wave) {
    XcdBarrier b; b.bar = bar; b.x = xb_xcc_id(); b.st = st;
    if (wave == 0 && lane_id() == 0) (void)xb_add(&bar[XB_XCNT(b.x)], 1u);
    return b;
}
__device__ __forceinline__ void xcd_barrier_complete(unsigned* bar, unsigned x, unsigned& nloc, unsigned& nx) {
    const unsigned G = gridDim.x * gridDim.y * gridDim.z;
    unsigned sum, cnt, mine, sp = 0u;
    for (;;) {
        sum = 0u; cnt = 0u; mine = 0u;
#pragma unroll
        for (unsigned j = 0; j < 16; ++j) { const unsigned c = xb_ld(&bar[XB_XCNT(j)]); sum += c; cnt += (c > 0u) ? 1u : 0u; mine = (j == x) ? c : mine; }
        if (sum == G) break;
        __builtin_amdgcn_s_sleep(1);
        if ((++sp & 255u) == 0u) { if (xb_ld(&bar[XB_TMO])) break; if (sp > XB_SPIN_CAP) { atomicAdd(&bar[XB_TMO], 1u); break; } }
    }
    nloc = mine > 0u ? mine : 1u; nx = cnt > 0u ? cnt : 1u;
}
__device__ __forceinline__ void xcd_barrier(const XcdBarrier& b, int wave) {
    asm volatile("s_waitcnt vmcnt(0)" ::: "memory");
    __syncthreads();
    if (wave == 0 && lane_id() == 0) {
        unsigned* bar = b.bar;
        __builtin_amdgcn_s_waitcnt(0);
        unsigned nloc = b.st[0], nx = b.st[1];
        if (nloc == 0u) { xcd_barrier_complete(bar, b.x, nloc, nx); b.st[0] = nloc; b.st[1] = nx; }
        const unsigned old = xb_add(&bar[XB_XSUB(b.x)], 1u);
        const unsigned gen = old / nloc;
        if (old + 1u == (gen + 1u) * nloc) {
            __builtin_amdgcn_fence(__ATOMIC_RELEASE, "agent");
            asm volatile("s_waitcnt vmcnt(0)" ::: "memory");
            const unsigned og = xb_add(&bar[XB_TOP], 1u);
            const unsigned tg = og / nx;
            if (og + 1u == (tg + 1u) * nx) xb_add(&bar[XB_TOPGEN], 1u);
            else XB_SPIN(xb_ld(&bar[XB_TOPGEN]) == tg, bar);
            __builtin_amdgcn_fence(__ATOMIC_ACQUIRE, "agent");
            xb_add(&bar[XB_XGEN(b.x)], 1u);
            asm volatile("s_waitcnt vmcnt(0)" ::: "memory");
        } else {
            XB_SPIN(xb_ld(&bar[XB_XGEN(b.x)]) == gen, bar);
            __builtin_amdgcn_fence(__ATOMIC_ACQUIRE, "agent");
            asm volatile("s_waitcnt vmcnt(0)" ::: "memory");
        }
    }
    __syncthreads();
}


struct Args { const float* in[25]; float* out; unsigned char* ws; int ph_lo, ph_hi; };
struct Frame {
    LAS unsigned char* lds;
    volatile LAS unsigned* MISC;
    gu32* ctl;
    int wave;
    int vcu, G;
    float* out; unsigned char* ws;
};
using pg8::stat_t; using pg8::stat_get;
__device__ __forceinline__ stat_t* stat_ptr(Frame& F, int l, int id) { return (stat_t*)(F.ws + WS_STATS) + (size_t)(l * ST_PER_LAYER + id) * STAT_STRIDE; }
__device__ __forceinline__ bf16* wptr(Frame& F, int l, size_t off) { return (bf16*)(F.ws + WS_W + (size_t)l * W_LAYER + off); }
__device__ __forceinline__ float wave_sum(float v) {
#pragma unroll
    for (int o = 1; o < 64; o <<= 1) v += __shfl_xor(v, o);
    return v;
}
__device__ __forceinline__ float wave_max(float v) {
#pragma unroll
    for (int o = 1; o < 64; o <<= 1) v = fmaxf(v, __shfl_xor(v, o));
    return v;
}
__device__ __forceinline__ int key_row(int b, int kp) { return kp < NMETA ? MREAL + kp : b * SEQ + (kp - NMETA); }

__device__ __forceinline__ int win_srccol(int n) {
    if (n < 384) return n;
    if (n < 448) return 640 + (n - 384);
    if (n < 452) return 704 + (n - 448);
    if (n < 512) return -1;
    if (n < 768) return 384 + (n - 512);
    if (n < 1280) return 708 + (n - 768);
    return 1220 + (n - 1280);
}
__device__ __forceinline__ void p0_transpose_item(const Args& A, Frame& F, int l, int mat, int item, LAS float* scr) {
    const int lane = lane_id();
    int N, K, ldw; const float* W; bf16* WT;
    if (mat == 0) { N = 2048; K = 1024; ldw = NIN_SRC; W = A.in[4] + (size_t)l * 1024 * NIN_SRC; WT = wptr(F, l, WO_IN); }
    else if (mat == 1) { N = 512; K = 512; ldw = 512; W = A.in[16] + (size_t)l * 512 * 512; WT = wptr(F, l, WO_GLU); }
    else if (mat == 2) { N = 1024; K = 1024; ldw = 1024; W = A.in[20] + (size_t)l * 1024 * 1024; WT = wptr(F, l, WO_OUT); }
    else if (mat == 3) { N = 4096; K = 1024; ldw = 4096; W = A.in[22] + (size_t)l * 1024 * 4096; WT = wptr(F, l, WO_1); }
    else { N = 1024; K = 4096; ldw = 1024; W = A.in[23] + (size_t)l * 4096 * 1024; WT = wptr(F, l, WO_2); }
    if (mat == 3) {
        const int nblk = N / 32, kb = item / nblk, nb = item % nblk, k0 = 64 * kb, n0 = 32 * nb, kr = lane >> 3, c4 = lane & 7; float m[4] = {0.f, 0.f, 0.f, 0.f};
#pragma unroll
        for (int i = 0; i < 8; ++i) { const int kk = k0 + 8 * i + kr; const pg8::f32x4 v = *(const GAS pg8::f32x4*)(W + (size_t)kk * ldw + n0 + 4 * c4); const float g = A.in[21][l * 1024 + kk];
#pragma unroll
            for (int e_ = 0; e_ < 4; ++e_) m[e_] = fmaxf(m[e_], fabsf(v[e_] * g)); }
#pragma unroll
        for (int e_ = 0; e_ < 4; ++e_) { m[e_] = fmaxf(m[e_], __shfl_xor(m[e_], 8)); m[e_] = fmaxf(m[e_], __shfl_xor(m[e_], 16)); m[e_] = fmaxf(m[e_], __shfl_xor(m[e_], 32)); }
        if (lane < 8) {
#pragma unroll
            for (int e_ = 0; e_ < 4; ++e_) atomicMax((unsigned*)(F.ctl + CW_WMAX1 + l * 4096 + n0 + 4 * c4 + e_), __float_as_uint(m[e_])); }
        return; }
    if (mat == 4) {
        const int nblk = N / 32, kb = item / nblk, nb = item % nblk, k0 = 64 * kb, n0 = 32 * nb, kr = lane >> 3, c4 = lane & 7; float m[4] = {0.f, 0.f, 0.f, 0.f};
#pragma unroll
        for (int i = 0; i < 8; ++i) { const pg8::f32x4 v = *(const GAS pg8::f32x4*)(W + (size_t)(k0 + 8 * i + kr) * ldw + n0 + 4 * c4);
#pragma unroll
            for (int e_ = 0; e_ < 4; ++e_) m[e_] = fmaxf(m[e_], fabsf(v[e_])); }
#pragma unroll
        for (int e_ = 0; e_ < 4; ++e_) { m[e_] = fmaxf(m[e_], __shfl_xor(m[e_], 8)); m[e_] = fmaxf(m[e_], __shfl_xor(m[e_], 16)); m[e_] = fmaxf(m[e_], __shfl_xor(m[e_], 32)); }
        if (lane < 8) {
#pragma unroll
            for (int e_ = 0; e_ < 4; ++e_) atomicMax((unsigned*)(F.ctl + CW_WMAX + l * 1024 + n0 + 4 * c4 + e_), __float_as_uint(m[e_])); }
        return; }
    const int nblk = N / 32, kb = item / nblk, nb = item % nblk, k0 = 64 * kb, n0 = 32 * nb;
    const int kr = lane >> 3, c4 = lane & 7, n = n0 + 4 * c4;
    int sc = n; float cs = 1.f;
    if (mat == 0) { sc = win_srccol(n); if (n >= PC_QC && n < PC_KC) cs = 0.125f; }
#pragma unroll
    for (int i = 0; i < 8; ++i) { const int kk = 8 * i + kr, k = k0 + kk; int ks = k; float g = 1.f;
        if (mat == 0) g = A.in[3][l * 1024 + k];
        else if (mat == 2) { if (k < 512) { ks = 256 + k; g = A.in[18][l * 512 + k]; } else if (k < 768) { ks = k - 512; g = A.in[17][l * 256 + (k - 512)]; } else { ks = k; g = A.in[19][l * 256 + (k - 768)]; } }
        pg8::f32x4 v = (pg8::f32x4){0.f, 0.f, 0.f, 0.f}; if (sc >= 0) v = *(const GAS pg8::f32x4*)(W + (size_t)ks * ldw + sc);
        g *= cs;
#pragma unroll
        for (int e_ = 0; e_ < 4; ++e_) scr[kk * 33 + 4 * c4 + e_] = v[e_] * g; }
    LDS_WAIT(); asm volatile("" ::: "memory");
    const int c = lane & 7;
#pragma unroll
    for (int j = 0; j < 4; ++j) { const int nn = (lane >> 3) + 8 * j; const LAS float* s = scr + (8 * c) * 33 + nn;
        v4u o; o.x = pk2(s[0 * 33], s[1 * 33]); o.y = pk2(s[2 * 33], s[3 * 33]); o.z = pk2(s[4 * 33], s[5 * 33]); o.w = pk2(s[6 * 33], s[7 * 33]);
        *(GAS v4u*)(WT + (size_t)(n0 + nn) * K + k0 + 8 * c) = o; }
    LDS_WAIT(); asm volatile("" ::: "memory");
}
__device__ __forceinline__ void s5_build_item(const Args& A, Frame& F, int l, int kind, int g, int x, LAS float* scr);
__device__ __forceinline__ void p0_prologue(const Args& A, Frame& F) {
    const int lane = lane_id();
    LAS float* scr = (LAS float*)(F.lds + RING_OFF + F.wave * 16384);
    const int gw = F.vcu * NWAVES + F.wave, NGW = F.G * NWAVES;
    constexpr int I0 = 16 * 64, I1 = 8 * 16, I2 = 16 * 32, I3 = 16 * 128, I4 = 64 * 32, IL = I0 + I1 + I2 + I3 + I4;
    for (int it = gw; it < DEPTH * IL; it += NGW) {
        const int l = it / IL; int r = it % IL;
        if (r < I0) { p0_transpose_item(A, F, l, 0, r, scr); continue; } r -= I0;
        if (r < I1) { p0_transpose_item(A, F, l, 1, r, scr); continue; } r -= I1;
        if (r < I2) { p0_transpose_item(A, F, l, 2, r, scr); continue; } r -= I2;
        if (r < I3) { p0_transpose_item(A, F, l, 3, r, scr); continue; } r -= I3;
        p0_transpose_item(A, F, l, 4, r, scr);
    }
    for (int it = gw; it < DEPTH * 3 * 1024; it += NGW) { const int l = it / 3072, r = it % 3072; s5_build_item(A, F, l, r >> 10, (r >> 5) & 31, r & 31, scr); }
    for (int it = gw; it < DEPTH * 4 * 16 * 2; it += NGW) { const int tb_ = it & 1, fr_ = (it >> 1) & 15, h_ = (it >> 5) & 3, l_ = it >> 7; const int r32_ = lane & 31, hi_ = lane >> 5;
        const float* wuk_ = A.in[6] + (size_t)l_ * 128 * 256; const float* wuv_ = A.in[7] + (size_t)l_ * 128 * 256; const float* kvg_ = A.in[5] + l_ * 128;
        float v_[8];
        if (tb_ == 0) { const int c_ = fr_ >> 2, ks_ = fr_ & 3, rank_ = 32 * c_ + r32_; const float sc_ = kvg_[rank_] * 0.125f;
#pragma unroll
            for (int e_ = 0; e_ < 8; ++e_) v_[e_] = wuk_[((size_t)rank_ * 4 + h_) * 64 + ks_ * 16 + hi_ * 8 + e_] * sc_; }
        else { const int c_ = fr_ >> 2, s_ = (fr_ >> 1) & 1, db_ = fr_ & 1, d_ = 32 * db_ + r32_;
#pragma unroll
            for (int j_ = 0; j_ < 8; ++j_) { const int rk_ = 32 * c_ + 16 * s_ + 8 * (j_ >> 2) + 4 * hi_ + (j_ & 3); v_[j_] = wuv_[((size_t)rk_ * 4 + h_) * 64 + d_] * kvg_[rk_]; } }
        v4u o_; o_.x = pk2(v_[0], v_[1]); o_.y = pk2(v_[2], v_[3]); o_.z = pk2(v_[4], v_[5]); o_.w = pk2(v_[6], v_[7]);
        *((GAS v4u*)(F.ws + (tb_ == 0 ? WS_WUKF : WS_WUVF)) + ((size_t)(l_ * 4 + h_) * 16 + fr_) * 64 + lane) = o_; }
    bf16* Hb = (bf16*)(F.ws + WS_HB); stat_t* ss = stat_ptr(F, 0, ST_SS1);
    for (int m0 = gw * 4; m0 < MVALID; m0 += NGW * 4) {
        f32x4 v[4][4];
#pragma unroll
        for (int q = 0; q < 4; ++q) { const int m = m0 + q < MVALID ? m0 + q : MVALID - 1;
            const float* src = m < MREAL ? A.in[0] + (size_t)m * DM : A.in[1] + (size_t)(m - MREAL) * DM; const GAS f32x4* xr = (const GAS f32x4*)src + 2 * lane;
#pragma unroll
            for (int j = 0; j < 4; ++j) v[q][j] = xr[(j >> 1) * 128 + (j & 1)]; }
#pragma unroll
        for (int q = 0; q < 4; ++q) { const int m = m0 + q; if (m < MVALID) {
            GAS v4u* o16 = (GAS v4u*)(Hb + (size_t)m * DM) + lane; float s = 0.f;
#pragma unroll
            for (int jh = 0; jh < 2; ++jh) { v4u o;
#pragma unroll
                for (int i = 0; i < 2; ++i) { const f32x4 vv = v[q][2 * jh + i]; const unsigned w0 = pk2(vv.x, vv.y), w1 = pk2(vv.z, vv.w); o[2 * i] = w0; o[2 * i + 1] = w1;
                    s += (bflo(w0) * bflo(w0) + bfhi(w0) * bfhi(w0)) + (bflo(w1) * bflo(w1) + bfhi(w1) * bfhi(w1)); }
                o16[64 * jh] = o; }
            s = wave_sum(s); if (lane == 0) ss[m] = (stat_t)((double)s * 4294967296.0); } }
    }
}

__device__ __forceinline__ float log_sigmoid_f(float x) { return fminf(x, 0.f) - log1pf(__expf(-fabsf(x))); }
__device__ __forceinline__ float gelu_tanh_f(float x) { const float u = 0.7978845608028654f * (x + 0.044715f * x * x * x); return 0.5f * x * (1.0f + tanhf(u)); }
__device__ __forceinline__ unsigned mono_key(float f) { const unsigned u = __float_as_uint(f); return (u & 0x80000000u) ? ~u : (u | 0x80000000u); }
__device__ __forceinline__ int t5_bucket(int d) {
    if (d < 16) return d;
    const int v = 16 + (int)(logf((float)d / 16.0f) / 2.0794415416798357f * 16.0f);
    return v < 31 ? v : 31;
}

__device__ __forceinline__ void s5_naive_item(const Args& A, Frame& F, int l, int b, int g) {
    const int p = lane_id();
    const bf16* P = (const bf16*)(F.ws + WS_P); bf16* YG = (bf16*)(F.ws + WS_YG);
    const int lg = l * 32 + g;
    const float dt = expf(A.in[10][lg]), lr = A.in[8][lg * 64 + p], li = A.in[9][lg * 64 + p];
    const float mag = expf(lr * dt), ar = mag * cosf(li * dt), ai = mag * sinf(li * dt);
    const float den = lr * lr + li * li, nr = ar - 1.0f, ni = ai;
    const float fr_ = (nr * lr + ni * li) / den, fi_ = (ni * lr - nr * li) / den;
    float Br[16], Bi[16], Cr[16], Ci[16];
#pragma unroll
    for (int c = 0; c < 16; ++c) { const float br = A.in[11][((size_t)lg * 64 + p) * 16 + c], bi = A.in[12][((size_t)lg * 64 + p) * 16 + c];
        Br[c] = fr_ * br - fi_ * bi; Bi[c] = fr_ * bi + fi_ * br;
        Cr[c] = A.in[13][((size_t)lg * 16 + c) * 64 + p]; Ci[c] = A.in[14][((size_t)lg * 16 + c) * 64 + p]; }
    const int myc = ((p >> 5) & 1) * 8 + ((p >> 4) & 1) * 4 + ((p >> 3) & 1) * 2 + ((p >> 2) & 1);
    const float dsk = A.in[15][l * 512 + g * 16 + myc];
    float hr = 0.f, hi = 0.f;
    for (int kp = 0; kp < NMETA; ++kp) {
        const int row = key_row(b, kp);
        const v4u uw = *(const GAS v4u*)(P + (size_t)row * NIN + PC_UB + g * 16 + (p & 1) * 8);
        float u[16];
#pragma unroll
        for (int j = 0; j < 4; ++j) { const unsigned w0 = __builtin_amdgcn_readlane(uw[j], 0), w1 = __builtin_amdgcn_readlane(uw[j], 1);
            u[2 * j] = bflo(w0); u[2 * j + 1] = bfhi(w0); u[8 + 2 * j] = bflo(w1); u[8 + 2 * j + 1] = bfhi(w1); }
        float bur = 0.f, bui = 0.f;
#pragma unroll
        for (int c = 0; c < 16; ++c) { bur += Br[c] * u[c]; bui += Bi[c] * u[c]; }
        const float nhr = ar * hr - ai * hi + bur, nhi = ar * hi + ai * hr + bui; hr = nhr; hi = nhi;
        float v[16];
#pragma unroll
        for (int c = 0; c < 16; ++c) v[c] = Cr[c] * hr - Ci[c] * hi;
#pragma unroll
        for (int i = 0; i < 8; ++i) { const float send = (p & 32) ? v[i] : v[i + 8]; const float keep = (p & 32) ? v[i + 8] : v[i]; v[i] = keep + __shfl_xor(send, 32); }
#pragma unroll
        for (int i = 0; i < 4; ++i) { const float send = (p & 16) ? v[i] : v[i + 4]; const float keep = (p & 16) ? v[i + 4] : v[i]; v[i] = keep + __shfl_xor(send, 16); }
#pragma unroll
        for (int i = 0; i < 2; ++i) { const float send = (p & 8) ? v[i] : v[i + 2]; const float keep = (p & 8) ? v[i + 2] : v[i]; v[i] = keep + __shfl_xor(send, 8); }
        { const float send = (p & 4) ? v[0] : v[1]; const float keep = (p & 4) ? v[1] : v[0]; v[0] = keep + __shfl_xor(send, 4); }
        float y = v[0]; y += __shfl_xor(y, 1); y += __shfl_xor(y, 2);
        float um = u[0];
#pragma unroll
        for (int c = 1; c < 16; ++c) um = (myc == c) ? u[c] : um;
        y = gelu_tanh_f(y + dsk * um);
        if ((p & 3) == 0 && (b == 0 || kp >= NMETA)) YG[(size_t)row * 512 + g * 16 + myc] = (bf16)f2bf(y);
    }
}

__device__ __forceinline__ void dsa_naive_item(const Args& A, Frame& F, int l, int qi, LAS float* wl) {
    const int lane = lane_id();
    const bf16* P = (const bf16*)(F.ws + WS_P); bf16* Ycat = (bf16*)(F.ws + WS_YCAT);
    const stat_t* sskv = stat_ptr(F, l, ST_SSKV);
    LAS float* sc = wl;
    LAS unsigned* hist = (LAS unsigned*)(wl + 2080);
    LAS float* ql = wl + 2336;
    LAS float* qv = wl + 2848;
    LAS int* sel = (LAS int*)(wl + 3104);
    LAS float* ol = wl + 3360;
    int b, n, row;
    if (qi < MREAL) { b = qi >> 11; n = (qi & 2047) + NMETA + 1; row = qi; } else { b = 0; n = (qi - MREAL) + 1; row = qi; }
    const bf16* Pq = P + (size_t)row * NIN;
    LDS_WAIT(); asm volatile("" ::: "memory");
#pragma unroll
    for (int j = 0; j < 4; ++j) qv[lane + 64 * j] = bf2f(Pq[PC_IQ + lane + 64 * j]);
    float iw[4];
#pragma unroll
    for (int h = 0; h < 4; ++h) iw[h] = bf2f(Pq[PC_IW + h]);
    LDS_WAIT(); asm volatile("" ::: "memory");
#pragma unroll 1
    for (int kp = lane; kp < n; kp += 64) {
        const int krow = key_row(b, kp); const GAS v4u* ikp = (const GAS v4u*)(P + (size_t)krow * NIN + PC_IK);
        float d0 = 0.f, d1 = 0.f, d2 = 0.f, d3 = 0.f;
#pragma unroll 2
        for (int c = 0; c < 8; ++c) { const v4u w = ikp[c]; const float k8[8] = {bflo(w.x), bfhi(w.x), bflo(w.y), bfhi(w.y), bflo(w.z), bfhi(w.z), bflo(w.w), bfhi(w.w)};
#pragma unroll
            for (int j = 0; j < 8; ++j) { const float kk = k8[j]; d0 += qv[c * 8 + j] * kk; d1 += qv[64 + c * 8 + j] * kk; d2 += qv[128 + c * 8 + j] * kk; d3 += qv[192 + c * 8 + j] * kk; } }
        float s = iw[0] * fmaxf(d0, 0.f) + iw[1] * fmaxf(d1, 0.f) + iw[2] * fmaxf(d2, 0.f) + iw[3] * fmaxf(d3, 0.f);
        s += 0.0f;
        sc[kp] = s;
    }
    LDS_WAIT(); asm volatile("" ::: "memory");
    const int keff = n < TOPK ? n : TOPK;
    unsigned prefix = 0u; int krem = keff;
#pragma unroll 1
    for (int pass = 0; pass < 4; ++pass) {
        const int shift = 24 - 8 * pass;
#pragma unroll
        for (int j = 0; j < 4; ++j) hist[lane * 4 + j] = 0u;
        LDS_WAIT(); asm volatile("" ::: "memory");
        for (int kp = lane; kp < n; kp += 64) { const unsigned key = mono_key(sc[kp]);
            const bool match = (pass == 0) || ((key >> (shift + 8)) == (prefix >> (shift + 8)));
            if (match) __hip_atomic_fetch_add(&hist[(key >> shift) & 255u], 1u, __ATOMIC_RELAXED, __HIP_MEMORY_SCOPE_WORKGROUP); }
        LDS_WAIT(); asm volatile("" ::: "memory");
        const int c0 = (int)hist[lane * 4 + 0], c1 = (int)hist[lane * 4 + 1], c2 = (int)hist[lane * 4 + 2], c3 = (int)hist[lane * 4 + 3];
        const int tot = c0 + c1 + c2 + c3; int S = tot;
#pragma unroll
        for (int off = 1; off < 64; off <<= 1) { const int t = __shfl_down(S, off); if (lane + off < 64) S += t; }
        const int above = S - tot;
        const bool here = (above < krem) && (S >= krem);
        int bin = 0, newk = 0;
        if (here) { int a = above;
            if (a + c3 >= krem) { bin = 3; newk = krem - a; } else { a += c3;
            if (a + c2 >= krem) { bin = 2; newk = krem - a; } else { a += c2;
            if (a + c1 >= krem) { bin = 1; newk = krem - a; } else { a += c1; bin = 0; newk = krem - a; } } }
            bin += 4 * lane; }
        const unsigned long long mm = __ballot(here); const int src = mm ? (__ffsll((long long)mm) - 1) : 0;
        bin = __shfl(bin, src); krem = __shfl(newk, src);
        prefix |= (unsigned)bin << shift;
        LDS_WAIT(); asm volatile("" ::: "memory");
    }
    const unsigned T = prefix; const int rneed = krem;
    int selbase = 0, eqbase = 0;
    for (int k0 = 0; k0 < n; k0 += 64) { const int kp = k0 + lane; const bool valid = kp < n;
        const unsigned key = valid ? mono_key(sc[valid ? kp : 0]) : 0u;
        const bool gt = valid && key > T, eq = valid && key == T;
        const unsigned long long eqm = __ballot(eq); const unsigned long long lt = (1ull << lane) - 1ull;
        const int eqr = eqbase + __popcll(eqm & lt);
        const bool s = gt || (eq && eqr < rneed);
        const unsigned long long sm = __ballot(s);
        if (s) sel[selbase + __popcll(sm & lt)] = kp;
        selbase += __popcll(sm); eqbase += __popcll(eqm); }
    LDS_WAIT(); asm volatile("" ::: "memory");
#pragma unroll
    for (int j = 0; j < 4; ++j) qv[lane + 64 * j] = bf2f(Pq[PC_QA + lane + 64 * j]);
    LDS_WAIT(); asm volatile("" ::: "memory");
    const float* wuk = A.in[6] + (size_t)l * 128 * 256; const float* wuv = A.in[7] + (size_t)l * 128 * 256; const float* kvg = A.in[5] + l * 128;
#pragma unroll 1
    for (int h = 0; h < 4; ++h)
#pragma unroll 1
        for (int rr = 0; rr < 2; ++rr) { const int r = lane + 64 * rr; const GAS f32x4* wp = (const GAS f32x4*)(wuk + ((size_t)r * 4 + h) * 64); float a = 0.f;
#pragma unroll
            for (int d4 = 0; d4 < 16; ++d4) { const f32x4 w = wp[d4]; a += qv[h * 64 + d4 * 4] * w.x + qv[h * 64 + d4 * 4 + 1] * w.y + qv[h * 64 + d4 * 4 + 2] * w.z + qv[h * 64 + d4 * 4 + 3] * w.w; }
            ql[h * 128 + r] = a * kvg[r] * 0.125f; }
    LDS_WAIT(); asm volatile("" ::: "memory");
    float ya[4];
#pragma unroll 1
    for (int h = 0; h < 4; ++h) {
        float mx = -3.0e38f;
#pragma unroll 1
        for (int j = 0; j < 4; ++j) { const int i = lane + 64 * j;
            if (i < keff) { const int kp = sel[i]; const int krow = key_row(b, kp); const GAS v4u* cp = (const GAS v4u*)(P + (size_t)krow * NIN + PC_CKV); float d = 0.f;
#pragma unroll 4
                for (int c = 0; c < 16; ++c) { const v4u w = cp[c]; const LAS float* q8 = ql + h * 128 + c * 8;
                    d += q8[0] * bflo(w.x) + q8[1] * bfhi(w.x) + q8[2] * bflo(w.y) + q8[3] * bfhi(w.y) + q8[4] * bflo(w.z) + q8[5] * bfhi(w.z) + q8[6] * bflo(w.w) + q8[7] * bfhi(w.w); }
                const float rkv = rsqrtf(stat_get(sskv + krow) * (1.0f / 128.0f) + pg8::RMS_EPS);
                const float lgv = d * rkv + A.in[2][t5_bucket((n - 1) - kp) * 4 + h];
                sc[i] = lgv; sc[256 + i] = rkv; mx = fmaxf(mx, lgv); } }
        mx = wave_max(mx); float sum = 0.f;
        LDS_WAIT(); asm volatile("" ::: "memory");
#pragma unroll 1
        for (int j = 0; j < 4; ++j) { const int i = lane + 64 * j; if (i < keff) { const float e = __expf(sc[i] - mx); sc[i] = e; sum += e; } }
        sum = wave_sum(sum); const float inv = 1.0f / sum;
        LDS_WAIT(); asm volatile("" ::: "memory");
#pragma unroll 1
        for (int j = 0; j < 4; ++j) { const int i = lane + 64 * j; if (i < keff) qv[i] = sc[i] * inv * sc[256 + i]; }
        LDS_WAIT(); asm volatile("" ::: "memory");
        float o0 = 0.f, o1 = 0.f;
#pragma unroll 4
        for (int i = 0; i < keff; ++i) { const int krow = key_row(b, sel[i]); const float pw = qv[i]; const bf16* cp = P + (size_t)krow * NIN + PC_CKV;
            o0 += pw * bf2f(cp[lane]); o1 += pw * bf2f(cp[lane + 64]); }
        ol[lane] = o0 * kvg[lane]; ol[lane + 64] = o1 * kvg[lane + 64];
        LDS_WAIT(); asm volatile("" ::: "memory");
        float a = 0.f;
#pragma unroll 8
        for (int r = 0; r < 128; ++r) a += ol[r] * wuv[((size_t)r * 4 + h) * 64 + lane];
        ya[h] = a;
        LDS_WAIT(); asm volatile("" ::: "memory");
    }
    float ssq = 0.f;
#pragma unroll
    for (int h = 0; h < 4; ++h) { const unsigned w = f2bf(ya[h]); Ycat[(size_t)row * 1024 + YC_A + h * 64 + lane] = (bf16)w; const float v = __uint_as_float(w << 16); ssq += v * v; }
    ssq = wave_sum(ssq); if (lane == 0) pg8::stat_add(stat_ptr(F, l, ST_SSA) + row, ssq);
}

__device__ __forceinline__ void sb_naive_item(const Args& A, Frame& F, int l, int qi, LAS float* wl) {
    const int lane = lane_id();
    const bf16* P = (const bf16*)(F.ws + WS_P); bf16* Ycat = (bf16*)(F.ws + WS_YCAT);
    LAS float* qs = wl;
    LAS float* wbuf = wl + 64;
    LAS int* rbuf = (LAS int*)(wl + 128);
    int b, n, row;
    if (qi < MREAL) { b = qi >> 11; n = (qi & 2047) + NMETA; row = qi; } else { b = 0; n = qi - MREAL; row = qi; }
    const bf16* Pq = P + (size_t)row * NIN;
    float yc[4];
#pragma unroll 1
    for (int h = 0; h < 4; ++h) {
        LDS_WAIT(); asm volatile("" ::: "memory");
        qs[lane] = bf2f(Pq[PC_QC + h * 64 + lane]);
        LDS_WAIT(); asm volatile("" ::: "memory");
        float carry = 0.f, acc = 0.f;
        for (int top = n - 1; top >= 0; top -= 64) {
            const int kp = top - lane; const bool valid = kp >= 0; const int krow = key_row(b, valid ? kp : 0);
            const GAS v4u* kpn = (const GAS v4u*)(P + (size_t)krow * NIN + PC_KC + h * 64); float z = 0.f;
#pragma unroll
            for (int c = 0; c < 8; ++c) { const v4u w = kpn[c]; const LAS float* q8 = qs + c * 8;
                z += q8[0] * bflo(w.x) + q8[1] * bfhi(w.x) + q8[2] * bflo(w.y) + q8[3] * bfhi(w.y) + q8[4] * bflo(w.z) + q8[5] * bfhi(w.z) + q8[6] * bflo(w.w) + q8[7] * bfhi(w.w); }
            const float lk = valid ? log_sigmoid_f(-z) : 0.f;
            float incl = lk;
#pragma unroll
            for (int off = 1; off < 64; off <<= 1) { const float t = __shfl_up(incl, off); if (lane >= off) incl += t; }
            const float later = carry + incl - lk;
            const float w = valid ? __expf(log_sigmoid_f(z) + later) : 0.f;
            carry += __shfl(incl, 63);
            LDS_WAIT(); asm volatile("" ::: "memory");
            wbuf[lane] = w; rbuf[lane] = krow;
            LDS_WAIT(); asm volatile("" ::: "memory");
            const int cnt = top + 1 < 64 ? top + 1 : 64;
            for (int j = 0; j < cnt; ++j) acc += wbuf[j] * bf2f(P[(size_t)rbuf[j] * NIN + PC_VC + h * 64 + lane]);
        }
        yc[h] = acc;
    }
    float ssq = 0.f;
#pragma unroll
    for (int h = 0; h < 4; ++h) { const unsigned w = f2bf(yc[h]); Ycat[(size_t)row * 1024 + YC_C + h * 64 + lane] = (bf16)w; const float v = __uint_as_float(w << 16); ssq += v * v; }
    ssq = wave_sum(ssq); if (lane == 0) pg8::stat_add(stat_ptr(F, l, ST_SSC) + row, ssq);
}


typedef short bf16x8_t __attribute__((ext_vector_type(8)));
typedef short s16x4_t __attribute__((ext_vector_type(4)));
typedef float f32x16_t __attribute__((ext_vector_type(16)));
typedef float f32x2_t __attribute__((ext_vector_type(2)));
typedef __bf16 bf16x2_t __attribute__((ext_vector_type(2)));
typedef short v4i16_t __attribute__((ext_vector_type(4)));
typedef __attribute__((address_space(3))) const char* lds_cptr;
__device__ __forceinline__ s16x4_t vtr(lds_cptr p) { return __builtin_bit_cast(s16x4_t, __builtin_amdgcn_ds_read_tr16_b64_v4i16((__attribute__((address_space(3))) v4i16_t*)p)); }
__device__ __forceinline__ unsigned cvtpk(float lo, float hi) { f32x2_t v = {lo, hi}; bf16x2_t b = __builtin_convertvector(v, bf16x2_t); return __builtin_bit_cast(unsigned, b); }
__device__ __forceinline__ int crow(int r, int hi) { return (r & 3) + 8 * (r >> 2) + 4 * hi; }
__device__ __forceinline__ float relu_bits(float x) { const int i = (int)__float_as_uint(x); return __uint_as_float((unsigned)(i > 0 ? i : 0)); }
#define MFMA32(a, b, c) __builtin_amdgcn_mfma_f32_32x32x16_bf16((a), (b), (c), 0, 0, 0)

__device__ __forceinline__ void sb_mfma_unit(const Args& A, Frame& F, int l, int unit, LAS unsigned char* wl) {
    const int lane = lane_id(), r32 = lane & 31, hi = lane >> 5;
    const int qt = unit & 63, h = (unit >> 6) & 3, b = unit >> 8;
    const bf16* P = (const bf16*)(F.ws + WS_P); bf16* Ycat = (bf16*)(F.ws + WS_YCAT); stat_t* ssc = stat_ptr(F, l, ST_SSC);
    const int qrow0 = b * SEQ + 32 * qt;
    bf16x8_t qr[4];
#pragma unroll
    for (int ks = 0; ks < 4; ++ks) qr[ks] = *(const GAS bf16x8_t*)(P + (size_t)(qrow0 + r32) * NIN + PC_QC + h * 64 + ks * 16 + hi * 8);
    f32x16_t o0, o1;
#pragma unroll
    for (int r = 0; r < 16; ++r) { o0[r] = 0.f; o1[r] = 0.f; }
    float carry = 0.f;
    const int jt = qt >> 1;
    const lds_cptr vp = (lds_cptr)wl + ((lane >> 4) & 1) * 32 + (lane & 3) * 8 + (4 * hi + ((lane & 15) >> 2)) * 64;
    constexpr float LOG2E = 1.4426950408889634f;
    v4u vld[8]; bf16x8_t kf0[4], kf1[4];
#define SB_LOAD_TILE(it_) do { const int itt_ = (it_); const bool meta_ = itt_ < 0; const int kb_ = meta_ ? MREAL : b * SEQ + 64 * itt_; \
        _Pragma("unroll") for (int i = 0; i < 8; ++i) { int kl = (lane >> 3) + 8 * i; if (meta_ && kl > NMETA - 1) kl = NMETA - 1; \
            vld[i] = *(const GAS v4u*)(P + (size_t)(kb_ + kl) * NIN + PC_VC + h * 64 + (lane & 7) * 8); } \
        const int kr0 = (meta_ && r32 > NMETA - 1) ? NMETA - 1 : r32, kr1 = meta_ ? NMETA - 1 : 32 + r32; \
        _Pragma("unroll") for (int ks = 0; ks < 4; ++ks) { kf0[ks] = *(const GAS bf16x8_t*)(P + (size_t)(kb_ + kr0) * NIN + PC_KC + h * 64 + ks * 16 + hi * 8); \
                                                            kf1[ks] = *(const GAS bf16x8_t*)(P + (size_t)(kb_ + kr1) * NIN + PC_KC + h * 64 + ks * 16 + hi * 8); } } while (0)
    SB_LOAD_TILE(jt);
#pragma unroll 1
    for (int it = jt; it >= -1; --it) {
        const bool meta = it < 0;
        f32x16_t p0, p1;
#pragma unroll
        for (int r = 0; r < 16; ++r) { p0[r] = 0.f; p1[r] = 0.f; }
#pragma unroll
        for (int ks = 0; ks < 4; ++ks) { p0 = MFMA32(kf0[ks], qr[ks], p0); p1 = MFMA32(kf1[ks], qr[ks], p1); }
#pragma unroll
        for (int i = 0; i < 8; ++i) *(LAS v4u*)(wl + ((lane & 7) >> 2) * 4096 + ((lane >> 3) + 8 * i) * 64 + (lane & 3) * 16) = vld[i];
        if (it > -1) SB_LOAD_TILE(it - 1);
        const int lim = meta ? NMETA : (it == jt ? 32 * (qt & 1) + r32 : 64);
        float lk0[16], lk1[16];
#pragma unroll
        for (int r = 0; r < 16; ++r) {
            { const float Z = p0[r] * LOG2E; const float L = __builtin_amdgcn_logf(1.0f + __builtin_amdgcn_exp2f(-fabsf(Z))); const float nl = -(relu_bits(Z) + L);
              const bool valid = crow(r, hi) < lim; lk0[r] = valid ? nl : 0.f; p0[r] = valid ? Z + nl : -1.0e30f; }
            { const float Z = p1[r] * LOG2E; const float L = __builtin_amdgcn_logf(1.0f + __builtin_amdgcn_exp2f(-fabsf(Z))); const float nl = -(relu_bits(Z) + L);
              const bool valid = 32 + crow(r, hi) < lim; lk1[r] = valid ? nl : 0.f; p1[r] = valid ? Z + nl : -1.0e30f; }
        }
        float base[8]; float E = carry;
#pragma unroll
        for (int B = 7; B >= 0; --B) {
            const int rb = 4 * (B & 3);
            const float own = (B >> 2) ? ((lk1[rb] + lk1[rb + 1]) + (lk1[rb + 2] + lk1[rb + 3])) : ((lk0[rb] + lk0[rb + 1]) + (lk0[rb + 2] + lk0[rb + 3]));
            const auto rr = __builtin_amdgcn_permlane32_swap(__float_as_uint(own), __float_as_uint(own), false, false);
            const float lo_s = __uint_as_float(rr[0]), hi_s = __uint_as_float(rr[1]);
            base[B] = E + (hi ? 0.f : hi_s);
            E += lo_s + hi_s;
        }
        carry = E;
#pragma unroll
        for (int B = 0; B < 8; ++B) {
            const int rb = 4 * (B & 3);
            if (B >> 2) { const float l3 = base[B], l2 = l3 + lk1[rb + 3], l1 = l2 + lk1[rb + 2], l0 = l1 + lk1[rb + 1];
                p1[rb + 3] = __builtin_amdgcn_exp2f(p1[rb + 3] + l3); p1[rb + 2] = __builtin_amdgcn_exp2f(p1[rb + 2] + l2); p1[rb + 1] = __builtin_amdgcn_exp2f(p1[rb + 1] + l1); p1[rb] = __builtin_amdgcn_exp2f(p1[rb] + l0); }
            else { const float l3 = base[B], l2 = l3 + lk0[rb + 3], l1 = l2 + lk0[rb + 2], l0 = l1 + lk0[rb + 1];
                p0[rb + 3] = __builtin_amdgcn_exp2f(p0[rb + 3] + l3); p0[rb + 2] = __builtin_amdgcn_exp2f(p0[rb + 2] + l2); p0[rb + 1] = __builtin_amdgcn_exp2f(p0[rb + 1] + l1); p0[rb] = __builtin_amdgcn_exp2f(p0[rb] + l0); }
        }
        v4u pw[4];
#pragma unroll
        for (int j = 0; j < 4; ++j) { pw[0][j] = cvtpk(p0[2 * j], p0[2 * j + 1]); pw[1][j] = cvtpk(p0[8 + 2 * j], p0[8 + 2 * j + 1]); pw[2][j] = cvtpk(p1[2 * j], p1[2 * j + 1]); pw[3][j] = cvtpk(p1[8 + 2 * j], p1[8 + 2 * j + 1]); }
#pragma unroll
        for (int ks = 0; ks < 4; ++ks) {
            const s16x4_t a_lo = vtr(vp + ks * 1024), a_hi = vtr(vp + ks * 1024 + 512), b_lo = vtr(vp + 4096 + ks * 1024), b_hi = vtr(vp + 4096 + ks * 1024 + 512);
            const bf16x8_t v0 = (bf16x8_t){a_lo[0], a_lo[1], a_lo[2], a_lo[3], a_hi[0], a_hi[1], a_hi[2], a_hi[3]};
            const bf16x8_t v1 = (bf16x8_t){b_lo[0], b_lo[1], b_lo[2], b_lo[3], b_hi[0], b_hi[1], b_hi[2], b_hi[3]};
            const bf16x8_t pa = __builtin_bit_cast(bf16x8_t, pw[ks]);
            o0 = MFMA32(pa, v0, o0); o1 = MFMA32(pa, v1, o1); }
        if (__all(carry < -160.0f)) break;
    }
    LAS unsigned short* stg = (LAS unsigned short*)(wl + 8192);
#pragma unroll
    for (int r = 0; r < 16; ++r) { stg[crow(r, hi) * 64 + r32] = (unsigned short)f2bf(o0[r]); stg[crow(r, hi) * 64 + 32 + r32] = (unsigned short)f2bf(o1[r]); }
    LDS_WAIT(); asm volatile("" ::: "memory");
#pragma unroll
    for (int i = 0; i < 4; ++i) { const int row = i * 8 + (lane >> 3), ch = lane & 7; const v4u v = *(const LAS v4u*)(stg + row * 64 + ch * 8);
        float q = (bflo(v.x) * bflo(v.x) + bfhi(v.x) * bfhi(v.x)) + (bflo(v.y) * bflo(v.y) + bfhi(v.y) * bfhi(v.y)) + (bflo(v.z) * bflo(v.z) + bfhi(v.z) * bfhi(v.z)) + (bflo(v.w) * bflo(v.w) + bfhi(v.w) * bfhi(v.w));
        q += __shfl_xor(q, 1); q += __shfl_xor(q, 2); q += __shfl_xor(q, 4);
        if (ch == 0) pg8::stat_add(ssc + qrow0 + row, q);
        *(GAS v4u*)(Ycat + (size_t)(qrow0 + row) * 1024 + YC_C + h * 64 + ch * 8) = v; }
    LDS_WAIT(); asm volatile("" ::: "memory");
}

constexpr int DSA_HIST = 0, DSA_HIST_STRIDE = 257;
constexpr int DSA_ZC = 65792, DSA_ZC_STRIDE = 36;
constexpr int DSA_MASK = DSA_ZC + 64 * 36 * 4;
constexpr int DSA_Q = DSA_MASK + 64 * 34 * 2 * 4;
constexpr int DSA_BD = DSA_Q + 10 * 64 * 4;
constexpr int DSA_IQ = DSA_BD + 4 * 132 * 4, DSA_IQ_STRIDE = 528;
constexpr int DSA_END = DSA_IQ + 64 * DSA_IQ_STRIDE;
static_assert(DSA_END <= RING_BYTES, "DSA LDS map");
constexpr int DSA_CAP = 32;
constexpr unsigned KEY_ZERO = 0x80000000u;

__device__ __forceinline__ constexpr int crow0(int r) { return (r & 3) + 8 * (r >> 2); }
__device__ __forceinline__ unsigned off_a(unsigned row, unsigned ch) { return 2048u * (row >> 3) + 512u * (ch >> 2) + 64u * (row & 7) + 16u * ((ch & 3) ^ ((row >> 2) & 3)); }

__device__ __forceinline__ void dsa_scores(f32x16_t& s0, f32x16_t& s1, const bf16x8_t (&ikf)[2][4], const LAS unsigned char* iqrow, const float (&iw)[4]) {
#pragma unroll
    for (int r = 0; r < 16; ++r) { s0[r] = 0.f; s1[r] = 0.f; }
#pragma unroll
    for (int hp = 0; hp < 4; hp += 2) {
        f32x16_t a0, a1, b0, b1;
#pragma unroll
        for (int r = 0; r < 16; ++r) { a0[r] = 0.f; a1[r] = 0.f; b0[r] = 0.f; b1[r] = 0.f; }
#pragma unroll
        for (int ks = 0; ks < 4; ++ks) { const bf16x8_t qa = *(const LAS bf16x8_t*)(iqrow + hp * 128 + ks * 32), qb = *(const LAS bf16x8_t*)(iqrow + (hp + 1) * 128 + ks * 32);
            a0 = MFMA32(ikf[0][ks], qa, a0); a1 = MFMA32(ikf[1][ks], qa, a1); b0 = MFMA32(ikf[0][ks], qb, b0); b1 = MFMA32(ikf[1][ks], qb, b1); }
#pragma unroll
        for (int r = 0; r < 16; ++r) { s0[r] += iw[hp] * relu_bits(a0[r]); s1[r] += iw[hp] * relu_bits(a1[r]); }
#pragma unroll
        for (int r = 0; r < 16; ++r) { s0[r] += iw[hp + 1] * relu_bits(b0[r]); s1[r] += iw[hp + 1] * relu_bits(b1[r]); }
        __builtin_amdgcn_sched_barrier(0);
    }
}
__device__ __forceinline__ void dsa_load_ik(bf16x8_t (&ikf)[2][4], const bf16* P, int b, int j, int r32, int hi) {
    const int row0 = j == 0 ? MREAL + (r32 < NMETA ? r32 : NMETA - 1) : b * SEQ + 64 * (j - 1) + r32;
    const int row1 = j == 0 ? MREAL + NMETA - 1 : b * SEQ + 64 * (j - 1) + 32 + r32;
#pragma unroll
    for (int ks = 0; ks < 4; ++ks) { ikf[0][ks] = *(const GAS bf16x8_t*)(P + (size_t)row0 * NIN + PC_IK + ks * 16 + hi * 8);
                                     ikf[1][ks] = *(const GAS bf16x8_t*)(P + (size_t)row1 * NIN + PC_IK + ks * 16 + hi * 8); }
}


template <bool P0, bool EDGE>
__device__ __forceinline__ void dsa_hist_tile(const f32x16_t& s0, const f32x16_t& s1, LAS unsigned* hrow, const int shift, const unsigned psh, const int limh, unsigned& zcount) {
#pragma unroll
    for (int r = 0; r < 16; ++r) {
#pragma unroll
        for (int hf = 0; hf < 2; ++hf) {
            float sv = hf ? s1[r] : s0[r]; asm volatile("" : "+v"(sv) :: "memory");
            const unsigned u = __float_as_uint(sv);
            const unsigned key = u ^ ((unsigned)((int)u >> 31) | 0x80000000u);
            unsigned bin;
            if (P0) { bin = key >> 24;
                if (EDGE) { const bool valid = (32 * hf + crow0(r)) < limh; bin = valid ? bin : 256u; zcount += (valid && key == KEY_ZERO) ? 1u : 0u; }
                else zcount += (key == KEY_ZERO) ? 1u : 0u; }
            else { const unsigned d = (key >> shift) & 255u; bool m = (key >> (shift + 8)) == psh; if (EDGE) m = m && ((32 * hf + crow0(r)) < limh); bin = m ? d : 256u; }
            __hip_atomic_fetch_add(hrow + bin, 1u, __ATOMIC_RELAXED, __HIP_MEMORY_SCOPE_WORKGROUP);
        }
        if ((r & 1) == 1) asm volatile("" ::: "memory");
    }
}

__device__ __forceinline__ void dsa_unit(const Args& A, Frame& F, int l, int b, int qt) {
    const int lane = lane_id(), r32 = lane & 31, hi = lane >> 5, w = F.wave;
    LAS unsigned char* L = F.lds + RING_OFF;
    LAS unsigned* hist = (LAS unsigned*)(L + DSA_HIST); LAS unsigned* zc = (LAS unsigned*)(L + DSA_ZC); LAS unsigned* maskw = (LAS unsigned*)(L + DSA_MASK);
    LAS unsigned* qT = (LAS unsigned*)(L + DSA_Q); LAS unsigned* qK = qT + 64; LAS unsigned* qM = qT + 128; LAS unsigned* qJ = qT + 192; LAS unsigned* qR = qT + 256; LAS unsigned* qF = qT + 320; LAS unsigned* qT2 = qT + 384; LAS unsigned* qJ2 = qT + 448; LAS unsigned* qR2 = qT + 512; LAS unsigned* qC = qT + 576;
    LAS float* bd = (LAS float*)(L + DSA_BD);
    const bf16* P = (const bf16*)(F.ws + WS_P); bf16* Ycat = (bf16*)(F.ws + WS_YCAT);
    const int nt = qt + 2;
    const int t0 = 64 * qt, qrow0 = b * SEQ + t0;
    const int tid = w * 64 + lane;
    for (int i = tid; i < (DSA_MASK - DSA_HIST) / 4; i += 512) hist[i] = 0u;
    for (int i = tid; i < 4 * 132; i += 512) { const int h = i / 132, d = i % 132; bd[i] = A.in[2][t5_bucket(d) * 4 + h] * 1.4426950408889634f; }
    if (tid < 64) qF[tid] = 0u;
    {
        const int qh = w & 1, ts = w >> 1;
        const int ql = 32 * qh + r32;
        float iw[4];
        { const bf16* Pq = P + (size_t)(qrow0 + ql) * NIN;
#pragma unroll
          for (int h = 0; h < 4; ++h) iw[h] = bf2f(Pq[PC_IW + h]); }
#pragma unroll
        for (int i = 0; i < 4; ++i) { const int cidx = tid + 512 * i, row = cidx >> 5, ch = cidx & 31;
            *(LAS v4u*)(L + DSA_IQ + row * DSA_IQ_STRIDE + ch * 16) = *(const GAS v4u*)(P + (size_t)(qrow0 + row) * NIN + PC_IQ + ch * 8); }
        const LAS unsigned char* iqrow = L + DSA_IQ + ql * DSA_IQ_STRIDE + hi * 16;
        const int nq = NMETA + t0 + ql + 1;
        unsigned pref = 0u, Tq = 0u, candlim = 0u; int jstar = 1000, rprime = 0; bool fast = false;
        __syncthreads();
        bf16x8_t ikf[2][4];
        if (ts < nt) dsa_load_ik(ikf, P, b, ts, r32, hi);
#pragma unroll 1
        for (int pass = 0; pass < 6; ++pass) {
            if (pass == 4) { if (qF[0] == 0u) continue; }
            const int shift = 24 - 8 * pass;
#pragma unroll 1
            for (int j = ts; j < nt; j += 4) {
                f32x16_t s0, s1;
                dsa_scores(s0, s1, ikf, iqrow, iw);
                if (j + 4 < nt) dsa_load_ik(ikf, P, b, j + 4, r32, hi);
                else if (pass < 5) dsa_load_ik(ikf, P, b, ts, r32, hi);
                const int lim = (j == 0) ? NMETA : ((j == nt - 1) ? ql + 1 : 64);
                const int limh = lim - 4 * hi;
                if (pass < 4) {
                    LAS unsigned* hrow = hist + ql * DSA_HIST_STRIDE;
                    const bool edge = (j == 0) || (j == nt - 1);
                    if (pass == 0) { unsigned zcount = 0u;
                        if (edge) dsa_hist_tile<true, true>(s0, s1, hrow, 24, 0u, limh, zcount); else dsa_hist_tile<true, false>(s0, s1, hrow, 24, 0u, limh, zcount);
                        __hip_atomic_fetch_add(zc + ql * DSA_ZC_STRIDE + j, zcount, __ATOMIC_RELAXED, __HIP_MEMORY_SCOPE_WORKGROUP);
                    } else { unsigned zdummy = 0u; const unsigned psh = pref >> (shift + 8);
                        if (edge) dsa_hist_tile<false, true>(s0, s1, hrow, shift, psh, limh, zdummy); else dsa_hist_tile<false, false>(s0, s1, hrow, shift, psh, limh, zdummy); }
                } else if (pass == 4) {
                    LAS unsigned* zrow = zc + ql * DSA_ZC_STRIDE;
#pragma unroll
                    for (int r = 0; r < 16; ++r) {
#pragma unroll
                        for (int hf = 0; hf < 2; ++hf) { const float s = (hf ? s1[r] : s0[r]); const unsigned key = mono_key(s);
                            const unsigned zs = ((32 * hf + crow0(r)) < limh && key == Tq) ? (unsigned)j : 35u; __hip_atomic_fetch_add(zrow + zs, 1u, __ATOMIC_RELAXED, __HIP_MEMORY_SCOPE_WORKGROUP); }
                        if ((r & 3) == 3) asm volatile("" ::: "memory"); }
                } else {
                    unsigned sel0 = 0u, sel1 = 0u;
                    LAS unsigned* lrow = hist + ql * DSA_HIST_STRIDE;
                    const unsigned posb = 64u * (unsigned)j + 4u * (unsigned)hi;
#define DSA_CAND(key_, kidx_) do { const unsigned slot_ = __hip_atomic_fetch_add(lrow, 1u, __ATOMIC_RELAXED, __HIP_MEMORY_SCOPE_WORKGROUP); \
                        if (slot_ < (unsigned)DSA_CAP) { lrow[1 + 2 * slot_] = (key_); lrow[2 + 2 * slot_] = posb + (unsigned)(kidx_); } } while (0)
                    if (!__any(j == jstar)) {
                        const unsigned Tj = (j < jstar) ? Tq : Tq + 1u;
                        if ((j == 0) || (j == nt - 1)) {
#pragma unroll
                            for (int r = 15; r >= 0; --r) {
                                { float sv = s0[r]; asm volatile("" : "+v"(sv) :: "memory"); const unsigned u = __float_as_uint(sv); const unsigned key = u ^ ((unsigned)((int)u >> 31) | 0x80000000u);
                                  sel0 = sel0 * 2u + ((key >= Tj && crow0(r) < limh) ? 1u : 0u); if ((key ^ Tq) < candlim && crow0(r) < limh) DSA_CAND(key, crow0(r)); }
                                { float sv = s1[r]; asm volatile("" : "+v"(sv) :: "memory"); const unsigned u = __float_as_uint(sv); const unsigned key = u ^ ((unsigned)((int)u >> 31) | 0x80000000u);
                                  sel1 = sel1 * 2u + ((key >= Tj && (32 + crow0(r)) < limh) ? 1u : 0u); if ((key ^ Tq) < candlim && (32 + crow0(r)) < limh) DSA_CAND(key, 32 + crow0(r)); } }
                        } else {
#pragma unroll
                            for (int r = 15; r >= 0; --r) {
                                { float sv = s0[r]; asm volatile("" : "+v"(sv) :: "memory"); const unsigned u = __float_as_uint(sv); const unsigned key = u ^ ((unsigned)((int)u >> 31) | 0x80000000u);
                                  sel0 = sel0 * 2u + ((key >= Tj) ? 1u : 0u); if ((key ^ Tq) < candlim) DSA_CAND(key, crow0(r)); }
                                { float sv = s1[r]; asm volatile("" : "+v"(sv) :: "memory"); const unsigned u = __float_as_uint(sv); const unsigned key = u ^ ((unsigned)((int)u >> 31) | 0x80000000u);
                                  sel1 = sel1 * 2u + ((key >= Tj) ? 1u : 0u); if ((key ^ Tq) < candlim) DSA_CAND(key, 32 + crow0(r)); } }
                        }
                    } else {
                    unsigned e0 = 0u, e1 = 0u, g0 = 0u, g1 = 0u;
#pragma unroll
                    for (int r = 15; r >= 0; --r) {
                        { const unsigned key = mono_key(s0[r]); const bool valid = crow0(r) < limh; e0 = e0 * 2u + ((valid && key == Tq) ? 1u : 0u); g0 = g0 * 2u + ((valid && key > Tq) ? 1u : 0u); }
                        { const unsigned key = mono_key(s1[r]); const bool valid = (32 + crow0(r)) < limh; e1 = e1 * 2u + ((valid && key == Tq) ? 1u : 0u); g1 = g1 * 2u + ((valid && key > Tq) ? 1u : 0u); } }
                    unsigned t0m = 0u, t1m = 0u;
                    if (j < jstar) { t0m = e0; t1m = e1; }
                    {
                        int E = 0; unsigned r0m = 0u, r1m = 0u;
#pragma unroll
                        for (int B = 0; B < 8; ++B) { const int rb = 4 * (B & 3); const unsigned em = (B >> 2) ? e1 : e0;
                            const int own = __popc((em >> rb) & 15u);
                            const auto rr = __builtin_amdgcn_permlane32_swap((unsigned)own, (unsigned)own, false, false);
                            const int lo_s = (int)rr[0], hi_s = (int)rr[1];
                            int rk = E + (hi ? lo_s : 0);
#pragma unroll
                            for (int i = 0; i < 4; ++i) { const bool isq = (em >> (rb + i)) & 1u; if (isq && rk < rprime) { if (B >> 2) r1m |= 1u << (rb + i); else r0m |= 1u << (rb + i); } rk += isq ? 1 : 0; }
                            E += lo_s + hi_s; }
                        if (j == jstar) { t0m = r0m; t1m = r1m; }
                    }
                    sel0 = g0 | t0m; sel1 = g1 | t1m;
                    if (__any(candlim != 0u)) {
#pragma unroll
                        for (int r = 0; r < 16; ++r) {
                            { float sv = s0[r]; asm volatile("" : "+v"(sv) :: "memory"); const unsigned key = mono_key(sv); if ((key ^ Tq) < candlim && crow0(r) < limh) DSA_CAND(key, crow0(r)); }
                            { float sv = s1[r]; asm volatile("" : "+v"(sv) :: "memory"); const unsigned key = mono_key(sv); if ((key ^ Tq) < candlim && (32 + crow0(r)) < limh) DSA_CAND(key, 32 + crow0(r)); } }
                    }
                    }
                    unsigned w0 = ((sel0 & 0xfu) | ((sel0 & 0xf0u) << 4) | ((sel0 & 0xf00u) << 8) | ((sel0 & 0xf000u) << 12)) << (4 * hi);
                    unsigned w1 = ((sel1 & 0xfu) | ((sel1 & 0xf0u) << 4) | ((sel1 & 0xf00u) << 8) | ((sel1 & 0xf000u) << 12)) << (4 * hi);
                    { const auto rr = __builtin_amdgcn_permlane32_swap(w0, w0, false, false); w0 = rr[0] | rr[1]; }
                    { const auto rr = __builtin_amdgcn_permlane32_swap(w1, w1, false, false); w1 = rr[0] | rr[1]; }
                    if (hi == 0) { maskw[(ql * 34 + j) * 2] = w0; maskw[(ql * 34 + j) * 2 + 1] = w1; }
                }
            }
            if (pass == 5) {
                if (fast) {
                    __syncthreads();
#pragma unroll 1
                    for (int it = 0; it < 4; ++it) { const int q = 8 * w + 2 * it + hi, i = r32;
                        const LAS unsigned* lr = hist + q * DSA_HIST_STRIDE; const unsigned c0 = lr[0]; const int cnt = (int)(c0 < (unsigned)DSA_CAP ? c0 : (unsigned)DSA_CAP); const int kr = (int)qK[q];
                        unsigned mk = 0u, mp = 0u; if (i < cnt) { mk = lr[1 + 2 * i]; mp = lr[2 + 2 * i]; }
                        int rank = 0;
#pragma unroll 1
                        for (int jj = 0; jj < DSA_CAP; ++jj) { if (!__any(jj < cnt)) break;
                            const unsigned kj = lr[1 + 2 * jj], pj = lr[2 + 2 * jj]; rank += (jj < cnt && (kj > mk || (kj == mk && pj < mp))) ? 1 : 0; }
                        if (i < cnt && rank < kr) __hip_atomic_fetch_or(maskw + (q * 34 + (int)(mp >> 6)) * 2 + (int)((mp >> 5) & 1u), 1u << (mp & 31u), __ATOMIC_RELAXED, __HIP_MEMORY_SCOPE_WORKGROUP); }
                }
                break; }
            __syncthreads();
            if (pass < 4) {
                const int qi = lane >> 3, part = lane & 7, q = 8 * w + qi; LAS unsigned* hr = hist + q * DSA_HIST_STRIDE + 32 * part;
                const int nqq = NMETA + t0 + q + 1; const int krem = (pass == 0) ? (nqq < TOPK ? nqq : TOPK) : (int)qK[q];
                int c[32]; int tot = 0;
#pragma unroll
                for (int i = 0; i < 32; ++i) { c[i] = (int)hr[i]; tot += c[i]; }
#pragma unroll
                for (int i = 0; i < 32; ++i) hr[i] = 0u;
                int S = tot;
#pragma unroll
                for (int off = 1; off < 8; off <<= 1) { const int t = __shfl_down(S, off); if (part + off < 8) S += t; }
                const int above = S - tot; const bool here = (above < krem) && (S >= krem);
                int a = above, bin = 0, newk = 0, cb = 0; bool done = false;
#pragma unroll
                for (int i = 31; i >= 0; --i) { const bool f = !done && (a + c[i] >= krem); bin = f ? i : bin; newk = f ? krem - a : newk; cb = f ? c[i] : cb; done = done || f; a += done ? 0 : c[i]; }
                if (here) { const unsigned np = ((pass == 0) ? 0u : qT[q]) | ((unsigned)(bin + 32 * part) << shift); qT[q] = np; qK[q] = (unsigned)newk; qM[q] = (unsigned)cb;
                    if (pass == 3 && cb > newk && np != KEY_ZERO) qF[0] = 1u;
                    if (pass == 1) {
                        if (cb <= DSA_CAP) { qT2[q] = np | 0xffffu; qJ2[q] = 0xffffffffu; qR2[q] = 0u; qC[q] = 0x10000u; }
                        else if (np == KEY_ZERO) { const LAS unsigned* zr = zc + q * DSA_ZC_STRIDE; int acc = 0, js = 1000, rp = 0;
#pragma unroll 1
                            for (int jj = 0; jj < nt; ++jj) { const int cz = (int)zr[jj]; if (js == 1000 && acc + cz >= newk) { js = jj; rp = newk - acc; } acc += cz; }
                            if (acc == cb) { qT2[q] = KEY_ZERO; qJ2[q] = (unsigned)js; qR2[q] = (unsigned)rp; qC[q] = 0u; } else qF[1] = 1u; }
                        else qF[1] = 1u; } }
            }
            if (pass == 3 || pass == 4) {
                __syncthreads();
                const bool generic = qF[0] != 0u;
                if (pass == 4 || !generic) {
#pragma unroll 1
                    for (int i = 0; i < 8; ++i) { const int q = 8 * w + i; const int m = (int)qM[q], rn = (int)qK[q];
                        int js = 1000, rp = 0;
                        if (m > rn) { const int c = lane < nt ? (int)zc[q * DSA_ZC_STRIDE + lane] : 0; int inc = c;
#pragma unroll
                            for (int off = 1; off < 64; off <<= 1) { const int t = __shfl_up(inc, off); if (lane >= off) inc += t; }
                            const bool here = (inc >= rn) && (inc - c < rn);
                            const unsigned long long mm = __ballot(here); const int src = mm ? (__ffsll((long long)mm) - 1) : 0;
                            js = src; rp = rn - __shfl(inc - c, src); }
                        if (lane == 0) { qJ[q] = (unsigned)js; qR[q] = (unsigned)rp; } }
                } else {
                    for (int i = tid; i < 64 * DSA_ZC_STRIDE; i += 512) zc[i] = 0u;
                }
            }
            __syncthreads();
            pref = qT[ql]; Tq = pref; jstar = (int)qJ[ql]; rprime = (int)qR[ql];
            if (pass == 1 && qF[1] == 0u) { fast = true; Tq = qT2[ql]; jstar = (int)qJ2[ql]; rprime = (int)qR2[ql]; candlim = qC[ql]; pass = 4; }
        }
    }
    __syncthreads();
    {
        const int h = w & 3, qh2 = w >> 2, ql = 32 * qh2 + r32;
        const stat_t* sskv = stat_ptr(F, l, ST_SSKV);
        LAS unsigned short* QL = (LAS unsigned short*)(L + w * 8192);
        {
            bf16x8_t qaf[4];
#pragma unroll
            for (int ks = 0; ks < 4; ++ks) qaf[ks] = *(const GAS bf16x8_t*)(P + (size_t)(qrow0 + ql) * NIN + PC_QA + h * 64 + ks * 16 + hi * 8);
#pragma unroll 1
            for (int c = 0; c < 4; ++c) {
                f32x16_t d;
#pragma unroll
                for (int r = 0; r < 16; ++r) d[r] = 0.f;
                const GAS bf16x8_t* wf = (const GAS bf16x8_t*)(F.ws + WS_WUKF) + ((size_t)(l * 4 + h) * 16 + 4 * c) * 64 + lane;
#pragma unroll
                for (int ks = 0; ks < 4; ++ks) d = MFMA32(wf[64 * ks], qaf[ks], d);
#pragma unroll
                for (int r = 0; r < 16; ++r) QL[r32 * 128 + 32 * c + crow(r, hi)] = (unsigned short)f2bf(d[r]); }
        }
        LDS_WAIT(); asm volatile("" ::: "memory");
        bf16x8_t qlf[8];
#pragma unroll
        for (int s = 0; s < 8; ++s) qlf[s] = *(const LAS bf16x8_t*)(QL + r32 * 128 + 16 * s + 8 * hi);
        LDS_WAIT(); asm volatile("" ::: "memory");
        __syncthreads();
        LAS unsigned char* ckb = L;
        LAS float* rkb = (LAS float*)(L + DSA_IQ);
#define DSA_DMA(j_, buf_) do { const int jj_ = (j_); const int row_ = 8 * w + ((lane >> 2) & 7); \
            const int grow_ = jj_ == 0 ? MREAL + (row_ < NMETA ? row_ : NMETA - 1) : b * SEQ + 64 * (jj_ - 1) + row_; \
            const bf16* gp_ = P + (size_t)grow_ * NIN + PC_CKV + (4 * (lane >> 5) + ((lane & 3) ^ ((row_ >> 2) & 3))) * 8; \
            __builtin_amdgcn_global_load_lds((const unsigned*)gp_, (LAS unsigned*)(ckb + (buf_) * 16384 + 2048 * w), 16, 0, 0); \
            __builtin_amdgcn_global_load_lds((const unsigned*)(gp_ + 64), (LAS unsigned*)(ckb + (buf_) * 16384 + 2048 * w + 1024), 16, 0, 0); } while (0)
        DSA_DMA(0, 0); if (1 < nt) DSA_DMA(1, 1);
        for (int i = tid; i < nt * 64; i += 512) { const int jj_ = i >> 6, kk_ = i & 63; const int grow_ = jj_ == 0 ? MREAL + (kk_ < NMETA ? kk_ : NMETA - 1) : b * SEQ + 64 * (jj_ - 1) + kk_;
            const float rks_ = rsqrtf(stat_get(sskv + grow_) * (1.0f / 128.0f) + pg8::RMS_EPS); rkb[jj_ * 128 + kk_] = rks_; rkb[jj_ * 128 + 64 + kk_] = rks_ * 1.4426950408889634f; }
        asm volatile("s_waitcnt vmcnt(0)" ::: "memory");
        __syncthreads();
        f32x16_t oT[4];
#pragma unroll
        for (int c = 0; c < 4; ++c)
#pragma unroll
            for (int r = 0; r < 16; ++r) oT[c][r] = 0.f;
        float mrun = -1.0e30f, lrun = 0.f;
        constexpr float LOG2E = 1.4426950408889634f;
        const float bfar = bd[h * 132 + 128]; const LAS float* bdh = bd + h * 132;
        const unsigned xr = (r32 >> 2) & 3u, rowpart = 2048u * (r32 >> 3) + 64u * (r32 & 7);
        const unsigned rrA = rowpart + 16u * ((unsigned)hi ^ xr), rrB = rowpart + 16u * (((unsigned)hi ^ xr) ^ 2u);
        const unsigned yb = 2u * ((lane >> 4) & 1) + ((lane & 3) >> 1), trpart = 64u * (4u * hi + ((lane & 15) >> 2)) + 8u * (lane & 1);
        const unsigned trA = trpart + 16u * (yb ^ (unsigned)hi), trB = trpart + 16u * (yb ^ (unsigned)hi ^ 2u);
        if (qh2 == 0) __builtin_amdgcn_s_setprio(2);
#pragma unroll 1
        for (int j0 = 0; j0 < nt; j0 += 2) {
            if (j0 + 2 < nt) DSA_DMA(j0 + 2, (j0 + 2) & 3);
            if (j0 + 3 < nt) DSA_DMA(j0 + 3, (j0 + 3) & 3);
#pragma unroll
            for (int jj = 0; jj < 2; ++jj) { const int j = j0 + jj; if (j >= nt) break;
            const LAS unsigned char* tb = ckb + (j & 3) * 16384; const LAS float* rk = rkb + j * 128;
            f32x16_t p0, p1;
#pragma unroll
            for (int r = 0; r < 16; ++r) { p0[r] = 0.f; p1[r] = 0.f; }
            { const LAS unsigned char* ra = tb + rrA; const LAS unsigned char* rb_ = tb + rrB;
              bf16x8_t a0 = *(const LAS bf16x8_t*)(ra), a1 = *(const LAS bf16x8_t*)(ra + 8192);
#pragma unroll
              for (int s = 0; s < 8; ++s) { bf16x8_t n0 = a0, n1 = a1;
                if (s < 7) { const LAS unsigned char* bp = ((s + 1) & 1) ? rb_ : ra; n0 = *(const LAS bf16x8_t*)(bp + 512 * ((s + 1) >> 1)); n1 = *(const LAS bf16x8_t*)(bp + 512 * ((s + 1) >> 1) + 8192); }
                p0 = MFMA32(a0, qlf[s], p0); p1 = MFMA32(a1, qlf[s], p1); a0 = n0; a1 = n1; } }
            const unsigned mw0 = maskw[(ql * 34 + j) * 2] >> (4 * hi), mw1 = maskw[(ql * 34 + j) * 2 + 1] >> (4 * hi);
            const int dbase = ((j == 0) ? (NMETA + t0 + ql) : (t0 + ql - 64 * (j - 1))) - 4 * hi;
            const bool nearb = __any((dbase - 63) < 128);
            const LAS float* rkh = rk + 4 * hi;
            float mx = -INFINITY;
            const unsigned NINF = 0xff800000u;
#define DSA_LOGITS(NEAR_) \
            _Pragma("unroll") for (int g = 0; g < 4; ++g) {        \
                const f32x4 ka = *(const LAS f32x4*)(rkh + 64 + 8 * g), kb = *(const LAS f32x4*)(rkh + 64 + 32 + 8 * g);        \
                _Pragma("unroll") for (int i = 0; i < 4; ++i) { const int r = 4 * g + i, c0 = 8 * g + i; \
                    float x0 = p0[r], x1 = p1[r]; asm volatile("" : "+v"(x0), "+v"(x1) :: "memory");        \
                    float b0 = bfar, b1 = bfar; \
                    if (NEAR_) { int d0 = dbase - c0; d0 = d0 < 0 ? 0 : (d0 > 128 ? 128 : d0); int d1 = dbase - 32 - c0; d1 = d1 < 0 ? 0 : (d1 > 128 ? 128 : d1); b0 = bdh[d0]; b1 = bdh[d1]; } \
                    const unsigned v0 = __float_as_uint(fmaf(x0, ka[i], b0)), v1 = __float_as_uint(fmaf(x1, kb[i], b1)); \
                    const unsigned m0 = (unsigned)(((int)(mw0 << (31 - c0))) >> 31), m1 = (unsigned)(((int)(mw1 << (31 - c0))) >> 31);        \
                    const float y0 = __uint_as_float((m0 & v0) | (~m0 & NINF)), y1 = __uint_as_float((m1 & v1) | (~m1 & NINF)); \
                    p0[r] = y0; p1[r] = y1; asm("v_max3_f32 %0, %1, %2, %3" : "=v"(mx) : "v"(mx), "v"(y0), "v"(y1)); } }
            if (nearb) { DSA_LOGITS(true) } else { DSA_LOGITS(false) }
#undef DSA_LOGITS
            { const auto rr = __builtin_amdgcn_permlane32_swap(__float_as_uint(mx), __float_as_uint(mx), false, false); mx = fmaxf(__uint_as_float(rr[0]), __uint_as_float(rr[1])); }
            const float mnew = fmaxf(mrun, mx);
            const float scl = __builtin_amdgcn_exp2f(mrun - mnew);
            if (__any(mnew > mrun)) {
#pragma unroll
                for (int c = 0; c < 4; ++c)
#pragma unroll
                    for (int r = 0; r < 16; ++r) oT[c][r] *= scl;
            }
            mrun = mnew; f32x2_t psv = (f32x2_t){0.f, 0.f}; const f32x2_t mv = (f32x2_t){mnew, mnew};
#pragma unroll
            for (int g = 0; g < 4; ++g) {
                const f32x4 ka = *(const LAS f32x4*)(rkh + 8 * g), kb = *(const LAS f32x4*)(rkh + 32 + 8 * g);
#pragma unroll
                for (int i = 0; i < 4; i += 2) { const int r = 4 * g + i;
                    f32x2_t xa = (f32x2_t){p0[r], p0[r + 1]}, xb = (f32x2_t){p1[r], p1[r + 1]}; asm volatile("" : "+v"(xa), "+v"(xb) :: "memory");
                    xa = xa - mv; xb = xb - mv;
                    const f32x2_t ea = (f32x2_t){__builtin_amdgcn_exp2f(xa.x), __builtin_amdgcn_exp2f(xa.y)}, eb = (f32x2_t){__builtin_amdgcn_exp2f(xb.x), __builtin_amdgcn_exp2f(xb.y)};
                    psv = psv + ea; psv = psv + eb;
                    const f32x2_t wa = ea * (f32x2_t){ka[i], ka[i + 1]}, wb = eb * (f32x2_t){kb[i], kb[i + 1]};
                    p0[r] = wa.x; p0[r + 1] = wa.y; p1[r] = wb.x; p1[r + 1] = wb.y; } }
            float ps = psv.x + psv.y;
            { const auto rr = __builtin_amdgcn_permlane32_swap(__float_as_uint(ps), __float_as_uint(ps), false, false); ps = __uint_as_float(rr[0]) + __uint_as_float(rr[1]); }
            lrun = lrun * scl + ps;
            v4u pw[4];
#pragma unroll
            for (int i = 0; i < 4; ++i) { pw[0][i] = cvtpk(p0[2 * i], p0[2 * i + 1]); pw[1][i] = cvtpk(p0[8 + 2 * i], p0[8 + 2 * i + 1]); pw[2][i] = cvtpk(p1[2 * i], p1[2 * i + 1]); pw[3][i] = cvtpk(p1[8 + 2 * i], p1[8 + 2 * i + 1]); }
            { const lds_cptr t0p = (lds_cptr)(tb + trA), t1p = (lds_cptr)(tb + trB);
              s16x4_t lo = vtr(t0p), hh = vtr(t1p + 2048);
#pragma unroll
              for (int i = 0; i < 16; ++i) { const int ks = i >> 2, c = i & 3;
                s16x4_t lo2 = lo, hh2 = hh;
                if (i < 15) { const int ks2 = (i + 1) >> 2, c2 = (i + 1) & 3; lo2 = vtr(t0p + 4096 * ks2 + 512 * c2); hh2 = vtr(t1p + 4096 * ks2 + 2048 + 512 * c2); }
                const bf16x8_t av = (bf16x8_t){lo[0], lo[1], lo[2], lo[3], hh[0], hh[1], hh[2], hh[3]};
                oT[c] = MFMA32(av, __builtin_bit_cast(bf16x8_t, pw[ks]), oT[c]);
                lo = lo2; hh = hh2; } }
            }
            asm volatile("s_waitcnt vmcnt(0)" ::: "memory");
            __syncthreads();
        }
        __builtin_amdgcn_s_setprio(0);
        { const int lane = lane_id(), r32 = lane & 31, hi = lane >> 5;
        const float linv = 1.0f / lrun;
        f32x16_t ot[2];
#pragma unroll
        for (int db = 0; db < 2; ++db)
#pragma unroll
            for (int r = 0; r < 16; ++r) ot[db][r] = 0.f;
#pragma unroll
        for (int c = 0; c < 4; ++c) {
#pragma unroll
            for (int s = 0; s < 2; ++s) {
                v4u pk;
#pragma unroll
                for (int i = 0; i < 4; ++i) pk[i] = cvtpk(oT[c][8 * s + 2 * i] * linv, oT[c][8 * s + 2 * i + 1] * linv);
                const bf16x8_t bfrag = __builtin_bit_cast(bf16x8_t, pk);
#pragma unroll
                for (int db = 0; db < 2; ++db) {
                    const bf16x8_t wa = *((const GAS bf16x8_t*)(F.ws + WS_WUVF) + ((size_t)(l * 4 + h) * 16 + 4 * c + 2 * s + db) * 64 + lane);
                    ot[db] = MFMA32(wa, bfrag, ot[db]); } } }
        LAS unsigned short* stg = (LAS unsigned short*)(L + 36864 + w * 4096);
#pragma unroll
        for (int db = 0; db < 2; ++db)
#pragma unroll
            for (int r = 0; r < 16; ++r) stg[r32 * 64 + 32 * db + crow(r, hi)] = (unsigned short)f2bf(ot[db][r]);
        LDS_WAIT(); asm volatile("" ::: "memory");
        stat_t* ssa = stat_ptr(F, l, ST_SSA);
#pragma unroll
        for (int i = 0; i < 4; ++i) { const int row = i * 8 + (lane >> 3), ch = lane & 7; const v4u v = *(const LAS v4u*)(stg + row * 64 + ch * 8);
            float q = (bflo(v.x) * bflo(v.x) + bfhi(v.x) * bfhi(v.x)) + (bflo(v.y) * bflo(v.y) + bfhi(v.y) * bfhi(v.y)) + (bflo(v.z) * bflo(v.z) + bfhi(v.z) * bfhi(v.z)) + (bflo(v.w) * bflo(v.w) + bfhi(v.w) * bfhi(v.w));
            q += __shfl_xor(q, 1); q += __shfl_xor(q, 2); q += __shfl_xor(q, 4);
            if (ch == 0) pg8::stat_add(ssa + qrow0 + 32 * qh2 + row, q);
            *(GAS v4u*)(Ycat + (size_t)(qrow0 + 32 * qh2 + row) * 1024 + YC_A + h * 64 + ch * 8) = v; }
        LDS_WAIT(); asm volatile("" ::: "memory");
        }
    }
    __syncthreads();
}


constexpr int S5T = 32, S5NC = SEQ / S5T, S5RG = BATCH * S5NC, S5KU = 640;
constexpr size_t WS_U = 376 * MiB, WS_TZ = 416 * MiB, TZ_LAYER = 20 * MiB, WS_MG = 456 * MiB, MG_LAYER = 4 * MiB, WS_HQ = 464 * MiB, WS_END2 = 497 * MiB;
static_assert(WS_HQ + (size_t)MROWS * 1024 <= WS_WUKF && WS_WUVF + 128 * 1024 <= WS_END2 && WS_END2 <= 512 * MiB, "HQ buffer / fragment tables");
static_assert((size_t)32 * S5RG * S5KU * 2 <= WS_TZ - WS_U && (size_t)32 * 512 * S5KU * 2 <= TZ_LAYER && (size_t)32 * 128 * 512 * 2 <= MG_LAYER, "S5 buffers");

struct S5P { float lrdt, lidt, fr, fi; };
__device__ __forceinline__ S5P s5_params(const Args& A, int lg, int p) {
    const float dt = expf(A.in[10][lg]), lr = A.in[8][lg * 64 + p], li = A.in[9][lg * 64 + p];
    const float mag = expf(lr * dt), ar = mag * cosf(li * dt), ai = mag * sinf(li * dt);
    const float den = lr * lr + li * li, nr = ar - 1.0f, ni = ai;
    S5P o; o.lrdt = lr * dt; o.lidt = li * dt; o.fr = (nr * lr + ni * li) / den; o.fi = (ni * lr - nr * li) / den; return o;
}
__device__ __forceinline__ void s5_apow(const S5P& q, int n, float& re, float& im) { const float m = expf(q.lrdt * (float)n); re = m * cosf(q.lidt * (float)n); im = m * sinf(q.lidt * (float)n); }

__device__ __forceinline__ void s5_build_item(const Args& A, Frame& F, int l, int kind, int g, int x, LAS float* scr) {
    const int lane = lane_id(), lg = l * 32 + g, p = lane;
    bf16* TZ = (bf16*)(F.ws + WS_TZ + (size_t)l * TZ_LAYER) + (size_t)g * 512 * S5KU;
    bf16* MG = (bf16*)(F.ws + WS_MG + (size_t)l * MG_LAYER) + (size_t)g * 128 * 512;
    const S5P q = s5_params(A, lg, p);
    if (kind == 0) {
        const int d = x;
        float pr, pi; s5_apow(q, d, pr, pi);
        LDS_WAIT(); asm volatile("" ::: "memory");
#pragma unroll
        for (int ch = 0; ch < 16; ++ch) { const float br = A.in[11][((size_t)lg * 64 + p) * 16 + ch], bi = A.in[12][((size_t)lg * 64 + p) * 16 + ch];
            const float b1r = q.fr * br - q.fi * bi, b1i = q.fr * bi + q.fi * br;
            scr[p * 34 + ch] = pr * b1r - pi * b1i; scr[p * 34 + 16 + ch] = pr * b1i + pi * b1r; }
        LDS_WAIT(); asm volatile("" ::: "memory");
        const int ch = lane >> 2, c4 = 4 * (lane & 3); float k0 = 0.f, k1 = 0.f, k2 = 0.f, k3 = 0.f;
#pragma unroll 16
        for (int pp = 0; pp < 64; ++pp) { const float cr = A.in[13][((size_t)lg * 16 + ch) * 64 + pp], ci = A.in[14][((size_t)lg * 16 + ch) * 64 + pp]; const LAS float* xr = scr + pp * 34 + c4; const LAS float* xi = xr + 16;
            k0 += cr * xr[0] - ci * xi[0]; k1 += cr * xr[1] - ci * xi[1]; k2 += cr * xr[2] - ci * xi[2]; k3 += cr * xr[3] - ci * xi[3]; }
        const unsigned long long kv = (unsigned long long)pk2(k0, k1) | ((unsigned long long)pk2(k2, k3) << 32);
        for (int tau = d; tau < S5T; ++tau) *(GAS unsigned long long*)(TZ + (size_t)(tau * 16 + ch) * S5KU + (tau - d) * 16 + c4) = kv;
        if (d > 0) for (int tau = 0; tau + d < S5T; ++tau) *(GAS unsigned long long*)(TZ + (size_t)(tau * 16 + ch) * S5KU + (tau + d) * 16 + c4) = 0ull;
        LDS_WAIT(); asm volatile("" ::: "memory");
    } else if (kind == 1) {
        const int tau = x; float pr, pi; s5_apow(q, tau + 1, pr, pi);
#pragma unroll 4
        for (int ch = 0; ch < 16; ++ch) { const float cr = A.in[13][((size_t)lg * 16 + ch) * 64 + p], ci = A.in[14][((size_t)lg * 16 + ch) * 64 + p];
            const float wr_ = cr * pr - ci * pi, wi_ = cr * pi + ci * pr;
            bf16* rowp = TZ + (size_t)(tau * 16 + ch) * S5KU + 512;
            rowp[p] = (bf16)f2bf(wr_); rowp[64 + p] = (bf16)f2bf(-wi_); }
    } else {
        const int sg = x; float pr, pi; s5_apow(q, S5T - 1 - sg, pr, pi);
        unsigned wre[8], wim[8];
#pragma unroll
        for (int c2 = 0; c2 < 8; ++c2) { float vr[2], vi[2];
#pragma unroll
            for (int e = 0; e < 2; ++e) { const int ch = 2 * c2 + e; const float br = A.in[11][((size_t)lg * 64 + p) * 16 + ch], bi = A.in[12][((size_t)lg * 64 + p) * 16 + ch];
                const float b1r = q.fr * br - q.fi * bi, b1i = q.fr * bi + q.fi * br; vr[e] = pr * b1r - pi * b1i; vi[e] = pr * b1i + pi * b1r; }
            wre[c2] = pk2(vr[0], vr[1]); wim[c2] = pk2(vi[0], vi[1]); }
        GAS v4u* r0 = (GAS v4u*)(MG + (size_t)(2 * p) * 512 + sg * 16); GAS v4u* r1 = (GAS v4u*)(MG + (size_t)(2 * p + 1) * 512 + sg * 16);
        r0[0] = (v4u){wre[0], wre[1], wre[2], wre[3]}; r0[1] = (v4u){wre[4], wre[5], wre[6], wre[7]};
        r1[0] = (v4u){wim[0], wim[1], wim[2], wim[3]}; r1[1] = (v4u){wim[4], wim[5], wim[6], wim[7]};
    }
}

typedef float f32x4_t __attribute__((ext_vector_type(4)));
__device__ __forceinline__ void s5_scan_task(const Args& A, Frame& F, int l, int g) {
    const int lane = lane_id(), w = F.wave, bcol = lane & 15, kg = lane >> 4, lg = l * 32 + g;
    const bf16* P = (const bf16*)(F.ws + WS_P);
    bf16* U = (bf16*)(F.ws + WS_U) + (size_t)g * S5RG * S5KU;
    const bf16* MG = (const bf16*)(F.ws + WS_MG + (size_t)l * MG_LAYER) + (size_t)g * 128 * 512;
    LAS unsigned char* ring = F.lds + RING_OFF;
    asm volatile("s_waitcnt vmcnt(0)" ::: "memory");
    __syncthreads();
#define S5_DMA(k_) do { const int kk_ = (k_); _Pragma("unroll") for (int i_ = 0; i_ < 2; ++i_) { const int r_ = 2 * w + i_; \
        __builtin_amdgcn_global_load_lds((const unsigned*)(U + (size_t)(r_ * S5NC + kk_) * S5KU + 8 * (lane ^ r_)), (LAS unsigned*)(ring + (kk_ & 7) * 16384 + r_ * 1024), 16, 0, 0); } } while (0)
#pragma unroll
    for (int k0 = 0; k0 < 7; ++k0) S5_DMA(k0);
    bf16x8_t af[16];
#pragma unroll
    for (int ks = 0; ks < 16; ++ks) af[ks] = *(const GAS bf16x8_t*)(MG + (size_t)(16 * w + bcol) * 512 + 32 * ks + 8 * kg);
    const int pA = 8 * w + 2 * kg;
    float aTr[2], aTi[2];
#pragma unroll
    for (int e = 0; e < 2; ++e) { const S5P q = s5_params(A, lg, pA + e); s5_apow(q, S5T, aTr[e], aTi[e]); }
    f32x4_t h;
    {
        f32x4_t s = (f32x4_t){0.f, 0.f, 0.f, 0.f};
#pragma unroll
        for (int ks = 0; ks < 16; ++ks) { const int sg = 2 * ks + (kg >> 1);
            if (sg >= 16) { const bf16x8_t bfm = *(const GAS bf16x8_t*)(P + (size_t)(MREAL + sg - 16) * NIN + PC_UB + g * 16 + 8 * (kg & 1)); s = __builtin_amdgcn_mfma_f32_16x16x32_bf16(af[ks], bfm, s, 0, 0, 0); } }
        h = s;
        bf16* hp = U + (size_t)(bcol * S5NC) * S5KU + 512 + pA;
        *(GAS unsigned*)hp = pk2(h[0], h[2]); *(GAS unsigned*)(hp + 64) = pk2(h[1], h[3]);
    }
    const unsigned lbase = (unsigned)bcol * 1024u + 16u * (unsigned)((kg ^ bcol) & 3), bc2 = (unsigned)bcol >> 2;
#pragma unroll 1
    for (int c = 0; c < S5NC - 1; ++c) {
        if (c <= S5NC - 2 - 6) asm volatile("s_waitcnt vmcnt(12)" ::: "memory"); else asm volatile("s_waitcnt vmcnt(0)" ::: "memory");
        __syncthreads();
        if (c + 7 <= S5NC - 2) S5_DMA(c + 7);
        const LAS unsigned char* bufp = ring + (c & 7) * 16384 + lbase;
        f32x4_t s4[4];
#pragma unroll
        for (int j = 0; j < 4; ++j) s4[j] = (f32x4_t){0.f, 0.f, 0.f, 0.f};
#pragma unroll
        for (int m = 0; m < 4; ++m)
#pragma unroll
            for (int j = 0; j < 4; ++j) { const bf16x8_t bfr = *(const LAS bf16x8_t*)(bufp + 256 * m + 64u * ((unsigned)j ^ bc2)); s4[j] = __builtin_amdgcn_mfma_f32_16x16x32_bf16(af[4 * m + j], bfr, s4[j], 0, 0, 0); }
        const f32x4_t s = (s4[0] + s4[1]) + (s4[2] + s4[3]);
        { const float r0 = aTr[0] * h[0] - aTi[0] * h[1] + s[0], i0 = aTr[0] * h[1] + aTi[0] * h[0] + s[1], r1 = aTr[1] * h[2] - aTi[1] * h[3] + s[2], i1 = aTr[1] * h[3] + aTi[1] * h[2] + s[3];
          h = (f32x4_t){r0, i0, r1, i1}; }
        bf16* hp = U + (size_t)(bcol * S5NC + (c + 1)) * S5KU + 512 + pA;
        *(GAS unsigned*)hp = pk2(h[0], h[2]); *(GAS unsigned*)(hp + 64) = pk2(h[1], h[3]);
    }
#undef S5_DMA
    asm volatile("s_waitcnt vmcnt(0)" ::: "memory");
    __syncthreads();
    if (w == 0 && lane == 0) { __builtin_amdgcn_fence(__ATOMIC_RELEASE, "agent"); asm volatile("s_waitcnt vmcnt(0)" ::: "memory"); __hip_atomic_store(F.ctl + CW_SF + l * 32 + g, 1u, RLX_AGENT); }
}

struct OneUnit {
    pg8::Unit u0;
    __device__ __forceinline__ bool next(int i, pg8::Unit& u) const { if (i != 0) return false; u = u0; return true; }
    __device__ __forceinline__ void a_ready(const pg8::Unit&) const {}
    __device__ __forceinline__ void done(const pg8::Unit&) const {}
};
struct S5Order {
    int G, c;
    __device__ __forceinline__ bool next(int i, pg8::Unit& u) const { const int L = i * G + c; if (L >= 256) return false; const int g = L >> 3, wi = L & 7; u.pm = 4 * g + (wi >> 1); u.pn = 2 * g + (wi & 1); return true; }
    __device__ __forceinline__ void a_ready(const pg8::Unit&) const {}
    __device__ __forceinline__ void done(const pg8::Unit&) const {}
};
namespace pg8 {
struct EpiS5 {
    static constexpr bool PERM = true, AFTER_DRAIN = false; static constexpr int MIDT = 0, MIDT2 = 0;
    const bf16_t* Pm; bf16_t* YG; const float* dsk;
    __device__ __forceinline__ void operator()(const f32x4 (&acc)[2][2][4][2], const Unit& u, int wr, int wc, int fr, int fq) const {
        const int g = u.pm >> 2, rg0 = (u.pm & 3) * BM + wr * 64 + fr, cg0 = (u.pn & 1) * BM + wc * 32 + 8 * fq;
        const int colq = g * 16 + (cg0 & 15);
        const f32x4 d0 = *(const PG8_GAS f32x4*)(dsk + colq), d1 = *(const PG8_GAS f32x4*)(dsk + colq + 4);
#pragma unroll
        for (int ai = 0; ai < 2; ++ai) {
            u32x4 ul[4][2];
#pragma unroll
            for (int m = 0; m < 4; ++m) { const int rg = rg0 + ai * HALF + m * 16, b = rg >> 6, c = rg & 63;
#pragma unroll
                for (int bj = 0; bj < 2; ++bj) { const int cg = cg0 + bj * HALF, tau = cg >> 4, ch = cg & 15; const size_t row = (size_t)b * 2048 + c * 32 + tau; const int col = g * 16 + ch;
                    ul[m][bj] = *(const PG8_GAS u32x4*)(Pm + ((size_t)g * 1024 + rg) * 640 + cg); (void)row; (void)col; } }
#pragma unroll
            for (int m = 0; m < 4; ++m) { const int rg = rg0 + ai * HALF + m * 16, b = rg >> 6, c = rg & 63;
#pragma unroll
                for (int bj = 0; bj < 2; ++bj) { const int cg = cg0 + bj * HALF, tau = cg >> 4, ch = cg & 15; const size_t row = (size_t)b * 2048 + c * 32 + tau; const int col = g * 16 + ch;
                    const u32x4 u8 = ul[m][bj];
                    const f32x4 a0 = acc[ai][bj][m][0], a1 = acc[ai][bj][m][1];
                    float y[8] = {a0[0] + d0[0] * bf_lo(u8.x), a0[1] + d0[1] * bf_hi(u8.x), a0[2] + d0[2] * bf_lo(u8.y), a0[3] + d0[3] * bf_hi(u8.y),
                                  a1[0] + d1[0] * bf_lo(u8.z), a1[1] + d1[1] * bf_hi(u8.z), a1[2] + d1[2] * bf_lo(u8.w), a1[3] + d1[3] * bf_hi(u8.w)};
#pragma unroll
                    for (int j = 0; j < 8; ++j) { const float x = y[j], t = fminf(0.7978845608028654f * (x + 0.044715f * x * x * x), 15.0f); const float e = __expf(2.0f * t); y[j] = x * (1.0f - __builtin_amdgcn_rcpf(e + 1.0f)); }
                    u32x4 w; w.x = cvt_pk_bf16(y[0], y[1]); w.y = cvt_pk_bf16(y[2], y[3]); w.z = cvt_pk_bf16(y[4], y[5]); w.w = cvt_pk_bf16(y[6], y[7]);
                    *(PG8_GAS u32x4*)(YG + row * 512 + col) = w; } } }
    }
};
}


__device__ __forceinline__ void w2_quant_item(const Args& A, Frame& F, int l, int item, LAS float* scr) {
    const int lane = lane_id();
    const float* W = A.in[23] + (size_t)l * 4096 * 1024; unsigned char* WQ = (unsigned char*)wptr(F, l, WO_2);
    const int kb = item >> 5, nb = item & 31, k0 = 64 * kb, n0 = 32 * nb;
    const int kr = lane >> 3, c4 = lane & 7; float sc[4];
#pragma unroll
    for (int e_ = 0; e_ < 4; ++e_) sc[e_] = 448.0f / fmaxf(__uint_as_float(__hip_atomic_load(F.ctl + CW_WMAX + l * 1024 + n0 + 4 * c4 + e_, RLX_AGENT)), 1e-30f);
#pragma unroll
    for (int i = 0; i < 8; ++i) { const int kk = 8 * i + kr; const f32x4_t v = *(const GAS f32x4_t*)(W + (size_t)(k0 + kk) * 1024 + n0 + 4 * c4);
#pragma unroll
        for (int e_ = 0; e_ < 4; ++e_) scr[kk * 33 + 4 * c4 + e_] = v[e_] * sc[e_]; }
    LDS_WAIT(); asm volatile("" ::: "memory");
#pragma unroll
    for (int j = 0; j < 2; ++j) { const int c = lane + 64 * j, n = c >> 2, part = c & 3; const LAS float* s = scr + (16 * part) * 33 + n;
        v4u o;
#pragma unroll
        for (int q = 0; q < 4; ++q) o[q] = pg8::pk4_fp8(s[(4 * q) * 33], s[(4 * q + 1) * 33], s[(4 * q + 2) * 33], s[(4 * q + 3) * 33]);
        *(GAS v4u*)(WQ + (size_t)(n0 + n) * 4096 + k0 + 16 * part) = o; }
    LDS_WAIT(); asm volatile("" ::: "memory");
}

__device__ __forceinline__ void w1_quant_item(const Args& A, Frame& F, int l, int item, LAS float* scr) {
    const int lane = lane_id();
    const float* W = A.in[22] + (size_t)l * 1024 * 4096; unsigned char* WQ = (unsigned char*)wptr(F, l, WO_1);
    const int kb = item >> 7, nb = item & 127, k0 = 64 * kb, n0 = 32 * nb;
    const int kr = lane >> 3, c4 = lane & 7; float sc[4];
#pragma unroll
    for (int e_ = 0; e_ < 4; ++e_) sc[e_] = 448.0f / fmaxf(__uint_as_float(__hip_atomic_load(F.ctl + CW_WMAX1 + l * 4096 + n0 + 4 * c4 + e_, RLX_AGENT)), 1e-30f);
#pragma unroll
    for (int i = 0; i < 8; ++i) { const int kk = 8 * i + kr; const f32x4_t v = *(const GAS f32x4_t*)(W + (size_t)(k0 + kk) * 4096 + n0 + 4 * c4); const float g = A.in[21][l * 1024 + k0 + kk];
#pragma unroll
        for (int e_ = 0; e_ < 4; ++e_) scr[kk * 33 + 4 * c4 + e_] = v[e_] * g * sc[e_]; }
    LDS_WAIT(); asm volatile("" ::: "memory");
#pragma unroll
    for (int j = 0; j < 2; ++j) { const int c = lane + 64 * j, n = c >> 2, part = c & 3; const LAS float* s = scr + (16 * part) * 33 + n;
        v4u o;
#pragma unroll
        for (int q = 0; q < 4; ++q) o[q] = pg8::pk4_fp8(s[(4 * q) * 33], s[(4 * q + 1) * 33], s[(4 * q + 2) * 33], s[(4 * q + 3) * 33]);
        *(GAS v4u*)(WQ + (size_t)(n0 + n) * 1024 + k0 + 16 * part) = o; }
    LDS_WAIT(); asm volatile("" ::: "memory");
}
__device__ __forceinline__ void hq_phase(Frame& F, const stat_t* ss) {
    const int lane = lane_id();
    const int gw = F.vcu * NWAVES + F.wave, NGW = F.G * NWAVES;
    const bf16* Hb = (const bf16*)(F.ws + WS_HB); unsigned char* HQ = F.ws + WS_HQ;
    for (int m0 = gw * 4; m0 < MVALID; m0 += NGW * 4) {
        v4u hw[4][2]; float r[4];
#pragma unroll
        for (int q = 0; q < 4; ++q) { const GAS v4u* h16 = (const GAS v4u*)(Hb + (size_t)(m0 + q) * DM) + 2 * lane;
            hw[q][0] = h16[0]; hw[q][1] = h16[1];
            r[q] = 8.0f * rsqrtf(stat_get(ss + m0 + q) * (1.0f / 1024.0f) + pg8::RMS_EPS); }
#pragma unroll
        for (int q = 0; q < 4; ++q) { v4u o;
#pragma unroll
            for (int i = 0; i < 2; ++i) { const v4u hv = hw[q][i];
                o[2 * i] = pg8::pk4_fp8(bflo(hv.x) * r[q], bfhi(hv.x) * r[q], bflo(hv.y) * r[q], bfhi(hv.y) * r[q]); o[2 * i + 1] = pg8::pk4_fp8(bflo(hv.z) * r[q], bfhi(hv.z) * r[q], bflo(hv.w) * r[q], bfhi(hv.w) * r[q]); }
            *((GAS v4u*)(HQ + (size_t)(m0 + q) * 1024) + lane) = o; }
    }
}
__device__ __forceinline__ void mixers_naive_phase(const Args& A, Frame& F, int l) {
    LAS float* wl = (LAS float*)(F.lds + RING_OFF + F.wave * 16384);
    if (l == 0) {
        const int gw = F.vcu * NWAVES + F.wave, NGW = F.G * NWAVES;
        for (int it = gw; it < DEPTH * 2048; it += NGW) w2_quant_item(A, F, it >> 11, it & 2047, wl);
        for (int it = gw; it < DEPTH * 2048; it += NGW) w1_quant_item(A, F, it >> 11, it & 2047, wl);
        __syncthreads();
    }
    {
        const int x0 = (int)(xb_xcc_id() & 7u);
        int xq = x0;
        gu32* qbase = F.ctl + CW_Q + 64 * (4 + 8 * l);
        for (;;) {
            unsigned slot_a = (unsigned)(size_t)(F.MISC + 16); asm volatile("" : "+s"(slot_a));
            volatile LAS unsigned* slot = (volatile LAS unsigned*)(size_t)slot_a;
            if (F.wave == 0 && lane_id() == 0) {
                unsigned v = __hip_atomic_fetch_add(qbase + 64 * xq, 1u, RLX_AGENT); int nq = xq;
                if (v >= 68u) {
                    unsigned hd[7];
#pragma unroll
                    for (int q = 0; q < 7; ++q) hd[q] = __hip_atomic_load(qbase + 64 * ((x0 + 1 + q) & 7), RLX_AGENT);
                    nq = -1;
#pragma unroll
                    for (int q = 6; q >= 0; --q) if (hd[q] < 68u) nq = (x0 + 1 + q) & 7;
                }
                slot[0] = v; slot[1] = (unsigned)nq; }
            __syncthreads();
            const int idx = (int)slot[0], nq = (int)slot[1];
            __syncthreads();
            if (idx >= 4 + 64) { if (nq < 0) break; xq = nq; continue; }
            if (idx < 4) { s5_scan_task(A, F, l, 4 * xq + idx); continue; }
            { const int i2 = idx - 4; dsa_unit(A, F, l, 2 * xq + (i2 & 1), 31 - (i2 >> 1)); }
        }
    }
    gu32* head = F.ctl + CW_Q + 64 * l;
    constexpr int N_S5 = 32, N_SB = BATCH * 4 * 64, N_META_Q = 2 * NMETA, TOTAL = N_S5 + N_SB + N_META_Q;
    for (;;) {
        int idx = 0;
        if (lane_id() == 0) idx = (int)__hip_atomic_fetch_add(head, 1u, RLX_AGENT);
        idx = __builtin_amdgcn_readfirstlane(idx);
        if (idx >= TOTAL) break;
        if (idx < N_S5) { s5_naive_item(A, F, l, 0, idx); continue; }
        idx -= N_S5;
        if (idx < N_META_Q) { if (idx < NMETA) dsa_naive_item(A, F, l, MREAL + idx, wl); else sb_naive_item(A, F, l, MREAL + (idx - NMETA), wl); continue; }
        idx -= N_META_Q;
        sb_mfma_unit(A, F, l, (idx & ~63) | (63 - (idx & 63)), (LAS unsigned char*)wl);
    }
    __syncthreads();
    {
        gu32* head3 = F.ctl + CW_Q + 64 * (20 + l);
        for (;;) {
            unsigned slot_a = (unsigned)(size_t)(F.MISC + 16); asm volatile("" : "+s"(slot_a));
            volatile LAS unsigned* slot = (volatile LAS unsigned*)(size_t)slot_a;
            if (F.wave == 0 && lane_id() == 0) { const unsigned v = __hip_atomic_fetch_add(head3, 1u, RLX_AGENT);
                if (v < 256u) { gu32* sf = F.ctl + CW_SF + l * 32 + (int)(v >> 3); unsigned sp = 0u; while (__hip_atomic_load(sf, RLX_AGENT) == 0u) { __builtin_amdgcn_s_sleep(2); if (++sp > (1u << 22)) break; }
                    __builtin_amdgcn_fence(__ATOMIC_ACQUIRE, "agent"); }
                slot[0] = v; }
            __syncthreads();
            const int idx = (int)slot[0];
            __syncthreads();
            if (idx >= 256) break;
            const int g_ = idx >> 3, wi = idx & 7;
            pg8::Gemm gm{(bf16*)(F.ws + WS_U), (bf16*)(F.ws + WS_TZ + (size_t)l * TZ_LAYER), 32 * S5RG, 32 * 512, S5KU};
            OneUnit S{pg8::Unit{4 * g_ + (wi >> 1), 2 * g_ + (wi & 1)}};
            pg8::EpiS5 E{(bf16*)(F.ws + WS_U), (bf16*)(F.ws + WS_YG), A.in[15] + l * 512};
            pg8::gemm_phase<pg8::EpiS5, OneUnit, true, true>(F.lds + RING_OFF, gm, S, E, F.wave);
        }
    }
}

__device__ __forceinline__ void final_phase(const Args& A, Frame& F) {
    const int lane = lane_id();
    const int gw = F.vcu * NWAVES + F.wave, NGW = F.G * NWAVES;
    const bf16* Hb = (const bf16*)(F.ws + WS_HB); const stat_t* ss = stat_ptr(F, DEPTH, ST_SS1); const float* fg = A.in[24];
    for (int m0 = gw * 4; m0 < MREAL; m0 += NGW * 4) {
        v4u hw[4][2]; float r[4];
#pragma unroll
        for (int q = 0; q < 4; ++q) { const GAS v4u* h16 = (const GAS v4u*)(Hb + (size_t)(m0 + q) * DM) + lane;
            hw[q][0] = h16[0]; hw[q][1] = h16[64];
            r[q] = rsqrtf(stat_get(ss + m0 + q) * (1.0f / 1024.0f) + pg8::RMS_EPS); }
#pragma unroll
        for (int q = 0; q < 4; ++q) { GAS f32x4* o = (GAS f32x4*)(F.out + (size_t)(m0 + q) * DM) + 2 * lane;
#pragma unroll
            for (int jh = 0; jh < 2; ++jh) { const v4u hv = hw[q][jh]; const f32x4 g0 = *((const GAS f32x4*)fg + 2 * lane + 128 * jh), g1 = *((const GAS f32x4*)fg + 2 * lane + 128 * jh + 1);
                o[128 * jh] = (f32x4){bflo(hv.x) * r[q] * g0.x, bfhi(hv.x) * r[q] * g0.y, bflo(hv.y) * r[q] * g0.z, bfhi(hv.y) * r[q] * g0.w};
                o[128 * jh + 1] = (f32x4){bflo(hv.z) * r[q] * g1.x, bfhi(hv.z) * r[q] * g1.y, bflo(hv.w) * r[q] * g1.z, bfhi(hv.w) * r[q] * g1.w}; } }
    }
}


struct MetaArgs { const bf16* A; const bf16* Bt; int N, K; bf16* O; bf16* H; const bf16* Y; const stat_t* ss; stat_t* so; const stat_t* ssb; const stat_t* ssa; const stat_t* ssc; const unsigned* wmax; };
template <int KIND> __device__ __forceinline__ void meta_gemm(Frame& F, const MetaArgs& a, LAS float* red  ) {
    const int lane = lane_id(), w = F.wave, m16 = lane & 15, kg = lane >> 4;
    const int kw = a.K / 8;
    for (int cb = F.vcu; cb < a.N / 16; cb += F.G) {
        f32x4_t acc = (f32x4_t){0.f, 0.f, 0.f, 0.f};
        const bf16* ap = a.A + (size_t)(MREAL + m16) * a.K + w * kw + 8 * kg;
        const bf16* bp = a.Bt + (size_t)(cb * 16 + m16) * a.K + w * kw + 8 * kg;
        constexpr int KW = (KIND == 1 ? 512 : (KIND == 4 ? 4096 : 1024)) / 8, NS = KW / 32, GS = NS < 8 ? NS : 8;
        if constexpr (KIND == 3) {
            const unsigned char* ap8 = (const unsigned char*)a.A + (size_t)(MREAL + m16) * 1024 + w * 128 + 8 * kg;
            const unsigned char* bp8 = (const unsigned char*)a.Bt + (size_t)(cb * 16 + m16) * 1024 + w * 128 + 8 * kg;
            long fa[4], fb[4];
#pragma unroll
            for (int s = 0; s < 4; ++s) { fa[s] = *(const GAS long*)(ap8 + 32 * s); fb[s] = *(const GAS long*)(bp8 + 32 * s); }
#pragma unroll
            for (int s = 0; s < 4; ++s) acc = __builtin_amdgcn_mfma_f32_16x16x32_fp8_fp8(fa[s], fb[s], acc, 0, 0, 0);
        } else if constexpr (KIND == 4) {
            const unsigned char* ap8 = (const unsigned char*)a.A + (size_t)(MREAL + m16) * 4096 + w * 512 + 8 * kg;
            const unsigned char* bp8 = (const unsigned char*)a.Bt + (size_t)(cb * 16 + m16) * 4096 + w * 512 + 8 * kg;
#pragma unroll
            for (int s0 = 0; s0 < 16; s0 += 8) { long fa[8], fb[8];
#pragma unroll
                for (int s = 0; s < 8; ++s) { fa[s] = *(const GAS long*)(ap8 + 32 * (s0 + s)); fb[s] = *(const GAS long*)(bp8 + 32 * (s0 + s)); }
#pragma unroll
                for (int s = 0; s < 8; ++s) acc = __builtin_amdgcn_mfma_f32_16x16x32_fp8_fp8(fa[s], fb[s], acc, 0, 0, 0); }
        } else {
#pragma unroll
        for (int s0 = 0; s0 < NS; s0 += GS) { bf16x8_t fa[GS], fb[GS];
#pragma unroll
            for (int s = 0; s < GS; ++s) { fa[s] = *(const GAS bf16x8_t*)(ap + 32 * (s0 + s)); fb[s] = *(const GAS bf16x8_t*)(bp + 32 * (s0 + s)); }
#pragma unroll
            for (int s = 0; s < GS; ++s) acc = __builtin_amdgcn_mfma_f32_16x16x32_bf16(fa[s], fb[s], acc, 0, 0, 0); }
        }
        *(LAS f32x4_t*)(red + (w * 64 + lane) * 4) = acc;
        __syncthreads();
        if (w == 0) {
            const int col = cb * 16 + m16;
#pragma unroll
            for (int r = 0; r < 4; ++r) { const int row = MREAL + 4 * kg + r; float v = 0.f;
                if (KIND == 2) {
                    const float rb = rsqrtf(stat_get(a.ssb + row) * (1.0f / 512.0f) + pg8::RMS_EPS), ra = rsqrtf(stat_get(a.ssa + row) * (1.0f / 256.0f) + pg8::RMS_EPS), rc = rsqrtf(stat_get(a.ssc + row) * (1.0f / 256.0f) + pg8::RMS_EPS);
#pragma unroll
                    for (int ww = 0; ww < 8; ++ww) v += red[(ww * 64 + lane) * 4 + r] * (ww < 4 ? rb : (ww < 6 ? ra : rc));
                } else {
#pragma unroll
                    for (int ww = 0; ww < 8; ++ww) v += red[(ww * 64 + lane) * 4 + r];
                }
                float sq = 0.f; stat_t* sp = nullptr;
                if (KIND == 0) { v *= rsqrtf(stat_get(a.ss + row) * (1.0f / 1024.0f) + pg8::RMS_EPS); const unsigned wv = f2bf(v); a.O[(size_t)row * NIN + col] = (bf16)wv;
                    if (col >= PC_CKV && col < PC_IK) { const float x = __uint_as_float(wv << 16); sq = x * x; sp = a.so; } }
                else if (KIND == 1) { const float y = bf2f(a.Y[(size_t)row * 512 + col]); const unsigned wv = f2bf(y / (1.0f + __expf(-v))); a.O[(size_t)row * 1024 + col] = (bf16)wv; const float x = __uint_as_float(wv << 16); sq = x * x; sp = a.so; }
                else if (KIND == 2 || KIND == 4) { if (KIND == 4) v *= fmaxf(__uint_as_float(a.wmax[col]), 1e-30f) * (1.0f / (448.0f * pg8::HID_SCALE));
                    const unsigned wv = f2bf(bf2f(a.H[(size_t)row * 1024 + col]) + v); a.H[(size_t)row * 1024 + col] = (bf16)wv; const float x = __uint_as_float(wv << 16); sq = x * x; sp = a.so; }
                else { v *= fmaxf(__uint_as_float(a.wmax[col]), 1e-30f) * (1.0f / (448.0f * 8.0f)); v = fmaxf(v, 0.f); ((unsigned char*)a.O)[(size_t)row * DFF + col] = (unsigned char)(pg8::pk4_fp8(v * v * pg8::HID_SCALE, 0.f, 0.f, 0.f) & 0xffu); }
                if (KIND != 3) { sq += __shfl_xor(sq, 1); sq += __shfl_xor(sq, 2); sq += __shfl_xor(sq, 4); sq += __shfl_xor(sq, 8);
                    if (m16 == 0 && sp != nullptr) pg8::stat_add(sp + row, sq); }
            }
        }
        __syncthreads();
    }
}

#define IN(k) (lo <= (k) && (k) < hi)
#define SEAM(k) do { if (IN(k) && IN((k) + 1)) xcd_barrier(bar, F.wave); } while (0)
__device__ __forceinline__ unsigned char* opaque_ptr(unsigned char* p) { asm volatile("" : "+s"(p)); return p; }
__device__ __forceinline__ stat_t* stat_at(unsigned char* ws, int l, int id) { return (stat_t*)(ws + WS_STATS) + (size_t)(l * ST_PER_LAYER + id) * STAT_STRIDE; }
__device__ __forceinline__ bf16* w_at(unsigned char* ws, int l, size_t off) { return (bf16*)(ws + WS_W + (size_t)l * W_LAYER + off); }
template <int l> __device__ __forceinline__ void layer_phases(const Args& args, Frame& F, const XcdBarrier& bar, int lo, int hi) {
    const int pb = 8 * l;
    if (IN(pb + 1)) {
        unsigned char* ws = opaque_ptr(args.ws);
        { MetaArgs ma{(bf16*)(ws + WS_HB), w_at(ws, l, WO_IN), NIN, DM, (bf16*)(ws + WS_P), nullptr, nullptr, stat_at(ws, l, ST_SS1), stat_at(ws, l, ST_SSKV), nullptr, nullptr, nullptr, nullptr}; meta_gemm<0>(F, ma, (LAS float*)(F.lds + RING_OFF)); }
        pg8::Gemm g{(bf16*)(ws + WS_HB), w_at(ws, l, WO_IN), MREAL, NIN, DM}; pg8::StaticOrder S; S.init(MREAL, NIN, F.G, (int)blockIdx.x);
        pg8::EpiIn E{(bf16*)(ws + WS_P), stat_at(ws, l, ST_SS1), stat_at(ws, l, ST_SSKV), (bf16*)(ws + WS_U)};
        pg8::gemm_phase<pg8::EpiIn, pg8::StaticOrder, true, true>(F.lds + RING_OFF, g, S, E, F.wave);
    } SEAM(pb + 1);
    if (IN(pb + 2)) { mixers_naive_phase(args, F, l); } SEAM(pb + 2);
    if (IN(pb + 4)) {
        unsigned char* ws = opaque_ptr(args.ws);
        { MetaArgs ma{(bf16*)(ws + WS_YG), w_at(ws, l, WO_GLU), 512, 512, (bf16*)(ws + WS_YCAT), nullptr, (bf16*)(ws + WS_YG), nullptr, stat_at(ws, l, ST_SSB), nullptr, nullptr, nullptr, nullptr}; meta_gemm<1>(F, ma, (LAS float*)(F.lds + RING_OFF)); }
        pg8::Gemm g{(bf16*)(ws + WS_YG), w_at(ws, l, WO_GLU), MREAL, 512, 512}; pg8::StaticOrder S; S.init(MREAL, 512, F.G, (int)blockIdx.x);
        pg8::EpiGlu E{(bf16*)(ws + WS_YG), (bf16*)(ws + WS_YCAT), stat_at(ws, l, ST_SSB)};
        pg8::gemm_phase<pg8::EpiGlu, pg8::StaticOrder, true, true>(F.lds + RING_OFF, g, S, E, F.wave);
    } SEAM(pb + 4);
    if (IN(pb + 5)) {
        unsigned char* ws = opaque_ptr(args.ws);
        { MetaArgs ma{(bf16*)(ws + WS_YCAT), w_at(ws, l, WO_OUT), DM, DM, nullptr, (bf16*)(ws + WS_HB), nullptr, nullptr, stat_at(ws, l, ST_SS2), stat_at(ws, l, ST_SSB), stat_at(ws, l, ST_SSA), stat_at(ws, l, ST_SSC), nullptr}; meta_gemm<2>(F, ma, (LAS float*)(F.lds + RING_OFF)); }
        pg8::Gemm g{(bf16*)(ws + WS_YCAT), w_at(ws, l, WO_OUT), MREAL, DM, DM}; pg8::StaticOrder S; S.init(MREAL, DM, F.G, (int)blockIdx.x);
        pg8::EpiRes<true> E{(bf16*)(ws + WS_HB), stat_at(ws, l, ST_SS2), stat_at(ws, l, ST_SSB), stat_at(ws, l, ST_SSA), stat_at(ws, l, ST_SSC)};
        pg8::gemm_phase<pg8::EpiRes<true>, pg8::StaticOrder, true, true>(F.lds + RING_OFF, g, S, E, F.wave);
    } SEAM(pb + 5);
    if (IN(pb + 6)) { hq_phase(F, stat_at(opaque_ptr(args.ws), l, ST_SS2)); } SEAM(pb + 6);
    if (IN(pb + 7)) {
        unsigned char* ws = opaque_ptr(args.ws);
        { MetaArgs ma{(bf16*)(ws + WS_HQ), w_at(ws, l, WO_1), DFF, DM, (bf16*)(ws + WS_BIG), nullptr, nullptr, nullptr, nullptr, nullptr, nullptr, nullptr, (const unsigned*)(ws + WS_CTL) + CW_WMAX1 + l * 4096}; meta_gemm<3>(F, ma, (LAS float*)(F.lds + RING_OFF)); }
        pg8::Gemm g{(bf16*)(ws + WS_HQ), w_at(ws, l, WO_1), MREAL, DFF, DM / 2}; pg8::StaticOrder S; S.init(MREAL, DFF, F.G, (int)blockIdx.x);
        pg8::EpiMlp1F8B E{(unsigned char*)(ws + WS_BIG), (const unsigned*)(ws + WS_CTL) + CW_WMAX1 + l * 4096};
        pg8::gemm_phase<pg8::EpiMlp1F8B, pg8::StaticOrder, true, true, true>(F.lds + RING_OFF, g, S, E, F.wave);
    } SEAM(pb + 7);
    if (IN(pb + 8)) {
        unsigned char* ws = opaque_ptr(args.ws);
        { MetaArgs ma{(bf16*)(ws + WS_BIG), w_at(ws, l, WO_2), DM, DFF, nullptr, (bf16*)(ws + WS_HB), nullptr, nullptr, stat_at(ws, l + 1, ST_SS1), nullptr, nullptr, nullptr, (const unsigned*)(ws + WS_CTL) + CW_WMAX + l * 1024}; meta_gemm<4>(F, ma, (LAS float*)(F.lds + RING_OFF)); }
        pg8::Gemm g{(bf16*)(ws + WS_BIG), w_at(ws, l, WO_2), MREAL, DM, DFF / 2}; pg8::StaticOrder S; S.init(MREAL, DM, F.G, (int)blockIdx.x);
        pg8::EpiRes8 E{(bf16*)(ws + WS_HB), stat_at(ws, l + 1, ST_SS1), (const unsigned*)(ws + WS_CTL) + CW_WMAX + l * 1024};
        pg8::gemm_phase<pg8::EpiRes8, pg8::StaticOrder, true, true, true>(F.lds + RING_OFF, g, S, E, F.wave);
    } SEAM(pb + 8);
}
#undef IN
#undef SEAM
constexpr int N_PHASES = 18;
#if defined(__HIP_DEVICE_COMPILE__)
#define MK_NO_PK_F32 __attribute__((target("no-packed-fp32-ops")))
#else
#define MK_NO_PK_F32
#endif
__global__ void __launch_bounds__(NWAVES * 64, 2) MK_NO_PK_F32 hymba_fwd(Args args) {
    extern __shared__ __attribute__((aligned(16))) unsigned char lds[];
    Frame F;
    F.lds = (LAS unsigned char*)lds;
    F.MISC = (volatile LAS unsigned*)(F.lds + MISC_OFF);
    F.wave = __builtin_amdgcn_readfirstlane((int)threadIdx.x >> 6);
    F.G = gridDim.x; { const int bx = blockIdx.x; F.vcu = (F.G % 8 == 0) ? (bx % 8) * (F.G / 8) + bx / 8 : bx; }
    F.out = args.out; F.ws = args.ws;
    F.ctl = (gu32*)(args.ws + WS_CTL);
    for (int u = threadIdx.x; u < (LDS_BYTES - LDSCTL_OFF) / 4; u += NWAVES * 64) ((LAS unsigned*)(F.lds + LDSCTL_OFF))[u] = 0u;
    __syncthreads();
    const int lo = args.ph_lo, hi = args.ph_hi;
    const bool multi = (hi - lo) > 1;
    XcdBarrier bar; bar.bar = (unsigned*)(F.ctl + CW_BAR); bar.x = 0; bar.st = F.MISC + 8;
    if (multi) bar = xcd_barrier_post((unsigned*)(F.ctl + CW_BAR), F.MISC + 8, F.wave);
#define IN(k) (lo <= (k) && (k) < hi)
#define SEAM(k) do { if (IN(k) && IN((k) + 1)) xcd_barrier(bar, F.wave); } while (0)
    if (IN(0)) { p0_prologue(args, F); } SEAM(0);
    layer_phases<0>(args, F, bar, lo, hi);
    layer_phases<1>(args, F, bar, lo, hi);
    if (IN(17)) { final_phase(args, F); }
#undef IN
#undef SEAM
}

#ifndef MK_ONE_LAUNCH
#define MK_ONE_LAUNCH 1
#endif
extern "C" void kernel_launch(void* const* d_in, const int* in_sizes, int n_in, void* d_out, int out_size, void* d_ws, size_t ws_size, hipStream_t stream) {
    static int grid = 0;
    if (grid == 0) {
        if (n_in != 25 || in_sizes[0] != MREAL * DM || out_size != MREAL * DM || ws_size < WS_END2) {
            fprintf(stderr, "kernel_launch: unexpected problem: n_in %d, in0 %d, out %d, ws %zu (need %zu); nothing launched\n", n_in, n_in > 0 ? in_sizes[0] : -1, out_size, ws_size, (size_t)WS_END2); grid = -1; return; }
        int dev = 0, cus = 0, per_cu = 0;
        if (hipGetDevice(&dev) != hipSuccess || hipDeviceGetAttribute(&cus, hipDeviceAttributeMultiprocessorCount, dev) != hipSuccess) { grid = -1; return; }
        if (hipFuncSetAttribute((const void*)hymba_fwd, hipFuncAttributeMaxDynamicSharedMemorySize, LDS_BYTES) != hipSuccess) { fprintf(stderr, "kernel_launch: hipFuncSetAttribute failed\n"); grid = -1; return; }
        if (hipOccupancyMaxActiveBlocksPerMultiprocessor(&per_cu, (const void*)hymba_fwd, NWAVES * 64, LDS_BYTES) != hipSuccess || per_cu < 1)
            fprintf(stderr, "kernel_launch: note: occupancy query reports %d workgroups per CU\n", per_cu);
        (void)hipGetLastError();
        grid = cus;
    }
    if (grid < 0) return;
    if (hipMemsetAsync((char*)d_ws + WS_CTL, 0, CTL_ZERO_BYTES, stream) != hipSuccess) { fprintf(stderr, "kernel_launch: memset failed\n"); return; }
    Args a{};
    for (int i = 0; i < 25; ++i) a.in[i] = (const float*)d_in[i];
    a.out = (float*)d_out; a.ws = (unsigned char*)d_ws;
#if MK_ONE_LAUNCH
    a.ph_lo = 0; a.ph_hi = N_PHASES;
    hipLaunchKernelGGL(hymba_fwd, dim3(grid), dim3(NWAVES * 64), LDS_BYTES, stream, a);
#else
    for (int p = 0; p < N_PHASES; ++p) { a.ph_lo = p; a.ph_hi = p + 1;
        hipLaunchKernelGGL(hymba_fwd, dim3(grid), dim3(NWAVES * 64), LDS_BYTES, stream, a); }
#endif
    const hipError_t le = hipPeekAtLastError();
    if (le != hipSuccess) fprintf(stderr, "kernel_launch: launch failed: %s\n", hipGetErrorName(le));
}
```

```cpp
#include <hip/hip_runtime.h>
#include <cstdio>
#include <cstdint>
namespace pg8 {
#define PG8_LAS __attribute__((address_space(3)))
typedef unsigned short bf16_t;
typedef short bf16x8 __attribute__((ext_vector_type(8)));
typedef float f32x4 __attribute__((ext_vector_type(4)));
typedef unsigned u32x4 __attribute__((ext_vector_type(4)));
constexpr int BM = 256, BK = 64, HALF = 128, HTB = HALF * BK * 2  , STAGE_BYTES = 8 * HTB, NXCD = 8, WGM = 8;

__host__ __device__ __forceinline__ int lds_byte(int r, int c) { const int st = (r >> 4) * 2 + (c >> 5), rr = r & 15, cc = c & 31, ob = rr * 64 + cc * 2; return st * 1024 + (ob ^ (((ob >> 9) & 1) << 5)); }
__host__ __device__ __forceinline__ void stage_rc(int b, int& R, int& C) { const int st = b / 1024, sb = b % 1024, swz = sb ^ (((sb >> 9) & 1) << 5); R = (st >> 1) * 16 + swz / 64; C = (st & 1) * 32 + (swz % 64) / 2; }
__host__ __device__ __forceinline__ int perm32(int rho) { const int n = rho >> 4, i = rho & 15; return 8 * (i >> 2) + 4 * n + (i & 3); }

struct Unit { int pm, pn; };
struct Gemm { const bf16_t* A; const bf16_t* Bt; int M, N, K; };

struct StaticOrder {
    int nM, nN, nwg, G, c;
    __host__ __device__ void init(int M, int N, int G_, int c_) { nM = M / BM; nN = N / BM; nwg = nM * nN; G = G_; c = c_; }
    __host__ __device__ bool next(int i, Unit& u) const {
        const long L = (long)i * G + c; if (L >= nwg) return false;
        int wgid = (int)L; { const int q = nwg / NXCD, r = nwg % NXCD, xcd = wgid % NXCD, off = wgid / NXCD; wgid = (xcd < r ? xcd * (q + 1) : r * (q + 1) + (xcd - r) * q) + off; }
        const int nig = WGM * nN, gid = wgid / nig, fm = gid * WGM, gsz = (nM - fm) < WGM ? (nM - fm) : WGM;
        u.pm = fm + ((wgid % nig) % gsz); u.pn = (wgid % nig) / gsz; return true;
    }
    __device__ __forceinline__ void a_ready(const Unit&) const {}
    __device__ __forceinline__ void done(const Unit&) const {}
};

__device__ __forceinline__ unsigned cvt_pk_bf16(float lo, float hi) { unsigned r; asm volatile("v_cvt_pk_bf16_f32 %0, %1, %2" : "=v"(r) : "v"(lo), "v"(hi)); return r; }
typedef float f32x2 __attribute__((ext_vector_type(2)));
#define PG8_GAS __attribute__((address_space(1)))
constexpr float RMS_EPS = 1e-6f;
__device__ __forceinline__ float bf_lo(unsigned w) { return __uint_as_float(w << 16); }
__device__ __forceinline__ float bf_hi(unsigned w) { return __uint_as_float(w & 0xffff0000u); }
typedef unsigned long long stat_t;
__device__ __forceinline__ void stat_add(stat_t* p, float q) { atomicAdd(p, (stat_t)((double)q * 4294967296.0)); }
__device__ __forceinline__ float stat_get(const stat_t* p) { const stat_t v = *p; return (float)(unsigned)(v >> 32) + (float)(unsigned)v * 2.3283064365386963e-10f; }
__device__ __forceinline__ float stat_val(stat_t s) { return (float)((double)s * (1.0 / 4294967296.0)); }
__device__ __forceinline__ float quad_sum(float q) { q += __shfl_xor(q, 16); q += __shfl_xor(q, 32); return q; }

struct EpiIn {
    static constexpr bool PERM = true, AFTER_DRAIN = false; static constexpr int MIDT = 0, MIDT2 = 0;
    bf16_t* O; const stat_t* ss; stat_t* sskv; bf16_t* U;
    __device__ __forceinline__ void operator()(const f32x4 (&acc)[2][2][4][2], const Unit& u, int wr, int wc, int fr, int fq) const {
        const int row0 = u.pm * BM + wr * 64 + fr, col0 = u.pn * BM + wc * 32 + 8 * fq;
        stat_t sv[2][4];
#pragma unroll
        for (int ai = 0; ai < 2; ++ai)
#pragma unroll
            for (int m = 0; m < 4; ++m) sv[ai][m] = *(const PG8_GAS stat_t*)(ss + row0 + ai * HALF + m * 16);
#pragma unroll
        for (int ai = 0; ai < 2; ++ai)
#pragma unroll
            for (int m = 0; m < 4; ++m) { const int row = row0 + ai * HALF + m * 16; const float r = rsqrtf(stat_val(sv[ai][m]) * (1.0f / 1024.0f) + RMS_EPS);
                bf16_t* rowp = O + (size_t)row * 2048 + col0;
#pragma unroll
                for (int bj = 0; bj < 2; ++bj) { const f32x4 v0 = acc[ai][bj][m][0] * r, v1 = acc[ai][bj][m][1] * r;
                    u32x4 w; w.x = cvt_pk_bf16(v0[0], v0[1]); w.y = cvt_pk_bf16(v0[2], v0[3]); w.z = cvt_pk_bf16(v1[0], v1[1]); w.w = cvt_pk_bf16(v1[2], v1[3]);
                    if (u.pn == 3 || u.pn == 4) {
                        const int gc = col0 + bj * HALF - 768, gg = gc >> 4, t = row & 2047;
                        *(PG8_GAS u32x4*)(U + ((size_t)gg * 1024 + (row >> 11) * 64 + (t >> 5)) * 640 + (t & 31) * 16 + (gc & 15)) = w; }
                    else *(PG8_GAS u32x4*)(rowp + bj * HALF) = w;
                    if (bj == 0 && u.pn == 1) { float q = (bf_lo(w.x) * bf_lo(w.x) + bf_hi(w.x) * bf_hi(w.x)) + (bf_lo(w.y) * bf_lo(w.y) + bf_hi(w.y) * bf_hi(w.y))
                                                      + (bf_lo(w.z) * bf_lo(w.z) + bf_hi(w.z) * bf_hi(w.z)) + (bf_lo(w.w) * bf_lo(w.w) + bf_hi(w.w) * bf_hi(w.w));
                        q = quad_sum(q); if (fq == 0) stat_add(sskv + row, q); } } }
    }
};
struct EpiGlu {
    static constexpr bool PERM = true, AFTER_DRAIN = false; static constexpr int MIDT = 0, MIDT2 = 0;
    const bf16_t* Y; bf16_t* O; stat_t* ssb;
    __device__ __forceinline__ void operator()(const f32x4 (&acc)[2][2][4][2], const Unit& u, int wr, int wc, int fr, int fq) const {
        const int row0 = u.pm * BM + wr * 64 + fr, col0 = u.pn * BM + wc * 32 + 8 * fq;
#pragma unroll
        for (int ai = 0; ai < 2; ++ai) {
            u32x4 yl[4][2];
#pragma unroll
            for (int m = 0; m < 4; ++m) { const int row = row0 + ai * HALF + m * 16; const PG8_GAS u32x4* rp = (const PG8_GAS u32x4*)(Y + (size_t)row * 512 + col0); yl[m][0] = rp[0]; yl[m][1] = rp[HALF / 8]; }
#pragma unroll
            for (int m = 0; m < 4; ++m) { const int row = row0 + ai * HALF + m * 16; float q = 0.f;
#pragma unroll
                for (int bj = 0; bj < 2; ++bj) { const u32x4 y8 = yl[m][bj];
                    const f32x4 g0 = acc[ai][bj][m][0], g1 = acc[ai][bj][m][1];
                    float o[8]; const float yv[8] = {bf_lo(y8.x), bf_hi(y8.x), bf_lo(y8.y), bf_hi(y8.y), bf_lo(y8.z), bf_hi(y8.z), bf_lo(y8.w), bf_hi(y8.w)};
                    const float gv[8] = {g0[0], g0[1], g0[2], g0[3], g1[0], g1[1], g1[2], g1[3]};
#pragma unroll
                    for (int j = 0; j < 8; ++j) o[j] = yv[j] * __builtin_amdgcn_rcpf(1.0f + __expf(-gv[j]));
                    u32x4 w; w.x = cvt_pk_bf16(o[0], o[1]); w.y = cvt_pk_bf16(o[2], o[3]); w.z = cvt_pk_bf16(o[4], o[5]); w.w = cvt_pk_bf16(o[6], o[7]);
                    *(PG8_GAS u32x4*)(O + (size_t)row * 1024 + col0 + bj * HALF) = w;
                    q += (bf_lo(w.x) * bf_lo(w.x) + bf_hi(w.x) * bf_hi(w.x)) + (bf_lo(w.y) * bf_lo(w.y) + bf_hi(w.y) * bf_hi(w.y))
                       + (bf_lo(w.z) * bf_lo(w.z) + bf_hi(w.z) * bf_hi(w.z)) + (bf_lo(w.w) * bf_lo(w.w) + bf_hi(w.w) * bf_hi(w.w)); }
                q = quad_sum(q); if (fq == 0) stat_add(ssb + row, q); } }
    }
};
template <bool OUT> struct EpiRes {
    static constexpr bool PERM = true, AFTER_DRAIN = false; static constexpr int MIDT = OUT ? 8 : 0, MIDT2 = OUT ? 12 : 0;
    bf16_t* H; stat_t* ssn; const stat_t* ssb; const stat_t* ssa; const stat_t* ssc;
    __device__ __forceinline__ void mid(f32x4 (&acc)[2][2][4][2], const Unit& u, int wr, int fr, int t) const {
        const stat_t* sn = (t == MIDT) ? ssb : ssa; const stat_t* sd = (t == MIDT) ? ssa : ssc;
        const float wn = (t == MIDT) ? (1.0f / 512.0f) : (1.0f / 256.0f);
        stat_t vn[2][4], vd[2][4];
#pragma unroll
        for (int ai = 0; ai < 2; ++ai)
#pragma unroll
            for (int m = 0; m < 4; ++m) { const int row = u.pm * BM + ai * HALF + wr * 64 + m * 16 + fr; vn[ai][m] = *(const PG8_GAS stat_t*)(sn + row); vd[ai][m] = *(const PG8_GAS stat_t*)(sd + row); }
#pragma unroll
        for (int ai = 0; ai < 2; ++ai)
#pragma unroll
            for (int m = 0; m < 4; ++m) {
                const float xn = stat_val(vn[ai][m]) * wn + RMS_EPS, xd = stat_val(vd[ai][m]) * (1.0f / 256.0f) + RMS_EPS;
                const float f = __builtin_amdgcn_sqrtf(xd * __builtin_amdgcn_rcpf(xn));
#pragma unroll
                for (int bj = 0; bj < 2; ++bj)
#pragma unroll
                    for (int n = 0; n < 2; ++n) acc[ai][bj][m][n] *= f; }
    }
    __device__ __forceinline__ void operator()(const f32x4 (&acc)[2][2][4][2], const Unit& u, int wr, int wc, int fr, int fq) const {
        const int row0 = u.pm * BM + wr * 64 + fr, col0 = u.pn * BM + wc * 32 + 8 * fq;
#pragma unroll
        for (int ai = 0; ai < 2; ++ai) {
            u32x4 h8[4][2]; stat_t sc[4];
#pragma unroll
            for (int m = 0; m < 4; ++m) { const int row = row0 + ai * HALF + m * 16; const PG8_GAS u32x4* rp = (const PG8_GAS u32x4*)(H + (size_t)row * 1024 + col0);
                h8[m][0] = rp[0]; h8[m][1] = rp[HALF / 8]; if (OUT) sc[m] = *(const PG8_GAS stat_t*)(ssc + row); }
#pragma unroll
            for (int m = 0; m < 4; ++m) { const int row = row0 + ai * HALF + m * 16; float q = 0.f; PG8_GAS u32x4* wp = (PG8_GAS u32x4*)(H + (size_t)row * 1024 + col0);
                float post = 1.0f; if (OUT) post = rsqrtf(stat_val(sc[m]) * (1.0f / 256.0f) + RMS_EPS);
#pragma unroll
                for (int bj = 0; bj < 2; ++bj) { const u32x4 hv = h8[m][bj];
                    const f32x4 a0 = acc[ai][bj][m][0] * post, a1 = acc[ai][bj][m][1] * post;
                    u32x4 w; w.x = cvt_pk_bf16(bf_lo(hv.x) + a0[0], bf_hi(hv.x) + a0[1]); w.y = cvt_pk_bf16(bf_lo(hv.y) + a0[2], bf_hi(hv.y) + a0[3]);
                    w.z = cvt_pk_bf16(bf_lo(hv.z) + a1[0], bf_hi(hv.z) + a1[1]); w.w = cvt_pk_bf16(bf_lo(hv.w) + a1[2], bf_hi(hv.w) + a1[3]);
                    wp[bj * (HALF / 8)] = w;
                    q += (bf_lo(w.x) * bf_lo(w.x) + bf_hi(w.x) * bf_hi(w.x)) + (bf_lo(w.y) * bf_lo(w.y) + bf_hi(w.y) * bf_hi(w.y))
                       + (bf_lo(w.z) * bf_lo(w.z) + bf_hi(w.z) * bf_hi(w.z)) + (bf_lo(w.w) * bf_lo(w.w) + bf_hi(w.w) * bf_hi(w.w)); }
                q = quad_sum(q); if (fq == 0) stat_add(ssn + row, q); } }
    }
};
struct EpiMlp1 {
    static constexpr bool PERM = true, AFTER_DRAIN = false; static constexpr int MIDT = 0, MIDT2 = 0;
    bf16_t* O; const stat_t* ss;
    __device__ __forceinline__ void operator()(const f32x4 (&acc)[2][2][4][2], const Unit& u, int wr, int wc, int fr, int fq) const {
        const int row0 = u.pm * BM + wr * 64 + fr, col0 = u.pn * BM + wc * 32 + 8 * fq;
#pragma unroll
        for (int ai = 0; ai < 2; ++ai)
#pragma unroll
            for (int m = 0; m < 4; ++m) { const int row = row0 + ai * HALF + m * 16; const float r = rsqrtf(stat_get(ss + row) * (1.0f / 1024.0f) + RMS_EPS);
                bf16_t* rowp = O + (size_t)row * 4096 + col0;
#pragma unroll
                for (int bj = 0; bj < 2; ++bj) { f32x4 v0 = acc[ai][bj][m][0] * r, v1 = acc[ai][bj][m][1] * r;
#pragma unroll
                    for (int j = 0; j < 4; ++j) { const float a = fmaxf(v0[j], 0.f), b = fmaxf(v1[j], 0.f); v0[j] = a * a; v1[j] = b * b; }
                    u32x4 w; w.x = cvt_pk_bf16(v0[0], v0[1]); w.y = cvt_pk_bf16(v0[2], v0[3]); w.z = cvt_pk_bf16(v1[0], v1[1]); w.w = cvt_pk_bf16(v1[2], v1[3]);
                    *(u32x4*)(rowp + bj * HALF) = w; } }
    }
};
__device__ __forceinline__ float relu_i(float x) { const int i = (int)__builtin_bit_cast(unsigned, x); return __builtin_bit_cast(float, (unsigned)(i > 0 ? i : 0)); }
__device__ __forceinline__ unsigned pk4_fp8(float a, float b, float c, float d) {
    a = __builtin_amdgcn_fmed3f(a, -448.f, 448.f); b = __builtin_amdgcn_fmed3f(b, -448.f, 448.f); c = __builtin_amdgcn_fmed3f(c, -448.f, 448.f); d = __builtin_amdgcn_fmed3f(d, -448.f, 448.f);
    int w = 0; w = __builtin_amdgcn_cvt_pk_fp8_f32(a, b, w, false); w = __builtin_amdgcn_cvt_pk_fp8_f32(c, d, w, true); return (unsigned)w;
}
constexpr float HID_SCALE = 0.25f; static_assert(HID_SCALE == 0.25f, "EpiMlp1F8B folds sqrt(HID_SCALE) = 0.5 into its column scales");
struct EpiMlp1F8 {
    static constexpr bool PERM = true, AFTER_DRAIN = false; static constexpr int MIDT = 0, MIDT2 = 0;
    unsigned char* O; const stat_t* ss;
    __device__ __forceinline__ void operator()(const f32x4 (&acc)[2][2][4][2], const Unit& u, int wr, int wc, int fr, int fq) const {
        typedef unsigned u32x2v __attribute__((ext_vector_type(2)));
        const int row0 = u.pm * BM + wr * 64 + fr, col0 = u.pn * BM + wc * 32 + 8 * fq;
#pragma unroll
        for (int ai = 0; ai < 2; ++ai)
#pragma unroll
            for (int m = 0; m < 4; ++m) { const int row = row0 + ai * HALF + m * 16; const float r = rsqrtf(stat_get(ss + row) * (1.0f / 1024.0f) + RMS_EPS);
                unsigned char* rowp = O + (size_t)row * 4096 + col0;
#pragma unroll
                for (int bj = 0; bj < 2; ++bj) { f32x4 v0 = acc[ai][bj][m][0] * r, v1 = acc[ai][bj][m][1] * r;
#pragma unroll
                    for (int j = 0; j < 4; ++j) { const float a = fmaxf(v0[j], 0.f), b = fmaxf(v1[j], 0.f); v0[j] = a * a * HID_SCALE; v1[j] = b * b * HID_SCALE; }
                    u32x2v w; w.x = pk4_fp8(v0[0], v0[1], v0[2], v0[3]); w.y = pk4_fp8(v1[0], v1[1], v1[2], v1[3]);
                    *(u32x2v*)(rowp + bj * HALF) = w; } }
    }
};
struct EpiMlp1F8B {
    static constexpr bool PERM = true, AFTER_DRAIN = false; static constexpr int MIDT = 0, MIDT2 = 0;
    unsigned char* O; const unsigned* wmax;
    __device__ __forceinline__ void operator()(const f32x4 (&acc)[2][2][4][2], const Unit& u, int wr, int wc, int fr, int fq) const {
        const int row0 = u.pm * BM + wr * 64 + fr, col0 = u.pn * BM + wc * 32 + 8 * fq;
        f32x4 cs[2][2];
#pragma unroll
        for (int bj = 0; bj < 2; ++bj)
#pragma unroll
            for (int n = 0; n < 2; ++n) { const u32x4 wm = *(const PG8_GAS u32x4*)(wmax + col0 + bj * HALF + 4 * n);
                cs[bj][n] = (f32x4){fmaxf(__uint_as_float(wm.x), 1e-30f), fmaxf(__uint_as_float(wm.y), 1e-30f), fmaxf(__uint_as_float(wm.z), 1e-30f), fmaxf(__uint_as_float(wm.w), 1e-30f)} * (0.5f / (448.0f * 8.0f)); }
        const bool odd = (fq & 1) != 0;
#pragma unroll
        for (int ai = 0; ai < 2; ++ai)
#pragma unroll
            for (int mp = 0; mp < 4; mp += 2) {
#pragma unroll
                for (int bj = 0; bj < 2; ++bj) { unsigned wa[2][2];
#pragma unroll
                    for (int q = 0; q < 2; ++q) { f32x4 v0 = acc[ai][bj][mp + q][0] * cs[bj][0], v1 = acc[ai][bj][mp + q][1] * cs[bj][1];
#pragma unroll
                        for (int j = 0; j < 4; ++j) { const float a = relu_i(v0[j]), b = relu_i(v1[j]); v0[j] = a * a; v1[j] = b * b; }
                        wa[q][0] = pk4_fp8(v0[0], v0[1], v0[2], v0[3]); wa[q][1] = pk4_fp8(v1[0], v1[1], v1[2], v1[3]); }
                    const unsigned s0 = odd ? wa[0][0] : wa[1][0], s1 = odd ? wa[0][1] : wa[1][1];
                    const unsigned r0 = (unsigned)__shfl_xor((int)s0, 16), r1 = (unsigned)__shfl_xor((int)s1, 16);
                    u32x4 o; if (odd) { o.x = r0; o.y = r1; o.z = wa[1][0]; o.w = wa[1][1]; } else { o.x = wa[0][0]; o.y = wa[0][1]; o.z = r0; o.w = r1; }
                    const int row = row0 + ai * HALF + (mp + (odd ? 1 : 0)) * 16;
                    *(PG8_GAS u32x4*)(O + (size_t)row * 4096 + (col0 & ~15) + bj * HALF) = o; } }
    }
};
struct EpiRes8 {
    static constexpr bool PERM = true, AFTER_DRAIN = false; static constexpr int MIDT = 0, MIDT2 = 0;
    bf16_t* H; stat_t* ssn; const unsigned* wmax;
    __device__ __forceinline__ void operator()(const f32x4 (&acc)[2][2][4][2], const Unit& u, int wr, int wc, int fr, int fq) const {
        const int row0 = u.pm * BM + wr * 64 + fr, col0 = u.pn * BM + wc * 32 + 8 * fq;
        f32x4 cs[2][2];
#pragma unroll
        for (int bj = 0; bj < 2; ++bj)
#pragma unroll
            for (int n = 0; n < 2; ++n) { const u32x4 wm = *(const u32x4*)(wmax + col0 + bj * HALF + 4 * n);
                cs[bj][n] = (f32x4){fmaxf(__uint_as_float(wm.x), 1e-30f), fmaxf(__uint_as_float(wm.y), 1e-30f), fmaxf(__uint_as_float(wm.z), 1e-30f), fmaxf(__uint_as_float(wm.w), 1e-30f)} * (1.0f / (448.0f * HID_SCALE)); }
#pragma unroll
        for (int ai = 0; ai < 2; ++ai) {
            u32x4 h8[4][2];
#pragma unroll
            for (int m = 0; m < 4; ++m) { const int row = row0 + ai * HALF + m * 16; const PG8_GAS u32x4* rp = (const PG8_GAS u32x4*)(H + (size_t)row * 1024 + col0); h8[m][0] = rp[0]; h8[m][1] = rp[HALF / 8]; }
#pragma unroll
            for (int m = 0; m < 4; ++m) { const int row = row0 + ai * HALF + m * 16; float q = 0.f; PG8_GAS u32x4* wp = (PG8_GAS u32x4*)(H + (size_t)row * 1024 + col0);
#pragma unroll
                for (int bj = 0; bj < 2; ++bj) { const u32x4 hv = h8[m][bj];
                    const f32x4 a0 = acc[ai][bj][m][0] * cs[bj][0], a1 = acc[ai][bj][m][1] * cs[bj][1];
                    u32x4 w; w.x = cvt_pk_bf16(bf_lo(hv.x) + a0[0], bf_hi(hv.x) + a0[1]); w.y = cvt_pk_bf16(bf_lo(hv.y) + a0[2], bf_hi(hv.y) + a0[3]);
                    w.z = cvt_pk_bf16(bf_lo(hv.z) + a1[0], bf_hi(hv.z) + a1[1]); w.w = cvt_pk_bf16(bf_lo(hv.w) + a1[2], bf_hi(hv.w) + a1[3]);
                    wp[bj * (HALF / 8)] = w;
                    q += (bf_lo(w.x) * bf_lo(w.x) + bf_hi(w.x) * bf_hi(w.x)) + (bf_lo(w.y) * bf_lo(w.y) + bf_hi(w.y) * bf_hi(w.y))
                       + (bf_lo(w.z) * bf_lo(w.z) + bf_hi(w.z) * bf_hi(w.z)) + (bf_lo(w.w) * bf_lo(w.w) + bf_hi(w.w) * bf_hi(w.w)); }
                q = quad_sum(q); if (fq == 0) stat_add(ssn + row, q); } }
    }
};
typedef int v8i_t __attribute__((ext_vector_type(8))); typedef int v4i_t __attribute__((ext_vector_type(4)));
template <class Epi, class Sched, bool ALIGN_EPI = false, bool SP2 = false, bool F8 = false>
__device__ __forceinline__ void gemm_phase(PG8_LAS unsigned char* lds, const Gemm g, const Sched& S, const Epi& E, const int wid_in) {
    int lane_; asm volatile("v_mbcnt_lo_u32_b32 %0, -1, 0\n\tv_mbcnt_hi_u32_b32 %0, -1, %0" : "=v"(lane_)); const int tid_ = wid_in * 64 + lane_;
    const int tid = tid_, wid = wid_in, lane = lane_, wr = wid >> 2, wc = wid & 3, fr = lane & 15, fq = lane >> 4;
    const int K = g.K, nt = K / BK;
    unsigned voffA[2], voffB[2];
#pragma unroll
    for (int i = 0; i < 2; ++i) { int R, C; stage_rc(tid * 16 + i * 8192, R, C); const int Rb = Epi::PERM ? ((R & ~31) + perm32(R & 31)) : R;
        voffA[i] = (unsigned)(R * K + C) * 2u; voffB[i] = (unsigned)(Rb * K + C) * 2u; }
    const size_t kstep = (size_t)(BK * 2);
    const size_t hstep = (size_t)HALF * K * 2;
    const size_t tstep = 2 * hstep;
    const unsigned ldsw = (unsigned)wid * 1024u;
    const int aoff = lds_byte(wr * 64 + fr, fq * 8), boff = lds_byte(wc * 32 + fr, fq * 8);
#define PG8_SA(b, h) (((b) * 2 + (h)) * HTB)
#define PG8_SB(b, h) ((4 + (b) * 2 + (h)) * HTB)
#define PG8_STAGE(bufoff, gbase, voff) do { _Pragma("unroll") for (int _i = 0; _i < 2; ++_i) \
        __builtin_amdgcn_global_load_lds((const unsigned*)((const char*)(gbase) + (voff)[_i]), (PG8_LAS unsigned*)(lds + (bufoff) + ldsw + _i * 8192), 16, 0, 0); } while (0)
#define PG8_LDA(dst, b, h) do { if constexpr (F8) { _Pragma("unroll") for (int m = 0; m < 4; ++m) dst##_8[m] = __builtin_shufflevector(*(const PG8_LAS v4i_t*)(lds + PG8_SA(b, h) + aoff + m * 2048), *(const PG8_LAS v4i_t*)(lds + PG8_SA(b, h) + aoff + m * 2048 + 1024), 0, 1, 2, 3, 4, 5, 6, 7); } \
        else { _Pragma("unroll") for (int m = 0; m < 4; ++m) _Pragma("unroll") for (int k = 0; k < 2; ++k) dst[m][k] = *(const PG8_LAS bf16x8*)(lds + PG8_SA(b, h) + aoff + m * 2048 + k * 1024); } } while (0)
#define PG8_LDB(dst, b, h) do { if constexpr (F8) { _Pragma("unroll") for (int n = 0; n < 2; ++n) dst##_8[n] = __builtin_shufflevector(*(const PG8_LAS v4i_t*)(lds + PG8_SB(b, h) + boff + n * 2048), *(const PG8_LAS v4i_t*)(lds + PG8_SB(b, h) + boff + n * 2048 + 1024), 0, 1, 2, 3, 4, 5, 6, 7); } \
        else { _Pragma("unroll") for (int n = 0; n < 2; ++n) _Pragma("unroll") for (int k = 0; k < 2; ++k) dst[n][k] = *(const PG8_LAS bf16x8*)(lds + PG8_SB(b, h) + boff + n * 2048 + k * 1024); } } while (0)
#define PG8_MMA(ai, bj, At, Bt) do { __builtin_amdgcn_s_setprio(1); \
        if constexpr (F8) { _Pragma("unroll") for (int m = 0; m < 4; ++m) _Pragma("unroll") for (int n = 0; n < 2; ++n) { \
            asm volatile("v_mfma_f32_16x16x128_f8f6f4 %0, %1, %2, %0" : "+v"(acc[ai][bj][m][n]) : "v"(Bt##_8[n]), "v"(At##_8[m])); } } \
        else { _Pragma("unroll") for (int m = 0; m < 4; ++m) _Pragma("unroll") for (int n = 0; n < 2; ++n) _Pragma("unroll") for (int k = 0; k < 2; ++k) \
            acc[ai][bj][m][n] = __builtin_amdgcn_mfma_f32_16x16x32_bf16(Bt[n][k], At[m][k], acc[ai][bj][m][n], 0, 0, 0); } \
        __builtin_amdgcn_s_setprio(0); } while (0)
#define PG8_WAIT_V(n) asm volatile("s_waitcnt vmcnt(" #n ")" ::: "memory")
#define PG8_WAIT_L(n) asm volatile("s_waitcnt lgkmcnt(" #n ")" ::: "memory")
#define PG8_BAR __builtin_amdgcn_s_barrier()
#define PG8_SCHED __builtin_amdgcn_sched_barrier(0)
    Unit cur, nxt; int ui = 0;
    if (!S.next(0, cur)) return;
    f32x4 acc[2][2][4][2];
#pragma unroll
    for (int a = 0; a < 2; ++a)
#pragma unroll
        for (int b = 0; b < 2; ++b)
#pragma unroll
            for (int m = 0; m < 4; ++m)
#pragma unroll
                for (int n = 0; n < 2; ++n) acc[a][b][m][n] = (f32x4){0.f, 0.f, 0.f, 0.f};
    bf16x8 At[4][2], B0[2][2], B1[2][2];
    v8i_t At_8[4], B0_8[2], B1_8[2];
    const char* cA = (const char*)g.A + (size_t)cur.pm * tstep; const char* cB = (const char*)g.Bt + (size_t)cur.pn * tstep;
    S.a_ready(cur);
    if constexpr (SP2) {
        PG8_STAGE(PG8_SB(0, 0), cB, voffB); PG8_STAGE(PG8_SB(0, 1), cB + hstep, voffB); PG8_STAGE(PG8_SA(0, 0), cA, voffA); PG8_STAGE(PG8_SA(0, 1), cA + hstep, voffA);
        if (wr == 1) PG8_BAR;
        PG8_WAIT_V(2); PG8_BAR;
        PG8_STAGE(PG8_SB(1, 0), cB + kstep, voffB); PG8_STAGE(PG8_SA(1, 0), cA + kstep, voffA); PG8_STAGE(PG8_SB(1, 1), cB + hstep + kstep, voffB);
        PG8_WAIT_V(6); PG8_BAR;
    } else {
        PG8_STAGE(PG8_SB(0, 0), cB, voffB); PG8_STAGE(PG8_SA(0, 0), cA, voffA); PG8_STAGE(PG8_SB(0, 1), cB + hstep, voffB); PG8_STAGE(PG8_SA(0, 1), cA + hstep, voffA);
        if (wr == 1) PG8_BAR;
        PG8_WAIT_V(4); PG8_BAR;
        PG8_STAGE(PG8_SB(1, 0), cB + kstep, voffB); PG8_STAGE(PG8_SA(1, 0), cA + kstep, voffA); PG8_STAGE(PG8_SB(1, 1), cB + hstep + kstep, voffB);
        PG8_WAIT_V(6); PG8_BAR;
    }
    for (;;) {
        const bool has_next = S.next(ui + 1, nxt);
        const char* nA = has_next ? (const char*)g.A + (size_t)nxt.pm * tstep : cA; const char* nB = has_next ? (const char*)g.Bt + (size_t)nxt.pn * tstep : cB;
        for (int t = 0; t < nt; t += 2) {
            const bool last = (t == nt - 2);
            const char* a1 = cA + (size_t)(t + 1) * kstep;
            const char* a2 = last ? nA : cA + (size_t)(t + 2) * kstep; const char* b2 = last ? nB : cB + (size_t)(t + 2) * kstep;
            const char* a3 = a2 + kstep; const char* b3 = b2 + kstep;
            if (last && has_next) S.a_ready(nxt);
            if constexpr (SP2) {
            PG8_LDB(B0, 0, 0); PG8_LDB(B1, 0, 1); PG8_SCHED; PG8_LDA(At, 0, 0); PG8_STAGE(PG8_SA(1, 1), a1 + hstep, voffA);
            PG8_WAIT_V(8); PG8_WAIT_L(0); PG8_BAR; PG8_MMA(0, 0, At, B0); PG8_MMA(0, 1, At, B1); PG8_BAR; PG8_SCHED;
            PG8_LDA(At, 0, 1); PG8_STAGE(PG8_SB(0, 0), b2, voffB); PG8_STAGE(PG8_SB(0, 1), b2 + hstep, voffB); PG8_STAGE(PG8_SA(0, 0), a2, voffA);
            PG8_WAIT_V(8); PG8_WAIT_L(0); PG8_BAR; PG8_MMA(1, 0, At, B0); PG8_MMA(1, 1, At, B1); PG8_BAR; PG8_SCHED;
            PG8_LDB(B0, 1, 0); PG8_LDB(B1, 1, 1); PG8_SCHED; PG8_LDA(At, 1, 0); PG8_STAGE(PG8_SA(0, 1), a2 + hstep, voffA);
            PG8_WAIT_V(8); PG8_WAIT_L(0); PG8_BAR; PG8_MMA(0, 0, At, B0); PG8_MMA(0, 1, At, B1); PG8_BAR; PG8_SCHED;
            PG8_LDA(At, 1, 1); PG8_STAGE(PG8_SB(1, 0), b3, voffB); PG8_STAGE(PG8_SB(1, 1), b3 + hstep, voffB); PG8_STAGE(PG8_SA(1, 0), a3, voffA);
            PG8_WAIT_V(8); PG8_WAIT_L(0); PG8_BAR; PG8_MMA(1, 0, At, B0); PG8_MMA(1, 1, At, B1); PG8_BAR; PG8_SCHED;
            } else {
            PG8_LDB(B0, 0, 0); PG8_SCHED; PG8_LDA(At, 0, 0); PG8_STAGE(PG8_SA(1, 1), a1 + hstep, voffA);
            PG8_WAIT_L(8); PG8_BAR; PG8_WAIT_L(0); PG8_MMA(0, 0, At, B0); PG8_BAR; PG8_SCHED;
            PG8_LDB(B1, 0, 1); PG8_STAGE(PG8_SB(0, 0), b2, voffB);
            PG8_BAR; PG8_WAIT_L(0); PG8_MMA(0, 1, At, B1); PG8_BAR;
            PG8_LDA(At, 0, 1); PG8_STAGE(PG8_SA(0, 0), a2, voffA);
            PG8_BAR; PG8_WAIT_L(0); PG8_MMA(1, 0, At, B0); PG8_BAR; PG8_SCHED;
            PG8_STAGE(PG8_SB(0, 1), b2 + hstep, voffB);
            PG8_WAIT_V(6); PG8_BAR; PG8_MMA(1, 1, At, B1); PG8_BAR;
            PG8_LDB(B0, 1, 0); PG8_SCHED; PG8_LDA(At, 1, 0); PG8_STAGE(PG8_SA(0, 1), a2 + hstep, voffA);
            PG8_WAIT_L(8); PG8_BAR; PG8_WAIT_L(0); PG8_MMA(0, 0, At, B0); PG8_BAR; PG8_SCHED;
            PG8_LDB(B1, 1, 1); PG8_STAGE(PG8_SB(1, 0), b3, voffB);
            PG8_BAR; PG8_WAIT_L(0); PG8_MMA(0, 1, At, B1); PG8_BAR;
            PG8_LDA(At, 1, 1); PG8_STAGE(PG8_SA(1, 0), a3, voffA);
            PG8_BAR; PG8_WAIT_L(0); PG8_MMA(1, 0, At, B0); PG8_BAR; PG8_SCHED;
            PG8_STAGE(PG8_SB(1, 1), b3 + hstep, voffB);
            PG8_WAIT_V(6); PG8_BAR; PG8_MMA(1, 1, At, B1); PG8_BAR;
            }
            if constexpr (Epi::MIDT > 0) { if (t + 2 == Epi::MIDT || t + 2 == Epi::MIDT2) { int l2_; asm volatile("v_mbcnt_lo_u32_b32 %0, -1, 0\n\tv_mbcnt_hi_u32_b32 %0, -1, %0" : "=v"(l2_)); E.mid(acc, cur, wr, l2_ & 15, t + 2); } }
        }
        if constexpr (F8) asm volatile("s_nop 15\n\ts_nop 15" ::: "memory");
        if constexpr (ALIGN_EPI) { if (wr == 0) PG8_BAR; }
        if constexpr (!Epi::AFTER_DRAIN) { int l2_; asm volatile("v_mbcnt_lo_u32_b32 %0, -1, 0\n\tv_mbcnt_hi_u32_b32 %0, -1, %0" : "=v"(l2_));
            E(acc, cur, wr, wc, l2_ & 15, l2_ >> 4); S.done(cur); }
        if (!has_next) break;
#pragma unroll
        for (int a = 0; a < 2; ++a)
#pragma unroll
            for (int b = 0; b < 2; ++b)
#pragma unroll
                for (int m = 0; m < 4; ++m)
#pragma unroll
                    for (int n = 0; n < 2; ++n) acc[a][b][m][n] = (f32x4){0.f, 0.f, 0.f, 0.f};
        cur = nxt; cA = nA; cB = nB; ++ui;
        if constexpr (ALIGN_EPI) { if (wr == 1) PG8_BAR; }
    }
    PG8_WAIT_V(0);
    if constexpr (!ALIGN_EPI) { if (wr == 0) PG8_BAR; }
    PG8_BAR;
    if constexpr (Epi::AFTER_DRAIN) { E.fused(acc, cur, wr, wc, fr, fq, lds, wid, lane); S.done(cur); }
#undef PG8_SA
#undef PG8_SB
#undef PG8_STAGE
#undef PG8_LDA
#undef PG8_LDB
#undef PG8_MMA
#undef PG8_WAIT_V
#undef PG8_WAIT_L
#undef PG8_BAR
#undef PG8_SCHED
}
}

constexpr int NWAVES = 8;
constexpr int BATCH = 16, SEQ = 2048, DM = 1024, DEPTH = 2, NMETA = 16, DFF = 4096;
constexpr int MROWS = 33024;
constexpr int MREAL = BATCH * SEQ, MVALID = MREAL + NMETA;
constexpr int NIN_SRC = 1988, NIN = 2048;
constexpr int PC_QA = 0, PC_CKV = 256, PC_IK = 384, PC_IW = 448, PC_IQ = 512, PC_UB = 768, PC_QC = 1280, PC_KC = 1536, PC_VC = 1792;
constexpr int YC_B = 0, YC_A = 512, YC_C = 768;
constexpr int TOPK = 256;

constexpr size_t MiB = 1u << 20;
constexpr size_t WS_CTL = 0;
constexpr size_t WS_STATS = 1 * MiB, CTL_ZERO_BYTES = 5 * MiB;
constexpr size_t STAT_STRIDE = 33024;
enum StatId { ST_SS1 = 0, ST_SSKV = 1, ST_SSB = 2, ST_SS2 = 3, ST_SSA = 4, ST_SSC = 5, ST_PER_LAYER = 6 };
constexpr size_t WS_W = 6 * MiB;
constexpr size_t W_LAYER = 23 * MiB, WO_IN = 0, WO_GLU = 4 * MiB, WO_OUT = 5 * MiB, WO_1 = 7 * MiB, WO_2 = 15 * MiB;
constexpr size_t WS_HB = 52 * MiB;
constexpr size_t WS_BIG = 118 * MiB;
constexpr size_t WS_P = WS_BIG, WS_YCAT = WS_BIG + 130 * MiB, WS_YG = WS_BIG + 196 * MiB;
constexpr size_t WS_END = 376 * MiB;
constexpr size_t WS_WUKF = 497 * MiB - 512 * 1024, WS_WUVF = WS_WUKF + 128 * 1024;
static_assert(WS_STATS + (2 * ST_PER_LAYER + 1) * STAT_STRIDE * 8 <= CTL_ZERO_BYTES && CTL_ZERO_BYTES <= WS_W && WS_W + 2 * W_LAYER <= WS_HB && WS_HB + (size_t)MROWS * 1024 * 2 <= WS_BIG && WS_P + (size_t)MROWS * 2048 * 2 <= WS_YCAT && WS_YCAT + (size_t)MROWS * 1024 * 2 <= WS_YG
              && WS_YG + (size_t)MROWS * 512 * 2 <= WS_BIG + (size_t)MROWS * 4096 * 2 && WS_BIG + (size_t)MROWS * 4096 * 2 <= WS_END, "d_ws map");
constexpr int CW_TMO = 0, CW_CODE = 1;
constexpr int CW_BAR = 4096;
constexpr int CW_WMAX1 = 65536 + 2048;
constexpr int CW_WMAX = 65536;
constexpr int CW_SF = 120000;
constexpr int CW_Q = 16384;

constexpr int RING_OFF = 0, RING_BYTES = 131072;
constexpr int LDSCTL_OFF = RING_BYTES, MISC_OFF = LDSCTL_OFF + 320;
constexpr int LDS_BYTES = 147456;

#define GAS __attribute__((address_space(1)))
#define LAS __attribute__((address_space(3)))
typedef unsigned short bf16;
typedef unsigned v4u __attribute__((ext_vector_type(4)));
typedef float f32x4 __attribute__((ext_vector_type(4)));
typedef GAS unsigned gu32;
#define RLX_AGENT __ATOMIC_RELAXED, __HIP_MEMORY_SCOPE_AGENT
#define LDS_WAIT() asm volatile("s_waitcnt lgkmcnt(0)" ::: "memory")
#define VM_WAIT() asm volatile("s_waitcnt vmcnt(0)" ::: "memory")
__device__ __forceinline__ unsigned f2bf(float f) { unsigned u = __builtin_bit_cast(unsigned, f); return (u + 0x7fffu + ((u >> 16) & 1u)) >> 16; }
__device__ __forceinline__ unsigned pk2(float lo, float hi) { return f2bf(lo) | (f2bf(hi) << 16); }
__device__ __forceinline__ float bf2f(bf16 v) { return __uint_as_float((unsigned)v << 16); }
__device__ __forceinline__ float bflo(unsigned w) { return __uint_as_float(w << 16); }
__device__ __forceinline__ float bfhi(unsigned w) { return __uint_as_float(w & 0xffff0000u); }

__device__ __forceinline__ int lane_id() { int l; asm volatile("v_mbcnt_lo_u32_b32 %0, -1, 0\n\tv_mbcnt_hi_u32_b32 %0, -1, %0" : "=v"(l)); return l; }
#define XB_TMO      128
#define XB_XCNT(j)  (256  + 64 * (j))
#define XB_XSUB(j)  (1280 + 64 * (j))
#define XB_XGEN(j)  (2304 + 64 * (j))
#define XB_TOP      3328
#define XB_TOPGEN   3392
#define XCD_BAR_WORDS 3456
#define XB_SPIN_CAP (1u << 21)

__device__ __forceinline__ unsigned xb_ld(unsigned* p)              { return __hip_atomic_load(p, __ATOMIC_RELAXED, __HIP_MEMORY_SCOPE_AGENT); }
__device__ __forceinline__ unsigned xb_add(unsigned* p, unsigned v) { return __hip_atomic_fetch_add(p, v, __ATOMIC_RELAXED, __HIP_MEMORY_SCOPE_AGENT); }
__device__ __forceinline__ unsigned xb_xcc_id() { return (unsigned)__builtin_amdgcn_s_getreg((3 << 11) | 20) & 0xFu; }
#define XB_SPIN(cond, bar) do { unsigned _sp = 0; while (cond) { __builtin_amdgcn_s_sleep(1); \
    if ((++_sp & 255u) == 0u) { if (xb_ld(&(bar)[XB_TMO])) break; if (_sp > XB_SPIN_CAP) { atomicAdd(&(bar)[XB_TMO], 1u); break; } } } } while (0)

struct XcdBarrier { unsigned* bar; unsigned x; volatile LAS unsigned* st; };
__device__ __forceinline__ XcdBarrier xcd_barrier_post(unsigned* bar, volatile LAS unsigned* st, int wave) {
    XcdBarrier b; b.bar = bar; b.x = xb_xcc_id(); b.st = st;
    if (wave == 0 && lane_id() == 0) (void)xb_add(&bar[XB_XCNT(b.x)], 1u);
    return b;
}
__device__ __forceinline__ void xcd_barrier_complete(unsigned* bar, unsigned x, unsigned& nloc, unsigned& nx) {
    const unsigned G = gridDim.x * gridDim.y * gridDim.z;
    unsigned sum, cnt, mine, sp = 0u;
    for (;;) {
        sum = 0u; cnt = 0u; mine = 0u;
#pragma unroll
        for (unsigned j = 0; j < 16; ++j) { const unsigned c = xb_ld(&bar[XB_XCNT(j)]); sum += c; cnt += (c > 0u) ? 1u : 0u; mine = (j == x) ? c : mine; }
        if (sum == G) break;
        __builtin_amdgcn_s_sleep(1);
        if ((++sp & 255u) == 0u) { if (xb_ld(&bar[XB_TMO])) break; if (sp > XB_SPIN_CAP) { atomicAdd(&bar[XB_TMO], 1u); break; } }
    }
    nloc = mine > 0u ? mine : 1u; nx = cnt > 0u ? cnt : 1u;
}
__device__ __forceinline__ void xcd_barrier(const XcdBarrier& b, int wave) {
    asm volatile("s_waitcnt vmcnt(0)" ::: "memory");
    __syncthreads();
    if (wave == 0 && lane_id() == 0) {
        unsigned* bar = b.bar;
        __builtin_amdgcn_s_waitcnt(0);
        unsigned nloc = b.st[0], nx = b.st[1];
        if (nloc == 0u) { xcd_barrier_complete(bar, b.x, nloc, nx); b.st[0] = nloc; b.st[1] = nx; }
        const unsigned old = xb_add(&bar[XB_XSUB(b.x)], 1u);
        const unsigned gen = old / nloc;
        if (old + 1u == (gen + 1u) * nloc) {
            __builtin_amdgcn_fence(__ATOMIC_RELEASE, "agent");
            asm volatile("s_waitcnt vmcnt(0)" ::: "memory");
            const unsigned og = xb_add(&bar[XB_TOP], 1u);
            const unsigned tg = og / nx;
            if (og + 1u == (tg + 1u) * nx) xb_add(&bar[XB_TOPGEN], 1u);
            else XB_SPIN(xb_ld(&bar[XB_TOPGEN]) == tg, bar);
            __builtin_amdgcn_fence(__ATOMIC_ACQUIRE, "agent");
            xb_add(&bar[XB_XGEN(b.x)], 1u);
            asm volatile("s_waitcnt vmcnt(0)" ::: "memory");
        } else {
            XB_SPIN(xb_ld(&bar[XB_XGEN(b.x)]) == gen, bar);
            __builtin_amdgcn_fence(__ATOMIC_ACQUIRE, "agent");
            asm volatile("s_waitcnt vmcnt(0)" ::: "memory");
        }
    }
    __syncthreads();
}


struct Args { const float* in[25]; float* out; unsigned char* ws; int ph_lo, ph_hi; };
struct Frame {
    LAS unsigned char* lds;
    volatile LAS unsigned* MISC;
    gu32* ctl;
    int wave;
    int vcu, G;
    float* out; unsigned char* ws;
};
using pg8::stat_t; using pg8::stat_get;
__device__ __forceinline__ stat_t* stat_ptr(Frame& F, int l, int id) { return (stat_t*)(F.ws + WS_STATS) + (size_t)(l * ST_PER_LAYER + id) * STAT_STRIDE; }
__device__ __forceinline__ bf16* wptr(Frame& F, int l, size_t off) { return (bf16*)(F.ws + WS_W + (size_t)l * W_LAYER + off); }
__device__ __forceinline__ float wave_sum(float v) {
#pragma unroll
    for (int o = 1; o < 64; o <<= 1) v += __shfl_xor(v, o);
    return v;
}
__device__ __forceinline__ float wave_max(float v) {
#pragma unroll
    for (int o = 1; o < 64; o <<= 1) v = fmaxf(v, __shfl_xor(v, o));
    return v;
}
__device__ __forceinline__ int key_row(int b, int kp) { return kp < NMETA ? MREAL + kp : b * SEQ + (kp - NMETA); }

__device__ __forceinline__ int win_srccol(int n) {
    if (n < 384) return n;
    if (n < 448) return 640 + (n - 384);
    if (n < 452) return 704 + (n - 448);
    if (n < 512) return -1;
    if (n < 768) return 384 + (n - 512);
    if (n < 1280) return 708 + (n - 768);
    return 1220 + (n - 1280);
}
__device__ __forceinline__ void p0_transpose_item(const Args& A, Frame& F, int l, int mat, int item, LAS float* scr) {
    const int lane = lane_id();
    int N, K, ldw; const float* W; bf16* WT;
    if (mat == 0) { N = 2048; K = 1024; ldw = NIN_SRC; W = A.in[4] + (size_t)l * 1024 * NIN_SRC; WT = wptr(F, l, WO_IN); }
    else if (mat == 1) { N = 512; K = 512; ldw = 512; W = A.in[16] + (size_t)l * 512 * 512; WT = wptr(F, l, WO_GLU); }
    else if (mat == 2) { N = 1024; K = 1024; ldw = 1024; W = A.in[20] + (size_t)l * 1024 * 1024; WT = wptr(F, l, WO_OUT); }
    else if (mat == 3) { N = 4096; K = 1024; ldw = 4096; W = A.in[22] + (size_t)l * 1024 * 4096; WT = wptr(F, l, WO_1); }
    else { N = 1024; K = 4096; ldw = 1024; W = A.in[23] + (size_t)l * 4096 * 1024; WT = wptr(F, l, WO_2); }
    if (mat == 3) {
        const int nblk = N / 32, kb = item / nblk, nb = item % nblk, k0 = 64 * kb, n0 = 32 * nb, kr = lane >> 3, c4 = lane & 7; float m[4] = {0.f, 0.f, 0.f, 0.f};
#pragma unroll
        for (int i = 0; i < 8; ++i) { const int kk = k0 + 8 * i + kr; const pg8::f32x4 v = *(const GAS pg8::f32x4*)(W + (size_t)kk * ldw + n0 + 4 * c4); const float g = A.in[21][l * 1024 + kk];
#pragma unroll
            for (int e_ = 0; e_ < 4; ++e_) m[e_] = fmaxf(m[e_], fabsf(v[e_] * g)); }
#pragma unroll
        for (int e_ = 0; e_ < 4; ++e_) { m[e_] = fmaxf(m[e_], __shfl_xor(m[e_], 8)); m[e_] = fmaxf(m[e_], __shfl_xor(m[e_], 16)); m[e_] = fmaxf(m[e_], __shfl_xor(m[e_], 32)); }
        if (lane < 8) {
#pragma unroll
            for (int e_ = 0; e_ < 4; ++e_) atomicMax((unsigned*)(F.ctl + CW_WMAX1 + l * 4096 + n0 + 4 * c4 + e_), __float_as_uint(m[e_])); }
        return; }
    if (mat == 4) {
        const int nblk = N / 32, kb = item / nblk, nb = item % nblk, k0 = 64 * kb, n0 = 32 * nb, kr = lane >> 3, c4 = lane & 7; float m[4] = {0.f, 0.f, 0.f, 0.f};
#pragma unroll
        for (int i = 0; i < 8; ++i) { const pg8::f32x4 v = *(const GAS pg8::f32x4*)(W + (size_t)(k0 + 8 * i + kr) * ldw + n0 + 4 * c4);
#pragma unroll
            for (int e_ = 0; e_ < 4; ++e_) m[e_] = fmaxf(m[e_], fabsf(v[e_])); }
#pragma unroll
        for (int e_ = 0; e_ < 4; ++e_) { m[e_] = fmaxf(m[e_], __shfl_xor(m[e_], 8)); m[e_] = fmaxf(m[e_], __shfl_xor(m[e_], 16)); m[e_] = fmaxf(m[e_], __shfl_xor(m[e_], 32)); }
        if (lane < 8) {
#pragma unroll
            for (int e_ = 0; e_ < 4; ++e_) atomicMax((unsigned*)(F.ctl + CW_WMAX + l * 1024 + n0 + 4 * c4 + e_), __float_as_uint(m[e_])); }
        return; }
    const int nblk = N / 32, kb = item / nblk, nb = item % nblk, k0 = 64 * kb, n0 = 32 * nb;
    const int kr = lane >> 3, c4 = lane & 7, n = n0 + 4 * c4;
    int sc = n; float cs = 1.f;
    if (mat == 0) { sc = win_srccol(n); if (n >= PC_QC && n < PC_KC) cs = 0.125f; }
#pragma unroll
    for (int i = 0; i < 8; ++i) { const int kk = 8 * i + kr, k = k0 + kk; int ks = k; float g = 1.f;
        if (mat == 0) g = A.in[3][l * 1024 + k];
        else if (mat == 2) { if (k < 512) { ks = 256 + k; g = A.in[18][l * 512 + k]; } else if (k < 768) { ks = k - 512; g = A.in[17][l * 256 + (k - 512)]; } else { ks = k; g = A.in[19][l * 256 + (k - 768)]; } }
        pg8::f32x4 v = (pg8::f32x4){0.f, 0.f, 0.f, 0.f}; if (sc >= 0) v = *(const GAS pg8::f32x4*)(W + (size_t)ks * ldw + sc);
        g *= cs;
#pragma unroll
        for (int e_ = 0; e_ < 4; ++e_) scr[kk * 33 + 4 * c4 + e_] = v[e_] * g; }
    LDS_WAIT(); asm volatile("" ::: "memory");
    const int c = lane & 7;
#pragma unroll
    for (int j = 0; j < 4; ++j) { const int nn = (lane >> 3) + 8 * j; const LAS float* s = scr + (8 * c) * 33 + nn;
        v4u o; o.x = pk2(s[0 * 33], s[1 * 33]); o.y = pk2(s[2 * 33], s[3 * 33]); o.z = pk2(s[4 * 33], s[5 * 33]); o.w = pk2(s[6 * 33], s[7 * 33]);
        *(GAS v4u*)(WT + (size_t)(n0 + nn) * K + k0 + 8 * c) = o; }
    LDS_WAIT(); asm volatile("" ::: "memory");
}
__device__ __forceinline__ void s5_build_item(const Args& A, Frame& F, int l, int kind, int g, int x, LAS float* scr);
__device__ __forceinline__ void p0_prologue(const Args& A, Frame& F) {
    const int lane = lane_id();
    LAS float* scr = (LAS float*)(F.lds + RING_OFF + F.wave * 16384);
    const int gw = F.vcu * NWAVES + F.wave, NGW = F.G * NWAVES;
    constexpr int I0 = 16 * 64, I1 = 8 * 16, I2 = 16 * 32, I3 = 16 * 128, I4 = 64 * 32, IL = I0 + I1 + I2 + I3 + I4;
    for (int it = gw; it < DEPTH * IL; it += NGW) {
        const int l = it / IL; int r = it % IL;
        if (r < I0) { p0_transpose_item(A, F, l, 0, r, scr); continue; } r -= I0;
        if (r < I1) { p0_transpose_item(A, F, l, 1, r, scr); continue; } r -= I1;
        if (r < I2) { p0_transpose_item(A, F, l, 2, r, scr); continue; } r -= I2;
        if (r < I3) { p0_transpose_item(A, F, l, 3, r, scr); continue; } r -= I3;
        p0_transpose_item(A, F, l, 4, r, scr);
    }
    for (int it = gw; it < DEPTH * 3 * 1024; it += NGW) { const int l = it / 3072, r = it % 3072; s5_build_item(A, F, l, r >> 10, (r >> 5) & 31, r & 31, scr); }
    for (int it = gw; it < DEPTH * 4 * 16 * 2; it += NGW) { const int tb_ = it & 1, fr_ = (it >> 1) & 15, h_ = (it >> 5) & 3, l_ = it >> 7; const int r32_ = lane & 31, hi_ = lane >> 5;
        const float* wuk_ = A.in[6] + (size_t)l_ * 128 * 256; const float* wuv_ = A.in[7] + (size_t)l_ * 128 * 256; const float* kvg_ = A.in[5] + l_ * 128;
        float v_[8];
        if (tb_ == 0) { const int c_ = fr_ >> 2, ks_ = fr_ & 3, rank_ = 32 * c_ + r32_; const float sc_ = kvg_[rank_] * 0.125f;
#pragma unroll
            for (int e_ = 0; e_ < 8; ++e_) v_[e_] = wuk_[((size_t)rank_ * 4 + h_) * 64 + ks_ * 16 + hi_ * 8 + e_] * sc_; }
        else { const int c_ = fr_ >> 2, s_ = (fr_ >> 1) & 1, db_ = fr_ & 1, d_ = 32 * db_ + r32_;
#pragma unroll
            for (int j_ = 0; j_ < 8; ++j_) { const int rk_ = 32 * c_ + 16 * s_ + 8 * (j_ >> 2) + 4 * hi_ + (j_ & 3); v_[j_] = wuv_[((size_t)rk_ * 4 + h_) * 64 + d_] * kvg_[rk_]; } }
        v4u o_; o_.x = pk2(v_[0], v_[1]); o_.y = pk2(v_[2], v_[3]); o_.z = pk2(v_[4], v_[5]); o_.w = pk2(v_[6], v_[7]);
        *((GAS v4u*)(F.ws + (tb_ == 0 ? WS_WUKF : WS_WUVF)) + ((size_t)(l_ * 4 + h_) * 16 + fr_) * 64 + lane) = o_; }
    bf16* Hb = (bf16*)(F.ws + WS_HB); stat_t* ss = stat_ptr(F, 0, ST_SS1);
    for (int m0 = gw * 4; m0 < MVALID; m0 += NGW * 4) {
        f32x4 v[4][4];
#pragma unroll
        for (int q = 0; q < 4; ++q) { const int m = m0 + q < MVALID ? m0 + q : MVALID - 1;
            const float* src = m < MREAL ? A.in[0] + (size_t)m * DM : A.in[1] + (size_t)(m - MREAL) * DM; const GAS f32x4* xr = (const GAS f32x4*)src + 2 * lane;
#pragma unroll
            for (int j = 0; j < 4; ++j) v[q][j] = xr[(j >> 1) * 128 + (j & 1)]; }
#pragma unroll
        for (int q = 0; q < 4; ++q) { const int m = m0 + q; if (m < MVALID) {
            GAS v4u* o16 = (GAS v4u*)(Hb + (size_t)m * DM) + lane; float s = 0.f;
#pragma unroll
            for (int jh = 0; jh < 2; ++jh) { v4u o;
#pragma unroll
                for (int i = 0; i < 2; ++i) { const f32x4 vv = v[q][2 * jh + i]; const unsigned w0 = pk2(vv.x, vv.y), w1 = pk2(vv.z, vv.w); o[2 * i] = w0; o[2 * i + 1] = w1;
                    s += (bflo(w0) * bflo(w0) + bfhi(w0) * bfhi(w0)) + (bflo(w1) * bflo(w1) + bfhi(w1) * bfhi(w1)); }
                o16[64 * jh] = o; }
            s = wave_sum(s); if (lane == 0) ss[m] = (stat_t)((double)s * 4294967296.0); } }
    }
}

__device__ __forceinline__ float log_sigmoid_f(float x) { return fminf(x, 0.f) - log1pf(__expf(-fabsf(x))); }
__device__ __forceinline__ float gelu_tanh_f(float x) { const float u = 0.7978845608028654f * (x + 0.044715f * x * x * x); return 0.5f * x * (1.0f + tanhf(u)); }
__device__ __forceinline__ unsigned mono_key(float f) { const unsigned u = __float_as_uint(f); return (u & 0x80000000u) ? ~u : (u | 0x80000000u); }
__device__ __forceinline__ int t5_bucket(int d) {
    if (d < 16) return d;
    const int v = 16 + (int)(logf((float)d / 16.0f) / 2.0794415416798357f * 16.0f);
    return v < 31 ? v : 31;
}

__device__ __forceinline__ void s5_naive_item(const Args& A, Frame& F, int l, int b, int g) {
    const int p = lane_id();
    const bf16* P = (const bf16*)(F.ws + WS_P); bf16* YG = (bf16*)(F.ws + WS_YG);
    const int lg = l * 32 + g;
    const float dt = expf(A.in[10][lg]), lr = A.in[8][lg * 64 + p], li = A.in[9][lg * 64 + p];
    const float mag = expf(lr * dt), ar = mag * cosf(li * dt), ai = mag * sinf(li * dt);
    const float den = lr * lr + li * li, nr = ar - 1.0f, ni = ai;
    const float fr_ = (nr * lr + ni * li) / den, fi_ = (ni * lr - nr * li) / den;
    float Br[16], Bi[16], Cr[16], Ci[16];
#pragma unroll
    for (int c = 0; c < 16; ++c) { const float br = A.in[11][((size_t)lg * 64 + p) * 16 + c], bi = A.in[12][((size_t)lg * 64 + p) * 16 + c];
        Br[c] = fr_ * br - fi_ * bi; Bi[c] = fr_ * bi + fi_ * br;
        Cr[c] = A.in[13][((size_t)lg * 16 + c) * 64 + p]; Ci[c] = A.in[14][((size_t)lg * 16 + c) * 64 + p]; }
    const int myc = ((p >> 5) & 1) * 8 + ((p >> 4) & 1) * 4 + ((p >> 3) & 1) * 2 + ((p >> 2) & 1);
    const float dsk = A.in[15][l * 512 + g * 16 + myc];
    float hr = 0.f, hi = 0.f;
    for (int kp = 0; kp < NMETA; ++kp) {
        const int row = key_row(b, kp);
        const v4u uw = *(const GAS v4u*)(P + (size_t)row * NIN + PC_UB + g * 16 + (p & 1) * 8);
        float u[16];
#pragma unroll
        for (int j = 0; j < 4; ++j) { const unsigned w0 = __builtin_amdgcn_readlane(uw[j], 0), w1 = __builtin_amdgcn_readlane(uw[j], 1);
            u[2 * j] = bflo(w0); u[2 * j + 1] = bfhi(w0); u[8 + 2 * j] = bflo(w1); u[8 + 2 * j + 1] = bfhi(w1); }
        float bur = 0.f, bui = 0.f;
#pragma unroll
        for (int c = 0; c < 16; ++c) { bur += Br[c] * u[c]; bui += Bi[c] * u[c]; }
        const float nhr = ar * hr - ai * hi + bur, nhi = ar * hi + ai * hr + bui; hr = nhr; hi = nhi;
        float v[16];
#pragma unroll
        for (int c = 0; c < 16; ++c) v[c] = Cr[c] * hr - Ci[c] * hi;
#pragma unroll
        for (int i = 0; i < 8; ++i) { const float send = (p & 32) ? v[i] : v[i + 8]; const float keep = (p & 32) ? v[i + 8] : v[i]; v[i] = keep + __shfl_xor(send, 32); }
#pragma unroll
        for (int i = 0; i < 4; ++i) { const float send = (p & 16) ? v[i] : v[i + 4]; const float keep = (p & 16) ? v[i + 4] : v[i]; v[i] = keep + __shfl_xor(send, 16); }
#pragma unroll
        for (int i = 0; i < 2; ++i) { const float send = (p & 8) ? v[i] : v[i + 2]; const float keep = (p & 8) ? v[i + 2] : v[i]; v[i] = keep + __shfl_xor(send, 8); }
        { const float send = (p & 4) ? v[0] : v[1]; const float keep = (p & 4) ? v[1] : v[0]; v[0] = keep + __shfl_xor(send, 4); }
        float y = v[0]; y += __shfl_xor(y, 1); y += __shfl_xor(y, 2);
        float um = u[0];
#pragma unroll
        for (int c = 1; c < 16; ++c) um = (myc == c) ? u[c] : um;
        y = gelu_tanh_f(y + dsk * um);
        if ((p & 3) == 0 && (b == 0 || kp >= NMETA)) YG[(size_t)row * 512 + g * 16 + myc] = (bf16)f2bf(y);
    }
}

__device__ __forceinline__ void dsa_naive_item(const Args& A, Frame& F, int l, int qi, LAS float* wl) {
    const int lane = lane_id();
    const bf16* P = (const bf16*)(F.ws + WS_P); bf16* Ycat = (bf16*)(F.ws + WS_YCAT);
    const stat_t* sskv = stat_ptr(F, l, ST_SSKV);
    LAS float* sc = wl;
    LAS unsigned* hist = (LAS unsigned*)(wl + 2080);
    LAS float* ql = wl + 2336;
    LAS float* qv = wl + 2848;
    LAS int* sel = (LAS int*)(wl + 3104);
    LAS float* ol = wl + 3360;
    int b, n, row;
    if (qi < MREAL) { b = qi >> 11; n = (qi & 2047) + NMETA + 1; row = qi; } else { b = 0; n = (qi - MREAL) + 1; row = qi; }
    const bf16* Pq = P + (size_t)row * NIN;
    LDS_WAIT(); asm volatile("" ::: "memory");
#pragma unroll
    for (int j = 0; j < 4; ++j) qv[lane + 64 * j] = bf2f(Pq[PC_IQ + lane + 64 * j]);
    float iw[4];
#pragma unroll
    for (int h = 0; h < 4; ++h) iw[h] = bf2f(Pq[PC_IW + h]);
    LDS_WAIT(); asm volatile("" ::: "memory");
#pragma unroll 1
    for (int kp = lane; kp < n; kp += 64) {
        const int krow = key_row(b, kp); const GAS v4u* ikp = (const GAS v4u*)(P + (size_t)krow * NIN + PC_IK);
        float d0 = 0.f, d1 = 0.f, d2 = 0.f, d3 = 0.f;
#pragma unroll 2
        for (int c = 0; c < 8; ++c) { const v4u w = ikp[c]; const float k8[8] = {bflo(w.x), bfhi(w.x), bflo(w.y), bfhi(w.y), bflo(w.z), bfhi(w.z), bflo(w.w), bfhi(w.w)};
#pragma unroll
            for (int j = 0; j < 8; ++j) { const float kk = k8[j]; d0 += qv[c * 8 + j] * kk; d1 += qv[64 + c * 8 + j] * kk; d2 += qv[128 + c * 8 + j] * kk; d3 += qv[192 + c * 8 + j] * kk; } }
        float s = iw[0] * fmaxf(d0, 0.f) + iw[1] * fmaxf(d1, 0.f) + iw[2] * fmaxf(d2, 0.f) + iw[3] * fmaxf(d3, 0.f);
        s += 0.0f;
        sc[kp] = s;
    }
    LDS_WAIT(); asm volatile("" ::: "memory");
    const int keff = n < TOPK ? n : TOPK;
    unsigned prefix = 0u; int krem = keff;
#pragma unroll 1
    for (int pass = 0; pass < 4; ++pass) {
        const int shift = 24 - 8 * pass;
#pragma unroll
        for (int j = 0; j < 4; ++j) hist[lane * 4 + j] = 0u;
        LDS_WAIT(); asm volatile("" ::: "memory");
        for (int kp = lane; kp < n; kp += 64) { const unsigned key = mono_key(sc[kp]);
            const bool match = (pass == 0) || ((key >> (shift + 8)) == (prefix >> (shift + 8)));
            if (match) __hip_atomic_fetch_add(&hist[(key >> shift) & 255u], 1u, __ATOMIC_RELAXED, __HIP_MEMORY_SCOPE_WORKGROUP); }
        LDS_WAIT(); asm volatile("" ::: "memory");
        const int c0 = (int)hist[lane * 4 + 0], c1 = (int)hist[lane * 4 + 1], c2 = (int)hist[lane * 4 + 2], c3 = (int)hist[lane * 4 + 3];
        const int tot = c0 + c1 + c2 + c3; int S = tot;
#pragma unroll
        for (int off = 1; off < 64; off <<= 1) { const int t = __shfl_down(S, off); if (lane + off < 64) S += t; }
        const int above = S - tot;
        const bool here = (above < krem) && (S >= krem);
        int bin = 0, newk = 0;
        if (here) { int a = above;
            if (a + c3 >= krem) { bin = 3; newk = krem - a; } else { a += c3;
            if (a + c2 >= krem) { bin = 2; newk = krem - a; } else { a += c2;
            if (a + c1 >= krem) { bin = 1; newk = krem - a; } else { a += c1; bin = 0; newk = krem - a; } } }
            bin += 4 * lane; }
        const unsigned long long mm = __ballot(here); const int src = mm ? (__ffsll((long long)mm) - 1) : 0;
        bin = __shfl(bin, src); krem = __shfl(newk, src);
        prefix |= (unsigned)bin << shift;
        LDS_WAIT(); asm volatile("" ::: "memory");
    }
    const unsigned T = prefix; const int rneed = krem;
    int selbase = 0, eqbase = 0;
    for (int k0 = 0; k0 < n; k0 += 64) { const int kp = k0 + lane; const bool valid = kp < n;
        const unsigned key = valid ? mono_key(sc[valid ? kp : 0]) : 0u;
        const bool gt = valid && key > T, eq = valid && key == T;
        const unsigned long long eqm = __ballot(eq); const unsigned long long lt = (1ull << lane) - 1ull;
        const int eqr = eqbase + __popcll(eqm & lt);
        const bool s = gt || (eq && eqr < rneed);
        const unsigned long long sm = __ballot(s);
        if (s) sel[selbase + __popcll(sm & lt)] = kp;
        selbase += __popcll(sm); eqbase += __popcll(eqm); }
    LDS_WAIT(); asm volatile("" ::: "memory");
#pragma unroll
    for (int j = 0; j < 4; ++j) qv[lane + 64 * j] = bf2f(Pq[PC_QA + lane + 64 * j]);
    LDS_WAIT(); asm volatile("" ::: "memory");
    const float* wuk = A.in[6] + (size_t)l * 128 * 256; const float* wuv = A.in[7] + (size_t)l * 128 * 256; const float* kvg = A.in[5] + l * 128;
#pragma unroll 1
    for (int h = 0; h < 4; ++h)
#pragma unroll 1
        for (int rr = 0; rr < 2; ++rr) { const int r = lane + 64 * rr; const GAS f32x4* wp = (const GAS f32x4*)(wuk + ((size_t)r * 4 + h) * 64); float a = 0.f;
#pragma unroll
            for (int d4 = 0; d4 < 16; ++d4) { const f32x4 w = wp[d4]; a += qv[h * 64 + d4 * 4] * w.x + qv[h * 64 + d4 * 4 + 1] * w.y + qv[h * 64 + d4 * 4 + 2] * w.z + qv[h * 64 + d4 * 4 + 3] * w.w; }
            ql[h * 128 + r] = a * kvg[r] * 0.125f; }
    LDS_WAIT(); asm volatile("" ::: "memory");
    float ya[4];
#pragma unroll 1
    for (int h = 0; h < 4; ++h) {
        float mx = -3.0e38f;
#pragma unroll 1
        for (int j = 0; j < 4; ++j) { const int i = lane + 64 * j;
            if (i < keff) { const int kp = sel[i]; const int krow = key_row(b, kp); const GAS v4u* cp = (const GAS v4u*)(P + (size_t)krow * NIN + PC_CKV); float d = 0.f;
#pragma unroll 4
                for (int c = 0; c < 16; ++c) { const v4u w = cp[c]; const LAS float* q8 = ql + h * 128 + c * 8;
                    d += q8[0] * bflo(w.x) + q8[1] * bfhi(w.x) + q8[2] * bflo(w.y) + q8[3] * bfhi(w.y) + q8[4] * bflo(w.z) + q8[5] * bfhi(w.z) + q8[6] * bflo(w.w) + q8[7] * bfhi(w.w); }
                const float rkv = rsqrtf(stat_get(sskv + krow) * (1.0f / 128.0f) + pg8::RMS_EPS);
                const float lgv = d * rkv + A.in[2][t5_bucket((n - 1) - kp) * 4 + h];
                sc[i] = lgv; sc[256 + i] = rkv; mx = fmaxf(mx, lgv); } }
        mx = wave_max(mx); float sum = 0.f;
        LDS_WAIT(); asm volatile("" ::: "memory");
#pragma unroll 1
        for (int j = 0; j < 4; ++j) { const int i = lane + 64 * j; if (i < keff) { const float e = __expf(sc[i] - mx); sc[i] = e; sum += e; } }
        sum = wave_sum(sum); const float inv = 1.0f / sum;
        LDS_WAIT(); asm volatile("" ::: "memory");
#pragma unroll 1
        for (int j = 0; j < 4; ++j) { const int i = lane + 64 * j; if (i < keff) qv[i] = sc[i] * inv * sc[256 + i]; }
        LDS_WAIT(); asm volatile("" ::: "memory");
        float o0 = 0.f, o1 = 0.f;
#pragma unroll 4
        for (int i = 0; i < keff; ++i) { const int krow = key_row(b, sel[i]); const float pw = qv[i]; const bf16* cp = P + (size_t)krow * NIN + PC_CKV;
            o0 += pw * bf2f(cp[lane]); o1 += pw * bf2f(cp[lane + 64]); }
        ol[lane] = o0 * kvg[lane]; ol[lane + 64] = o1 * kvg[lane + 64];
        LDS_WAIT(); asm volatile("" ::: "memory");
        float a = 0.f;
#pragma unroll 8
        for (int r = 0; r < 128; ++r) a += ol[r] * wuv[((size_t)r * 4 + h) * 64 + lane];
        ya[h] = a;
        LDS_WAIT(); asm volatile("" ::: "memory");
    }
    float ssq = 0.f;
#pragma unroll
    for (int h = 0; h < 4; ++h) { const unsigned w = f2bf(ya[h]); Ycat[(size_t)row * 1024 + YC_A + h * 64 + lane] = (bf16)w; const float v = __uint_as_float(w << 16); ssq += v * v; }
    ssq = wave_sum(ssq); if (lane == 0) pg8::stat_add(stat_ptr(F, l, ST_SSA) + row, ssq);
}

__device__ __forceinline__ void sb_naive_item(const Args& A, Frame& F, int l, int qi, LAS float* wl) {
    const int lane = lane_id();
    const bf16* P = (const bf16*)(F.ws + WS_P); bf16* Ycat = (bf16*)(F.ws + WS_YCAT);
    LAS float* qs = wl;
    LAS float* wbuf = wl + 64;
    LAS int* rbuf = (LAS int*)(wl + 128);
    int b, n, row;
    if (qi < MREAL) { b = qi >> 11; n = (qi & 2047) + NMETA; row = qi; } else { b = 0; n = qi - MREAL; row = qi; }
    const bf16* Pq = P + (size_t)row * NIN;
    float yc[4];
#pragma unroll 1
    for (int h = 0; h < 4; ++h) {
        LDS_WAIT(); asm volatile("" ::: "memory");
        qs[lane] = bf2f(Pq[PC_QC + h * 64 + lane]);
        LDS_WAIT(); asm volatile("" ::: "memory");
        float carry = 0.f, acc = 0.f;
        for (int top = n - 1; top >= 0; top -= 64) {
            const int kp = top - lane; const bool valid = kp >= 0; const int krow = key_row(b, valid ? kp : 0);
            const GAS v4u* kpn = (const GAS v4u*)(P + (size_t)krow * NIN + PC_KC + h * 64); float z = 0.f;
#pragma unroll
            for (int c = 0; c < 8; ++c) { const v4u w = kpn[c]; const LAS float* q8 = qs + c * 8;
                z += q8[0] * bflo(w.x) + q8[1] * bfhi(w.x) + q8[2] * bflo(w.y) + q8[3] * bfhi(w.y) + q8[4] * bflo(w.z) + q8[5] * bfhi(w.z) + q8[6] * bflo(w.w) + q8[7] * bfhi(w.w); }
            const float lk = valid ? log_sigmoid_f(-z) : 0.f;
            float incl = lk;
#pragma unroll
            for (int off = 1; off < 64; off <<= 1) { const float t = __shfl_up(incl, off); if (lane >= off) incl += t; }
            const float later = carry + incl - lk;
            const float w = valid ? __expf(log_sigmoid_f(z) + later) : 0.f;
            carry += __shfl(incl, 63);
            LDS_WAIT(); asm volatile("" ::: "memory");
            wbuf[lane] = w; rbuf[lane] = krow;
            LDS_WAIT(); asm volatile("" ::: "memory");
            const int cnt = top + 1 < 64 ? top + 1 : 64;
            for (int j = 0; j < cnt; ++j) acc += wbuf[j] * bf2f(P[(size_t)rbuf[j] * NIN + PC_VC + h * 64 + lane]);
        }
        yc[h] = acc;
    }
    float ssq = 0.f;
#pragma unroll
    for (int h = 0; h < 4; ++h) { const unsigned w = f2bf(yc[h]); Ycat[(size_t)row * 1024 + YC_C + h * 64 + lane] = (bf16)w; const float v = __uint_as_float(w << 16); ssq += v * v; }
    ssq = wave_sum(ssq); if (lane == 0) pg8::stat_add(stat_ptr(F, l, ST_SSC) + row, ssq);
}


typedef short bf16x8_t __attribute__((ext_vector_type(8)));
typedef short s16x4_t __attribute__((ext_vector_type(4)));
typedef float f32x16_t __attribute__((ext_vector_type(16)));
typedef float f32x2_t __attribute__((ext_vector_type(2)));
typedef __bf16 bf16x2_t __attribute__((ext_vector_type(2)));
typedef short v4i16_t __attribute__((ext_vector_type(4)));
typedef __attribute__((address_space(3))) const char* lds_cptr;
__device__ __forceinline__ s16x4_t vtr(lds_cptr p) { return __builtin_bit_cast(s16x4_t, __builtin_amdgcn_ds_read_tr16_b64_v4i16((__attribute__((address_space(3))) v4i16_t*)p)); }
__device__ __forceinline__ unsigned cvtpk(float lo, float hi) { f32x2_t v = {lo, hi}; bf16x2_t b = __builtin_convertvector(v, bf16x2_t); return __builtin_bit_cast(unsigned, b); }
__device__ __forceinline__ int crow(int r, int hi) { return (r & 3) + 8 * (r >> 2) + 4 * hi; }
__device__ __forceinline__ float relu_bits(float x) { const int i = (int)__float_as_uint(x); return __uint_as_float((unsigned)(i > 0 ? i : 0)); }
#define MFMA32(a, b, c) __builtin_amdgcn_mfma_f32_32x32x16_bf16((a), (b), (c), 0, 0, 0)

__device__ __forceinline__ void sb_mfma_unit(const Args& A, Frame& F, int l, int unit, LAS unsigned char* wl) {
    const int lane = lane_id(), r32 = lane & 31, hi = lane >> 5;
    const int qt = unit & 63, h = (unit >> 6) & 3, b = unit >> 8;
    const bf16* P = (const bf16*)(F.ws + WS_P); bf16* Ycat = (bf16*)(F.ws + WS_YCAT); stat_t* ssc = stat_ptr(F, l, ST_SSC);
    const int qrow0 = b * SEQ + 32 * qt;
    bf16x8_t qr[4];
#pragma unroll
    for (int ks = 0; ks < 4; ++ks) qr[ks] = *(const GAS bf16x8_t*)(P + (size_t)(qrow0 + r32) * NIN + PC_QC + h * 64 + ks * 16 + hi * 8);
    f32x16_t o0, o1;
#pragma unroll
    for (int r = 0; r < 16; ++r) { o0[r] = 0.f; o1[r] = 0.f; }
    float carry = 0.f;
    const int jt = qt >> 1;
    const lds_cptr vp = (lds_cptr)wl + ((lane >> 4) & 1) * 32 + (lane & 3) * 8 + (4 * hi + ((lane & 15) >> 2)) * 64;
    constexpr float LOG2E = 1.4426950408889634f;
    v4u vld[8]; bf16x8_t kf0[4], kf1[4];
#define SB_LOAD_TILE(it_) do { const int itt_ = (it_); const bool meta_ = itt_ < 0; const int kb_ = meta_ ? MREAL : b * SEQ + 64 * itt_; \
        _Pragma("unroll") for (int i = 0; i < 8; ++i) { int kl = (lane >> 3) + 8 * i; if (meta_ && kl > NMETA - 1) kl = NMETA - 1; \
            vld[i] = *(const GAS v4u*)(P + (size_t)(kb_ + kl) * NIN + PC_VC + h * 64 + (lane & 7) * 8); } \
        const int kr0 = (meta_ && r32 > NMETA - 1) ? NMETA - 1 : r32, kr1 = meta_ ? NMETA - 1 : 32 + r32; \
        _Pragma("unroll") for (int ks = 0; ks < 4; ++ks) { kf0[ks] = *(const GAS bf16x8_t*)(P + (size_t)(kb_ + kr0) * NIN + PC_KC + h * 64 + ks * 16 + hi * 8); \
                                                            kf1[ks] = *(const GAS bf16x8_t*)(P + (size_t)(kb_ + kr1) * NIN + PC_KC + h * 64 + ks * 16 + hi * 8); } } while (0)
    SB_LOAD_TILE(jt);
#pragma unroll 1
    for (int it = jt; it >= -1; --it) {
        const bool meta = it < 0;
        f32x16_t p0, p1;
#pragma unroll
        for (int r = 0; r < 16; ++r) { p0[r] = 0.f; p1[r] = 0.f; }
#pragma unroll
        for (int ks = 0; ks < 4; ++ks) { p0 = MFMA32(kf0[ks], qr[ks], p0); p1 = MFMA32(kf1[ks], qr[ks], p1); }
#pragma unroll
        for (int i = 0; i < 8; ++i) *(LAS v4u*)(wl + ((lane & 7) >> 2) * 4096 + ((lane >> 3) + 8 * i) * 64 + (lane & 3) * 16) = vld[i];
        if (it > -1) SB_LOAD_TILE(it - 1);
        const int lim = meta ? NMETA : (it == jt ? 32 * (qt & 1) + r32 : 64);
        float lk0[16], lk1[16];
#pragma unroll
        for (int r = 0; r < 16; ++r) {
            { const float Z = p0[r] * LOG2E; const float L = __builtin_amdgcn_logf(1.0f + __builtin_amdgcn_exp2f(-fabsf(Z))); const float nl = -(relu_bits(Z) + L);
              const bool valid = crow(r, hi) < lim; lk0[r] = valid ? nl : 0.f; p0[r] = valid ? Z + nl : -1.0e30f; }
            { const float Z = p1[r] * LOG2E; const float L = __builtin_amdgcn_logf(1.0f + __builtin_amdgcn_exp2f(-fabsf(Z))); const float nl = -(relu_bits(Z) + L);
              const bool valid = 32 + crow(r, hi) < lim; lk1[r] = valid ? nl : 0.f; p1[r] = valid ? Z + nl : -1.0e30f; }
        }
        float base[8]; float E = carry;
#pragma unroll
        for (int B = 7; B >= 0; --B) {
            const int rb = 4 * (B & 3);
            const float own = (B >> 2) ? ((lk1[rb] + lk1[rb + 1]) + (lk1[rb + 2] + lk1[rb + 3])) : ((lk0[rb] + lk0[rb + 1]) + (lk0[rb + 2] + lk0[rb + 3]));
            const auto rr = __builtin_amdgcn_permlane32_swap(__float_as_uint(own), __float_as_uint(own), false, false);
            const float lo_s = __uint_as_float(rr[0]), hi_s = __uint_as_float(rr[1]);
            base[B] = E + (hi ? 0.f : hi_s);
            E += lo_s + hi_s;
        }
        carry = E;
#pragma unroll
        for (int B = 0; B < 8; ++B) {
            const int rb = 4 * (B & 3);
            if (B >> 2) { const float l3 = base[B], l2 = l3 + lk1[rb + 3], l1 = l2 + lk1[rb + 2], l0 = l1 + lk1[rb + 1];
                p1[rb + 3] = __builtin_amdgcn_exp2f(p1[rb + 3] + l3); p1[rb + 2] = __builtin_amdgcn_exp2f(p1[rb + 2] + l2); p1[rb + 1] = __builtin_amdgcn_exp2f(p1[rb + 1] + l1); p1[rb] = __builtin_amdgcn_exp2f(p1[rb] + l0); }
            else { const float l3 = base[B], l2 = l3 + lk0[rb + 3], l1 = l2 + lk0[rb + 2], l0 = l1 + lk0[rb + 1];
                p0[rb + 3] = __builtin_amdgcn_exp2f(p0[rb + 3] + l3); p0[rb + 2] = __builtin_amdgcn_exp2f(p0[rb + 2] + l2); p0[rb + 1] = __builtin_amdgcn_exp2f(p0[rb + 1] + l1); p0[rb] = __builtin_amdgcn_exp2f(p0[rb] + l0); }
        }
        v4u pw[4];
#pragma unroll
        for (int j = 0; j < 4; ++j) { pw[0][j] = cvtpk(p0[2 * j], p0[2 * j + 1]); pw[1][j] = cvtpk(p0[8 + 2 * j], p0[8 + 2 * j + 1]); pw[2][j] = cvtpk(p1[2 * j], p1[2 * j + 1]); pw[3][j] = cvtpk(p1[8 + 2 * j], p1[8 + 2 * j + 1]); }
#pragma unroll
        for (int ks = 0; ks < 4; ++ks) {
            const s16x4_t a_lo = vtr(vp + ks * 1024), a_hi = vtr(vp + ks * 1024 + 512), b_lo = vtr(vp + 4096 + ks * 1024), b_hi = vtr(vp + 4096 + ks * 1024 + 512);
            const bf16x8_t v0 = (bf16x8_t){a_lo[0], a_lo[1], a_lo[2], a_lo[3], a_hi[0], a_hi[1], a_hi[2], a_hi[3]};
            const bf16x8_t v1 = (bf16x8_t){b_lo[0], b_lo[1], b_lo[2], b_lo[3], b_hi[0], b_hi[1], b_hi[2], b_hi[3]};
            const bf16x8_t pa = __builtin_bit_cast(bf16x8_t, pw[ks]);
            o0 = MFMA32(pa, v0, o0); o1 = MFMA32(pa, v1, o1); }
        if (__all(carry < -160.0f)) break;
    }
    LAS unsigned short* stg = (LAS unsigned short*)(wl + 8192);
#pragma unroll
    for (int r = 0; r < 16; ++r) { stg[crow(r, hi) * 64 + r32] = (unsigned short)f2bf(o0[r]); stg[crow(r, hi) * 64 + 32 + r32] = (unsigned short)f2bf(o1[r]); }
    LDS_WAIT(); asm volatile("" ::: "memory");
#pragma unroll
    for (int i = 0; i < 4; ++i) { const int row = i * 8 + (lane >> 3), ch = lane & 7; const v4u v = *(const LAS v4u*)(stg + row * 64 + ch * 8);
        float q = (bflo(v.x) * bflo(v.x) + bfhi(v.x) * bfhi(v.x)) + (bflo(v.y) * bflo(v.y) + bfhi(v.y) * bfhi(v.y)) + (bflo(v.z) * bflo(v.z) + bfhi(v.z) * bfhi(v.z)) + (bflo(v.w) * bflo(v.w) + bfhi(v.w) * bfhi(v.w));
        q += __shfl_xor(q, 1); q += __shfl_xor(q, 2); q += __shfl_xor(q, 4);
        if (ch == 0) pg8::stat_add(ssc + qrow0 + row, q);
        *(GAS v4u*)(Ycat + (size_t)(qrow0 + row) * 1024 + YC_C + h * 64 + ch * 8) = v; }
    LDS_WAIT(); asm volatile("" ::: "memory");
}

constexpr int DSA_HIST = 0, DSA_HIST_STRIDE = 257;
constexpr int DSA_ZC = 65792, DSA_ZC_STRIDE = 36;
constexpr int DSA_MASK = DSA_ZC + 64 * 36 * 4;
constexpr int DSA_Q = DSA_MASK + 64 * 34 * 2 * 4;
constexpr int DSA_BD = DSA_Q + 10 * 64 * 4;
constexpr int DSA_IQ = DSA_BD + 4 * 132 * 4, DSA_IQ_STRIDE = 528;
constexpr int DSA_END = DSA_IQ + 64 * DSA_IQ_STRIDE;
static_assert(DSA_END <= RING_BYTES, "DSA LDS map");
constexpr int DSA_CAP = 32;
constexpr unsigned KEY_ZERO = 0x80000000u;

__device__ __forceinline__ constexpr int crow0(int r) { return (r & 3) + 8 * (r >> 2); }
__device__ __forceinline__ unsigned off_a(unsigned row, unsigned ch) { return 2048u * (row >> 3) + 512u * (ch >> 2) + 64u * (row & 7) + 16u * ((ch & 3) ^ ((row >> 2) & 3)); }

__device__ __forceinline__ void dsa_scores(f32x16_t& s0, f32x16_t& s1, const bf16x8_t (&ikf)[2][4], const LAS unsigned char* iqrow, const float (&iw)[4]) {
#pragma unroll
    for (int r = 0; r < 16; ++r) { s0[r] = 0.f; s1[r] = 0.f; }
#pragma unroll
    for (int hp = 0; hp < 4; hp += 2) {
        f32x16_t a0, a1, b0, b1;
#pragma unroll
        for (int r = 0; r < 16; ++r) { a0[r] = 0.f; a1[r] = 0.f; b0[r] = 0.f; b1[r] = 0.f; }
#pragma unroll
        for (int ks = 0; ks < 4; ++ks) { const bf16x8_t qa = *(const LAS bf16x8_t*)(iqrow + hp * 128 + ks * 32), qb = *(const LAS bf16x8_t*)(iqrow + (hp + 1) * 128 + ks * 32);
            a0 = MFMA32(ikf[0][ks], qa, a0); a1 = MFMA32(ikf[1][ks], qa, a1); b0 = MFMA32(ikf[0][ks], qb, b0); b1 = MFMA32(ikf[1][ks], qb, b1); }
#pragma unroll
        for (int r = 0; r < 16; ++r) { s0[r] += iw[hp] * relu_bits(a0[r]); s1[r] += iw[hp] * relu_bits(a1[r]); }
#pragma unroll
        for (int r = 0; r < 16; ++r) { s0[r] += iw[hp + 1] * relu_bits(b0[r]); s1[r] += iw[hp + 1] * relu_bits(b1[r]); }
        __builtin_amdgcn_sched_barrier(0);
    }
}
__device__ __forceinline__ void dsa_load_ik(bf16x8_t (&ikf)[2][4], const bf16* P, int b, int j, int r32, int hi) {
    const int row0 = j == 0 ? MREAL + (r32 < NMETA ? r32 : NMETA - 1) : b * SEQ + 64 * (j - 1) + r32;
    const int row1 = j == 0 ? MREAL + NMETA - 1 : b * SEQ + 64 * (j - 1) + 32 + r32;
#pragma unroll
    for (int ks = 0; ks < 4; ++ks) { ikf[0][ks] = *(const GAS bf16x8_t*)(P + (size_t)row0 * NIN + PC_IK + ks * 16 + hi * 8);
                                     ikf[1][ks] = *(const GAS bf16x8_t*)(P + (size_t)row1 * NIN + PC_IK + ks * 16 + hi * 8); }
}


template <bool P0, bool EDGE>
__device__ __forceinline__ void dsa_hist_tile(const f32x16_t& s0, const f32x16_t& s1, LAS unsigned* hrow, const int shift, const unsigned psh, const int limh, unsigned& zcount) {
#pragma unroll
    for (int r = 0; r < 16; ++r) {
#pragma unroll
        for (int hf = 0; hf < 2; ++hf) {
            float sv = hf ? s1[r] : s0[r]; asm volatile("" : "+v"(sv) :: "memory");
            const unsigned u = __float_as_uint(sv);
            const unsigned key = u ^ ((unsigned)((int)u >> 31) | 0x80000000u);
            unsigned bin;
            if (P0) { bin = key >> 24;
                if (EDGE) { const bool valid = (32 * hf + crow0(r)) < limh; bin = valid ? bin : 256u; zcount += (valid && key == KEY_ZERO) ? 1u : 0u; }
                else zcount += (key == KEY_ZERO) ? 1u : 0u; }
            else { const unsigned d = (key >> shift) & 255u; bool m = (key >> (shift + 8)) == psh; if (EDGE) m = m && ((32 * hf + crow0(r)) < limh); bin = m ? d : 256u; }
            __hip_atomic_fetch_add(hrow + bin, 1u, __ATOMIC_RELAXED, __HIP_MEMORY_SCOPE_WORKGROUP);
        }
        if ((r & 1) == 1) asm volatile("" ::: "memory");
    }
}

__device__ __forceinline__ void dsa_unit(const Args& A, Frame& F, int l, int b, int qt) {
    const int lane = lane_id(), r32 = lane & 31, hi = lane >> 5, w = F.wave;
    LAS unsigned char* L = F.lds + RING_OFF;
    LAS unsigned* hist = (LAS unsigned*)(L + DSA_HIST); LAS unsigned* zc = (LAS unsigned*)(L + DSA_ZC); LAS unsigned* maskw = (LAS unsigned*)(L + DSA_MASK);
    LAS unsigned* qT = (LAS unsigned*)(L + DSA_Q); LAS unsigned* qK = qT + 64; LAS unsigned* qM = qT + 128; LAS unsigned* qJ = qT + 192; LAS unsigned* qR = qT + 256; LAS unsigned* qF = qT + 320; LAS unsigned* qT2 = qT + 384; LAS unsigned* qJ2 = qT + 448; LAS unsigned* qR2 = qT + 512; LAS unsigned* qC = qT + 576;
    LAS float* bd = (LAS float*)(L + DSA_BD);
    const bf16* P = (const bf16*)(F.ws + WS_P); bf16* Ycat = (bf16*)(F.ws + WS_YCAT);
    const int nt = qt + 2;
    const int t0 = 64 * qt, qrow0 = b * SEQ + t0;
    const int tid = w * 64 + lane;
    for (int i = tid; i < (DSA_MASK - DSA_HIST) / 4; i += 512) hist[i] = 0u;
    for (int i = tid; i < 4 * 132; i += 512) { const int h = i / 132, d = i % 132; bd[i] = A.in[2][t5_bucket(d) * 4 + h] * 1.4426950408889634f; }
    if (tid < 64) qF[tid] = 0u;
    {
        const int qh = w & 1, ts = w >> 1;
        const int ql = 32 * qh + r32;
        float iw[4];
        { const bf16* Pq = P + (size_t)(qrow0 + ql) * NIN;
#pragma unroll
          for (int h = 0; h < 4; ++h) iw[h] = bf2f(Pq[PC_IW + h]); }
#pragma unroll
        for (int i = 0; i < 4; ++i) { const int cidx = tid + 512 * i, row = cidx >> 5, ch = cidx & 31;
            *(LAS v4u*)(L + DSA_IQ + row * DSA_IQ_STRIDE + ch * 16) = *(const GAS v4u*)(P + (size_t)(qrow0 + row) * NIN + PC_IQ + ch * 8); }
        const LAS unsigned char* iqrow = L + DSA_IQ + ql * DSA_IQ_STRIDE + hi * 16;
        const int nq = NMETA + t0 + ql + 1;
        unsigned pref = 0u, Tq = 0u, candlim = 0u; int jstar = 1000, rprime = 0; bool fast = false;
        __syncthreads();
        bf16x8_t ikf[2][4];
        if (ts < nt) dsa_load_ik(ikf, P, b, ts, r32, hi);
#pragma unroll 1
        for (int pass = 0; pass < 6; ++pass) {
            if (pass == 4) { if (qF[0] == 0u) continue; }
            const int shift = 24 - 8 * pass;
#pragma unroll 1
            for (int j = ts; j < nt; j += 4) {
                f32x16_t s0, s1;
                dsa_scores(s0, s1, ikf, iqrow, iw);
                if (j + 4 < nt) dsa_load_ik(ikf, P, b, j + 4, r32, hi);
                else if (pass < 5) dsa_load_ik(ikf, P, b, ts, r32, hi);
                const int lim = (j == 0) ? NMETA : ((j == nt - 1) ? ql + 1 : 64);
                const int limh = lim - 4 * hi;
                if (pass < 4) {
                    LAS unsigned* hrow = hist + ql * DSA_HIST_STRIDE;
                    const bool edge = (j == 0) || (j == nt - 1);
                    if (pass == 0) { unsigned zcount = 0u;
                        if (edge) dsa_hist_tile<true, true>(s0, s1, hrow, 24, 0u, limh, zcount); else dsa_hist_tile<true, false>(s0, s1, hrow, 24, 0u, limh, zcount);
                        __hip_atomic_fetch_add(zc + ql * DSA_ZC_STRIDE + j, zcount, __ATOMIC_RELAXED, __HIP_MEMORY_SCOPE_WORKGROUP);
                    } else { unsigned zdummy = 0u; const unsigned psh = pref >> (shift + 8);
                        if (edge) dsa_hist_tile<false, true>(s0, s1, hrow, shift, psh, limh, zdummy); else dsa_hist_tile<false, false>(s0, s1, hrow, shift, psh, limh, zdummy); }
                } else if (pass == 4) {
                    LAS unsigned* zrow = zc + ql * DSA_ZC_STRIDE;
#pragma unroll
                    for (int r = 0; r < 16; ++r) {
#pragma unroll
                        for (int hf = 0; hf < 2; ++hf) { const float s = (hf ? s1[r] : s0[r]); const unsigned key = mono_key(s);
                            const unsigned zs = ((32 * hf + crow0(r)) < limh && key == Tq) ? (unsigned)j : 35u; __hip_atomic_fetch_add(zrow + zs, 1u, __ATOMIC_RELAXED, __HIP_MEMORY_SCOPE_WORKGROUP); }
                        if ((r & 3) == 3) asm volatile("" ::: "memory"); }
                } else {
                    unsigned sel0 = 0u, sel1 = 0u;
                    LAS unsigned* lrow = hist + ql * DSA_HIST_STRIDE;
                    const unsigned posb = 64u * (unsigned)j + 4u * (unsigned)hi;
#define DSA_CAND(key_, kidx_) do { const unsigned slot_ = __hip_atomic_fetch_add(lrow, 1u, __ATOMIC_RELAXED, __HIP_MEMORY_SCOPE_WORKGROUP); \
                        if (slot_ < (unsigned)DSA_CAP) { lrow[1 + 2 * slot_] = (key_); lrow[2 + 2 * slot_] = posb + (unsigned)(kidx_); } } while (0)
                    if (!__any(j == jstar)) {
                        const unsigned Tj = (j < jstar) ? Tq : Tq + 1u;
                        if ((j == 0) || (j == nt - 1)) {
#pragma unroll
                            for (int r = 15; r >= 0; --r) {
                                { float sv = s0[r]; asm volatile("" : "+v"(sv) :: "memory"); const unsigned u = __float_as_uint(sv); const unsigned key = u ^ ((unsigned)((int)u >> 31) | 0x80000000u);
                                  sel0 = sel0 * 2u + ((key >= Tj && crow0(r) < limh) ? 1u : 0u); if ((key ^ Tq) < candlim && crow0(r) < limh) DSA_CAND(key, crow0(r)); }
                                { float sv = s1[r]; asm volatile("" : "+v"(sv) :: "memory"); const unsigned u = __float_as_uint(sv); const unsigned key = u ^ ((unsigned)((int)u >> 31) | 0x80000000u);
                                  sel1 = sel1 * 2u + ((key >= Tj && (32 + crow0(r)) < limh) ? 1u : 0u); if ((key ^ Tq) < candlim && (32 + crow0(r)) < limh) DSA_CAND(key, 32 + crow0(r)); } }
                        } else {
#pragma unroll
                            for (int r = 15; r >= 0; --r) {
                                { float sv = s0[r]; asm volatile("" : "+v"(sv) :: "memory"); const unsigned u = __float_as_uint(sv); const unsigned key = u ^ ((unsigned)((int)u >> 31) | 0x80000000u);
                                  sel0 = sel0 * 2u + ((key >= Tj) ? 1u : 0u); if ((key ^ Tq) < candlim) DSA_CAND(key, crow0(r)); }
                                { float sv = s1[r]; asm volatile("" : "+v"(sv) :: "memory"); const unsigned u = __float_as_uint(sv); const unsigned key = u ^ ((unsigned)((int)u >> 31) | 0x80000000u);
                                  sel1 = sel1 * 2u + ((key >= Tj) ? 1u : 0u); if ((key ^ Tq) < candlim) DSA_CAND(key, 32 + crow0(r)); } }
                        }
                    } else {
                    unsigned e0 = 0u, e1 = 0u, g0 = 0u, g1 = 0u;
#pragma unroll
                    for (int r = 15; r >= 0; --r) {
                        { const unsigned key = mono_key(s0[r]); const bool valid = crow0(r) < limh; e0 = e0 * 2u + ((valid && key == Tq) ? 1u : 0u); g0 = g0 * 2u + ((valid && key > Tq) ? 1u : 0u); }
                        { const unsigned key = mono_key(s1[r]); const bool valid = (32 + crow0(r)) < limh; e1 = e1 * 2u + ((valid && key == Tq) ? 1u : 0u); g1 = g1 * 2u + ((valid && key > Tq) ? 1u : 0u); } }
                    unsigned t0m = 0u, t1m = 0u;
                    if (j < jstar) { t0m = e0; t1m = e1; }
                    {
                        int E = 0; unsigned r0m = 0u, r1m = 0u;
#pragma unroll
                        for (int B = 0; B < 8; ++B) { const int rb = 4 * (B & 3); const unsigned em = (B >> 2) ? e1 : e0;
                            const int own = __popc((em >> rb) & 15u);
                            const auto rr = __builtin_amdgcn_permlane32_swap((unsigned)own, (unsigned)own, false, false);
                            const int lo_s = (int)rr[0], hi_s = (int)rr[1];
                            int rk = E + (hi ? lo_s : 0);
#pragma unroll
                            for (int i = 0; i < 4; ++i) { const bool isq = (em >> (rb + i)) & 1u; if (isq && rk < rprime) { if (B >> 2) r1m |= 1u << (rb + i); else r0m |= 1u << (rb + i); } rk += isq ? 1 : 0; }
                            E += lo_s + hi_s; }
                        if (j == jstar) { t0m = r0m; t1m = r1m; }
                    }
                    sel0 = g0 | t0m; sel1 = g1 | t1m;
                    if (__any(candlim != 0u)) {
#pragma unroll
                        for (int r = 0; r < 16; ++r) {
                            { float sv = s0[r]; asm volatile("" : "+v"(sv) :: "memory"); const unsigned key = mono_key(sv); if ((key ^ Tq) < candlim && crow0(r) < limh) DSA_CAND(key, crow0(r)); }
                            { float sv = s1[r]; asm volatile("" : "+v"(sv) :: "memory"); const unsigned key = mono_key(sv); if ((key ^ Tq) < candlim && (32 + crow0(r)) < limh) DSA_CAND(key, 32 + crow0(r)); } }
                    }
                    }
                    unsigned w0 = ((sel0 & 0xfu) | ((sel0 & 0xf0u) << 4) | ((sel0 & 0xf00u) << 8) | ((sel0 & 0xf000u) << 12)) << (4 * hi);
                    unsigned w1 = ((sel1 & 0xfu) | ((sel1 & 0xf0u) << 4) | ((sel1 & 0xf00u) << 8) | ((sel1 & 0xf000u) << 12)) << (4 * hi);
                    { const auto rr = __builtin_amdgcn_permlane32_swap(w0, w0, false, false); w0 = rr[0] | rr[1]; }
                    { const auto rr = __builtin_amdgcn_permlane32_swap(w1, w1, false, false); w1 = rr[0] | rr[1]; }
                    if (hi == 0) { maskw[(ql * 34 + j) * 2] = w0; maskw[(ql * 34 + j) * 2 + 1] = w1; }
                }
            }
            if (pass == 5) {
                if (fast) {
                    __syncthreads();
#pragma unroll 1
                    for (int it = 0; it < 4; ++it) { const int q = 8 * w + 2 * it + hi, i = r32;
                        const LAS unsigned* lr = hist + q * DSA_HIST_STRIDE; const unsigned c0 = lr[0]; const int cnt = (int)(c0 < (unsigned)DSA_CAP ? c0 : (unsigned)DSA_CAP); const int kr = (int)qK[q];
                        unsigned mk = 0u, mp = 0u; if (i < cnt) { mk = lr[1 + 2 * i]; mp = lr[2 + 2 * i]; }
                        int rank = 0;
#pragma unroll 1
                        for (int jj = 0; jj < DSA_CAP; ++jj) { if (!__any(jj < cnt)) break;
                            const unsigned kj = lr[1 + 2 * jj], pj = lr[2 + 2 * jj]; rank += (jj < cnt && (kj > mk || (kj == mk && pj < mp))) ? 1 : 0; }
                        if (i < cnt && rank < kr) __hip_atomic_fetch_or(maskw + (q * 34 + (int)(mp >> 6)) * 2 + (int)((mp >> 5) & 1u), 1u << (mp & 31u), __ATOMIC_RELAXED, __HIP_MEMORY_SCOPE_WORKGROUP); }
                }
                break; }
            __syncthreads();
            if (pass < 4) {
                const int qi = lane >> 3, part = lane & 7, q = 8 * w + qi; LAS unsigned* hr = hist + q * DSA_HIST_STRIDE + 32 * part;
                const int nqq = NMETA + t0 + q + 1; const int krem = (pass == 0) ? (nqq < TOPK ? nqq : TOPK) : (int)qK[q];
                int c[32]; int tot = 0;
#pragma unroll
                for (int i = 0; i < 32; ++i) { c[i] = (int)hr[i]; tot += c[i]; }
#pragma unroll
                for (int i = 0; i < 32; ++i) hr[i] = 0u;
                int S = tot;
#pragma unroll
                for (int off = 1; off < 8; off <<= 1) { const int t = __shfl_down(S, off); if (part + off < 8) S += t; }
                const int above = S - tot; const bool here = (above < krem) && (S >= krem);
                int a = above, bin = 0, newk = 0, cb = 0; bool done = false;
#pragma unroll
                for (int i = 31; i >= 0; --i) { const bool f = !done && (a + c[i] >= krem); bin = f ? i : bin; newk = f ? krem - a : newk; cb = f ? c[i] : cb; done = done || f; a += done ? 0 : c[i]; }
                if (here) { const unsigned np = ((pass == 0) ? 0u : qT[q]) | ((unsigned)(bin + 32 * part) << shift); qT[q] = np; qK[q] = (unsigned)newk; qM[q] = (unsigned)cb;
                    if (pass == 3 && cb > newk && np != KEY_ZERO) qF[0] = 1u;
                    if (pass == 1) {
                        if (cb <= DSA_CAP) { qT2[q] = np | 0xffffu; qJ2[q] = 0xffffffffu; qR2[q] = 0u; qC[q] = 0x10000u; }
                        else if (np == KEY_ZERO) { const LAS unsigned* zr = zc + q * DSA_ZC_STRIDE; int acc = 0, js = 1000, rp = 0;
#pragma unroll 1
                            for (int jj = 0; jj < nt; ++jj) { const int cz = (int)zr[jj]; if (js == 1000 && acc + cz >= newk) { js = jj; rp = newk - acc; } acc += cz; }
                            if (acc == cb) { qT2[q] = KEY_ZERO; qJ2[q] = (unsigned)js; qR2[q] = (unsigned)rp; qC[q] = 0u; } else qF[1] = 1u; }
                        else qF[1] = 1u; } }
            }
            if (pass == 3 || pass == 4) {
                __syncthreads();
                const bool generic = qF[0] != 0u;
                if (pass == 4 || !generic) {
#pragma unroll 1
                    for (int i = 0; i < 8; ++i) { const int q = 8 * w + i; const int m = (int)qM[q], rn = (int)qK[q];
                        int js = 1000, rp = 0;
                        if (m > rn) { const int c = lane < nt ? (int)zc[q * DSA_ZC_STRIDE + lane] : 0; int inc = c;
#pragma unroll
                            for (int off = 1; off < 64; off <<= 1) { const int t = __shfl_up(inc, off); if (lane >= off) inc += t; }
                            const bool here = (inc >= rn) && (inc - c < rn);
                            const unsigned long long mm = __ballot(here); const int src = mm ? (__ffsll((long long)mm) - 1) : 0;
                            js = src; rp = rn - __shfl(inc - c, src); }
                        if (lane == 0) { qJ[q] = (unsigned)js; qR[q] = (unsigned)rp; } }
                } else {
                    for (int i = tid; i < 64 * DSA_ZC_STRIDE; i += 512) zc[i] = 0u;
                }
            }
            __syncthreads();
            pref = qT[ql]; Tq = pref; jstar = (int)qJ[ql]; rprime = (int)qR[ql];
            if (pass == 1 && qF[1] == 0u) { fast = true; Tq = qT2[ql]; jstar = (int)qJ2[ql]; rprime = (int)qR2[ql]; candlim = qC[ql]; pass = 4; }
        }
    }
    __syncthreads();
    {
        const int h = w & 3, qh2 = w >> 2, ql = 32 * qh2 + r32;
        const stat_t* sskv = stat_ptr(F, l, ST_SSKV);
        LAS unsigned short* QL = (LAS unsigned short*)(L + w * 8192);
        {
            bf16x8_t qaf[4];
#pragma unroll
            for (int ks = 0; ks < 4; ++ks) qaf[ks] = *(const GAS bf16x8_t*)(P + (size_t)(qrow0 + ql) * NIN + PC_QA + h * 64 + ks * 16 + hi * 8);
#pragma unroll 1
            for (int c = 0; c < 4; ++c) {
                f32x16_t d;
#pragma unroll
                for (int r = 0; r < 16; ++r) d[r] = 0.f;
                const GAS bf16x8_t* wf = (const GAS bf16x8_t*)(F.ws + WS_WUKF) + ((size_t)(l * 4 + h) * 16 + 4 * c) * 64 + lane;
#pragma unroll
                for (int ks = 0; ks < 4; ++ks) d = MFMA32(wf[64 * ks], qaf[ks], d);
#pragma unroll
                for (int r = 0; r < 16; ++r) QL[r32 * 128 + 32 * c + crow(r, hi)] = (unsigned short)f2bf(d[r]); }
        }
        LDS_WAIT(); asm volatile("" ::: "memory");
        bf16x8_t qlf[8];
#pragma unroll
        for (int s = 0; s < 8; ++s) qlf[s] = *(const LAS bf16x8_t*)(QL + r32 * 128 + 16 * s + 8 * hi);
        LDS_WAIT(); asm volatile("" ::: "memory");
        __syncthreads();
        LAS unsigned char* ckb = L;
        LAS float* rkb = (LAS float*)(L + DSA_IQ);
#define DSA_DMA(j_, buf_) do { const int jj_ = (j_); const int row_ = 8 * w + ((lane >> 2) & 7); \
            const int grow_ = jj_ == 0 ? MREAL + (row_ < NMETA ? row_ : NMETA - 1) : b * SEQ + 64 * (jj_ - 1) + row_; \
            const bf16* gp_ = P + (size_t)grow_ * NIN + PC_CKV + (4 * (lane >> 5) + ((lane & 3) ^ ((row_ >> 2) & 3))) * 8; \
            __builtin_amdgcn_global_load_lds((const unsigned*)gp_, (LAS unsigned*)(ckb + (buf_) * 16384 + 2048 * w), 16, 0, 0); \
            __builtin_amdgcn_global_load_lds((const unsigned*)(gp_ + 64), (LAS unsigned*)(ckb + (buf_) * 16384 + 2048 * w + 1024), 16, 0, 0); } while (0)
        DSA_DMA(0, 0); if (1 < nt) DSA_DMA(1, 1);
        for (int i = tid; i < nt * 64; i += 512) { const int jj_ = i >> 6, kk_ = i & 63; const int grow_ = jj_ == 0 ? MREAL + (kk_ < NMETA ? kk_ : NMETA - 1) : b * SEQ + 64 * (jj_ - 1) + kk_;
            const float rks_ = rsqrtf(stat_get(sskv + grow_) * (1.0f / 128.0f) + pg8::RMS_EPS); rkb[jj_ * 128 + kk_] = rks_; rkb[jj_ * 128 + 64 + kk_] = rks_ * 1.4426950408889634f; }
        asm volatile("s_waitcnt vmcnt(0)" ::: "memory");
        __syncthreads();
        f32x16_t oT[4];
#pragma unroll
        for (int c = 0; c < 4; ++c)
#pragma unroll
            for (int r = 0; r < 16; ++r) oT[c][r] = 0.f;
        float mrun = -1.0e30f, lrun = 0.f;
        constexpr float LOG2E = 1.4426950408889634f;
        const float bfar = bd[h * 132 + 128]; const LAS float* bdh = bd + h * 132;
        const unsigned xr = (r32 >> 2) & 3u, rowpart = 2048u * (r32 >> 3) + 64u * (r32 & 7);
        const unsigned rrA = rowpart + 16u * ((unsigned)hi ^ xr), rrB = rowpart + 16u * (((unsigned)hi ^ xr) ^ 2u);
        const unsigned yb = 2u * ((lane >> 4) & 1) + ((lane & 3) >> 1), trpart = 64u * (4u * hi + ((lane & 15) >> 2)) + 8u * (lane & 1);
        const unsigned trA = trpart + 16u * (yb ^ (unsigned)hi), trB = trpart + 16u * (yb ^ (unsigned)hi ^ 2u);
        if (qh2 == 0) __builtin_amdgcn_s_setprio(2);
#pragma unroll 1
        for (int j0 = 0; j0 < nt; j0 += 2) {
            if (j0 + 2 < nt) DSA_DMA(j0 + 2, (j0 + 2) & 3);
            if (j0 + 3 < nt) DSA_DMA(j0 + 3, (j0 + 3) & 3);
#pragma unroll
            for (int jj = 0; jj < 2; ++jj) { const int j = j0 + jj; if (j >= nt) break;
            const LAS unsigned char* tb = ckb + (j & 3) * 16384; const LAS float* rk = rkb + j * 128;
            f32x16_t p0, p1;
#pragma unroll
            for (int r = 0; r < 16; ++r) { p0[r] = 0.f; p1[r] = 0.f; }
            { const LAS unsigned char* ra = tb + rrA; const LAS unsigned char* rb_ = tb + rrB;
              bf16x8_t a0 = *(const LAS bf16x8_t*)(ra), a1 = *(const LAS bf16x8_t*)(ra + 8192);
#pragma unroll
              for (int s = 0; s < 8; ++s) { bf16x8_t n0 = a0, n1 = a1;
                if (s < 7) { const LAS unsigned char* bp = ((s + 1) & 1) ? rb_ : ra; n0 = *(const LAS bf16x8_t*)(bp + 512 * ((s + 1) >> 1)); n1 = *(const LAS bf16x8_t*)(bp + 512 * ((s + 1) >> 1) + 8192); }
                p0 = MFMA32(a0, qlf[s], p0); p1 = MFMA32(a1, qlf[s], p1); a0 = n0; a1 = n1; } }
            const unsigned mw0 = maskw[(ql * 34 + j) * 2] >> (4 * hi), mw1 = maskw[(ql * 34 + j) * 2 + 1] >> (4 * hi);
            const int dbase = ((j == 0) ? (NMETA + t0 + ql) : (t0 + ql - 64 * (j - 1))) - 4 * hi;
            const bool nearb = __any((dbase - 63) < 128);
            const LAS float* rkh = rk + 4 * hi;
            float mx = -INFINITY;
            const unsigned NINF = 0xff800000u;
#define DSA_LOGITS(NEAR_) \
            _Pragma("unroll") for (int g = 0; g < 4; ++g) {        \
                const f32x4 ka = *(const LAS f32x4*)(rkh + 64 + 8 * g), kb = *(const LAS f32x4*)(rkh + 64 + 32 + 8 * g);        \
                _Pragma("unroll") for (int i = 0; i < 4; ++i) { const int r = 4 * g + i, c0 = 8 * g + i; \
                    float x0 = p0[r], x1 = p1[r]; asm volatile("" : "+v"(x0), "+v"(x1) :: "memory");        \
                    float b0 = bfar, b1 = bfar; \
                    if (NEAR_) { int d0 = dbase - c0; d0 = d0 < 0 ? 0 : (d0 > 128 ? 128 : d0); int d1 = dbase - 32 - c0; d1 = d1 < 0 ? 0 : (d1 > 128 ? 128 : d1); b0 = bdh[d0]; b1 = bdh[d1]; } \
                    const unsigned v0 = __float_as_uint(fmaf(x0, ka[i], b0)), v1 = __float_as_uint(fmaf(x1, kb[i], b1)); \
                    const unsigned m0 = (unsigned)(((int)(mw0 << (31 - c0))) >> 31), m1 = (unsigned)(((int)(mw1 << (31 - c0))) >> 31);        \
                    const float y0 = __uint_as_float((m0 & v0) | (~m0 & NINF)), y1 = __uint_as_float((m1 & v1) | (~m1 & NINF)); \
                    p0[r] = y0; p1[r] = y1; asm("v_max3_f32 %0, %1, %2, %3" : "=v"(mx) : "v"(mx), "v"(y0), "v"(y1)); } }
            if (nearb) { DSA_LOGITS(true) } else { DSA_LOGITS(false) }
#undef DSA_LOGITS
            { const auto rr = __builtin_amdgcn_permlane32_swap(__float_as_uint(mx), __float_as_uint(mx), false, false); mx = fmaxf(__uint_as_float(rr[0]), __uint_as_float(rr[1])); }
            const float mnew = fmaxf(mrun, mx);
            const float scl = __builtin_amdgcn_exp2f(mrun - mnew);
            if (__any(mnew > mrun)) {
#pragma unroll
                for (int c = 0; c < 4; ++c)
#pragma unroll
                    for (int r = 0; r < 16; ++r) oT[c][r] *= scl;
            }
            mrun = mnew; f32x2_t psv = (f32x2_t){0.f, 0.f}; const f32x2_t mv = (f32x2_t){mnew, mnew};
#pragma unroll
            for (int g = 0; g < 4; ++g) {
                const f32x4 ka = *(const LAS f32x4*)(rkh + 8 * g), kb = *(const LAS f32x4*)(rkh + 32 + 8 * g);
#pragma unroll
                for (int i = 0; i < 4; i += 2) { const int r = 4 * g + i;
                    f32x2_t xa = (f32x2_t){p0[r], p0[r + 1]}, xb = (f32x2_t){p1[r], p1[r + 1]}; asm volatile("" : "+v"(xa), "+v"(xb) :: "memory");
                    xa = xa - mv; xb = xb - mv;
                    const f32x2_t ea = (f32x2_t){__builtin_amdgcn_exp2f(xa.x), __builtin_amdgcn_exp2f(xa.y)}, eb = (f32x2_t){__builtin_amdgcn_exp2f(xb.x), __builtin_amdgcn_exp2f(xb.y)};
                    psv = psv + ea; psv = psv + eb;
                    const f32x2_t wa = ea * (f32x2_t){ka[i], ka[i + 1]}, wb = eb * (f32x2_t){kb[i], kb[i + 1]};
                    p0[r] = wa.x; p0[r + 1] = wa.y; p1[r] = wb.x; p1[r + 1] = wb.y; } }
            float ps = psv.x + psv.y;
            { const auto rr = __builtin_amdgcn_permlane32_swap(__float_as_uint(ps), __float_as_uint(ps), false, false); ps = __uint_as_float(rr[0]) + __uint_as_float(rr[1]); }
            lrun = lrun * scl + ps;
            v4u pw[4];
#pragma unroll
            for (int i = 0; i < 4; ++i) { pw[0][i] = cvtpk(p0[2 * i], p0[2 * i + 1]); pw[1][i] = cvtpk(p0[8 + 2 * i], p0[8 + 2 * i + 1]); pw[2][i] = cvtpk(p1[2 * i], p1[2 * i + 1]); pw[3][i] = cvtpk(p1[8 + 2 * i], p1[8 + 2 * i + 1]); }
            { const lds_cptr t0p = (lds_cptr)(tb + trA), t1p = (lds_cptr)(tb + trB);
              s16x4_t lo = vtr(t0p), hh = vtr(t1p + 2048);
#pragma unroll
              for (int i = 0; i < 16; ++i) { const int ks = i >> 2, c = i & 3;
                s16x4_t lo2 = lo, hh2 = hh;
                if (i < 15) { const int ks2 = (i + 1) >> 2, c2 = (i + 1) & 3; lo2 = vtr(t0p + 4096 * ks2 + 512 * c2); hh2 = vtr(t1p + 4096 * ks2 + 2048 + 512 * c2); }
                const bf16x8_t av = (bf16x8_t){lo[0], lo[1], lo[2], lo[3], hh[0], hh[1], hh[2], hh[3]};
                oT[c] = MFMA32(av, __builtin_bit_cast(bf16x8_t, pw[ks]), oT[c]);
                lo = lo2; hh = hh2; } }
            }
            asm volatile("s_waitcnt vmcnt(0)" ::: "memory");
            __syncthreads();
        }
        __builtin_amdgcn_s_setprio(0);
        { const int lane = lane_id(), r32 = lane & 31, hi = lane >> 5;
        const float linv = 1.0f / lrun;
        f32x16_t ot[2];
#pragma unroll
        for (int db = 0; db < 2; ++db)
#pragma unroll
            for (int r = 0; r < 16; ++r) ot[db][r] = 0.f;
#pragma unroll
        for (int c = 0; c < 4; ++c) {
#pragma unroll
            for (int s = 0; s < 2; ++s) {
                v4u pk;
#pragma unroll
                for (int i = 0; i < 4; ++i) pk[i] = cvtpk(oT[c][8 * s + 2 * i] * linv, oT[c][8 * s + 2 * i + 1] * linv);
                const bf16x8_t bfrag = __builtin_bit_cast(bf16x8_t, pk);
#pragma unroll
                for (int db = 0; db < 2; ++db) {
                    const bf16x8_t wa = *((const GAS bf16x8_t*)(F.ws + WS_WUVF) + ((size_t)(l * 4 + h) * 16 + 4 * c + 2 * s + db) * 64 + lane);
                    ot[db] = MFMA32(wa, bfrag, ot[db]); } } }
        LAS unsigned short* stg = (LAS unsigned short*)(L + 36864 + w * 4096);
#pragma unroll
        for (int db = 0; db < 2; ++db)
#pragma unroll
            for (int r = 0; r < 16; ++r) stg[r32 * 64 + 32 * db + crow(r, hi)] = (unsigned short)f2bf(ot[db][r]);
        LDS_WAIT(); asm volatile("" ::: "memory");
        stat_t* ssa = stat_ptr(F, l, ST_SSA);
#pragma unroll
        for (int i = 0; i < 4; ++i) { const int row = i * 8 + (lane >> 3), ch = lane & 7; const v4u v = *(const LAS v4u*)(stg + row * 64 + ch * 8);
            float q = (bflo(v.x) * bflo(v.x) + bfhi(v.x) * bfhi(v.x)) + (bflo(v.y) * bflo(v.y) + bfhi(v.y) * bfhi(v.y)) + (bflo(v.z) * bflo(v.z) + bfhi(v.z) * bfhi(v.z)) + (bflo(v.w) * bflo(v.w) + bfhi(v.w) * bfhi(v.w));
            q += __shfl_xor(q, 1); q += __shfl_xor(q, 2); q += __shfl_xor(q, 4);
            if (ch == 0) pg8::stat_add(ssa + qrow0 + 32 * qh2 + row, q);
            *(GAS v4u*)(Ycat + (size_t)(qrow0 + 32 * qh2 + row) * 1024 + YC_A + h * 64 + ch * 8) = v; }
        LDS_WAIT(); asm volatile("" ::: "memory");
        }
    }
    __syncthreads();
}


constexpr int S5T = 32, S5NC = SEQ / S5T, S5RG = BATCH * S5NC, S5KU = 640;
constexpr size_t WS_U = 376 * MiB, WS_TZ = 416 * MiB, TZ_LAYER = 20 * MiB, WS_MG = 456 * MiB, MG_LAYER = 4 * MiB, WS_HQ = 464 * MiB, WS_END2 = 497 * MiB;
static_assert(WS_HQ + (size_t)MROWS * 1024 <= WS_WUKF && WS_WUVF + 128 * 1024 <= WS_END2 && WS_END2 <= 512 * MiB, "HQ buffer / fragment tables");
static_assert((size_t)32 * S5RG * S5KU * 2 <= WS_TZ - WS_U && (size_t)32 * 512 * S5KU * 2 <= TZ_LAYER && (size_t)32 * 128 * 512 * 2 <= MG_LAYER, "S5 buffers");

struct S5P { float lrdt, lidt, fr, fi; };
__device__ __forceinline__ S5P s5_params(const Args& A, int lg, int p) {
    const float dt = expf(A.in[10][lg]), lr = A.in[8][lg * 64 + p], li = A.in[9][lg * 64 + p];
    const float mag = expf(lr * dt), ar = mag * cosf(li * dt), ai = mag * sinf(li * dt);
    const float den = lr * lr + li * li, nr = ar - 1.0f, ni = ai;
    S5P o; o.lrdt = lr * dt; o.lidt = li * dt; o.fr = (nr * lr + ni * li) / den; o.fi = (ni * lr - nr * li) / den; return o;
}
__device__ __forceinline__ void s5_apow(const S5P& q, int n, float& re, float& im) { const float m = expf(q.lrdt * (float)n); re = m * cosf(q.lidt * (float)n); im = m * sinf(q.lidt * (float)n); }

__device__ __forceinline__ void s5_build_item(const Args& A, Frame& F, int l, int kind, int g, int x, LAS float* scr) {
    const int lane = lane_id(), lg = l * 32 + g, p = lane;
    bf16* TZ = (bf16*)(F.ws + WS_TZ + (size_t)l * TZ_LAYER) + (size_t)g * 512 * S5KU;
    bf16* MG = (bf16*)(F.ws + WS_MG + (size_t)l * MG_LAYER) + (size_t)g * 128 * 512;
    const S5P q = s5_params(A, lg, p);
    if (kind == 0) {
        const int d = x;
        float pr, pi; s5_apow(q, d, pr, pi);
        LDS_WAIT(); asm volatile("" ::: "memory");
#pragma unroll
        for (int ch = 0; ch < 16; ++ch) { const float br = A.in[11][((size_t)lg * 64 + p) * 16 + ch], bi = A.in[12][((size_t)lg * 64 + p) * 16 + ch];
            const float b1r = q.fr * br - q.fi * bi, b1i = q.fr * bi + q.fi * br;
            scr[p * 34 + ch] = pr * b1r - pi * b1i; scr[p * 34 + 16 + ch] = pr * b1i + pi * b1r; }
        LDS_WAIT(); asm volatile("" ::: "memory");
        const int ch = lane >> 2, c4 = 4 * (lane & 3); float k0 = 0.f, k1 = 0.f, k2 = 0.f, k3 = 0.f;
#pragma unroll 16
        for (int pp = 0; pp < 64; ++pp) { const float cr = A.in[13][((size_t)lg * 16 + ch) * 64 + pp], ci = A.in[14][((size_t)lg * 16 + ch) * 64 + pp]; const LAS float* xr = scr + pp * 34 + c4; const LAS float* xi = xr + 16;
            k0 += cr * xr[0] - ci * xi[0]; k1 += cr * xr[1] - ci * xi[1]; k2 += cr * xr[2] - ci * xi[2]; k3 += cr * xr[3] - ci * xi[3]; }
        const unsigned long long kv = (unsigned long long)pk2(k0, k1) | ((unsigned long long)pk2(k2, k3) << 32);
        for (int tau = d; tau < S5T; ++tau) *(GAS unsigned long long*)(TZ + (size_t)(tau * 16 + ch) * S5KU + (tau - d) * 16 + c4) = kv;
        if (d > 0) for (int tau = 0; tau + d < S5T; ++tau) *(GAS unsigned long long*)(TZ + (size_t)(tau * 16 + ch) * S5KU + (tau + d) * 16 + c4) = 0ull;
        LDS_WAIT(); asm volatile("" ::: "memory");
    } else if (kind == 1) {
        const int tau = x; float pr, pi; s5_apow(q, tau + 1, pr, pi);
#pragma unroll 4
        for (int ch = 0; ch < 16; ++ch) { const float cr = A.in[13][((size_t)lg * 16 + ch) * 64 + p], ci = A.in[14][((size_t)lg * 16 + ch) * 64 + p];
            const float wr_ = cr * pr - ci * pi, wi_ = cr * pi + ci * pr;
            bf16* rowp = TZ + (size_t)(tau * 16 + ch) * S5KU + 512;
            rowp[p] = (bf16)f2bf(wr_); rowp[64 + p] = (bf16)f2bf(-wi_); }
    } else {
        const int sg = x; float pr, pi; s5_apow(q, S5T - 1 - sg, pr, pi);
        unsigned wre[8], wim[8];
#pragma unroll
        for (int c2 = 0; c2 < 8; ++c2) { float vr[2], vi[2];
#pragma unroll
            for (int e = 0; e < 2; ++e) { const int ch = 2 * c2 + e; const float br = A.in[11][((size_t)lg * 64 + p) * 16 + ch], bi = A.in[12][((size_t)lg * 64 + p) * 16 + ch];
                const float b1r = q.fr * br - q.fi * bi, b1i = q.fr * bi + q.fi * br; vr[e] = pr * b1r - pi * b1i; vi[e] = pr * b1i + pi * b1r; }
            wre[c2] = pk2(vr[0], vr[1]); wim[c2] = pk2(vi[0], vi[1]); }
        GAS v4u* r0 = (GAS v4u*)(MG + (size_t)(2 * p) * 512 + sg * 16); GAS v4u* r1 = (GAS v4u*)(MG + (size_t)(2 * p + 1) * 512 + sg * 16);
        r0[0] = (v4u){wre[0], wre[1], wre[2], wre[3]}; r0[1] = (v4u){wre[4], wre[5], wre[6], wre[7]};
        r1[0] = (v4u){wim[0], wim[1], wim[2], wim[3]}; r1[1] = (v4u){wim[4], wim[5], wim[6], wim[7]};
    }
}

typedef float f32x4_t __attribute__((ext_vector_type(4)));
__device__ __forceinline__ void s5_scan_task(const Args& A, Frame& F, int l, int g) {
    const int lane = lane_id(), w = F.wave, bcol = lane & 15, kg = lane >> 4, lg = l * 32 + g;
    const bf16* P = (const bf16*)(F.ws + WS_P);
    bf16* U = (bf16*)(F.ws + WS_U) + (size_t)g * S5RG * S5KU;
    const bf16* MG = (const bf16*)(F.ws + WS_MG + (size_t)l * MG_LAYER) + (size_t)g * 128 * 512;
    LAS unsigned char* ring = F.lds + RING_OFF;
    asm volatile("s_waitcnt vmcnt(0)" ::: "memory");
    __syncthreads();
#define S5_DMA(k_) do { const int kk_ = (k_); _Pragma("unroll") for (int i_ = 0; i_ < 2; ++i_) { const int r_ = 2 * w + i_; \
        __builtin_amdgcn_global_load_lds((const unsigned*)(U + (size_t)(r_ * S5NC + kk_) * S5KU + 8 * (lane ^ r_)), (LAS unsigned*)(ring + (kk_ & 7) * 16384 + r_ * 1024), 16, 0, 0); } } while (0)
#pragma unroll
    for (int k0 = 0; k0 < 7; ++k0) S5_DMA(k0);
    bf16x8_t af[16];
#pragma unroll
    for (int ks = 0; ks < 16; ++ks) af[ks] = *(const GAS bf16x8_t*)(MG + (size_t)(16 * w + bcol) * 512 + 32 * ks + 8 * kg);
    const int pA = 8 * w + 2 * kg;
    float aTr[2], aTi[2];
#pragma unroll
    for (int e = 0; e < 2; ++e) { const S5P q = s5_params(A, lg, pA + e); s5_apow(q, S5T, aTr[e], aTi[e]); }
    f32x4_t h;
    {
        f32x4_t s = (f32x4_t){0.f, 0.f, 0.f, 0.f};
#pragma unroll
        for (int ks = 0; ks < 16; ++ks) { const int sg = 2 * ks + (kg >> 1);
            if (sg >= 16) { const bf16x8_t bfm = *(const GAS bf16x8_t*)(P + (size_t)(MREAL + sg - 16) * NIN + PC_UB + g * 16 + 8 * (kg & 1)); s = __builtin_amdgcn_mfma_f32_16x16x32_bf16(af[ks], bfm, s, 0, 0, 0); } }
        h = s;
        bf16* hp = U + (size_t)(bcol * S5NC) * S5KU + 512 + pA;
        *(GAS unsigned*)hp = pk2(h[0], h[2]); *(GAS unsigned*)(hp + 64) = pk2(h[1], h[3]);
    }
    const unsigned lbase = (unsigned)bcol * 1024u + 16u * (unsigned)((kg ^ bcol) & 3), bc2 = (unsigned)bcol >> 2;
#pragma unroll 1
    for (int c = 0; c < S5NC - 1; ++c) {
        if (c <= S5NC - 2 - 6) asm volatile("s_waitcnt vmcnt(12)" ::: "memory"); else asm volatile("s_waitcnt vmcnt(0)" ::: "memory");
        __syncthreads();
        if (c + 7 <= S5NC - 2) S5_DMA(c + 7);
        const LAS unsigned char* bufp = ring + (c & 7) * 16384 + lbase;
        f32x4_t s4[4];
#pragma unroll
        for (int j = 0; j < 4; ++j) s4[j] = (f32x4_t){0.f, 0.f, 0.f, 0.f};
#pragma unroll
        for (int m = 0; m < 4; ++m)
#pragma unroll
            for (int j = 0; j < 4; ++j) { const bf16x8_t bfr = *(const LAS bf16x8_t*)(bufp + 256 * m + 64u * ((unsigned)j ^ bc2)); s4[j] = __builtin_amdgcn_mfma_f32_16x16x32_bf16(af[4 * m + j], bfr, s4[j], 0, 0, 0); }
        const f32x4_t s = (s4[0] + s4[1]) + (s4[2] + s4[3]);
        { const float r0 = aTr[0] * h[0] - aTi[0] * h[1] + s[0], i0 = aTr[0] * h[1] + aTi[0] * h[0] + s[1], r1 = aTr[1] * h[2] - aTi[1] * h[3] + s[2], i1 = aTr[1] * h[3] + aTi[1] * h[2] + s[3];
          h = (f32x4_t){r0, i0, r1, i1}; }
        bf16* hp = U + (size_t)(bcol * S5NC + (c + 1)) * S5KU + 512 + pA;
        *(GAS unsigned*)hp = pk2(h[0], h[2]); *(GAS unsigned*)(hp + 64) = pk2(h[1], h[3]);
    }
#undef S5_DMA
    asm volatile("s_waitcnt vmcnt(0)" ::: "memory");
    __syncthreads();
    if (w == 0 && lane == 0) { __builtin_amdgcn_fence(__ATOMIC_RELEASE, "agent"); asm volatile("s_waitcnt vmcnt(0)" ::: "memory"); __hip_atomic_store(F.ctl + CW_SF + l * 32 + g, 1u, RLX_AGENT); }
}

struct OneUnit {
    pg8::Unit u0;
    __device__ __forceinline__ bool next(int i, pg8::Unit& u) const { if (i != 0) return false; u = u0; return true; }
    __device__ __forceinline__ void a_ready(const pg8::Unit&) const {}
    __device__ __forceinline__ void done(const pg8::Unit&) const {}
};
struct S5Order {
    int G, c;
    __device__ __forceinline__ bool next(int i, pg8::Unit& u) const { const int L = i * G + c; if (L >= 256) return false; const int g = L >> 3, wi = L & 7; u.pm = 4 * g + (wi >> 1); u.pn = 2 * g + (wi & 1); return true; }
    __device__ __forceinline__ void a_ready(const pg8::Unit&) const {}
    __device__ __forceinline__ void done(const pg8::Unit&) const {}
};
namespace pg8 {
struct EpiS5 {
    static constexpr bool PERM = true, AFTER_DRAIN = false; static constexpr int MIDT = 0, MIDT2 = 0;
    const bf16_t* Pm; bf16_t* YG; const float* dsk;
    __device__ __forceinline__ void operator()(const f32x4 (&acc)[2][2][4][2], const Unit& u, int wr, int wc, int fr, int fq) const {
        const int g = u.pm >> 2, rg0 = (u.pm & 3) * BM + wr * 64 + fr, cg0 = (u.pn & 1) * BM + wc * 32 + 8 * fq;
        const int colq = g * 16 + (cg0 & 15);
        const f32x4 d0 = *(const PG8_GAS f32x4*)(dsk + colq), d1 = *(const PG8_GAS f32x4*)(dsk + colq + 4);
#pragma unroll
        for (int ai = 0; ai < 2; ++ai) {
            u32x4 ul[4][2];
#pragma unroll
            for (int m = 0; m < 4; ++m) { const int rg = rg0 + ai * HALF + m * 16, b = rg >> 6, c = rg & 63;
#pragma unroll
                for (int bj = 0; bj < 2; ++bj) { const int cg = cg0 + bj * HALF, tau = cg >> 4, ch = cg & 15; const size_t row = (size_t)b * 2048 + c * 32 + tau; const int col = g * 16 + ch;
                    ul[m][bj] = *(const PG8_GAS u32x4*)(Pm + ((size_t)g * 1024 + rg) * 640 + cg); (void)row; (void)col; } }
#pragma unroll
            for (int m = 0; m < 4; ++m) { const int rg = rg0 + ai * HALF + m * 16, b = rg >> 6, c = rg & 63;
#pragma unroll
                for (int bj = 0; bj < 2; ++bj) { const int cg = cg0 + bj * HALF, tau = cg >> 4, ch = cg & 15; const size_t row = (size_t)b * 2048 + c * 32 + tau; const int col = g * 16 + ch;
                    const u32x4 u8 = ul[m][bj];
                    const f32x4 a0 = acc[ai][bj][m][0], a1 = acc[ai][bj][m][1];
                    float y[8] = {a0[0] + d0[0] * bf_lo(u8.x), a0[1] + d0[1] * bf_hi(u8.x), a0[2] + d0[2] * bf_lo(u8.y), a0[3] + d0[3] * bf_hi(u8.y),
                                  a1[0] + d1[0] * bf_lo(u8.z), a1[1] + d1[1] * bf_hi(u8.z), a1[2] + d1[2] * bf_lo(u8.w), a1[3] + d1[3] * bf_hi(u8.w)};
#pragma unroll
                    for (int j = 0; j < 8; ++j) { const float x = y[j], t = fminf(0.7978845608028654f * (x + 0.044715f * x * x * x), 15.0f); const float e = __expf(2.0f * t); y[j] = x * (1.0f - __builtin_amdgcn_rcpf(e + 1.0f)); }
                    u32x4 w; w.x = cvt_pk_bf16(y[0], y[1]); w.y = cvt_pk_bf16(y[2], y[3]); w.z = cvt_pk_bf16(y[4], y[5]); w.w = cvt_pk_bf16(y[6], y[7]);
                    *(PG8_GAS u32x4*)(YG + row * 512 + col) = w; } } }
    }
};
}


__device__ __forceinline__ void w2_quant_item(const Args& A, Frame& F, int l, int item, LAS float* scr) {
    const int lane = lane_id();
    const float* W = A.in[23] + (size_t)l * 4096 * 1024; unsigned char* WQ = (unsigned char*)wptr(F, l, WO_2);
    const int kb = item >> 5, nb = item & 31, k0 = 64 * kb, n0 = 32 * nb;
    const int kr = lane >> 3, c4 = lane & 7; float sc[4];
#pragma unroll
    for (int e_ = 0; e_ < 4; ++e_) sc[e_] = 448.0f / fmaxf(__uint_as_float(__hip_atomic_load(F.ctl + CW_WMAX + l * 1024 + n0 + 4 * c4 + e_, RLX_AGENT)), 1e-30f);
#pragma unroll
    for (int i = 0; i < 8; ++i) { const int kk = 8 * i + kr; const f32x4_t v = *(const GAS f32x4_t*)(W + (size_t)(k0 + kk) * 1024 + n0 + 4 * c4);
#pragma unroll
        for (int e_ = 0; e_ < 4; ++e_) scr[kk * 33 + 4 * c4 + e_] = v[e_] * sc[e_]; }
    LDS_WAIT(); asm volatile("" ::: "memory");
#pragma unroll
    for (int j = 0; j < 2; ++j) { const int c = lane + 64 * j, n = c >> 2, part = c & 3; const LAS float* s = scr + (16 * part) * 33 + n;
        v4u o;
#pragma unroll
        for (int q = 0; q < 4; ++q) o[q] = pg8::pk4_fp8(s[(4 * q) * 33], s[(4 * q + 1) * 33], s[(4 * q + 2) * 33], s[(4 * q + 3) * 33]);
        *(GAS v4u*)(WQ + (size_t)(n0 + n) * 4096 + k0 + 16 * part) = o; }
    LDS_WAIT(); asm volatile("" ::: "memory");
}

__device__ __forceinline__ void w1_quant_item(const Args& A, Frame& F, int l, int item, LAS float* scr) {
    const int lane = lane_id();
    const float* W = A.in[22] + (size_t)l * 1024 * 4096; unsigned char* WQ = (unsigned char*)wptr(F, l, WO_1);
    const int kb = item >> 7, nb = item & 127, k0 = 64 * kb, n0 = 32 * nb;
    const int kr = lane >> 3, c4 = lane & 7; float sc[4];
#pragma unroll
    for (int e_ = 0; e_ < 4; ++e_) sc[e_] = 448.0f / fmaxf(__uint_as_float(__hip_atomic_load(F.ctl + CW_WMAX1 + l * 4096 + n0 + 4 * c4 + e_, RLX_AGENT)), 1e-30f);
#pragma unroll
    for (int i = 0; i < 8; ++i) { const int kk = 8 * i + kr; const f32x4_t v = *(const GAS f32x4_t*)(W + (size_t)(k0 + kk) * 4096 + n0 + 4 * c4); const float g = A.in[21][l * 1024 + k0 + kk];
#pragma unroll
        for (int e_ = 0; e_ < 4; ++e_) scr[kk * 33 + 4 * c4 + e_] = v[e_] * g * sc[e_]; }
    LDS_WAIT(); asm volatile("" ::: "memory");
#pragma unroll
    for (int j = 0; j < 2; ++j) { const int c = lane + 64 * j, n = c >> 2, part = c & 3; const LAS float* s = scr + (16 * part) * 33 + n;
        v4u o;
#pragma unroll
        for (int q = 0; q < 4; ++q) o[q] = pg8::pk4_fp8(s[(4 * q) * 33], s[(4 * q + 1) * 33], s[(4 * q + 2) * 33], s[(4 * q + 3) * 33]);
        *(GAS v4u*)(WQ + (size_t)(n0 + n) * 1024 + k0 + 16 * part) = o; }
    LDS_WAIT(); asm volatile("" ::: "memory");
}
__device__ __forceinline__ void hq_phase(Frame& F, const stat_t* ss) {
    const int lane = lane_id();
    const int gw = F.vcu * NWAVES + F.wave, NGW = F.G * NWAVES;
    const bf16* Hb = (const bf16*)(F.ws + WS_HB); unsigned char* HQ = F.ws + WS_HQ;
    for (int m0 = gw * 4; m0 < MVALID; m0 += NGW * 4) {
        v4u hw[4][2]; float r[4];
#pragma unroll
        for (int q = 0; q < 4; ++q) { const GAS v4u* h16 = (const GAS v4u*)(Hb + (size_t)(m0 + q) * DM) + 2 * lane;
            hw[q][0] = h16[0]; hw[q][1] = h16[1];
            r[q] = 8.0f * rsqrtf(stat_get(ss + m0 + q) * (1.0f / 1024.0f) + pg8::RMS_EPS); }
#pragma unroll
        for (int q = 0; q < 4; ++q) { v4u o;
#pragma unroll
            for (int i = 0; i < 2; ++i) { const v4u hv = hw[q][i];
                o[2 * i] = pg8::pk4_fp8(bflo(hv.x) * r[q], bfhi(hv.x) * r[q], bflo(hv.y) * r[q], bfhi(hv.y) * r[q]); o[2 * i + 1] = pg8::pk4_fp8(bflo(hv.z) * r[q], bfhi(hv.z) * r[q], bflo(hv.w) * r[q], bfhi(hv.w) * r[q]); }
            *((GAS v4u*)(HQ + (size_t)(m0 + q) * 1024) + lane) = o; }
    }
}
__device__ __forceinline__ void mixers_naive_phase(const Args& A, Frame& F, int l) {
    LAS float* wl = (LAS float*)(F.lds + RING_OFF + F.wave * 16384);
    if (l == 0) {
        const int gw = F.vcu * NWAVES + F.wave, NGW = F.G * NWAVES;
        for (int it = gw; it < DEPTH * 2048; it += NGW) w2_quant_item(A, F, it >> 11, it & 2047, wl);
        for (int it = gw; it < DEPTH * 2048; it += NGW) w1_quant_item(A, F, it >> 11, it & 2047, wl);
        __syncthreads();
    }
    if (F.vcu < 8) { const int it = 8 * F.vcu + F.wave;
        if (it < 32) s5_naive_item(A, F, l, 0, it); else if (it < 32 + NMETA) dsa_naive_item(A, F, l, MREAL + (it - 32), wl); else sb_naive_item(A, F, l, MREAL + (it - 32 - NMETA), wl);
        __syncthreads(); }
    {
        const int x0 = (int)(xb_xcc_id() & 7u);
        int xq = x0;
        gu32* qbase = F.ctl + CW_Q + 64 * (4 + 8 * l);
        for (;;) {
            unsigned slot_a = (unsigned)(size_t)(F.MISC + 16); asm volatile("" : "+s"(slot_a));
            volatile LAS unsigned* slot = (volatile LAS unsigned*)(size_t)slot_a;
            if (F.wave == 0 && lane_id() == 0) {
                unsigned v = __hip_atomic_fetch_add(qbase + 64 * xq, 1u, RLX_AGENT); int nq = xq;
                if (v >= 68u) {
                    unsigned hd[7];
#pragma unroll
                    for (int q = 0; q < 7; ++q) hd[q] = __hip_atomic_load(qbase + 64 * ((x0 + 1 + q) & 7), RLX_AGENT);
                    nq = -1;
#pragma unroll
                    for (int q = 6; q >= 0; --q) if (hd[q] < 68u) nq = (x0 + 1 + q) & 7;
                }
                slot[0] = v; slot[1] = (unsigned)nq; }
            __syncthreads();
            const int idx = (int)slot[0], nq = (int)slot[1];
            __syncthreads();
            if (idx >= 4 + 64) { if (nq < 0) break; xq = nq; continue; }
            if (idx < 4) { s5_scan_task(A, F, l, 4 * xq + idx); continue; }
            { const int i2 = idx - 4; dsa_unit(A, F, l, 2 * xq + (i2 & 1), 31 - (i2 >> 1)); }
        }
    }
    {
        gu32* head3 = F.ctl + CW_Q + 64 * (20 + l);
        for (;;) {
            unsigned slot_a = (unsigned)(size_t)(F.MISC + 16); asm volatile("" : "+s"(slot_a));
            volatile LAS unsigned* slot = (volatile LAS unsigned*)(size_t)slot_a;
            if (F.wave == 0 && lane_id() == 0) { const unsigned v = __hip_atomic_fetch_add(head3, 1u, RLX_AGENT);
                if (v < 256u) { gu32* sf = F.ctl + CW_SF + l * 32 + (int)(v >> 3); unsigned sp = 0u; while (__hip_atomic_load(sf, RLX_AGENT) == 0u) { __builtin_amdgcn_s_sleep(2); if (++sp > (1u << 22)) break; }
                    __builtin_amdgcn_fence(__ATOMIC_ACQUIRE, "agent"); }
                slot[0] = v; }
            __syncthreads();
            const int idx = (int)slot[0];
            __syncthreads();
            if (idx >= 256) break;
            const int g_ = idx >> 3, wi = idx & 7;
            pg8::Gemm gm{(bf16*)(F.ws + WS_U), (bf16*)(F.ws + WS_TZ + (size_t)l * TZ_LAYER), 32 * S5RG, 32 * 512, S5KU};
            OneUnit S{pg8::Unit{4 * g_ + (wi >> 1), 2 * g_ + (wi & 1)}};
            pg8::EpiS5 E{(bf16*)(F.ws + WS_U), (bf16*)(F.ws + WS_YG), A.in[15] + l * 512};
            pg8::gemm_phase<pg8::EpiS5, OneUnit, true, true>(F.lds + RING_OFF, gm, S, E, F.wave);
        }
    }
    {
        gu32* head = F.ctl + CW_Q + 64 * l;
        constexpr int N_SB = BATCH * 4 * 64;
        for (;;) {
            int idx = 0;
            if (lane_id() == 0) idx = (int)__hip_atomic_fetch_add(head, 1u, RLX_AGENT);
            idx = __builtin_amdgcn_readfirstlane(idx);
            if (idx >= N_SB) break;
            sb_mfma_unit(A, F, l, (idx & ~63) | (63 - (idx & 63)), (LAS unsigned char*)wl);
        }
    }
}

__device__ __forceinline__ void final_phase(const Args& A, Frame& F) {
    const int lane = lane_id();
    const int gw = F.vcu * NWAVES + F.wave, NGW = F.G * NWAVES;
    const bf16* Hb = (const bf16*)(F.ws + WS_HB); const stat_t* ss = stat_ptr(F, DEPTH, ST_SS1); const float* fg = A.in[24];
    for (int m0 = gw * 4; m0 < MREAL; m0 += NGW * 4) {
        v4u hw[4][2]; float r[4];
#pragma unroll
        for (int q = 0; q < 4; ++q) { const GAS v4u* h16 = (const GAS v4u*)(Hb + (size_t)(m0 + q) * DM) + lane;
            hw[q][0] = h16[0]; hw[q][1] = h16[64];
            r[q] = rsqrtf(stat_get(ss + m0 + q) * (1.0f / 1024.0f) + pg8::RMS_EPS); }
#pragma unroll
        for (int q = 0; q < 4; ++q) { GAS f32x4* o = (GAS f32x4*)(F.out + (size_t)(m0 + q) * DM) + 2 * lane;
#pragma unroll
            for (int jh = 0; jh < 2; ++jh) { const v4u hv = hw[q][jh]; const f32x4 g0 = *((const GAS f32x4*)fg + 2 * lane + 128 * jh), g1 = *((const GAS f32x4*)fg + 2 * lane + 128 * jh + 1);
                o[128 * jh] = (f32x4){bflo(hv.x) * r[q] * g0.x, bfhi(hv.x) * r[q] * g0.y, bflo(hv.y) * r[q] * g0.z, bfhi(hv.y) * r[q] * g0.w};
                o[128 * jh + 1] = (f32x4){bflo(hv.z) * r[q] * g1.x, bfhi(hv.z) * r[q] * g1.y, bflo(hv.w) * r[q] * g1.z, bfhi(hv.w) * r[q] * g1.w}; } }
    }
}


struct MetaArgs { const bf16* A; const bf16* Bt; int N, K; bf16* O; bf16* H; const bf16* Y; const stat_t* ss; stat_t* so; const stat_t* ssb; const stat_t* ssa; const stat_t* ssc; const unsigned* wmax; };
template <int KIND> __device__ __forceinline__ void meta_gemm(Frame& F, const MetaArgs& a, LAS float* red  ) {
    const int lane = lane_id(), w = F.wave, m16 = lane & 15, kg = lane >> 4;
    const int kw = a.K / 8;
    for (int cb = F.vcu; cb < a.N / 16; cb += F.G) {
        f32x4_t acc = (f32x4_t){0.f, 0.f, 0.f, 0.f};
        const bf16* ap = a.A + (size_t)(MREAL + m16) * a.K + w * kw + 8 * kg;
        const bf16* bp = a.Bt + (size_t)(cb * 16 + m16) * a.K + w * kw + 8 * kg;
        constexpr int KW = (KIND == 1 ? 512 : (KIND == 4 ? 4096 : 1024)) / 8, NS = KW / 32, GS = NS < 8 ? NS : 8;
        if constexpr (KIND == 3) {
            const unsigned char* ap8 = (const unsigned char*)a.A + (size_t)(MREAL + m16) * 1024 + w * 128 + 8 * kg;
            const unsigned char* bp8 = (const unsigned char*)a.Bt + (size_t)(cb * 16 + m16) * 1024 + w * 128 + 8 * kg;
            long fa[4], fb[4];
#pragma unroll
            for (int s = 0; s < 4; ++s) { fa[s] = *(const GAS long*)(ap8 + 32 * s); fb[s] = *(const GAS long*)(bp8 + 32 * s); }
#pragma unroll
            for (int s = 0; s < 4; ++s) acc = __builtin_amdgcn_mfma_f32_16x16x32_fp8_fp8(fa[s], fb[s], acc, 0, 0, 0);
        } else if constexpr (KIND == 4) {
            const unsigned char* ap8 = (const unsigned char*)a.A + (size_t)(MREAL + m16) * 4096 + w * 512 + 8 * kg;
            const unsigned char* bp8 = (const unsigned char*)a.Bt + (size_t)(cb * 16 + m16) * 4096 + w * 512 + 8 * kg;
#pragma unroll
            for (int s0 = 0; s0 < 16; s0 += 8) { long fa[8], fb[8];
#pragma unroll
                for (int s = 0; s < 8; ++s) { fa[s] = *(const GAS long*)(ap8 + 32 * (s0 + s)); fb[s] = *(const GAS long*)(bp8 + 32 * (s0 + s)); }
#pragma unroll
                for (int s = 0; s < 8; ++s) acc = __builtin_amdgcn_mfma_f32_16x16x32_fp8_fp8(fa[s], fb[s], acc, 0, 0, 0); }
        } else {
#pragma unroll
        for (int s0 = 0; s0 < NS; s0 += GS) { bf16x8_t fa[GS], fb[GS];
#pragma unroll
            for (int s = 0; s < GS; ++s) { fa[s] = *(const GAS bf16x8_t*)(ap + 32 * (s0 + s)); fb[s] = *(const GAS bf16x8_t*)(bp + 32 * (s0 + s)); }
#pragma unroll
            for (int s = 0; s < GS; ++s) acc = __builtin_amdgcn_mfma_f32_16x16x32_bf16(fa[s], fb[s], acc, 0, 0, 0); }
        }
        *(LAS f32x4_t*)(red + (w * 64 + lane) * 4) = acc;
        __syncthreads();
        if (w == 0) {
            const int col = cb * 16 + m16;
#pragma unroll
            for (int r = 0; r < 4; ++r) { const int row = MREAL + 4 * kg + r; float v = 0.f;
                if (KIND == 2) {
                    const float rb = rsqrtf(stat_get(a.ssb + row) * (1.0f / 512.0f) + pg8::RMS_EPS), ra = rsqrtf(stat_get(a.ssa + row) * (1.0f / 256.0f) + pg8::RMS_EPS), rc = rsqrtf(stat_get(a.ssc + row) * (1.0f / 256.0f) + pg8::RMS_EPS);
#pragma unroll
                    for (int ww = 0; ww < 8; ++ww) v += red[(ww * 64 + lane) * 4 + r] * (ww < 4 ? rb : (ww < 6 ? ra : rc));
                } else {
#pragma unroll
                    for (int ww = 0; ww < 8; ++ww) v += red[(ww * 64 + lane) * 4 + r];
                }
                float sq = 0.f; stat_t* sp = nullptr;
                if (KIND == 0) { v *= rsqrtf(stat_get(a.ss + row) * (1.0f / 1024.0f) + pg8::RMS_EPS); const unsigned wv = f2bf(v); a.O[(size_t)row * NIN + col] = (bf16)wv;
                    if (col >= PC_CKV && col < PC_IK) { const float x = __uint_as_float(wv << 16); sq = x * x; sp = a.so; } }
                else if (KIND == 1) { const float y = bf2f(a.Y[(size_t)row * 512 + col]); const unsigned wv = f2bf(y / (1.0f + __expf(-v))); a.O[(size_t)row * 1024 + col] = (bf16)wv; const float x = __uint_as_float(wv << 16); sq = x * x; sp = a.so; }
                else if (KIND == 2 || KIND == 4) { if (KIND == 4) v *= fmaxf(__uint_as_float(a.wmax[col]), 1e-30f) * (1.0f / (448.0f * pg8::HID_SCALE));
                    const unsigned wv = f2bf(bf2f(a.H[(size_t)row * 1024 + col]) + v); a.H[(size_t)row * 1024 + col] = (bf16)wv; const float x = __uint_as_float(wv << 16); sq = x * x; sp = a.so; }
                else { v *= fmaxf(__uint_as_float(a.wmax[col]), 1e-30f) * (1.0f / (448.0f * 8.0f)); v = fmaxf(v, 0.f); ((unsigned char*)a.O)[(size_t)row * DFF + col] = (unsigned char)(pg8::pk4_fp8(v * v * pg8::HID_SCALE, 0.f, 0.f, 0.f) & 0xffu); }
                if (KIND != 3) { sq += __shfl_xor(sq, 1); sq += __shfl_xor(sq, 2); sq += __shfl_xor(sq, 4); sq += __shfl_xor(sq, 8);
                    if (m16 == 0 && sp != nullptr) pg8::stat_add(sp + row, sq); }
            }
        }
        __syncthreads();
    }
}

#define IN(k) (lo <= (k) && (k) < hi)
#define SEAM(k) do { if (IN(k) && IN((k) + 1)) xcd_barrier(bar, F.wave); } while (0)
__device__ __forceinline__ unsigned char* opaque_ptr(unsigned char* p) { asm volatile("" : "+s"(p)); return p; }
__device__ __forceinline__ stat_t* stat_at(unsigned char* ws, int l, int id) { return (stat_t*)(ws + WS_STATS) + (size_t)(l * ST_PER_LAYER + id) * STAT_STRIDE; }
__device__ __forceinline__ bf16* w_at(unsigned char* ws, int l, size_t off) { return (bf16*)(ws + WS_W + (size_t)l * W_LAYER + off); }
template <int l> __device__ __forceinline__ void layer_phases(const Args& args, Frame& F, const XcdBarrier& bar, int lo, int hi) {
    const int pb = 8 * l;
    if (IN(pb + 1)) {
        unsigned char* ws = opaque_ptr(args.ws);
        { MetaArgs ma{(bf16*)(ws + WS_HB), w_at(ws, l, WO_IN), NIN, DM, (bf16*)(ws + WS_P), nullptr, nullptr, stat_at(ws, l, ST_SS1), stat_at(ws, l, ST_SSKV), nullptr, nullptr, nullptr, nullptr}; meta_gemm<0>(F, ma, (LAS float*)(F.lds + RING_OFF)); }
        pg8::Gemm g{(bf16*)(ws + WS_HB), w_at(ws, l, WO_IN), MREAL, NIN, DM}; pg8::StaticOrder S; S.init(MREAL, NIN, F.G, (int)blockIdx.x);
        pg8::EpiIn E{(bf16*)(ws + WS_P), stat_at(ws, l, ST_SS1), stat_at(ws, l, ST_SSKV), (bf16*)(ws + WS_U)};
        pg8::gemm_phase<pg8::EpiIn, pg8::StaticOrder, true, true>(F.lds + RING_OFF, g, S, E, F.wave);
    } SEAM(pb + 1);
    if (IN(pb + 2)) { mixers_naive_phase(args, F, l); } SEAM(pb + 2);
    if (IN(pb + 4)) {
        unsigned char* ws = opaque_ptr(args.ws);
        { MetaArgs ma{(bf16*)(ws + WS_YG), w_at(ws, l, WO_GLU), 512, 512, (bf16*)(ws + WS_YCAT), nullptr, (bf16*)(ws + WS_YG), nullptr, stat_at(ws, l, ST_SSB), nullptr, nullptr, nullptr, nullptr}; meta_gemm<1>(F, ma, (LAS float*)(F.lds + RING_OFF)); }
        pg8::Gemm g{(bf16*)(ws + WS_YG), w_at(ws, l, WO_GLU), MREAL, 512, 512}; pg8::StaticOrder S; S.init(MREAL, 512, F.G, (int)blockIdx.x);
        pg8::EpiGlu E{(bf16*)(ws + WS_YG), (bf16*)(ws + WS_YCAT), stat_at(ws, l, ST_SSB)};
        pg8::gemm_phase<pg8::EpiGlu, pg8::StaticOrder, true, true>(F.lds + RING_OFF, g, S, E, F.wave);
    } SEAM(pb + 4);
    if (IN(pb + 5)) {
        unsigned char* ws = opaque_ptr(args.ws);
        { MetaArgs ma{(bf16*)(ws + WS_YCAT), w_at(ws, l, WO_OUT), DM, DM, nullptr, (bf16*)(ws + WS_HB), nullptr, nullptr, stat_at(ws, l, ST_SS2), stat_at(ws, l, ST_SSB), stat_at(ws, l, ST_SSA), stat_at(ws, l, ST_SSC), nullptr}; meta_gemm<2>(F, ma, (LAS float*)(F.lds + RING_OFF)); }
        pg8::Gemm g{(bf16*)(ws + WS_YCAT), w_at(ws, l, WO_OUT), MREAL, DM, DM}; pg8::StaticOrder S; S.init(MREAL, DM, F.G, (int)blockIdx.x);
        pg8::EpiRes<true> E{(bf16*)(ws + WS_HB), stat_at(ws, l, ST_SS2), stat_at(ws, l, ST_SSB), stat_at(ws, l, ST_SSA), stat_at(ws, l, ST_SSC)};
        pg8::gemm_phase<pg8::EpiRes<true>, pg8::StaticOrder, true, true>(F.lds + RING_OFF, g, S, E, F.wave);
    } SEAM(pb + 5);
    if (IN(pb + 6)) { hq_phase(F, stat_at(opaque_ptr(args.ws), l, ST_SS2)); } SEAM(pb + 6);
    if (IN(pb + 7)) {
        unsigned char* ws = opaque_ptr(args.ws);
        { MetaArgs ma{(bf16*)(ws + WS_HQ), w_at(ws, l, WO_1), DFF, DM, (bf16*)(ws + WS_BIG), nullptr, nullptr, nullptr, nullptr, nullptr, nullptr, nullptr, (const unsigned*)(ws + WS_CTL) + CW_WMAX1 + l * 4096}; meta_gemm<3>(F, ma, (LAS float*)(F.lds + RING_OFF)); }
        pg8::Gemm g{(bf16*)(ws + WS_HQ), w_at(ws, l, WO_1), MREAL, DFF, DM / 2}; pg8::StaticOrder S; S.init(MREAL, DFF, F.G, (int)blockIdx.x);
        pg8::EpiMlp1F8B E{(unsigned char*)(ws + WS_BIG), (const unsigned*)(ws + WS_CTL) + CW_WMAX1 + l * 4096};
        pg8::gemm_phase<pg8::EpiMlp1F8B, pg8::StaticOrder, true, true, true>(F.lds + RING_OFF, g, S, E, F.wave);
    } SEAM(pb + 7);
    if (IN(pb + 8)) {
        unsigned char* ws = opaque_ptr(args.ws);
        { MetaArgs ma{(bf16*)(ws + WS_BIG), w_at(ws, l, WO_2), DM, DFF, nullptr, (bf16*)(ws + WS_HB), nullptr, nullptr, stat_at(ws, l + 1, ST_SS1), nullptr, nullptr, nullptr, (const unsigned*)(ws + WS_CTL) + CW_WMAX + l * 1024}; meta_gemm<4>(F, ma, (LAS float*)(F.lds + RING_OFF)); }
        pg8::Gemm g{(bf16*)(ws + WS_BIG), w_at(ws, l, WO_2), MREAL, DM, DFF / 2}; pg8::StaticOrder S; S.init(MREAL, DM, F.G, (int)blockIdx.x);
        pg8::EpiRes8 E{(bf16*)(ws + WS_HB), stat_at(ws, l + 1, ST_SS1), (const unsigned*)(ws + WS_CTL) + CW_WMAX + l * 1024};
        pg8::gemm_phase<pg8::EpiRes8, pg8::StaticOrder, true, true, true>(F.lds + RING_OFF, g, S, E, F.wave);
    } SEAM(pb + 8);
}
#undef IN
#undef SEAM
constexpr int N_PHASES = 18;
#if defined(__HIP_DEVICE_COMPILE__)
#define MK_NO_PK_F32 __attribute__((target("no-packed-fp32-ops")))
#else
#define MK_NO_PK_F32
#endif
__global__ void __launch_bounds__(NWAVES * 64, 2) MK_NO_PK_F32 hymba_fwd(Args args) {
    extern __shared__ __attribute__((aligned(16))) unsigned char lds[];
    Frame F;
    F.lds = (LAS unsigned char*)lds;
    F.MISC = (volatile LAS unsigned*)(F.lds + MISC_OFF);
    F.wave = __builtin_amdgcn_readfirstlane((int)threadIdx.x >> 6);
    F.G = gridDim.x; { const int bx = blockIdx.x; F.vcu = (F.G % 8 == 0) ? (bx % 8) * (F.G / 8) + bx / 8 : bx; }
    F.out = args.out; F.ws = args.ws;
    F.ctl = (gu32*)(args.ws + WS_CTL);
    for (int u = threadIdx.x; u < (LDS_BYTES - LDSCTL_OFF) / 4; u += NWAVES * 64) ((LAS unsigned*)(F.lds + LDSCTL_OFF))[u] = 0u;
    __syncthreads();
    const int lo = args.ph_lo, hi = args.ph_hi;
    const bool multi = (hi - lo) > 1;
    XcdBarrier bar; bar.bar = (unsigned*)(F.ctl + CW_BAR); bar.x = 0; bar.st = F.MISC + 8;
    if (multi) bar = xcd_barrier_post((unsigned*)(F.ctl + CW_BAR), F.MISC + 8, F.wave);
#define IN(k) (lo <= (k) && (k) < hi)
#define SEAM(k) do { if (IN(k) && IN((k) + 1)) xcd_barrier(bar, F.wave); } while (0)
    if (IN(0)) { p0_prologue(args, F); } SEAM(0);
    layer_phases<0>(args, F, bar, lo, hi);
    layer_phases<1>(args, F, bar, lo, hi);
    if (IN(17)) { final_phase(args, F); }
#undef IN
#undef SEAM
}

#ifndef MK_ONE_LAUNCH
#define MK_ONE_LAUNCH 1
#endif
extern "C" void kernel_launch(void* const* d_in, const int* in_sizes, int n_in, void* d_out, int out_size, void* d_ws, size_t ws_size, hipStream_t stream) {
    static int grid = 0;
    if (grid == 0) {
        if (n_in != 25 || in_sizes[0] != MREAL * DM || out_size != MREAL * DM || ws_size < WS_END2) {
            fprintf(stderr, "kernel_launch: unexpected problem: n_in %d, in0 %d, out %d, ws %zu (need %zu); nothing launched\n", n_in, n_in > 0 ? in_sizes[0] : -1, out_size, ws_size, (size_t)WS_END2); grid = -1; return; }
        int dev = 0, cus = 0, per_cu = 0;
        if (hipGetDevice(&dev) != hipSuccess || hipDeviceGetAttribute(&cus, hipDeviceAttributeMultiprocessorCount, dev) != hipSuccess) { grid = -1; return; }
        if (hipFuncSetAttribute((const void*)hymba_fwd, hipFuncAttributeMaxDynamicSharedMemorySize, LDS_BYTES) != hipSuccess) { fprintf(stderr, "kernel_launch: hipFuncSetAttribute failed\n"); grid = -1; return; }
        if (hipOccupancyMaxActiveBlocksPerMultiprocessor(&per_cu, (const void*)hymba_fwd, NWAVES * 64, LDS_BYTES) != hipSuccess || per_cu < 1)
            fprintf(stderr, "kernel_launch: note: occupancy query reports %d workgroups per CU\n", per_cu);
        (void)hipGetLastError();
        grid = cus;
    }
    if (grid < 0) return;
    if (hipMemsetAsync((char*)d_ws + WS_CTL, 0, CTL_ZERO_BYTES, stream) != hipSuccess) { fprintf(stderr, "kernel_launch: memset failed\n"); return; }
    Args a{};
    for (int i = 0; i < 25; ++i) a.in[i] = (const float*)d_in[i];
    a.out = (float*)d_out; a.ws = (unsigned char*)d_ws;
#if MK_ONE_LAUNCH
    a.ph_lo = 0; a.ph_hi = N_PHASES;
    hipLaunchKernelGGL(hymba_fwd, dim3(grid), dim3(NWAVES * 64), LDS_BYTES, stream, a);
#else
    for (int p = 0; p < N_PHASES; ++p) { a.ph_lo = p; a.ph_hi = p + 1;
        hipLaunchKernelGGL(hymba_fwd, dim3(grid), dim3(NWAVES * 64), LDS_BYTES, stream, a); }
#endif
    const hipError_t le = hipPeekAtLastError();
    if (le != hipSuccess) fprintf(stderr, "kernel_launch: launch failed: %s\n", hipGetErrorName(le));
}
```

```cpp
#include <hip/hip_runtime.h>
#include <cstdio>
#include <cstdint>
namespace pg8 {
#define PG8_LAS __attribute__((address_space(3)))
typedef unsigned short bf16_t;
typedef short bf16x8 __attribute__((ext_vector_type(8)));
typedef float f32x4 __attribute__((ext_vector_type(4)));
typedef unsigned u32x4 __attribute__((ext_vector_type(4)));
constexpr int BM = 256, BK = 64, HALF = 128, HTB = HALF * BK * 2  , STAGE_BYTES = 8 * HTB, NXCD = 8, WGM = 8;

__host__ __device__ __forceinline__ int lds_byte(int r, int c) { const int st = (r >> 4) * 2 + (c >> 5), rr = r & 15, cc = c & 31, ob = rr * 64 + cc * 2; return st * 1024 + (ob ^ (((ob >> 9) & 1) << 5)); }
__host__ __device__ __forceinline__ void stage_rc(int b, int& R, int& C) { const int st = b / 1024, sb = b % 1024, swz = sb ^ (((sb >> 9) & 1) << 5); R = (st >> 1) * 16 + swz / 64; C = (st & 1) * 32 + (swz % 64) / 2; }
__host__ __device__ __forceinline__ int perm32(int rho) { const int n = rho >> 4, i = rho & 15; return 8 * (i >> 2) + 4 * n + (i & 3); }

struct Unit { int pm, pn; };
struct Gemm { const bf16_t* A; const bf16_t* Bt; int M, N, K; };

struct StaticOrder {
    int nM, nN, nwg, G, c;
    __host__ __device__ void init(int M, int N, int G_, int c_) { nM = M / BM; nN = N / BM; nwg = nM * nN; G = G_; c = c_; }
    __host__ __device__ __forceinline__ bool next(int i, Unit& u) const {
        const long L = (long)i * G + c; if (L >= nwg) return false;
        int wgid = (int)L; { const int q = nwg / NXCD, r = nwg % NXCD, xcd = wgid % NXCD, off = wgid / NXCD; wgid = (xcd < r ? xcd * (q + 1) : r * (q + 1) + (xcd - r) * q) + off; }
        const int nig = WGM * nN, gid = wgid / nig, fm = gid * WGM, gsz = (nM - fm) < WGM ? (nM - fm) : WGM;
        u.pm = fm + ((wgid % nig) % gsz); u.pn = (wgid % nig) / gsz; return true;
    }
    __device__ __forceinline__ void a_ready(const Unit&) const {}
    __device__ __forceinline__ void done(const Unit&) const {}
};

__device__ __forceinline__ unsigned cvt_pk_bf16(float lo, float hi) { unsigned r; asm volatile("v_cvt_pk_bf16_f32 %0, %1, %2" : "=v"(r) : "v"(lo), "v"(hi)); return r; }
typedef float f32x2 __attribute__((ext_vector_type(2)));
#define PG8_GAS __attribute__((address_space(1)))
constexpr float RMS_EPS = 1e-6f;
__device__ __forceinline__ float bf_lo(unsigned w) { return __uint_as_float(w << 16); }
__device__ __forceinline__ float bf_hi(unsigned w) { return __uint_as_float(w & 0xffff0000u); }
typedef unsigned long long stat_t;
__device__ __forceinline__ void stat_add(stat_t* p, float q) { atomicAdd(p, (stat_t)((double)q * 4294967296.0)); }
__device__ __forceinline__ float stat_get(const stat_t* p) { const stat_t v = *p; return (float)(unsigned)(v >> 32) + (float)(unsigned)v * 2.3283064365386963e-10f; }
__device__ __forceinline__ float stat_val(stat_t s) { return (float)((double)s * (1.0 / 4294967296.0)); }
__device__ __forceinline__ float quad_sum(float q) { q += __shfl_xor(q, 16); q += __shfl_xor(q, 32); return q; }

struct EpiIn {
    static constexpr bool PERM = true, AFTER_DRAIN = false; static constexpr int MIDT = 0, MIDT2 = 0;
    bf16_t* O; const PG8_LAS float* fac; int pm0; stat_t* sskv; bf16_t* U;
    __device__ __forceinline__ void operator()(const f32x4 (&acc)[2][2][4][2], const Unit& u, int wr, int wc, int fr, int fq) const {
        const int row0 = u.pm * BM + wr * 64 + fr, col0 = u.pn * BM + wc * 32 + 8 * fq;
        const PG8_LAS float* fp = fac + ((u.pm != pm0) ? 256 : 0) + wr * 64 + fr;
#pragma unroll
        for (int ai = 0; ai < 2; ++ai)
#pragma unroll
            for (int m = 0; m < 4; ++m) { const int row = row0 + ai * HALF + m * 16; const float r = fp[ai * HALF + m * 16];
                bf16_t* rowp = O + (size_t)row * 2048 + col0;
#pragma unroll
                for (int bj = 0; bj < 2; ++bj) { const f32x4 v0 = acc[ai][bj][m][0] * r, v1 = acc[ai][bj][m][1] * r;
                    u32x4 w; w.x = cvt_pk_bf16(v0[0], v0[1]); w.y = cvt_pk_bf16(v0[2], v0[3]); w.z = cvt_pk_bf16(v1[0], v1[1]); w.w = cvt_pk_bf16(v1[2], v1[3]);
                    if (u.pn == 3 || u.pn == 4) {
                        const int gc = col0 + bj * HALF - 768, gg = gc >> 4, t = row & 2047;
                        *(PG8_GAS u32x4*)(U + ((size_t)gg * 1024 + (row >> 11) * 64 + (t >> 5)) * 640 + (t & 31) * 16 + (gc & 15)) = w; }
                    else *(PG8_GAS u32x4*)(rowp + bj * HALF) = w;
                    if (bj == 0 && u.pn == 1) { float q = (bf_lo(w.x) * bf_lo(w.x) + bf_hi(w.x) * bf_hi(w.x)) + (bf_lo(w.y) * bf_lo(w.y) + bf_hi(w.y) * bf_hi(w.y))
                                                      + (bf_lo(w.z) * bf_lo(w.z) + bf_hi(w.z) * bf_hi(w.z)) + (bf_lo(w.w) * bf_lo(w.w) + bf_hi(w.w) * bf_hi(w.w));
                        q = quad_sum(q); if (fq == 0) stat_add(sskv + row, q); } } }
    }
};
struct EpiGlu {
    static constexpr bool PERM = true, AFTER_DRAIN = false; static constexpr int MIDT = 0, MIDT2 = 0;
    const bf16_t* Y; bf16_t* O; stat_t* ssb;
    __device__ __forceinline__ void operator()(const f32x4 (&acc)[2][2][4][2], const Unit& u, int wr, int wc, int fr, int fq) const {
        const int row0 = u.pm * BM + wr * 64 + fr, col0 = u.pn * BM + wc * 32 + 8 * fq;
#pragma unroll
        for (int ai = 0; ai < 2; ++ai) {
            u32x4 yl[4][2];
#pragma unroll
            for (int m = 0; m < 4; ++m) { const int row = row0 + ai * HALF + m * 16; const PG8_GAS u32x4* rp = (const PG8_GAS u32x4*)(Y + (size_t)row * 512 + col0); yl[m][0] = rp[0]; yl[m][1] = rp[HALF / 8]; }
#pragma unroll
            for (int m = 0; m < 4; ++m) { const int row = row0 + ai * HALF + m * 16; float q = 0.f;
#pragma unroll
                for (int bj = 0; bj < 2; ++bj) { const u32x4 y8 = yl[m][bj];
                    const f32x4 g0 = acc[ai][bj][m][0], g1 = acc[ai][bj][m][1];
                    float o[8]; const float yv[8] = {bf_lo(y8.x), bf_hi(y8.x), bf_lo(y8.y), bf_hi(y8.y), bf_lo(y8.z), bf_hi(y8.z), bf_lo(y8.w), bf_hi(y8.w)};
                    const float gv[8] = {g0[0], g0[1], g0[2], g0[3], g1[0], g1[1], g1[2], g1[3]};
#pragma unroll
                    for (int j = 0; j < 8; ++j) o[j] = yv[j] * __builtin_amdgcn_rcpf(1.0f + __expf(-gv[j]));
                    u32x4 w; w.x = cvt_pk_bf16(o[0], o[1]); w.y = cvt_pk_bf16(o[2], o[3]); w.z = cvt_pk_bf16(o[4], o[5]); w.w = cvt_pk_bf16(o[6], o[7]);
                    *(PG8_GAS u32x4*)(O + (size_t)row * 1024 + col0 + bj * HALF) = w;
                    q += (bf_lo(w.x) * bf_lo(w.x) + bf_hi(w.x) * bf_hi(w.x)) + (bf_lo(w.y) * bf_lo(w.y) + bf_hi(w.y) * bf_hi(w.y))
                       + (bf_lo(w.z) * bf_lo(w.z) + bf_hi(w.z) * bf_hi(w.z)) + (bf_lo(w.w) * bf_lo(w.w) + bf_hi(w.w) * bf_hi(w.w)); }
                q = quad_sum(q); if (fq == 0) stat_add(ssb + row, q); } }
    }
};
template <bool OUT> struct EpiRes {
    static constexpr bool PERM = true, AFTER_DRAIN = false; static constexpr int MIDT = OUT ? 8 : 0, MIDT2 = OUT ? 12 : 0;
    bf16_t* H; stat_t* ssn;
    const PG8_LAS float* fac; int pm0;
    __device__ __forceinline__ void mid(f32x4 (&acc)[2][2][4][2], const Unit& u, int wr, int fr, int t) const {
        const PG8_LAS float* fp = fac + ((u.pm != pm0) ? 1024 : 0) + ((t == MIDT) ? 0 : 1);
#pragma unroll
        for (int ai = 0; ai < 2; ++ai)
#pragma unroll
            for (int m = 0; m < 4; ++m) { const float f = fp[(ai * HALF + wr * 64 + m * 16 + fr) * 4];
#pragma unroll
                for (int bj = 0; bj < 2; ++bj)
#pragma unroll
                    for (int n = 0; n < 2; ++n) acc[ai][bj][m][n] *= f; }
    }
    __device__ __forceinline__ void operator()(const f32x4 (&acc)[2][2][4][2], const Unit& u, int wr, int wc, int fr, int fq) const {
        const int row0 = u.pm * BM + wr * 64 + fr, col0 = u.pn * BM + wc * 32 + 8 * fq;
        const PG8_LAS float* fp = fac + ((u.pm != pm0) ? 1024 : 0) + 2;
#pragma unroll
        for (int ai = 0; ai < 2; ++ai) {
            u32x4 h8[4][2];
#pragma unroll
            for (int m = 0; m < 4; ++m) { const int row = row0 + ai * HALF + m * 16; const PG8_GAS u32x4* rp = (const PG8_GAS u32x4*)(H + (size_t)row * 1024 + col0);
                h8[m][0] = rp[0]; h8[m][1] = rp[HALF / 8]; }
#pragma unroll
            for (int m = 0; m < 4; ++m) { const int row = row0 + ai * HALF + m * 16; float q = 0.f; PG8_GAS u32x4* wp = (PG8_GAS u32x4*)(H + (size_t)row * 1024 + col0);
                float post = 1.0f; if (OUT) post = fp[(ai * HALF + wr * 64 + m * 16 + fr) * 4];
#pragma unroll
                for (int bj = 0; bj < 2; ++bj) { const u32x4 hv = h8[m][bj];
                    const f32x4 a0 = acc[ai][bj][m][0] * post, a1 = acc[ai][bj][m][1] * post;
                    u32x4 w; w.x = cvt_pk_bf16(bf_lo(hv.x) + a0[0], bf_hi(hv.x) + a0[1]); w.y = cvt_pk_bf16(bf_lo(hv.y) + a0[2], bf_hi(hv.y) + a0[3]);
                    w.z = cvt_pk_bf16(bf_lo(hv.z) + a1[0], bf_hi(hv.z) + a1[1]); w.w = cvt_pk_bf16(bf_lo(hv.w) + a1[2], bf_hi(hv.w) + a1[3]);
                    wp[bj * (HALF / 8)] = w;
                    q += (bf_lo(w.x) * bf_lo(w.x) + bf_hi(w.x) * bf_hi(w.x)) + (bf_lo(w.y) * bf_lo(w.y) + bf_hi(w.y) * bf_hi(w.y))
                       + (bf_lo(w.z) * bf_lo(w.z) + bf_hi(w.z) * bf_hi(w.z)) + (bf_lo(w.w) * bf_lo(w.w) + bf_hi(w.w) * bf_hi(w.w)); }
                q = quad_sum(q); if (fq == 0) stat_add(ssn + row, q); } }
    }
};
struct EpiMlp1 {
    static constexpr bool PERM = true, AFTER_DRAIN = false; static constexpr int MIDT = 0, MIDT2 = 0;
    bf16_t* O; const stat_t* ss;
    __device__ __forceinline__ void operator()(const f32x4 (&acc)[2][2][4][2], const Unit& u, int wr, int wc, int fr, int fq) const {
        const int row0 = u.pm * BM + wr * 64 + fr, col0 = u.pn * BM + wc * 32 + 8 * fq;
#pragma unroll
        for (int ai = 0; ai < 2; ++ai)
#pragma unroll
            for (int m = 0; m < 4; ++m) { const int row = row0 + ai * HALF + m * 16; const float r = rsqrtf(stat_get(ss + row) * (1.0f / 1024.0f) + RMS_EPS);
                bf16_t* rowp = O + (size_t)row * 4096 + col0;
#pragma unroll
                for (int bj = 0; bj < 2; ++bj) { f32x4 v0 = acc[ai][bj][m][0] * r, v1 = acc[ai][bj][m][1] * r;
#pragma unroll
                    for (int j = 0; j < 4; ++j) { const float a = fmaxf(v0[j], 0.f), b = fmaxf(v1[j], 0.f); v0[j] = a * a; v1[j] = b * b; }
                    u32x4 w; w.x = cvt_pk_bf16(v0[0], v0[1]); w.y = cvt_pk_bf16(v0[2], v0[3]); w.z = cvt_pk_bf16(v1[0], v1[1]); w.w = cvt_pk_bf16(v1[2], v1[3]);
                    *(u32x4*)(rowp + bj * HALF) = w; } }
    }
};
__device__ __forceinline__ float relu_i(float x) { const int i = (int)__builtin_bit_cast(unsigned, x); return __builtin_bit_cast(float, (unsigned)(i > 0 ? i : 0)); }
__device__ __forceinline__ unsigned pk4_fp8(float a, float b, float c, float d) {
    a = __builtin_amdgcn_fmed3f(a, -448.f, 448.f); b = __builtin_amdgcn_fmed3f(b, -448.f, 448.f); c = __builtin_amdgcn_fmed3f(c, -448.f, 448.f); d = __builtin_amdgcn_fmed3f(d, -448.f, 448.f);
    int w = 0; w = __builtin_amdgcn_cvt_pk_fp8_f32(a, b, w, false); w = __builtin_amdgcn_cvt_pk_fp8_f32(c, d, w, true); return (unsigned)w;
}
constexpr float HID_SCALE = 0.25f; static_assert(HID_SCALE == 0.25f, "EpiMlp1F8B folds sqrt(HID_SCALE) = 0.5 into its column scales");
struct EpiMlp1F8 {
    static constexpr bool PERM = true, AFTER_DRAIN = false; static constexpr int MIDT = 0, MIDT2 = 0;
    unsigned char* O; const stat_t* ss;
    __device__ __forceinline__ void operator()(const f32x4 (&acc)[2][2][4][2], const Unit& u, int wr, int wc, int fr, int fq) const {
        typedef unsigned u32x2v __attribute__((ext_vector_type(2)));
        const int row0 = u.pm * BM + wr * 64 + fr, col0 = u.pn * BM + wc * 32 + 8 * fq;
#pragma unroll
        for (int ai = 0; ai < 2; ++ai)
#pragma unroll
            for (int m = 0; m < 4; ++m) { const int row = row0 + ai * HALF + m * 16; const float r = rsqrtf(stat_get(ss + row) * (1.0f / 1024.0f) + RMS_EPS);
                unsigned char* rowp = O + (size_t)row * 4096 + col0;
#pragma unroll
                for (int bj = 0; bj < 2; ++bj) { f32x4 v0 = acc[ai][bj][m][0] * r, v1 = acc[ai][bj][m][1] * r;
#pragma unroll
                    for (int j = 0; j < 4; ++j) { const float a = fmaxf(v0[j], 0.f), b = fmaxf(v1[j], 0.f); v0[j] = a * a * HID_SCALE; v1[j] = b * b * HID_SCALE; }
                    u32x2v w; w.x = pk4_fp8(v0[0], v0[1], v0[2], v0[3]); w.y = pk4_fp8(v1[0], v1[1], v1[2], v1[3]);
                    *(u32x2v*)(rowp + bj * HALF) = w; } }
    }
};
struct EpiMlp1F8B {
    static constexpr bool PERM = true, AFTER_DRAIN = false; static constexpr int MIDT = 0, MIDT2 = 0;
    unsigned char* O; const unsigned* wmax;
    __device__ __forceinline__ void operator()(const f32x4 (&acc)[2][2][4][2], const Unit& u, int wr, int wc, int fr, int fq) const {
        const int row0 = u.pm * BM + wr * 64 + fr, col0 = u.pn * BM + wc * 32 + 8 * fq;
        f32x4 cs[2][2];
#pragma unroll
        for (int bj = 0; bj < 2; ++bj)
#pragma unroll
            for (int n = 0; n < 2; ++n) { const u32x4 wm = *(const PG8_GAS u32x4*)(wmax + col0 + bj * HALF + 4 * n);
                cs[bj][n] = (f32x4){fmaxf(__uint_as_float(wm.x), 1e-30f), fmaxf(__uint_as_float(wm.y), 1e-30f), fmaxf(__uint_as_float(wm.z), 1e-30f), fmaxf(__uint_as_float(wm.w), 1e-30f)} * (0.5f / (448.0f * 8.0f)); }
        const bool odd = (fq & 1) != 0;
#pragma unroll
        for (int ai = 0; ai < 2; ++ai)
#pragma unroll
            for (int mp = 0; mp < 4; mp += 2) {
#pragma unroll
                for (int bj = 0; bj < 2; ++bj) { unsigned wa[2][2];
#pragma unroll
                    for (int q = 0; q < 2; ++q) { f32x4 v0 = acc[ai][bj][mp + q][0] * cs[bj][0], v1 = acc[ai][bj][mp + q][1] * cs[bj][1];
#pragma unroll
                        for (int j = 0; j < 4; ++j) { const float a = relu_i(v0[j]), b = relu_i(v1[j]); v0[j] = a * a; v1[j] = b * b; }
                        wa[q][0] = pk4_fp8(v0[0], v0[1], v0[2], v0[3]); wa[q][1] = pk4_fp8(v1[0], v1[1], v1[2], v1[3]); }
                    const unsigned s0 = odd ? wa[0][0] : wa[1][0], s1 = odd ? wa[0][1] : wa[1][1];
                    const unsigned r0 = (unsigned)__shfl_xor((int)s0, 16), r1 = (unsigned)__shfl_xor((int)s1, 16);
                    u32x4 o; if (odd) { o.x = r0; o.y = r1; o.z = wa[1][0]; o.w = wa[1][1]; } else { o.x = wa[0][0]; o.y = wa[0][1]; o.z = r0; o.w = r1; }
                    const int row = row0 + ai * HALF + (mp + (odd ? 1 : 0)) * 16;
                    *(PG8_GAS u32x4*)(O + (size_t)row * 4096 + (col0 & ~15) + bj * HALF) = o; } }
    }
};
struct EpiRes8 {
    static constexpr bool PERM = true, AFTER_DRAIN = false; static constexpr int MIDT = 0, MIDT2 = 0;
    bf16_t* H; stat_t* ssn; const unsigned* wmax;
    __device__ __forceinline__ void operator()(const f32x4 (&acc)[2][2][4][2], const Unit& u, int wr, int wc, int fr, int fq) const {
        const int row0 = u.pm * BM + wr * 64 + fr, col0 = u.pn * BM + wc * 32 + 8 * fq;
        f32x4 cs[2][2];
#pragma unroll
        for (int bj = 0; bj < 2; ++bj)
#pragma unroll
            for (int n = 0; n < 2; ++n) { const u32x4 wm = *(const u32x4*)(wmax + col0 + bj * HALF + 4 * n);
                cs[bj][n] = (f32x4){fmaxf(__uint_as_float(wm.x), 1e-30f), fmaxf(__uint_as_float(wm.y), 1e-30f), fmaxf(__uint_as_float(wm.z), 1e-30f), fmaxf(__uint_as_float(wm.w), 1e-30f)} * (1.0f / (448.0f * HID_SCALE)); }
#pragma unroll
        for (int ai = 0; ai < 2; ++ai) {
            u32x4 h8[4][2];
#pragma unroll
            for (int m = 0; m < 4; ++m) { const int row = row0 + ai * HALF + m * 16; const PG8_GAS u32x4* rp = (const PG8_GAS u32x4*)(H + (size_t)row * 1024 + col0); h8[m][0] = rp[0]; h8[m][1] = rp[HALF / 8]; }
#pragma unroll
            for (int m = 0; m < 4; ++m) { const int row = row0 + ai * HALF + m * 16; float q = 0.f; PG8_GAS u32x4* wp = (PG8_GAS u32x4*)(H + (size_t)row * 1024 + col0);
#pragma unroll
                for (int bj = 0; bj < 2; ++bj) { const u32x4 hv = h8[m][bj];
                    const f32x4 a0 = acc[ai][bj][m][0] * cs[bj][0], a1 = acc[ai][bj][m][1] * cs[bj][1];
                    u32x4 w; w.x = cvt_pk_bf16(bf_lo(hv.x) + a0[0], bf_hi(hv.x) + a0[1]); w.y = cvt_pk_bf16(bf_lo(hv.y) + a0[2], bf_hi(hv.y) + a0[3]);
                    w.z = cvt_pk_bf16(bf_lo(hv.z) + a1[0], bf_hi(hv.z) + a1[1]); w.w = cvt_pk_bf16(bf_lo(hv.w) + a1[2], bf_hi(hv.w) + a1[3]);
                    wp[bj * (HALF / 8)] = w;
                    q += (bf_lo(w.x) * bf_lo(w.x) + bf_hi(w.x) * bf_hi(w.x)) + (bf_lo(w.y) * bf_lo(w.y) + bf_hi(w.y) * bf_hi(w.y))
                       + (bf_lo(w.z) * bf_lo(w.z) + bf_hi(w.z) * bf_hi(w.z)) + (bf_lo(w.w) * bf_lo(w.w) + bf_hi(w.w) * bf_hi(w.w)); }
                q = quad_sum(q); if (fq == 0) stat_add(ssn + row, q); } }
    }
};
typedef int v8i_t __attribute__((ext_vector_type(8))); typedef int v4i_t __attribute__((ext_vector_type(4)));
template <class Epi, class Sched, bool ALIGN_EPI = false, bool SP2 = false, bool F8 = false>
__device__ __forceinline__ void gemm_phase(PG8_LAS unsigned char* lds, const Gemm g, const Sched& S, const Epi& E, const int wid_in) {
    int lane_; asm volatile("v_mbcnt_lo_u32_b32 %0, -1, 0\n\tv_mbcnt_hi_u32_b32 %0, -1, %0" : "=v"(lane_)); const int tid_ = wid_in * 64 + lane_;
    const int tid = tid_, wid = wid_in, lane = lane_, wr = wid >> 2, wc = wid & 3, fr = lane & 15, fq = lane >> 4;
    const int K = g.K, nt = K / BK;
    unsigned voffA[2], voffB[2];
#pragma unroll
    for (int i = 0; i < 2; ++i) { int R, C; stage_rc(tid * 16 + i * 8192, R, C); const int Rb = Epi::PERM ? ((R & ~31) + perm32(R & 31)) : R;
        voffA[i] = (unsigned)(R * K + C) * 2u; voffB[i] = (unsigned)(Rb * K + C) * 2u; }
    const size_t kstep = (size_t)(BK * 2);
    const size_t hstep = (size_t)HALF * K * 2;
    const size_t tstep = 2 * hstep;
    const unsigned ldsw = (unsigned)wid * 1024u;
    const int aoff = lds_byte(wr * 64 + fr, fq * 8), boff = lds_byte(wc * 32 + fr, fq * 8);
#define PG8_SA(b, h) (((b) * 2 + (h)) * HTB)
#define PG8_SB(b, h) ((4 + (b) * 2 + (h)) * HTB)
#define PG8_STAGE(bufoff, gbase, voff) do { _Pragma("unroll") for (int _i = 0; _i < 2; ++_i) \
        __builtin_amdgcn_global_load_lds((const unsigned*)((const char*)(gbase) + (voff)[_i]), (PG8_LAS unsigned*)(lds + (bufoff) + ldsw + _i * 8192), 16, 0, 0); } while (0)
#define PG8_LDA(dst, b, h) do { if constexpr (F8) { _Pragma("unroll") for (int m = 0; m < 4; ++m) dst##_8[m] = __builtin_shufflevector(*(const PG8_LAS v4i_t*)(lds + PG8_SA(b, h) + aoff + m * 2048), *(const PG8_LAS v4i_t*)(lds + PG8_SA(b, h) + aoff + m * 2048 + 1024), 0, 1, 2, 3, 4, 5, 6, 7); } \
        else { _Pragma("unroll") for (int m = 0; m < 4; ++m) _Pragma("unroll") for (int k = 0; k < 2; ++k) dst[m][k] = *(const PG8_LAS bf16x8*)(lds + PG8_SA(b, h) + aoff + m * 2048 + k * 1024); } } while (0)
#define PG8_LDB(dst, b, h) do { if constexpr (F8) { _Pragma("unroll") for (int n = 0; n < 2; ++n) dst##_8[n] = __builtin_shufflevector(*(const PG8_LAS v4i_t*)(lds + PG8_SB(b, h) + boff + n * 2048), *(const PG8_LAS v4i_t*)(lds + PG8_SB(b, h) + boff + n * 2048 + 1024), 0, 1, 2, 3, 4, 5, 6, 7); } \
        else { _Pragma("unroll") for (int n = 0; n < 2; ++n) _Pragma("unroll") for (int k = 0; k < 2; ++k) dst[n][k] = *(const PG8_LAS bf16x8*)(lds + PG8_SB(b, h) + boff + n * 2048 + k * 1024); } } while (0)
#define PG8_MMA(ai, bj, At, Bt) do { __builtin_amdgcn_s_setprio(1); \
        if constexpr (F8) { _Pragma("unroll") for (int m = 0; m < 4; ++m) _Pragma("unroll") for (int n = 0; n < 2; ++n) { \
            asm volatile("v_mfma_f32_16x16x128_f8f6f4 %0, %1, %2, %0" : "+v"(acc[ai][bj][m][n]) : "v"(Bt##_8[n]), "v"(At##_8[m])); } } \
        else { _Pragma("unroll") for (int m = 0; m < 4; ++m) _Pragma("unroll") for (int n = 0; n < 2; ++n) _Pragma("unroll") for (int k = 0; k < 2; ++k) \
            acc[ai][bj][m][n] = __builtin_amdgcn_mfma_f32_16x16x32_bf16(Bt[n][k], At[m][k], acc[ai][bj][m][n], 0, 0, 0); } \
        __builtin_amdgcn_s_setprio(0); } while (0)
#define PG8_WAIT_V(n) asm volatile("s_waitcnt vmcnt(" #n ")" ::: "memory")
#define PG8_WAIT_L(n) asm volatile("s_waitcnt lgkmcnt(" #n ")" ::: "memory")
#define PG8_BAR __builtin_amdgcn_s_barrier()
#define PG8_SCHED __builtin_amdgcn_sched_barrier(0)
    Unit cur, nxt; int ui = 0;
    if (!S.next(0, cur)) return;
    f32x4 acc[2][2][4][2];
#pragma unroll
    for (int a = 0; a < 2; ++a)
#pragma unroll
        for (int b = 0; b < 2; ++b)
#pragma unroll
            for (int m = 0; m < 4; ++m)
#pragma unroll
                for (int n = 0; n < 2; ++n) acc[a][b][m][n] = (f32x4){0.f, 0.f, 0.f, 0.f};
    bf16x8 At[4][2], B0[2][2], B1[2][2];
    v8i_t At_8[4], B0_8[2], B1_8[2];
    const char* cA = (const char*)g.A + (size_t)cur.pm * tstep; const char* cB = (const char*)g.Bt + (size_t)cur.pn * tstep;
    S.a_ready(cur);
    if constexpr (SP2) {
        PG8_STAGE(PG8_SB(0, 0), cB, voffB); PG8_STAGE(PG8_SB(0, 1), cB + hstep, voffB); PG8_STAGE(PG8_SA(0, 0), cA, voffA); PG8_STAGE(PG8_SA(0, 1), cA + hstep, voffA);
        if (wr == 1) PG8_BAR;
        PG8_WAIT_V(2); PG8_BAR;
        PG8_STAGE(PG8_SB(1, 0), cB + kstep, voffB); PG8_STAGE(PG8_SA(1, 0), cA + kstep, voffA); PG8_STAGE(PG8_SB(1, 1), cB + hstep + kstep, voffB);
        PG8_WAIT_V(6); PG8_BAR;
    } else {
        PG8_STAGE(PG8_SB(0, 0), cB, voffB); PG8_STAGE(PG8_SA(0, 0), cA, voffA); PG8_STAGE(PG8_SB(0, 1), cB + hstep, voffB); PG8_STAGE(PG8_SA(0, 1), cA + hstep, voffA);
        if (wr == 1) PG8_BAR;
        PG8_WAIT_V(4); PG8_BAR;
        PG8_STAGE(PG8_SB(1, 0), cB + kstep, voffB); PG8_STAGE(PG8_SA(1, 0), cA + kstep, voffA); PG8_STAGE(PG8_SB(1, 1), cB + hstep + kstep, voffB);
        PG8_WAIT_V(6); PG8_BAR;
    }
    for (;;) {
        const bool has_next = S.next(ui + 1, nxt);
        const char* nA = has_next ? (const char*)g.A + (size_t)nxt.pm * tstep : cA; const char* nB = has_next ? (const char*)g.Bt + (size_t)nxt.pn * tstep : cB;
        for (int t = 0; t < nt; t += 2) {
            const bool last = (t == nt - 2);
            const char* a1 = cA + (size_t)(t + 1) * kstep;
            const char* a2 = last ? nA : cA + (size_t)(t + 2) * kstep; const char* b2 = last ? nB : cB + (size_t)(t + 2) * kstep;
            const char* a3 = a2 + kstep; const char* b3 = b2 + kstep;
            if (last && has_next) S.a_ready(nxt);
            if constexpr (SP2) {
            PG8_LDB(B0, 0, 0); PG8_LDB(B1, 0, 1); PG8_SCHED; PG8_LDA(At, 0, 0); PG8_STAGE(PG8_SA(1, 1), a1 + hstep, voffA);
            PG8_WAIT_V(8); PG8_WAIT_L(0); PG8_BAR; PG8_MMA(0, 0, At, B0); PG8_MMA(0, 1, At, B1); PG8_BAR; PG8_SCHED;
            PG8_LDA(At, 0, 1); PG8_STAGE(PG8_SB(0, 0), b2, voffB); PG8_STAGE(PG8_SB(0, 1), b2 + hstep, voffB); PG8_STAGE(PG8_SA(0, 0), a2, voffA);
            PG8_WAIT_V(8); PG8_WAIT_L(0); PG8_BAR; PG8_MMA(1, 0, At, B0); PG8_MMA(1, 1, At, B1); PG8_BAR; PG8_SCHED;
            PG8_LDB(B0, 1, 0); PG8_LDB(B1, 1, 1); PG8_SCHED; PG8_LDA(At, 1, 0); PG8_STAGE(PG8_SA(0, 1), a2 + hstep, voffA);
            PG8_WAIT_V(8); PG8_WAIT_L(0); PG8_BAR; PG8_MMA(0, 0, At, B0); PG8_MMA(0, 1, At, B1); PG8_BAR; PG8_SCHED;
            PG8_LDA(At, 1, 1); PG8_STAGE(PG8_SB(1, 0), b3, voffB); PG8_STAGE(PG8_SB(1, 1), b3 + hstep, voffB); PG8_STAGE(PG8_SA(1, 0), a3, voffA);
            PG8_WAIT_V(8); PG8_WAIT_L(0); PG8_BAR; PG8_MMA(1, 0, At, B0); PG8_MMA(1, 1, At, B1); PG8_BAR; PG8_SCHED;
            } else {
            PG8_LDB(B0, 0, 0); PG8_SCHED; PG8_LDA(At, 0, 0); PG8_STAGE(PG8_SA(1, 1), a1 + hstep, voffA);
            PG8_WAIT_L(8); PG8_BAR; PG8_WAIT_L(0); PG8_MMA(0, 0, At, B0); PG8_BAR; PG8_SCHED;
            PG8_LDB(B1, 0, 1); PG8_STAGE(PG8_SB(0, 0), b2, voffB);
            PG8_BAR; PG8_WAIT_L(0); PG8_MMA(0, 1, At, B1); PG8_BAR;
            PG8_LDA(At, 0, 1); PG8_STAGE(PG8_SA(0, 0), a2, voffA);
            PG8_BAR; PG8_WAIT_L(0); PG8_MMA(1, 0, At, B0); PG8_BAR; PG8_SCHED;
            PG8_STAGE(PG8_SB(0, 1), b2 + hstep, voffB);
            PG8_WAIT_V(6); PG8_BAR; PG8_MMA(1, 1, At, B1); PG8_BAR;
            PG8_LDB(B0, 1, 0); PG8_SCHED; PG8_LDA(At, 1, 0); PG8_STAGE(PG8_SA(0, 1), a2 + hstep, voffA);
            PG8_WAIT_L(8); PG8_BAR; PG8_WAIT_L(0); PG8_MMA(0, 0, At, B0); PG8_BAR; PG8_SCHED;
            PG8_LDB(B1, 1, 1); PG8_STAGE(PG8_SB(1, 0), b3, voffB);
            PG8_BAR; PG8_WAIT_L(0); PG8_MMA(0, 1, At, B1); PG8_BAR;
            PG8_LDA(At, 1, 1); PG8_STAGE(PG8_SA(1, 0), a3, voffA);
            PG8_BAR; PG8_WAIT_L(0); PG8_MMA(1, 0, At, B0); PG8_BAR; PG8_SCHED;
            PG8_STAGE(PG8_SB(1, 1), b3 + hstep, voffB);
            PG8_WAIT_V(6); PG8_BAR; PG8_MMA(1, 1, At, B1); PG8_BAR;
            }
            if constexpr (Epi::MIDT > 0) { if (t + 2 == Epi::MIDT || t + 2 == Epi::MIDT2) { int l2_; asm volatile("v_mbcnt_lo_u32_b32 %0, -1, 0\n\tv_mbcnt_hi_u32_b32 %0, -1, %0" : "=v"(l2_)); E.mid(acc, cur, wr, l2_ & 15, t + 2); } }
        }
        if constexpr (F8) asm volatile("s_nop 15\n\ts_nop 15" ::: "memory");
        if constexpr (ALIGN_EPI) { if (wr == 0) PG8_BAR; }
        if constexpr (!Epi::AFTER_DRAIN) { int l2_; asm volatile("v_mbcnt_lo_u32_b32 %0, -1, 0\n\tv_mbcnt_hi_u32_b32 %0, -1, %0" : "=v"(l2_));
            E(acc, cur, wr, wc, l2_ & 15, l2_ >> 4); S.done(cur); }
        if (!has_next) break;
#pragma unroll
        for (int a = 0; a < 2; ++a)
#pragma unroll
            for (int b = 0; b < 2; ++b)
#pragma unroll
                for (int m = 0; m < 4; ++m)
#pragma unroll
                    for (int n = 0; n < 2; ++n) acc[a][b][m][n] = (f32x4){0.f, 0.f, 0.f, 0.f};
        cur = nxt; cA = nA; cB = nB; ++ui;
        if constexpr (ALIGN_EPI) { if (wr == 1) PG8_BAR; }
    }
    PG8_WAIT_V(0);
    if constexpr (!ALIGN_EPI) { if (wr == 0) PG8_BAR; }
    PG8_BAR;
    if constexpr (Epi::AFTER_DRAIN) { E.fused(acc, cur, wr, wc, fr, fq, lds, wid, lane); S.done(cur); }
#undef PG8_SA
#undef PG8_SB
#undef PG8_STAGE
#undef PG8_LDA
#undef PG8_LDB
#undef PG8_MMA
#undef PG8_WAIT_V
#undef PG8_WAIT_L
#undef PG8_BAR
#undef PG8_SCHED
}
}

constexpr int NWAVES = 8;
constexpr int BATCH = 16, SEQ = 2048, DM = 1024, DEPTH = 2, NMETA = 16, DFF = 4096;
constexpr int MROWS = 33024;
constexpr int MREAL = BATCH * SEQ, MVALID = MREAL + NMETA;
constexpr int NIN_SRC = 1988, NIN = 2048;
constexpr int PC_QA = 0, PC_CKV = 256, PC_IK = 384, PC_IW = 448, PC_IQ = 512, PC_UB = 768, PC_QC = 1280, PC_KC = 1536, PC_VC = 1792;
constexpr int YC_B = 0, YC_A = 512, YC_C = 768;
constexpr int TOPK = 256;

constexpr size_t MiB = 1u << 20;
constexpr size_t WS_CTL = 0;
constexpr size_t WS_STATS = 1 * MiB, CTL_ZERO_BYTES = 5 * MiB;
constexpr size_t STAT_STRIDE = 33024;
enum StatId { ST_SS1 = 0, ST_SSKV = 1, ST_SSB = 2, ST_SS2 = 3, ST_SSA = 4, ST_SSC = 5, ST_PER_LAYER = 6 };
constexpr size_t WS_W = 6 * MiB;
constexpr size_t W_LAYER = 23 * MiB, WO_IN = 0, WO_GLU = 4 * MiB, WO_OUT = 5 * MiB, WO_1 = 7 * MiB, WO_2 = 15 * MiB;
constexpr size_t WS_HB = 52 * MiB;
constexpr size_t WS_BIG = 118 * MiB;
constexpr size_t WS_P = WS_BIG, WS_YCAT = WS_BIG + 130 * MiB, WS_YG = WS_BIG + 196 * MiB;
constexpr size_t WS_END = 376 * MiB;
constexpr size_t WS_WUKF = 497 * MiB - 512 * 1024, WS_WUVF = WS_WUKF + 128 * 1024;
static_assert(WS_STATS + (2 * ST_PER_LAYER + 1) * STAT_STRIDE * 8 <= CTL_ZERO_BYTES && CTL_ZERO_BYTES <= WS_W && WS_W + 2 * W_LAYER <= WS_HB && WS_HB + (size_t)MROWS * 1024 * 2 <= WS_BIG && WS_P + (size_t)MROWS * 2048 * 2 <= WS_YCAT && WS_YCAT + (size_t)MROWS * 1024 * 2 <= WS_YG
              && WS_YG + (size_t)MROWS * 512 * 2 <= WS_BIG + (size_t)MROWS * 4096 * 2 && WS_BIG + (size_t)MROWS * 4096 * 2 <= WS_END, "d_ws map");
constexpr int CW_TMO = 0, CW_CODE = 1;
constexpr int CW_BAR = 4096;
constexpr int CW_WMAX1 = 65536 + 2048;
constexpr int CW_WMAX = 65536;
constexpr int CW_SF = 120000;
constexpr int CW_Q = 16384;

constexpr int RING_OFF = 0, RING_BYTES = 131072;
constexpr int LDSCTL_OFF = RING_BYTES, MISC_OFF = LDSCTL_OFF + 320;
constexpr int LDS_BYTES = 147456;

#define GAS __attribute__((address_space(1)))
#define LAS __attribute__((address_space(3)))
typedef unsigned short bf16;
typedef unsigned v4u __attribute__((ext_vector_type(4)));
typedef float f32x4 __attribute__((ext_vector_type(4)));
typedef GAS unsigned gu32;
#define RLX_AGENT __ATOMIC_RELAXED, __HIP_MEMORY_SCOPE_AGENT
#define LDS_WAIT() asm volatile("s_waitcnt lgkmcnt(0)" ::: "memory")
#define VM_WAIT() asm volatile("s_waitcnt vmcnt(0)" ::: "memory")
__device__ __forceinline__ unsigned f2bf(float f) { unsigned u = __builtin_bit_cast(unsigned, f); return (u + 0x7fffu + ((u >> 16) & 1u)) >> 16; }
__device__ __forceinline__ unsigned pk2(float lo, float hi) { return f2bf(lo) | (f2bf(hi) << 16); }
__device__ __forceinline__ float bf2f(bf16 v) { return __uint_as_float((unsigned)v << 16); }
__device__ __forceinline__ float bflo(unsigned w) { return __uint_as_float(w << 16); }
__device__ __forceinline__ float bfhi(unsigned w) { return __uint_as_float(w & 0xffff0000u); }

__device__ __forceinline__ int lane_id() { int l; asm volatile("v_mbcnt_lo_u32_b32 %0, -1, 0\n\tv_mbcnt_hi_u32_b32 %0, -1, %0" : "=v"(l)); return l; }
#define XB_TMO      128
#define XB_XCNT(j)  (256  + 64 * (j))
#define XB_XSUB(j)  (1280 + 64 * (j))
#define XB_XGEN(j)  (2304 + 64 * (j))
#define XB_TOP      3328
#define XB_TOPGEN   3392
#define XCD_BAR_WORDS 3456
#define XB_SPIN_CAP (1u << 21)

__device__ __forceinline__ unsigned xb_ld(unsigned* p)              { return __hip_atomic_load(p, __ATOMIC_RELAXED, __HIP_MEMORY_SCOPE_AGENT); }
__device__ __forceinline__ unsigned xb_add(unsigned* p, unsigned v) { return __hip_atomic_fetch_add(p, v, __ATOMIC_RELAXED, __HIP_MEMORY_SCOPE_AGENT); }
__device__ __forceinline__ unsigned xb_xcc_id() { return (unsigned)__builtin_amdgcn_s_getreg((3 << 11) | 20) & 0xFu; }
#define XB_SPIN(cond, bar) do { unsigned _sp = 0; while (cond) { __builtin_amdgcn_s_sleep(1); \
    if ((++_sp & 255u) == 0u) { if (xb_ld(&(bar)[XB_TMO])) break; if (_sp > XB_SPIN_CAP) { atomicAdd(&(bar)[XB_TMO], 1u); break; } } } } while (0)

struct XcdBarrier { unsigned* bar; unsigned x; volatile LAS unsigned* st; };
__device__ __forceinline__ XcdBarrier xcd_barrier_post(unsigned* bar, volatile LAS unsigned* st, int wave) {
    XcdBarrier b; b.bar = bar; b.x = xb_xcc_id(); b.st = st;
    if (wave == 0 && lane_id() == 0) (void)xb_add(&bar[XB_XCNT(b.x)], 1u);
    return b;
}
__device__ __forceinline__ void xcd_barrier_complete(unsigned* bar, unsigned x, unsigned& nloc, unsigned& nx) {
    const unsigned G = gridDim.x * gridDim.y * gridDim.z;
    unsigned sum, cnt, mine, sp = 0u;
    for (;;) {
        sum = 0u; cnt = 0u; mine = 0u;
#pragma unroll
        for (unsigned j = 0; j < 16; ++j) { const unsigned c = xb_ld(&bar[XB_XCNT(j)]); sum += c; cnt += (c > 0u) ? 1u : 0u; mine = (j == x) ? c : mine; }
        if (sum == G) break;
        __builtin_amdgcn_s_sleep(1);
        if ((++sp & 255u) == 0u) { if (xb_ld(&bar[XB_TMO])) break; if (sp > XB_SPIN_CAP) { atomicAdd(&bar[XB_TMO], 1u); break; } }
    }
    nloc = mine > 0u ? mine : 1u; nx = cnt > 0u ? cnt : 1u;
}
__device__ __forceinline__ void xcd_barrier(const XcdBarrier& b, int wave) {
    asm volatile("s_waitcnt vmcnt(0)" ::: "memory");
    __syncthreads();
    if (wave == 0 && lane_id() == 0) {
        unsigned* bar = b.bar;
        __builtin_amdgcn_s_waitcnt(0);
        unsigned nloc = b.st[0], nx = b.st[1];
        if (nloc == 0u) { xcd_barrier_complete(bar, b.x, nloc, nx); b.st[0] = nloc; b.st[1] = nx; }
        const unsigned old = xb_add(&bar[XB_XSUB(b.x)], 1u);
        const unsigned gen = old / nloc;
        if (old + 1u == (gen + 1u) * nloc) {
            __builtin_amdgcn_fence(__ATOMIC_RELEASE, "agent");
            asm volatile("s_waitcnt vmcnt(0)" ::: "memory");
            const unsigned og = xb_add(&bar[XB_TOP], 1u);
            const unsigned tg = og / nx;
            if (og + 1u == (tg + 1u) * nx) xb_add(&bar[XB_TOPGEN], 1u);
            else XB_SPIN(xb_ld(&bar[XB_TOPGEN]) == tg, bar);
            __builtin_amdgcn_fence(__ATOMIC_ACQUIRE, "agent");
            xb_add(&bar[XB_XGEN(b.x)], 1u);
            asm volatile("s_waitcnt vmcnt(0)" ::: "memory");
        } else {
            XB_SPIN(xb_ld(&bar[XB_XGEN(b.x)]) == gen, bar);
            __builtin_amdgcn_fence(__ATOMIC_ACQUIRE, "agent");
            asm volatile("s_waitcnt vmcnt(0)" ::: "memory");
        }
    }
    __syncthreads();
}


struct Args { const float* in[25]; float* out; unsigned char* ws; int ph_lo, ph_hi; };
struct Frame {
    LAS unsigned char* lds;
    volatile LAS unsigned* MISC;
    gu32* ctl;
    int wave;
    int vcu, G;
    float* out; unsigned char* ws;
};
using pg8::stat_t; using pg8::stat_get;
__device__ __forceinline__ stat_t* stat_ptr(Frame& F, int l, int id) { return (stat_t*)(F.ws + WS_STATS) + (size_t)(l * ST_PER_LAYER + id) * STAT_STRIDE; }
__device__ __forceinline__ bf16* wptr(Frame& F, int l, size_t off) { return (bf16*)(F.ws + WS_W + (size_t)l * W_LAYER + off); }
__device__ __forceinline__ float wave_sum(float v) {
#pragma unroll
    for (int o = 1; o < 64; o <<= 1) v += __shfl_xor(v, o);
    return v;
}
__device__ __forceinline__ float wave_max(float v) {
#pragma unroll
    for (int o = 1; o < 64; o <<= 1) v = fmaxf(v, __shfl_xor(v, o));
    return v;
}
__device__ __forceinline__ int row_step(const Frame& F, int s) {
    const int gw = F.vcu * NWAVES + F.wave;
    if (F.G == 256) { if (s < 4) return 4096 * (F.vcu >> 5) + 1024 * s + ((F.vcu & 31) * NWAVES + F.wave) * 4;
        const int m = MREAL + gw * 4; return (s == 4 && m < MVALID) ? m : -1; }
    const int m = (gw + s * F.G * NWAVES) * 4; return m < MVALID ? m : -1;
}
__device__ __forceinline__ int key_row(int b, int kp) { return kp < NMETA ? MREAL + kp : b * SEQ + (kp - NMETA); }

__device__ __forceinline__ int win_srccol(int n) {
    if (n < 384) return n;
    if (n < 448) return 640 + (n - 384);
    if (n < 452) return 704 + (n - 448);
    if (n < 512) return -1;
    if (n < 768) return 384 + (n - 512);
    if (n < 1280) return 708 + (n - 768);
    return 1220 + (n - 1280);
}
__device__ __forceinline__ void p0_transpose_item(const Args& A, Frame& F, int l, int mat, int item, LAS float* scr) {
    const int lane = lane_id();
    int N, K, ldw; const float* W; bf16* WT;
    if (mat == 0) { N = 2048; K = 1024; ldw = NIN_SRC; W = A.in[4] + (size_t)l * 1024 * NIN_SRC; WT = wptr(F, l, WO_IN); }
    else if (mat == 1) { N = 512; K = 512; ldw = 512; W = A.in[16] + (size_t)l * 512 * 512; WT = wptr(F, l, WO_GLU); }
    else if (mat == 2) { N = 1024; K = 1024; ldw = 1024; W = A.in[20] + (size_t)l * 1024 * 1024; WT = wptr(F, l, WO_OUT); }
    else if (mat == 3) { N = 4096; K = 1024; ldw = 4096; W = A.in[22] + (size_t)l * 1024 * 4096; WT = wptr(F, l, WO_1); }
    else { N = 1024; K = 4096; ldw = 1024; W = A.in[23] + (size_t)l * 4096 * 1024; WT = wptr(F, l, WO_2); }
    if (mat == 3) {
        const int nblk = N / 32, kb = item / nblk, nb = item % nblk, k0 = 64 * kb, n0 = 32 * nb, kr = lane >> 3, c4 = lane & 7; float m[4] = {0.f, 0.f, 0.f, 0.f};
#pragma unroll
        for (int i = 0; i < 8; ++i) { const int kk = k0 + 8 * i + kr; const pg8::f32x4 v = *(const GAS pg8::f32x4*)(W + (size_t)kk * ldw + n0 + 4 * c4); const float g = A.in[21][l * 1024 + kk];
#pragma unroll
            for (int e_ = 0; e_ < 4; ++e_) m[e_] = fmaxf(m[e_], fabsf(v[e_] * g)); }
#pragma unroll
        for (int e_ = 0; e_ < 4; ++e_) { m[e_] = fmaxf(m[e_], __shfl_xor(m[e_], 8)); m[e_] = fmaxf(m[e_], __shfl_xor(m[e_], 16)); m[e_] = fmaxf(m[e_], __shfl_xor(m[e_], 32)); }
        if (lane < 8) {
#pragma unroll
            for (int e_ = 0; e_ < 4; ++e_) atomicMax((unsigned*)(F.ctl + CW_WMAX1 + l * 4096 + n0 + 4 * c4 + e_), __float_as_uint(m[e_])); }
        return; }
    if (mat == 4) {
        const int nblk = N / 32, kb = item / nblk, nb = item % nblk, k0 = 64 * kb, n0 = 32 * nb, kr = lane >> 3, c4 = lane & 7; float m[4] = {0.f, 0.f, 0.f, 0.f};
#pragma unroll
        for (int i = 0; i < 8; ++i) { const pg8::f32x4 v = *(const GAS pg8::f32x4*)(W + (size_t)(k0 + 8 * i + kr) * ldw + n0 + 4 * c4);
#pragma unroll
            for (int e_ = 0; e_ < 4; ++e_) m[e_] = fmaxf(m[e_], fabsf(v[e_])); }
#pragma unroll
        for (int e_ = 0; e_ < 4; ++e_) { m[e_] = fmaxf(m[e_], __shfl_xor(m[e_], 8)); m[e_] = fmaxf(m[e_], __shfl_xor(m[e_], 16)); m[e_] = fmaxf(m[e_], __shfl_xor(m[e_], 32)); }
        if (lane < 8) {
#pragma unroll
            for (int e_ = 0; e_ < 4; ++e_) atomicMax((unsigned*)(F.ctl + CW_WMAX + l * 1024 + n0 + 4 * c4 + e_), __float_as_uint(m[e_])); }
        return; }
    const int nblk = N / 32, kb = item / nblk, nb = item % nblk, k0 = 64 * kb, n0 = 32 * nb;
    const int kr = lane >> 3, c4 = lane & 7, n = n0 + 4 * c4;
    int sc = n; float cs = 1.f;
    if (mat == 0) { sc = win_srccol(n); if (n >= PC_QC && n < PC_KC) cs = 0.125f; }
#pragma unroll
    for (int i = 0; i < 8; ++i) { const int kk = 8 * i + kr, k = k0 + kk; int ks = k; float g = 1.f;
        if (mat == 0) g = A.in[3][l * 1024 + k];
        else if (mat == 2) { if (k < 512) { ks = 256 + k; g = A.in[18][l * 512 + k]; } else if (k < 768) { ks = k - 512; g = A.in[17][l * 256 + (k - 512)]; } else { ks = k; g = A.in[19][l * 256 + (k - 768)]; } }
        pg8::f32x4 v = (pg8::f32x4){0.f, 0.f, 0.f, 0.f}; if (sc >= 0) v = *(const GAS pg8::f32x4*)(W + (size_t)ks * ldw + sc);
        g *= cs;
#pragma unroll
        for (int e_ = 0; e_ < 4; ++e_) scr[kk * 33 + 4 * c4 + e_] = v[e_] * g; }
    LDS_WAIT(); asm volatile("" ::: "memory");
    const int c = lane & 7;
#pragma unroll
    for (int j = 0; j < 4; ++j) { const int nn = (lane >> 3) + 8 * j; const LAS float* s = scr + (8 * c) * 33 + nn;
        v4u o; o.x = pk2(s[0 * 33], s[1 * 33]); o.y = pk2(s[2 * 33], s[3 * 33]); o.z = pk2(s[4 * 33], s[5 * 33]); o.w = pk2(s[6 * 33], s[7 * 33]);
        *(GAS v4u*)(WT + (size_t)(n0 + nn) * K + k0 + 8 * c) = o; }
    LDS_WAIT(); asm volatile("" ::: "memory");
}
__device__ __forceinline__ void s5_build_item(const Args& A, Frame& F, int l, int kind, int g, int x, LAS float* scr);
__device__ __forceinline__ void p0_prologue(const Args& A, Frame& F) {
    const int lane = lane_id();
    LAS float* scr = (LAS float*)(F.lds + RING_OFF + F.wave * 16384);
    const int gw = F.vcu * NWAVES + F.wave, NGW = F.G * NWAVES;
    constexpr int I0 = 16 * 64, I1 = 8 * 16, I2 = 16 * 32, I3 = 16 * 128, I4 = 64 * 32, IL = I0 + I1 + I2 + I3 + I4;
    for (int it = gw; it < DEPTH * IL; it += NGW) {
        const int l = it / IL; int r = it % IL;
        if (r < I0) { p0_transpose_item(A, F, l, 0, r, scr); continue; } r -= I0;
        if (r < I1) { p0_transpose_item(A, F, l, 1, r, scr); continue; } r -= I1;
        if (r < I2) { p0_transpose_item(A, F, l, 2, r, scr); continue; } r -= I2;
        if (r < I3) { p0_transpose_item(A, F, l, 3, r, scr); continue; } r -= I3;
        p0_transpose_item(A, F, l, 4, r, scr);
    }
    for (int it = gw; it < DEPTH * 3 * 1024; it += NGW) { const int l = it / 3072, r = it % 3072; s5_build_item(A, F, l, r >> 10, (r >> 5) & 31, r & 31, scr); }
    for (int it = gw; it < DEPTH * 4 * 16 * 2; it += NGW) { const int tb_ = it & 1, fr_ = (it >> 1) & 15, h_ = (it >> 5) & 3, l_ = it >> 7; const int r32_ = lane & 31, hi_ = lane >> 5;
        const float* wuk_ = A.in[6] + (size_t)l_ * 128 * 256; const float* wuv_ = A.in[7] + (size_t)l_ * 128 * 256; const float* kvg_ = A.in[5] + l_ * 128;
        float v_[8];
        if (tb_ == 0) { const int c_ = fr_ >> 2, ks_ = fr_ & 3, rank_ = 32 * c_ + r32_; const float sc_ = kvg_[rank_] * 0.125f;
#pragma unroll
            for (int e_ = 0; e_ < 8; ++e_) v_[e_] = wuk_[((size_t)rank_ * 4 + h_) * 64 + ks_ * 16 + hi_ * 8 + e_] * sc_; }
        else { const int c_ = fr_ >> 2, s_ = (fr_ >> 1) & 1, db_ = fr_ & 1, d_ = 32 * db_ + r32_;
#pragma unroll
            for (int j_ = 0; j_ < 8; ++j_) { const int rk_ = 32 * c_ + 16 * s_ + 8 * (j_ >> 2) + 4 * hi_ + (j_ & 3); v_[j_] = wuv_[((size_t)rk_ * 4 + h_) * 64 + d_] * kvg_[rk_]; } }
        v4u o_; o_.x = pk2(v_[0], v_[1]); o_.y = pk2(v_[2], v_[3]); o_.z = pk2(v_[4], v_[5]); o_.w = pk2(v_[6], v_[7]);
        *((GAS v4u*)(F.ws + (tb_ == 0 ? WS_WUKF : WS_WUVF)) + ((size_t)(l_ * 4 + h_) * 16 + fr_) * 64 + lane) = o_; }
    bf16* Hb = (bf16*)(F.ws + WS_HB); stat_t* ss = stat_ptr(F, 0, ST_SS1);
    for (int s_ = 0; ; ++s_) { const int m0 = row_step(F, s_); if (m0 < 0) break;
        f32x4 v[4][4];
#pragma unroll
        for (int q = 0; q < 4; ++q) { const int m = m0 + q < MVALID ? m0 + q : MVALID - 1;
            const float* src = m < MREAL ? A.in[0] + (size_t)m * DM : A.in[1] + (size_t)(m - MREAL) * DM; const GAS f32x4* xr = (const GAS f32x4*)src + 2 * lane;
#pragma unroll
            for (int j = 0; j < 4; ++j) v[q][j] = xr[(j >> 1) * 128 + (j & 1)]; }
#pragma unroll
        for (int q = 0; q < 4; ++q) { const int m = m0 + q; if (m < MVALID) {
            GAS v4u* o16 = (GAS v4u*)(Hb + (size_t)m * DM) + lane; float s = 0.f;
#pragma unroll
            for (int jh = 0; jh < 2; ++jh) { v4u o;
#pragma unroll
                for (int i = 0; i < 2; ++i) { const f32x4 vv = v[q][2 * jh + i]; const unsigned w0 = pk2(vv.x, vv.y), w1 = pk2(vv.z, vv.w); o[2 * i] = w0; o[2 * i + 1] = w1;
                    s += (bflo(w0) * bflo(w0) + bfhi(w0) * bfhi(w0)) + (bflo(w1) * bflo(w1) + bfhi(w1) * bfhi(w1)); }
                o16[64 * jh] = o; }
            s = wave_sum(s); if (lane == 0) ss[m] = (stat_t)((double)s * 4294967296.0); } }
    }
}

__device__ __forceinline__ float log_sigmoid_f(float x) { return fminf(x, 0.f) - log1pf(__expf(-fabsf(x))); }
__device__ __forceinline__ float gelu_tanh_f(float x) { const float u = 0.7978845608028654f * (x + 0.044715f * x * x * x); return 0.5f * x * (1.0f + tanhf(u)); }
__device__ __forceinline__ unsigned mono_key(float f) { const unsigned u = __float_as_uint(f); return (u & 0x80000000u) ? ~u : (u | 0x80000000u); }
__device__ __forceinline__ int t5_bucket(int d) {
    if (d < 16) return d;
    const int v = 16 + (int)(logf((float)d / 16.0f) / 2.0794415416798357f * 16.0f);
    return v < 31 ? v : 31;
}

__device__ __forceinline__ void s5_naive_item(const Args& A, Frame& F, int l, int b, int g) {
    const int p = lane_id();
    const bf16* P = (const bf16*)(F.ws + WS_P); bf16* YG = (bf16*)(F.ws + WS_YG);
    const int lg = l * 32 + g;
    const float dt = expf(A.in[10][lg]), lr = A.in[8][lg * 64 + p], li = A.in[9][lg * 64 + p];
    const float mag = expf(lr * dt), ar = mag * cosf(li * dt), ai = mag * sinf(li * dt);
    const float den = lr * lr + li * li, nr = ar - 1.0f, ni = ai;
    const float fr_ = (nr * lr + ni * li) / den, fi_ = (ni * lr - nr * li) / den;
    float Br[16], Bi[16], Cr[16], Ci[16];
#pragma unroll
    for (int c = 0; c < 16; ++c) { const float br = A.in[11][((size_t)lg * 64 + p) * 16 + c], bi = A.in[12][((size_t)lg * 64 + p) * 16 + c];
        Br[c] = fr_ * br - fi_ * bi; Bi[c] = fr_ * bi + fi_ * br;
        Cr[c] = A.in[13][((size_t)lg * 16 + c) * 64 + p]; Ci[c] = A.in[14][((size_t)lg * 16 + c) * 64 + p]; }
    const int myc = ((p >> 5) & 1) * 8 + ((p >> 4) & 1) * 4 + ((p >> 3) & 1) * 2 + ((p >> 2) & 1);
    const float dsk = A.in[15][l * 512 + g * 16 + myc];
    float hr = 0.f, hi = 0.f;
    for (int kp = 0; kp < NMETA; ++kp) {
        const int row = key_row(b, kp);
        const v4u uw = *(const GAS v4u*)(P + (size_t)row * NIN + PC_UB + g * 16 + (p & 1) * 8);
        float u[16];
#pragma unroll
        for (int j = 0; j < 4; ++j) { const unsigned w0 = __builtin_amdgcn_readlane(uw[j], 0), w1 = __builtin_amdgcn_readlane(uw[j], 1);
            u[2 * j] = bflo(w0); u[2 * j + 1] = bfhi(w0); u[8 + 2 * j] = bflo(w1); u[8 + 2 * j + 1] = bfhi(w1); }
        float bur = 0.f, bui = 0.f;
#pragma unroll
        for (int c = 0; c < 16; ++c) { bur += Br[c] * u[c]; bui += Bi[c] * u[c]; }
        const float nhr = ar * hr - ai * hi + bur, nhi = ar * hi + ai * hr + bui; hr = nhr; hi = nhi;
        float v[16];
#pragma unroll
        for (int c = 0; c < 16; ++c) v[c] = Cr[c] * hr - Ci[c] * hi;
#pragma unroll
        for (int i = 0; i < 8; ++i) { const float send = (p & 32) ? v[i] : v[i + 8]; const float keep = (p & 32) ? v[i + 8] : v[i]; v[i] = keep + __shfl_xor(send, 32); }
#pragma unroll
        for (int i = 0; i < 4; ++i) { const float send = (p & 16) ? v[i] : v[i + 4]; const float keep = (p & 16) ? v[i + 4] : v[i]; v[i] = keep + __shfl_xor(send, 16); }
#pragma unroll
        for (int i = 0; i < 2; ++i) { const float send = (p & 8) ? v[i] : v[i + 2]; const float keep = (p & 8) ? v[i + 2] : v[i]; v[i] = keep + __shfl_xor(send, 8); }
        { const float send = (p & 4) ? v[0] : v[1]; const float keep = (p & 4) ? v[1] : v[0]; v[0] = keep + __shfl_xor(send, 4); }
        float y = v[0]; y += __shfl_xor(y, 1); y += __shfl_xor(y, 2);
        float um = u[0];
#pragma unroll
        for (int c = 1; c < 16; ++c) um = (myc == c) ? u[c] : um;
        y = gelu_tanh_f(y + dsk * um);
        if ((p & 3) == 0 && (b == 0 || kp >= NMETA)) YG[(size_t)row * 512 + g * 16 + myc] = (bf16)f2bf(y);
    }
}

__device__ __forceinline__ void dsa_naive_item(const Args& A, Frame& F, int l, int qi, LAS float* wl) {
    const int lane = lane_id();
    const bf16* P = (const bf16*)(F.ws + WS_P); bf16* Ycat = (bf16*)(F.ws + WS_YCAT);
    const stat_t* sskv = stat_ptr(F, l, ST_SSKV);
    LAS float* sc = wl;
    LAS unsigned* hist = (LAS unsigned*)(wl + 2080);
    LAS float* ql = wl + 2336;
    LAS float* qv = wl + 2848;
    LAS int* sel = (LAS int*)(wl + 3104);
    LAS float* ol = wl + 3360;
    int b, n, row;
    if (qi < MREAL) { b = qi >> 11; n = (qi & 2047) + NMETA + 1; row = qi; } else { b = 0; n = (qi - MREAL) + 1; row = qi; }
    const bf16* Pq = P + (size_t)row * NIN;
    LDS_WAIT(); asm volatile("" ::: "memory");
#pragma unroll
    for (int j = 0; j < 4; ++j) qv[lane + 64 * j] = bf2f(Pq[PC_IQ + lane + 64 * j]);
    float iw[4];
#pragma unroll
    for (int h = 0; h < 4; ++h) iw[h] = bf2f(Pq[PC_IW + h]);
    LDS_WAIT(); asm volatile("" ::: "memory");
#pragma unroll 1
    for (int kp = lane; kp < n; kp += 64) {
        const int krow = key_row(b, kp); const GAS v4u* ikp = (const GAS v4u*)(P + (size_t)krow * NIN + PC_IK);
        float d0 = 0.f, d1 = 0.f, d2 = 0.f, d3 = 0.f;
#pragma unroll 2
        for (int c = 0; c < 8; ++c) { const v4u w = ikp[c]; const float k8[8] = {bflo(w.x), bfhi(w.x), bflo(w.y), bfhi(w.y), bflo(w.z), bfhi(w.z), bflo(w.w), bfhi(w.w)};
#pragma unroll
            for (int j = 0; j < 8; ++j) { const float kk = k8[j]; d0 += qv[c * 8 + j] * kk; d1 += qv[64 + c * 8 + j] * kk; d2 += qv[128 + c * 8 + j] * kk; d3 += qv[192 + c * 8 + j] * kk; } }
        float s = iw[0] * fmaxf(d0, 0.f) + iw[1] * fmaxf(d1, 0.f) + iw[2] * fmaxf(d2, 0.f) + iw[3] * fmaxf(d3, 0.f);
        s += 0.0f;
        sc[kp] = s;
    }
    LDS_WAIT(); asm volatile("" ::: "memory");
    const int keff = n < TOPK ? n : TOPK;
    unsigned prefix = 0u; int krem = keff;
#pragma unroll 1
    for (int pass = 0; pass < 4; ++pass) {
        const int shift = 24 - 8 * pass;
#pragma unroll
        for (int j = 0; j < 4; ++j) hist[lane * 4 + j] = 0u;
        LDS_WAIT(); asm volatile("" ::: "memory");
        for (int kp = lane; kp < n; kp += 64) { const unsigned key = mono_key(sc[kp]);
            const bool match = (pass == 0) || ((key >> (shift + 8)) == (prefix >> (shift + 8)));
            if (match) __hip_atomic_fetch_add(&hist[(key >> shift) & 255u], 1u, __ATOMIC_RELAXED, __HIP_MEMORY_SCOPE_WORKGROUP); }
        LDS_WAIT(); asm volatile("" ::: "memory");
        const int c0 = (int)hist[lane * 4 + 0], c1 = (int)hist[lane * 4 + 1], c2 = (int)hist[lane * 4 + 2], c3 = (int)hist[lane * 4 + 3];
        const int tot = c0 + c1 + c2 + c3; int S = tot;
#pragma unroll
        for (int off = 1; off < 64; off <<= 1) { const int t = __shfl_down(S, off); if (lane + off < 64) S += t; }
        const int above = S - tot;
        const bool here = (above < krem) && (S >= krem);
        int bin = 0, newk = 0;
        if (here) { int a = above;
            if (a + c3 >= krem) { bin = 3; newk = krem - a; } else { a += c3;
            if (a + c2 >= krem) { bin = 2; newk = krem - a; } else { a += c2;
            if (a + c1 >= krem) { bin = 1; newk = krem - a; } else { a += c1; bin = 0; newk = krem - a; } } }
            bin += 4 * lane; }
        const unsigned long long mm = __ballot(here); const int src = mm ? (__ffsll((long long)mm) - 1) : 0;
        bin = __shfl(bin, src); krem = __shfl(newk, src);
        prefix |= (unsigned)bin << shift;
        LDS_WAIT(); asm volatile("" ::: "memory");
    }
    const unsigned T = prefix; const int rneed = krem;
    int selbase = 0, eqbase = 0;
    for (int k0 = 0; k0 < n; k0 += 64) { const int kp = k0 + lane; const bool valid = kp < n;
        const unsigned key = valid ? mono_key(sc[valid ? kp : 0]) : 0u;
        const bool gt = valid && key > T, eq = valid && key == T;
        const unsigned long long eqm = __ballot(eq); const unsigned long long lt = (1ull << lane) - 1ull;
        const int eqr = eqbase + __popcll(eqm & lt);
        const bool s = gt || (eq && eqr < rneed);
        const unsigned long long sm = __ballot(s);
        if (s) sel[selbase + __popcll(sm & lt)] = kp;
        selbase += __popcll(sm); eqbase += __popcll(eqm); }
    LDS_WAIT(); asm volatile("" ::: "memory");
#pragma unroll
    for (int j = 0; j < 4; ++j) qv[lane + 64 * j] = bf2f(Pq[PC_QA + lane + 64 * j]);
    LDS_WAIT(); asm volatile("" ::: "memory");
    const float* wuk = A.in[6] + (size_t)l * 128 * 256; const float* wuv = A.in[7] + (size_t)l * 128 * 256; const float* kvg = A.in[5] + l * 128;
#pragma unroll 1
    for (int h = 0; h < 4; ++h)
#pragma unroll 1
        for (int rr = 0; rr < 2; ++rr) { const int r = lane + 64 * rr; const GAS f32x4* wp = (const GAS f32x4*)(wuk + ((size_t)r * 4 + h) * 64); float a = 0.f;
#pragma unroll
            for (int d4 = 0; d4 < 16; ++d4) { const f32x4 w = wp[d4]; a += qv[h * 64 + d4 * 4] * w.x + qv[h * 64 + d4 * 4 + 1] * w.y + qv[h * 64 + d4 * 4 + 2] * w.z + qv[h * 64 + d4 * 4 + 3] * w.w; }
            ql[h * 128 + r] = a * kvg[r] * 0.125f; }
    LDS_WAIT(); asm volatile("" ::: "memory");
    float ya[4];
#pragma unroll 1
    for (int h = 0; h < 4; ++h) {
        float mx = -3.0e38f;
#pragma unroll 1
        for (int j = 0; j < 4; ++j) { const int i = lane + 64 * j;
            if (i < keff) { const int kp = sel[i]; const int krow = key_row(b, kp); const GAS v4u* cp = (const GAS v4u*)(P + (size_t)krow * NIN + PC_CKV); float d = 0.f;
#pragma unroll 4
                for (int c = 0; c < 16; ++c) { const v4u w = cp[c]; const LAS float* q8 = ql + h * 128 + c * 8;
                    d += q8[0] * bflo(w.x) + q8[1] * bfhi(w.x) + q8[2] * bflo(w.y) + q8[3] * bfhi(w.y) + q8[4] * bflo(w.z) + q8[5] * bfhi(w.z) + q8[6] * bflo(w.w) + q8[7] * bfhi(w.w); }
                const float rkv = rsqrtf(stat_get(sskv + krow) * (1.0f / 128.0f) + pg8::RMS_EPS);
                const float lgv = d * rkv + A.in[2][t5_bucket((n - 1) - kp) * 4 + h];
                sc[i] = lgv; sc[256 + i] = rkv; mx = fmaxf(mx, lgv); } }
        mx = wave_max(mx); float sum = 0.f;
        LDS_WAIT(); asm volatile("" ::: "memory");
#pragma unroll 1
        for (int j = 0; j < 4; ++j) { const int i = lane + 64 * j; if (i < keff) { const float e = __expf(sc[i] - mx); sc[i] = e; sum += e; } }
        sum = wave_sum(sum); const float inv = 1.0f / sum;
        LDS_WAIT(); asm volatile("" ::: "memory");
#pragma unroll 1
        for (int j = 0; j < 4; ++j) { const int i = lane + 64 * j; if (i < keff) qv[i] = sc[i] * inv * sc[256 + i]; }
        LDS_WAIT(); asm volatile("" ::: "memory");
        float o0 = 0.f, o1 = 0.f;
#pragma unroll 4
        for (int i = 0; i < keff; ++i) { const int krow = key_row(b, sel[i]); const float pw = qv[i]; const bf16* cp = P + (size_t)krow * NIN + PC_CKV;
            o0 += pw * bf2f(cp[lane]); o1 += pw * bf2f(cp[lane + 64]); }
        ol[lane] = o0 * kvg[lane]; ol[lane + 64] = o1 * kvg[lane + 64];
        LDS_WAIT(); asm volatile("" ::: "memory");
        float a = 0.f;
#pragma unroll 8
        for (int r = 0; r < 128; ++r) a += ol[r] * wuv[((size_t)r * 4 + h) * 64 + lane];
        ya[h] = a;
        LDS_WAIT(); asm volatile("" ::: "memory");
    }
    float ssq = 0.f;
#pragma unroll
    for (int h = 0; h < 4; ++h) { const unsigned w = f2bf(ya[h]); Ycat[(size_t)row * 1024 + YC_A + h * 64 + lane] = (bf16)w; const float v = __uint_as_float(w << 16); ssq += v * v; }
    ssq = wave_sum(ssq); if (lane == 0) pg8::stat_add(stat_ptr(F, l, ST_SSA) + row, ssq);
}

__device__ __forceinline__ void sb_naive_item(const Args& A, Frame& F, int l, int qi, LAS float* wl) {
    const int lane = lane_id();
    const bf16* P = (const bf16*)(F.ws + WS_P); bf16* Ycat = (bf16*)(F.ws + WS_YCAT);
    LAS float* qs = wl;
    LAS float* wbuf = wl + 64;
    LAS int* rbuf = (LAS int*)(wl + 128);
    int b, n, row;
    if (qi < MREAL) { b = qi >> 11; n = (qi & 2047) + NMETA; row = qi; } else { b = 0; n = qi - MREAL; row = qi; }
    const bf16* Pq = P + (size_t)row * NIN;
    float yc[4];
#pragma unroll 1
    for (int h = 0; h < 4; ++h) {
        LDS_WAIT(); asm volatile("" ::: "memory");
        qs[lane] = bf2f(Pq[PC_QC + h * 64 + lane]);
        LDS_WAIT(); asm volatile("" ::: "memory");
        float carry = 0.f, acc = 0.f;
        for (int top = n - 1; top >= 0; top -= 64) {
            const int kp = top - lane; const bool valid = kp >= 0; const int krow = key_row(b, valid ? kp : 0);
            const GAS v4u* kpn = (const GAS v4u*)(P + (size_t)krow * NIN + PC_KC + h * 64); float z = 0.f;
#pragma unroll
            for (int c = 0; c < 8; ++c) { const v4u w = kpn[c]; const LAS float* q8 = qs + c * 8;
                z += q8[0] * bflo(w.x) + q8[1] * bfhi(w.x) + q8[2] * bflo(w.y) + q8[3] * bfhi(w.y) + q8[4] * bflo(w.z) + q8[5] * bfhi(w.z) + q8[6] * bflo(w.w) + q8[7] * bfhi(w.w); }
            const float lk = valid ? log_sigmoid_f(-z) : 0.f;
            float incl = lk;
#pragma unroll
            for (int off = 1; off < 64; off <<= 1) { const float t = __shfl_up(incl, off); if (lane >= off) incl += t; }
            const float later = carry + incl - lk;
            const float w = valid ? __expf(log_sigmoid_f(z) + later) : 0.f;
            carry += __shfl(incl, 63);
            LDS_WAIT(); asm volatile("" ::: "memory");
            wbuf[lane] = w; rbuf[lane] = krow;
            LDS_WAIT(); asm volatile("" ::: "memory");
            const int cnt = top + 1 < 64 ? top + 1 : 64;
            for (int j = 0; j < cnt; ++j) acc += wbuf[j] * bf2f(P[(size_t)rbuf[j] * NIN + PC_VC + h * 64 + lane]);
        }
        yc[h] = acc;
    }
    float ssq = 0.f;
#pragma unroll
    for (int h = 0; h < 4; ++h) { const unsigned w = f2bf(yc[h]); Ycat[(size_t)row * 1024 + YC_C + h * 64 + lane] = (bf16)w; const float v = __uint_as_float(w << 16); ssq += v * v; }
    ssq = wave_sum(ssq); if (lane == 0) pg8::stat_add(stat_ptr(F, l, ST_SSC) + row, ssq);
}


typedef short bf16x8_t __attribute__((ext_vector_type(8)));
typedef short s16x4_t __attribute__((ext_vector_type(4)));
typedef float f32x16_t __attribute__((ext_vector_type(16)));
typedef float f32x2_t __attribute__((ext_vector_type(2)));
typedef __bf16 bf16x2_t __attribute__((ext_vector_type(2)));
typedef short v4i16_t __attribute__((ext_vector_type(4)));
typedef __attribute__((address_space(3))) const char* lds_cptr;
__device__ __forceinline__ s16x4_t vtr(lds_cptr p) { return __builtin_bit_cast(s16x4_t, __builtin_amdgcn_ds_read_tr16_b64_v4i16((__attribute__((address_space(3))) v4i16_t*)p)); }
__device__ __forceinline__ unsigned cvtpk(float lo, float hi) { f32x2_t v = {lo, hi}; bf16x2_t b = __builtin_convertvector(v, bf16x2_t); return __builtin_bit_cast(unsigned, b); }
__device__ __forceinline__ int crow(int r, int hi) { return (r & 3) + 8 * (r >> 2) + 4 * hi; }
__device__ __forceinline__ float relu_bits(float x) { const int i = (int)__float_as_uint(x); return __uint_as_float((unsigned)(i > 0 ? i : 0)); }
#define MFMA32(a, b, c) __builtin_amdgcn_mfma_f32_32x32x16_bf16((a), (b), (c), 0, 0, 0)

__device__ __forceinline__ void sb_mfma_unit(const Args& A, Frame& F, int l, int unit, LAS unsigned char* wl) {
    const int lane = lane_id(), r32 = lane & 31, hi = lane >> 5;
    const int qt = unit & 63, h = (unit >> 6) & 3, b = unit >> 8;
    const bf16* P = (const bf16*)(F.ws + WS_P); bf16* Ycat = (bf16*)(F.ws + WS_YCAT); stat_t* ssc = stat_ptr(F, l, ST_SSC);
    const int qrow0 = b * SEQ + 32 * qt;
    bf16x8_t qr[4];
#pragma unroll
    for (int ks = 0; ks < 4; ++ks) qr[ks] = *(const GAS bf16x8_t*)(P + (size_t)(qrow0 + r32) * NIN + PC_QC + h * 64 + ks * 16 + hi * 8);
    f32x16_t o0, o1;
#pragma unroll
    for (int r = 0; r < 16; ++r) { o0[r] = 0.f; o1[r] = 0.f; }
    float carry = 0.f;
    const int jt = qt >> 1;
    const lds_cptr vp = (lds_cptr)wl + ((lane >> 4) & 1) * 32 + (lane & 3) * 8 + (4 * hi + ((lane & 15) >> 2)) * 64;
    constexpr float LOG2E = 1.4426950408889634f;
    v4u vld[8]; bf16x8_t kf0[4], kf1[4];
#define SB_LOAD_TILE(it_) do { const int itt_ = (it_); const bool meta_ = itt_ < 0; const int kb_ = meta_ ? MREAL : b * SEQ + 64 * itt_; \
        _Pragma("unroll") for (int i = 0; i < 8; ++i) { int kl = (lane >> 3) + 8 * i; if (meta_ && kl > NMETA - 1) kl = NMETA - 1; \
            vld[i] = *(const GAS v4u*)(P + (size_t)(kb_ + kl) * NIN + PC_VC + h * 64 + (lane & 7) * 8); } \
        const int kr0 = (meta_ && r32 > NMETA - 1) ? NMETA - 1 : r32, kr1 = meta_ ? NMETA - 1 : 32 + r32; \
        _Pragma("unroll") for (int ks = 0; ks < 4; ++ks) { kf0[ks] = *(const GAS bf16x8_t*)(P + (size_t)(kb_ + kr0) * NIN + PC_KC + h * 64 + ks * 16 + hi * 8); \
                                                            kf1[ks] = *(const GAS bf16x8_t*)(P + (size_t)(kb_ + kr1) * NIN + PC_KC + h * 64 + ks * 16 + hi * 8); } } while (0)
    SB_LOAD_TILE(jt);
#pragma unroll 1
    for (int it = jt; it >= -1; --it) {
        const bool meta = it < 0;
        f32x16_t p0, p1;
#pragma unroll
        for (int r = 0; r < 16; ++r) { p0[r] = 0.f; p1[r] = 0.f; }
#pragma unroll
        for (int ks = 0; ks < 4; ++ks) { p0 = MFMA32(kf0[ks], qr[ks], p0); p1 = MFMA32(kf1[ks], qr[ks], p1); }
#pragma unroll
        for (int i = 0; i < 8; ++i) *(LAS v4u*)(wl + ((lane & 7) >> 2) * 4096 + ((lane >> 3) + 8 * i) * 64 + (lane & 3) * 16) = vld[i];
        if (it > -1) SB_LOAD_TILE(it - 1);
        const int lim = meta ? NMETA : (it == jt ? 32 * (qt & 1) + r32 : 64);
        float lk0[16], lk1[16];
#pragma unroll
        for (int r = 0; r < 16; ++r) {
            { const float Z = p0[r] * LOG2E; const float L = __builtin_amdgcn_logf(1.0f + __builtin_amdgcn_exp2f(-fabsf(Z))); const float nl = -(relu_bits(Z) + L);
              const bool valid = crow(r, hi) < lim; lk0[r] = valid ? nl : 0.f; p0[r] = valid ? Z + nl : -1.0e30f; }
            { const float Z = p1[r] * LOG2E; const float L = __builtin_amdgcn_logf(1.0f + __builtin_amdgcn_exp2f(-fabsf(Z))); const float nl = -(relu_bits(Z) + L);
              const bool valid = 32 + crow(r, hi) < lim; lk1[r] = valid ? nl : 0.f; p1[r] = valid ? Z + nl : -1.0e30f; }
        }
        float base[8]; float E = carry;
#pragma unroll
        for (int B = 7; B >= 0; --B) {
            const int rb = 4 * (B & 3);
            const float own = (B >> 2) ? ((lk1[rb] + lk1[rb + 1]) + (lk1[rb + 2] + lk1[rb + 3])) : ((lk0[rb] + lk0[rb + 1]) + (lk0[rb + 2] + lk0[rb + 3]));
            const auto rr = __builtin_amdgcn_permlane32_swap(__float_as_uint(own), __float_as_uint(own), false, false);
            const float lo_s = __uint_as_float(rr[0]), hi_s = __uint_as_float(rr[1]);
            base[B] = E + (hi ? 0.f : hi_s);
            E += lo_s + hi_s;
        }
        carry = E;
#pragma unroll
        for (int B = 0; B < 8; ++B) {
            const int rb = 4 * (B & 3);
            if (B >> 2) { const float l3 = base[B], l2 = l3 + lk1[rb + 3], l1 = l2 + lk1[rb + 2], l0 = l1 + lk1[rb + 1];
                p1[rb + 3] = __builtin_amdgcn_exp2f(p1[rb + 3] + l3); p1[rb + 2] = __builtin_amdgcn_exp2f(p1[rb + 2] + l2); p1[rb + 1] = __builtin_amdgcn_exp2f(p1[rb + 1] + l1); p1[rb] = __builtin_amdgcn_exp2f(p1[rb] + l0); }
            else { const float l3 = base[B], l2 = l3 + lk0[rb + 3], l1 = l2 + lk0[rb + 2], l0 = l1 + lk0[rb + 1];
                p0[rb + 3] = __builtin_amdgcn_exp2f(p0[rb + 3] + l3); p0[rb + 2] = __builtin_amdgcn_exp2f(p0[rb + 2] + l2); p0[rb + 1] = __builtin_amdgcn_exp2f(p0[rb + 1] + l1); p0[rb] = __builtin_amdgcn_exp2f(p0[rb] + l0); }
        }
        v4u pw[4];
#pragma unroll
        for (int j = 0; j < 4; ++j) { pw[0][j] = cvtpk(p0[2 * j], p0[2 * j + 1]); pw[1][j] = cvtpk(p0[8 + 2 * j], p0[8 + 2 * j + 1]); pw[2][j] = cvtpk(p1[2 * j], p1[2 * j + 1]); pw[3][j] = cvtpk(p1[8 + 2 * j], p1[8 + 2 * j + 1]); }
#pragma unroll
        for (int ks = 0; ks < 4; ++ks) {
            const s16x4_t a_lo = vtr(vp + ks * 1024), a_hi = vtr(vp + ks * 1024 + 512), b_lo = vtr(vp + 4096 + ks * 1024), b_hi = vtr(vp + 4096 + ks * 1024 + 512);
            const bf16x8_t v0 = (bf16x8_t){a_lo[0], a_lo[1], a_lo[2], a_lo[3], a_hi[0], a_hi[1], a_hi[2], a_hi[3]};
            const bf16x8_t v1 = (bf16x8_t){b_lo[0], b_lo[1], b_lo[2], b_lo[3], b_hi[0], b_hi[1], b_hi[2], b_hi[3]};
            const bf16x8_t pa = __builtin_bit_cast(bf16x8_t, pw[ks]);
            o0 = MFMA32(pa, v0, o0); o1 = MFMA32(pa, v1, o1); }
        if (__all(carry < -160.0f)) break;
    }
    LAS unsigned short* stg = (LAS unsigned short*)(wl + 8192);
#pragma unroll
    for (int r = 0; r < 16; ++r) { stg[crow(r, hi) * 64 + r32] = (unsigned short)f2bf(o0[r]); stg[crow(r, hi) * 64 + 32 + r32] = (unsigned short)f2bf(o1[r]); }
    LDS_WAIT(); asm volatile("" ::: "memory");
#pragma unroll
    for (int i = 0; i < 4; ++i) { const int row = i * 8 + (lane >> 3), ch = lane & 7; const v4u v = *(const LAS v4u*)(stg + row * 64 + ch * 8);
        float q = (bflo(v.x) * bflo(v.x) + bfhi(v.x) * bfhi(v.x)) + (bflo(v.y) * bflo(v.y) + bfhi(v.y) * bfhi(v.y)) + (bflo(v.z) * bflo(v.z) + bfhi(v.z) * bfhi(v.z)) + (bflo(v.w) * bflo(v.w) + bfhi(v.w) * bfhi(v.w));
        q += __shfl_xor(q, 1); q += __shfl_xor(q, 2); q += __shfl_xor(q, 4);
        if (ch == 0) pg8::stat_add(ssc + qrow0 + row, q);
        *(GAS v4u*)(Ycat + (size_t)(qrow0 + row) * 1024 + YC_C + h * 64 + ch * 8) = v; }
    LDS_WAIT(); asm volatile("" ::: "memory");
}

constexpr int DSA_HIST = 0, DSA_HIST_STRIDE = 257;
constexpr int DSA_ZC = 65792, DSA_ZC_STRIDE = 36;
constexpr int DSA_MASK = DSA_ZC + 64 * 36 * 4;
constexpr int DSA_Q = DSA_MASK + 64 * 34 * 2 * 4;
constexpr int DSA_BD = DSA_Q + 10 * 64 * 4;
constexpr int DSA_IQ = DSA_BD + 4 * 132 * 4, DSA_IQ_STRIDE = 528;
constexpr int DSA_END = DSA_IQ + 64 * DSA_IQ_STRIDE;
static_assert(DSA_END <= RING_BYTES, "DSA LDS map");
constexpr int DSA_CAP = 32;
constexpr unsigned KEY_ZERO = 0x80000000u;

__device__ __forceinline__ constexpr int crow0(int r) { return (r & 3) + 8 * (r >> 2); }
__device__ __forceinline__ unsigned off_a(unsigned row, unsigned ch) { return 2048u * (row >> 3) + 512u * (ch >> 2) + 64u * (row & 7) + 16u * ((ch & 3) ^ ((row >> 2) & 3)); }

__device__ __forceinline__ void dsa_scores(f32x16_t& s0, f32x16_t& s1, const bf16x8_t (&ikf)[2][4], const LAS unsigned char* iqrow, const float (&iw)[4]) {
#pragma unroll
    for (int r = 0; r < 16; ++r) { s0[r] = 0.f; s1[r] = 0.f; }
#pragma unroll
    for (int hp = 0; hp < 4; hp += 2) {
        f32x16_t a0, a1, b0, b1;
#pragma unroll
        for (int r = 0; r < 16; ++r) { a0[r] = 0.f; a1[r] = 0.f; b0[r] = 0.f; b1[r] = 0.f; }
#pragma unroll
        for (int ks = 0; ks < 4; ++ks) { const bf16x8_t qa = *(const LAS bf16x8_t*)(iqrow + hp * 128 + ks * 32), qb = *(const LAS bf16x8_t*)(iqrow + (hp + 1) * 128 + ks * 32);
            a0 = MFMA32(ikf[0][ks], qa, a0); a1 = MFMA32(ikf[1][ks], qa, a1); b0 = MFMA32(ikf[0][ks], qb, b0); b1 = MFMA32(ikf[1][ks], qb, b1); }
#pragma unroll
        for (int r = 0; r < 16; ++r) { s0[r] += iw[hp] * relu_bits(a0[r]); s1[r] += iw[hp] * relu_bits(a1[r]); }
#pragma unroll
        for (int r = 0; r < 16; ++r) { s0[r] += iw[hp + 1] * relu_bits(b0[r]); s1[r] += iw[hp + 1] * relu_bits(b1[r]); }
        __builtin_amdgcn_sched_barrier(0);
    }
}
__device__ __forceinline__ void dsa_load_ik(bf16x8_t (&ikf)[2][4], const bf16* P, int b, int j, int r32, int hi) {
    const int row0 = j == 0 ? MREAL + (r32 < NMETA ? r32 : NMETA - 1) : b * SEQ + 64 * (j - 1) + r32;
    const int row1 = j == 0 ? MREAL + NMETA - 1 : b * SEQ + 64 * (j - 1) + 32 + r32;
#pragma unroll
    for (int ks = 0; ks < 4; ++ks) { ikf[0][ks] = *(const GAS bf16x8_t*)(P + (size_t)row0 * NIN + PC_IK + ks * 16 + hi * 8);
                                     ikf[1][ks] = *(const GAS bf16x8_t*)(P + (size_t)row1 * NIN + PC_IK + ks * 16 + hi * 8); }
}


template <bool P0, bool EDGE>
__device__ __forceinline__ void dsa_hist_tile(const f32x16_t& s0, const f32x16_t& s1, LAS unsigned* hrow, const int shift, const unsigned psh, const int limh, unsigned& zcount) {
#pragma unroll
    for (int r = 0; r < 16; ++r) {
#pragma unroll
        for (int hf = 0; hf < 2; ++hf) {
            float sv = hf ? s1[r] : s0[r]; asm volatile("" : "+v"(sv) :: "memory");
            const unsigned u = __float_as_uint(sv);
            const unsigned key = u ^ ((unsigned)((int)u >> 31) | 0x80000000u);
            unsigned bin;
            if (P0) { bin = key >> 24;
                if (EDGE) { const bool valid = (32 * hf + crow0(r)) < limh; bin = valid ? bin : 256u; zcount += (valid && key == KEY_ZERO) ? 1u : 0u; }
                else zcount += (key == KEY_ZERO) ? 1u : 0u; }
            else { const unsigned d = (key >> shift) & 255u; bool m = (key >> (shift + 8)) == psh; if (EDGE) m = m && ((32 * hf + crow0(r)) < limh); bin = m ? d : 256u; }
            __hip_atomic_fetch_add(hrow + bin, 1u, __ATOMIC_RELAXED, __HIP_MEMORY_SCOPE_WORKGROUP);
        }
        if ((r & 1) == 1) asm volatile("" ::: "memory");
    }
}

__device__ __forceinline__ void dsa_unit(const Args& A, Frame& F, int l, int b, int qt) {
    const int lane = lane_id(), r32 = lane & 31, hi = lane >> 5, w = F.wave;
    LAS unsigned char* L = F.lds + RING_OFF;
    LAS unsigned* hist = (LAS unsigned*)(L + DSA_HIST); LAS unsigned* zc = (LAS unsigned*)(L + DSA_ZC); LAS unsigned* maskw = (LAS unsigned*)(L + DSA_MASK);
    LAS unsigned* qT = (LAS unsigned*)(L + DSA_Q); LAS unsigned* qK = qT + 64; LAS unsigned* qM = qT + 128; LAS unsigned* qJ = qT + 192; LAS unsigned* qR = qT + 256; LAS unsigned* qF = qT + 320; LAS unsigned* qT2 = qT + 384; LAS unsigned* qJ2 = qT + 448; LAS unsigned* qR2 = qT + 512; LAS unsigned* qC = qT + 576;
    LAS float* bd = (LAS float*)(L + DSA_BD);
    const bf16* P = (const bf16*)(F.ws + WS_P); bf16* Ycat = (bf16*)(F.ws + WS_YCAT);
    const int nt = qt + 2;
    const int t0 = 64 * qt, qrow0 = b * SEQ + t0;
    const int tid = w * 64 + lane;
    for (int i = tid; i < (DSA_MASK - DSA_HIST) / 4; i += 512) hist[i] = 0u;
    for (int i = tid; i < 4 * 132; i += 512) { const int h = i / 132, d = i % 132; bd[i] = A.in[2][t5_bucket(d) * 4 + h] * 1.4426950408889634f; }
    if (tid < 64) qF[tid] = 0u;
    static_assert(NMETA + 64 * 2 + 64 <= TOPK, "units qt <= 2: every query sees at most TOPK keys");
    if (qt <= 2) {
        for (int i = tid; i < 64 * nt; i += 512) { const int q = i / nt, j = i - q * nt; const int lim = (j == 0) ? NMETA : ((j == nt - 1) ? q + 1 : 64);
            maskw[(q * 34 + j) * 2] = lim >= 32 ? 0xffffffffu : ((1u << lim) - 1u);
            maskw[(q * 34 + j) * 2 + 1] = lim > 32 ? (lim >= 64 ? 0xffffffffu : ((1u << (lim - 32)) - 1u)) : 0u; }
    } else {
        const int qh = w & 1, ts = w >> 1;
        const int ql = 32 * qh + r32;
        float iw[4];
        { const bf16* Pq = P + (size_t)(qrow0 + ql) * NIN;
#pragma unroll
          for (int h = 0; h < 4; ++h) iw[h] = bf2f(Pq[PC_IW + h]); }
#pragma unroll
        for (int i = 0; i < 4; ++i) { const int cidx = tid + 512 * i, row = cidx >> 5, ch = cidx & 31;
            *(LAS v4u*)(L + DSA_IQ + row * DSA_IQ_STRIDE + ch * 16) = *(const GAS v4u*)(P + (size_t)(qrow0 + row) * NIN + PC_IQ + ch * 8); }
        const LAS unsigned char* iqrow = L + DSA_IQ + ql * DSA_IQ_STRIDE + hi * 16;
        const int nq = NMETA + t0 + ql + 1;
        unsigned pref = 0u, Tq = 0u, candlim = 0u; int jstar = 1000, rprime = 0; bool fast = false;
        __syncthreads();
        bf16x8_t ikf[2][4];
        if (ts < nt) dsa_load_ik(ikf, P, b, ts, r32, hi);
#pragma unroll 1
        for (int pass = 0; pass < 6; ++pass) {
            if (pass == 4) { if (qF[0] == 0u) continue; }
            const int shift = 24 - 8 * pass;
#pragma unroll 1
            for (int j = ts; j < nt; j += 4) {
                f32x16_t s0, s1;
                dsa_scores(s0, s1, ikf, iqrow, iw);
                if (j + 4 < nt) dsa_load_ik(ikf, P, b, j + 4, r32, hi);
                else if (pass < 5) dsa_load_ik(ikf, P, b, ts, r32, hi);
                const int lim = (j == 0) ? NMETA : ((j == nt - 1) ? ql + 1 : 64);
                const int limh = lim - 4 * hi;
                if (pass < 4) {
                    LAS unsigned* hrow = hist + ql * DSA_HIST_STRIDE;
                    const bool edge = (j == 0) || (j == nt - 1);
                    if (pass == 0) { unsigned zcount = 0u;
                        if (edge) dsa_hist_tile<true, true>(s0, s1, hrow, 24, 0u, limh, zcount); else dsa_hist_tile<true, false>(s0, s1, hrow, 24, 0u, limh, zcount);
                        __hip_atomic_fetch_add(zc + ql * DSA_ZC_STRIDE + j, zcount, __ATOMIC_RELAXED, __HIP_MEMORY_SCOPE_WORKGROUP);
                    } else { unsigned zdummy = 0u; const unsigned psh = pref >> (shift + 8);
                        if (edge) dsa_hist_tile<false, true>(s0, s1, hrow, shift, psh, limh, zdummy); else dsa_hist_tile<false, false>(s0, s1, hrow, shift, psh, limh, zdummy); }
                } else if (pass == 4) {
                    LAS unsigned* zrow = zc + ql * DSA_ZC_STRIDE;
#pragma unroll
                    for (int r = 0; r < 16; ++r) {
#pragma unroll
                        for (int hf = 0; hf < 2; ++hf) { const float s = (hf ? s1[r] : s0[r]); const unsigned key = mono_key(s);
                            const unsigned zs = ((32 * hf + crow0(r)) < limh && key == Tq) ? (unsigned)j : 35u; __hip_atomic_fetch_add(zrow + zs, 1u, __ATOMIC_RELAXED, __HIP_MEMORY_SCOPE_WORKGROUP); }
                        if ((r & 3) == 3) asm volatile("" ::: "memory"); }
                } else {
                    unsigned sel0 = 0u, sel1 = 0u;
                    LAS unsigned* lrow = hist + ql * DSA_HIST_STRIDE;
                    const unsigned posb = 64u * (unsigned)j + 4u * (unsigned)hi;
#define DSA_CAND(key_, kidx_) do { const unsigned slot_ = __hip_atomic_fetch_add(lrow, 1u, __ATOMIC_RELAXED, __HIP_MEMORY_SCOPE_WORKGROUP); \
                        if (slot_ < (unsigned)DSA_CAP) { lrow[1 + 2 * slot_] = (key_); lrow[2 + 2 * slot_] = posb + (unsigned)(kidx_); } } while (0)
                    if (!__any(j == jstar)) {
                        const unsigned Tj = (j < jstar) ? Tq : Tq + 1u;
                        if ((j == 0) || (j == nt - 1)) {
#pragma unroll
                            for (int r = 15; r >= 0; --r) {
                                { float sv = s0[r]; asm volatile("" : "+v"(sv) :: "memory"); const unsigned u = __float_as_uint(sv); const unsigned key = u ^ ((unsigned)((int)u >> 31) | 0x80000000u);
                                  sel0 = sel0 * 2u + ((key >= Tj && crow0(r) < limh) ? 1u : 0u); if ((key ^ Tq) < candlim && crow0(r) < limh) DSA_CAND(key, crow0(r)); }
                                { float sv = s1[r]; asm volatile("" : "+v"(sv) :: "memory"); const unsigned u = __float_as_uint(sv); const unsigned key = u ^ ((unsigned)((int)u >> 31) | 0x80000000u);
                                  sel1 = sel1 * 2u + ((key >= Tj && (32 + crow0(r)) < limh) ? 1u : 0u); if ((key ^ Tq) < candlim && (32 + crow0(r)) < limh) DSA_CAND(key, 32 + crow0(r)); } }
                        } else {
#pragma unroll
                            for (int r = 15; r >= 0; --r) {
                                { float sv = s0[r]; asm volatile("" : "+v"(sv) :: "memory"); const unsigned u = __float_as_uint(sv); const unsigned key = u ^ ((unsigned)((int)u >> 31) | 0x80000000u);
                                  sel0 = sel0 * 2u + ((key >= Tj) ? 1u : 0u); if ((key ^ Tq) < candlim) DSA_CAND(key, crow0(r)); }
                                { float sv = s1[r]; asm volatile("" : "+v"(sv) :: "memory"); const unsigned u = __float_as_uint(sv); const unsigned key = u ^ ((unsigned)((int)u >> 31) | 0x80000000u);
                                  sel1 = sel1 * 2u + ((key >= Tj) ? 1u : 0u); if ((key ^ Tq) < candlim) DSA_CAND(key, 32 + crow0(r)); } }
                        }
                    } else {
                    unsigned e0 = 0u, e1 = 0u, g0 = 0u, g1 = 0u;
#pragma unroll
                    for (int r = 15; r >= 0; --r) {
                        { const unsigned key = mono_key(s0[r]); const bool valid = crow0(r) < limh; e0 = e0 * 2u + ((valid && key == Tq) ? 1u : 0u); g0 = g0 * 2u + ((valid && key > Tq) ? 1u : 0u); }
                        { const unsigned key = mono_key(s1[r]); const bool valid = (32 + crow0(r)) < limh; e1 = e1 * 2u + ((valid && key == Tq) ? 1u : 0u); g1 = g1 * 2u + ((valid && key > Tq) ? 1u : 0u); } }
                    unsigned t0m = 0u, t1m = 0u;
                    if (j < jstar) { t0m = e0; t1m = e1; }
                    {
                        int E = 0; unsigned r0m = 0u, r1m = 0u;
#pragma unroll
                        for (int B = 0; B < 8; ++B) { const int rb = 4 * (B & 3); const unsigned em = (B >> 2) ? e1 : e0;
                            const int own = __popc((em >> rb) & 15u);
                            const auto rr = __builtin_amdgcn_permlane32_swap((unsigned)own, (unsigned)own, false, false);
                            const int lo_s = (int)rr[0], hi_s = (int)rr[1];
                            int rk = E + (hi ? lo_s : 0);
#pragma unroll
                            for (int i = 0; i < 4; ++i) { const bool isq = (em >> (rb + i)) & 1u; if (isq && rk < rprime) { if (B >> 2) r1m |= 1u << (rb + i); else r0m |= 1u << (rb + i); } rk += isq ? 1 : 0; }
                            E += lo_s + hi_s; }
                        if (j == jstar) { t0m = r0m; t1m = r1m; }
                    }
                    sel0 = g0 | t0m; sel1 = g1 | t1m;
                    if (__any(candlim != 0u)) {
#pragma unroll
                        for (int r = 0; r < 16; ++r) {
                            { float sv = s0[r]; asm volatile("" : "+v"(sv) :: "memory"); const unsigned key = mono_key(sv); if ((key ^ Tq) < candlim && crow0(r) < limh) DSA_CAND(key, crow0(r)); }
                            { float sv = s1[r]; asm volatile("" : "+v"(sv) :: "memory"); const unsigned key = mono_key(sv); if ((key ^ Tq) < candlim && (32 + crow0(r)) < limh) DSA_CAND(key, 32 + crow0(r)); } }
                    }
                    }
                    unsigned w0 = ((sel0 & 0xfu) | ((sel0 & 0xf0u) << 4) | ((sel0 & 0xf00u) << 8) | ((sel0 & 0xf000u) << 12)) << (4 * hi);
                    unsigned w1 = ((sel1 & 0xfu) | ((sel1 & 0xf0u) << 4) | ((sel1 & 0xf00u) << 8) | ((sel1 & 0xf000u) << 12)) << (4 * hi);
                    { const auto rr = __builtin_amdgcn_permlane32_swap(w0, w0, false, false); w0 = rr[0] | rr[1]; }
                    { const auto rr = __builtin_amdgcn_permlane32_swap(w1, w1, false, false); w1 = rr[0] | rr[1]; }
                    if (hi == 0) { maskw[(ql * 34 + j) * 2] = w0; maskw[(ql * 34 + j) * 2 + 1] = w1; }
                }
            }
            if (pass == 5) {
                if (fast) {
                    __syncthreads();
#pragma unroll 1
                    for (int it = 0; it < 4; ++it) { const int q = 8 * w + 2 * it + hi, i = r32;
                        const LAS unsigned* lr = hist + q * DSA_HIST_STRIDE; const unsigned c0 = lr[0]; const int cnt = (int)(c0 < (unsigned)DSA_CAP ? c0 : (unsigned)DSA_CAP); const int kr = (int)qK[q];
                        unsigned mk = 0u, mp = 0u; if (i < cnt) { mk = lr[1 + 2 * i]; mp = lr[2 + 2 * i]; }
                        int rank = 0;
#pragma unroll 1
                        for (int jj = 0; jj < DSA_CAP; ++jj) { if (!__any(jj < cnt)) break;
                            const unsigned kj = lr[1 + 2 * jj], pj = lr[2 + 2 * jj]; rank += (jj < cnt && (kj > mk || (kj == mk && pj < mp))) ? 1 : 0; }
                        if (i < cnt && rank < kr) __hip_atomic_fetch_or(maskw + (q * 34 + (int)(mp >> 6)) * 2 + (int)((mp >> 5) & 1u), 1u << (mp & 31u), __ATOMIC_RELAXED, __HIP_MEMORY_SCOPE_WORKGROUP); }
                }
                break; }
            __syncthreads();
            if (pass < 4) {
                const int qi = lane >> 3, part = lane & 7, q = 8 * w + qi; LAS unsigned* hr = hist + q * DSA_HIST_STRIDE + 32 * part;
                const int nqq = NMETA + t0 + q + 1; const int krem = (pass == 0) ? (nqq < TOPK ? nqq : TOPK) : (int)qK[q];
                int c[32]; int tot = 0;
#pragma unroll
                for (int i = 0; i < 32; ++i) { c[i] = (int)hr[i]; tot += c[i]; }
#pragma unroll
                for (int i = 0; i < 32; ++i) hr[i] = 0u;
                int S = tot;
#pragma unroll
                for (int off = 1; off < 8; off <<= 1) { const int t = __shfl_down(S, off); if (part + off < 8) S += t; }
                const int above = S - tot; const bool here = (above < krem) && (S >= krem);
                int a = above, bin = 0, newk = 0, cb = 0; bool done = false;
#pragma unroll
                for (int i = 31; i >= 0; --i) { const bool f = !done && (a + c[i] >= krem); bin = f ? i : bin; newk = f ? krem - a : newk; cb = f ? c[i] : cb; done = done || f; a += done ? 0 : c[i]; }
                if (here) { const unsigned np = ((pass == 0) ? 0u : qT[q]) | ((unsigned)(bin + 32 * part) << shift); qT[q] = np; qK[q] = (unsigned)newk; qM[q] = (unsigned)cb;
                    if (pass == 3 && cb > newk && np != KEY_ZERO) qF[0] = 1u;
                    if (pass == 1) {
                        if (cb <= DSA_CAP) { qT2[q] = np | 0xffffu; qJ2[q] = 0xffffffffu; qR2[q] = 0u; qC[q] = 0x10000u; }
                        else if (np == KEY_ZERO) { const LAS unsigned* zr = zc + q * DSA_ZC_STRIDE; int acc = 0, js = 1000, rp = 0;
#pragma unroll 1
                            for (int jj = 0; jj < nt; ++jj) { const int cz = (int)zr[jj]; if (js == 1000 && acc + cz >= newk) { js = jj; rp = newk - acc; } acc += cz; }
                            if (acc == cb) { qT2[q] = KEY_ZERO; qJ2[q] = (unsigned)js; qR2[q] = (unsigned)rp; qC[q] = 0u; } else qF[1] = 1u; }
                        else qF[1] = 1u; } }
            }
            if (pass == 3 || pass == 4) {
                __syncthreads();
                const bool generic = qF[0] != 0u;
                if (pass == 4 || !generic) {
#pragma unroll 1
                    for (int i = 0; i < 8; ++i) { const int q = 8 * w + i; const int m = (int)qM[q], rn = (int)qK[q];
                        int js = 1000, rp = 0;
                        if (m > rn) { const int c = lane < nt ? (int)zc[q * DSA_ZC_STRIDE + lane] : 0; int inc = c;
#pragma unroll
                            for (int off = 1; off < 64; off <<= 1) { const int t = __shfl_up(inc, off); if (lane >= off) inc += t; }
                            const bool here = (inc >= rn) && (inc - c < rn);
                            const unsigned long long mm = __ballot(here); const int src = mm ? (__ffsll((long long)mm) - 1) : 0;
                            js = src; rp = rn - __shfl(inc - c, src); }
                        if (lane == 0) { qJ[q] = (unsigned)js; qR[q] = (unsigned)rp; } }
                } else {
                    for (int i = tid; i < 64 * DSA_ZC_STRIDE; i += 512) zc[i] = 0u;
                }
            }
            __syncthreads();
            pref = qT[ql]; Tq = pref; jstar = (int)qJ[ql]; rprime = (int)qR[ql];
            if (pass == 1 && qF[1] == 0u) { fast = true; Tq = qT2[ql]; jstar = (int)qJ2[ql]; rprime = (int)qR2[ql]; candlim = qC[ql]; pass = 4; }
        }
    }
    __syncthreads();
    {
        const int h = w & 3, qh2 = w >> 2, ql = 32 * qh2 + r32;
        const stat_t* sskv = stat_ptr(F, l, ST_SSKV);
        LAS unsigned short* QL = (LAS unsigned short*)(L + w * 8192);
        {
            bf16x8_t qaf[4];
#pragma unroll
            for (int ks = 0; ks < 4; ++ks) qaf[ks] = *(const GAS bf16x8_t*)(P + (size_t)(qrow0 + ql) * NIN + PC_QA + h * 64 + ks * 16 + hi * 8);
#pragma unroll 1
            for (int c = 0; c < 4; ++c) {
                f32x16_t d;
#pragma unroll
                for (int r = 0; r < 16; ++r) d[r] = 0.f;
                const GAS bf16x8_t* wf = (const GAS bf16x8_t*)(F.ws + WS_WUKF) + ((size_t)(l * 4 + h) * 16 + 4 * c) * 64 + lane;
#pragma unroll
                for (int ks = 0; ks < 4; ++ks) d = MFMA32(wf[64 * ks], qaf[ks], d);
#pragma unroll
                for (int r = 0; r < 16; ++r) QL[r32 * 128 + 32 * c + crow(r, hi)] = (unsigned short)f2bf(d[r]); }
        }
        LDS_WAIT(); asm volatile("" ::: "memory");
        bf16x8_t qlf[8];
#pragma unroll
        for (int s = 0; s < 8; ++s) qlf[s] = *(const LAS bf16x8_t*)(QL + r32 * 128 + 16 * s + 8 * hi);
        LDS_WAIT(); asm volatile("" ::: "memory");
        __syncthreads();
        LAS unsigned char* ckb = L;
        LAS float* rkb = (LAS float*)(L + DSA_IQ);
#define DSA_DMA(j_, buf_) do { const int jj_ = (j_); const int row_ = 8 * w + ((lane >> 2) & 7); \
            const int grow_ = jj_ == 0 ? MREAL + (row_ < NMETA ? row_ : NMETA - 1) : b * SEQ + 64 * (jj_ - 1) + row_; \
            const bf16* gp_ = P + (size_t)grow_ * NIN + PC_CKV + (4 * (lane >> 5) + ((lane & 3) ^ ((row_ >> 2) & 3))) * 8; \
            __builtin_amdgcn_global_load_lds((const unsigned*)gp_, (LAS unsigned*)(ckb + (buf_) * 16384 + 2048 * w), 16, 0, 0); \
            __builtin_amdgcn_global_load_lds((const unsigned*)(gp_ + 64), (LAS unsigned*)(ckb + (buf_) * 16384 + 2048 * w + 1024), 16, 0, 0); } while (0)
        DSA_DMA(0, 0); if (1 < nt) DSA_DMA(1, 1);
        for (int i = tid; i < nt * 64; i += 512) { const int jj_ = i >> 6, kk_ = i & 63; const int grow_ = jj_ == 0 ? MREAL + (kk_ < NMETA ? kk_ : NMETA - 1) : b * SEQ + 64 * (jj_ - 1) + kk_;
            const float rks_ = rsqrtf(stat_get(sskv + grow_) * (1.0f / 128.0f) + pg8::RMS_EPS); rkb[jj_ * 128 + kk_] = rks_; rkb[jj_ * 128 + 64 + kk_] = rks_ * 1.4426950408889634f; }
        asm volatile("s_waitcnt vmcnt(0)" ::: "memory");
        __syncthreads();
        f32x16_t oT[4];
#pragma unroll
        for (int c = 0; c < 4; ++c)
#pragma unroll
            for (int r = 0; r < 16; ++r) oT[c][r] = 0.f;
        float mrun = -1.0e30f, lrun = 0.f;
        constexpr float LOG2E = 1.4426950408889634f;
        const float bfar = bd[h * 132 + 128]; const LAS float* bdh = bd + h * 132;
        const unsigned xr = (r32 >> 2) & 3u, rowpart = 2048u * (r32 >> 3) + 64u * (r32 & 7);
        const unsigned rrA = rowpart + 16u * ((unsigned)hi ^ xr), rrB = rowpart + 16u * (((unsigned)hi ^ xr) ^ 2u);
        const unsigned yb = 2u * ((lane >> 4) & 1) + ((lane & 3) >> 1), trpart = 64u * (4u * hi + ((lane & 15) >> 2)) + 8u * (lane & 1);
        const unsigned trA = trpart + 16u * (yb ^ (unsigned)hi), trB = trpart + 16u * (yb ^ (unsigned)hi ^ 2u);
        if (qh2 == 0) __builtin_amdgcn_s_setprio(2);
#pragma unroll 1
        for (int j0 = 0; j0 < nt; j0 += 2) {
            if (j0 + 2 < nt) DSA_DMA(j0 + 2, (j0 + 2) & 3);
            if (j0 + 3 < nt) DSA_DMA(j0 + 3, (j0 + 3) & 3);
#pragma unroll
            for (int jj = 0; jj < 2; ++jj) { const int j = j0 + jj; if (j >= nt) break;
            const LAS unsigned char* tb = ckb + (j & 3) * 16384; const LAS float* rk = rkb + j * 128;
            f32x16_t p0, p1;
#pragma unroll
            for (int r = 0; r < 16; ++r) { p0[r] = 0.f; p1[r] = 0.f; }
            { const LAS unsigned char* ra = tb + rrA; const LAS unsigned char* rb_ = tb + rrB;
              bf16x8_t a0 = *(const LAS bf16x8_t*)(ra), a1 = *(const LAS bf16x8_t*)(ra + 8192);
#pragma unroll
              for (int s = 0; s < 8; ++s) { bf16x8_t n0 = a0, n1 = a1;
                if (s < 7) { const LAS unsigned char* bp = ((s + 1) & 1) ? rb_ : ra; n0 = *(const LAS bf16x8_t*)(bp + 512 * ((s + 1) >> 1)); n1 = *(const LAS bf16x8_t*)(bp + 512 * ((s + 1) >> 1) + 8192); }
                p0 = MFMA32(a0, qlf[s], p0); p1 = MFMA32(a1, qlf[s], p1); a0 = n0; a1 = n1; } }
            const unsigned mw0 = maskw[(ql * 34 + j) * 2] >> (4 * hi), mw1 = maskw[(ql * 34 + j) * 2 + 1] >> (4 * hi);
            const int dbase = ((j == 0) ? (NMETA + t0 + ql) : (t0 + ql - 64 * (j - 1))) - 4 * hi;
            const bool nearb = __any((dbase - 63) < 128);
            const LAS float* rkh = rk + 4 * hi;
            float mx = -INFINITY;
            const unsigned NINF = 0xff800000u;
#define DSA_LOGITS(NEAR_) \
            _Pragma("unroll") for (int g = 0; g < 4; ++g) {        \
                const f32x4 ka = *(const LAS f32x4*)(rkh + 64 + 8 * g), kb = *(const LAS f32x4*)(rkh + 64 + 32 + 8 * g);        \
                _Pragma("unroll") for (int i = 0; i < 4; ++i) { const int r = 4 * g + i, c0 = 8 * g + i; \
                    float x0 = p0[r], x1 = p1[r]; asm volatile("" : "+v"(x0), "+v"(x1) :: "memory");        \
                    float b0 = bfar, b1 = bfar; \
                    if (NEAR_) { int d0 = dbase - c0; d0 = d0 < 0 ? 0 : (d0 > 128 ? 128 : d0); int d1 = dbase - 32 - c0; d1 = d1 < 0 ? 0 : (d1 > 128 ? 128 : d1); b0 = bdh[d0]; b1 = bdh[d1]; } \
                    const unsigned v0 = __float_as_uint(fmaf(x0, ka[i], b0)), v1 = __float_as_uint(fmaf(x1, kb[i], b1)); \
                    const unsigned m0 = (unsigned)(((int)(mw0 << (31 - c0))) >> 31), m1 = (unsigned)(((int)(mw1 << (31 - c0))) >> 31);        \
                    const float y0 = __uint_as_float((m0 & v0) | (~m0 & NINF)), y1 = __uint_as_float((m1 & v1) | (~m1 & NINF)); \
                    p0[r] = y0; p1[r] = y1; asm("v_max3_f32 %0, %1, %2, %3" : "=v"(mx) : "v"(mx), "v"(y0), "v"(y1)); } }
            if (nearb) { DSA_LOGITS(true) } else { DSA_LOGITS(false) }
#undef DSA_LOGITS
            { const auto rr = __builtin_amdgcn_permlane32_swap(__float_as_uint(mx), __float_as_uint(mx), false, false); mx = fmaxf(__uint_as_float(rr[0]), __uint_as_float(rr[1])); }
            const float mnew = fmaxf(mrun, mx);
            const float scl = __builtin_amdgcn_exp2f(mrun - mnew);
            if (__any(mnew > mrun)) {
#pragma unroll
                for (int c = 0; c < 4; ++c)
#pragma unroll
                    for (int r = 0; r < 16; ++r) oT[c][r] *= scl;
            }
            mrun = mnew; f32x2_t psv = (f32x2_t){0.f, 0.f}; const f32x2_t mv = (f32x2_t){mnew, mnew};
#pragma unroll
            for (int g = 0; g < 4; ++g) {
                const f32x4 ka = *(const LAS f32x4*)(rkh + 8 * g), kb = *(const LAS f32x4*)(rkh + 32 + 8 * g);
#pragma unroll
                for (int i = 0; i < 4; i += 2) { const int r = 4 * g + i;
                    f32x2_t xa = (f32x2_t){p0[r], p0[r + 1]}, xb = (f32x2_t){p1[r], p1[r + 1]}; asm volatile("" : "+v"(xa), "+v"(xb) :: "memory");
                    xa = xa - mv; xb = xb - mv;
                    const f32x2_t ea = (f32x2_t){__builtin_amdgcn_exp2f(xa.x), __builtin_amdgcn_exp2f(xa.y)}, eb = (f32x2_t){__builtin_amdgcn_exp2f(xb.x), __builtin_amdgcn_exp2f(xb.y)};
                    psv = psv + ea; psv = psv + eb;
                    const f32x2_t wa = ea * (f32x2_t){ka[i], ka[i + 1]}, wb = eb * (f32x2_t){kb[i], kb[i + 1]};
                    p0[r] = wa.x; p0[r + 1] = wa.y; p1[r] = wb.x; p1[r + 1] = wb.y; } }
            float ps = psv.x + psv.y;
            { const auto rr = __builtin_amdgcn_permlane32_swap(__float_as_uint(ps), __float_as_uint(ps), false, false); ps = __uint_as_float(rr[0]) + __uint_as_float(rr[1]); }
            lrun = lrun * scl + ps;
            v4u pw[4];
#pragma unroll
            for (int i = 0; i < 4; ++i) { pw[0][i] = cvtpk(p0[2 * i], p0[2 * i + 1]); pw[1][i] = cvtpk(p0[8 + 2 * i], p0[8 + 2 * i + 1]); pw[2][i] = cvtpk(p1[2 * i], p1[2 * i + 1]); pw[3][i] = cvtpk(p1[8 + 2 * i], p1[8 + 2 * i + 1]); }
            { const lds_cptr t0p = (lds_cptr)(tb + trA), t1p = (lds_cptr)(tb + trB);
              s16x4_t lo = vtr(t0p), hh = vtr(t1p + 2048);
#pragma unroll
              for (int i = 0; i < 16; ++i) { const int ks = i >> 2, c = i & 3;
                s16x4_t lo2 = lo, hh2 = hh;
                if (i < 15) { const int ks2 = (i + 1) >> 2, c2 = (i + 1) & 3; lo2 = vtr(t0p + 4096 * ks2 + 512 * c2); hh2 = vtr(t1p + 4096 * ks2 + 2048 + 512 * c2); }
                const bf16x8_t av = (bf16x8_t){lo[0], lo[1], lo[2], lo[3], hh[0], hh[1], hh[2], hh[3]};
                oT[c] = MFMA32(av, __builtin_bit_cast(bf16x8_t, pw[ks]), oT[c]);
                lo = lo2; hh = hh2; } }
            }
            asm volatile("s_waitcnt vmcnt(0)" ::: "memory");
            __syncthreads();
        }
        __builtin_amdgcn_s_setprio(0);
        { const int lane = lane_id(), r32 = lane & 31, hi = lane >> 5;
        const float linv = 1.0f / lrun;
        f32x16_t ot[2];
#pragma unroll
        for (int db = 0; db < 2; ++db)
#pragma unroll
            for (int r = 0; r < 16; ++r) ot[db][r] = 0.f;
#pragma unroll
        for (int c = 0; c < 4; ++c) {
#pragma unroll
            for (int s = 0; s < 2; ++s) {
                v4u pk;
#pragma unroll
                for (int i = 0; i < 4; ++i) pk[i] = cvtpk(oT[c][8 * s + 2 * i] * linv, oT[c][8 * s + 2 * i + 1] * linv);
                const bf16x8_t bfrag = __builtin_bit_cast(bf16x8_t, pk);
#pragma unroll
                for (int db = 0; db < 2; ++db) {
                    const bf16x8_t wa = *((const GAS bf16x8_t*)(F.ws + WS_WUVF) + ((size_t)(l * 4 + h) * 16 + 4 * c + 2 * s + db) * 64 + lane);
                    ot[db] = MFMA32(wa, bfrag, ot[db]); } } }
        LAS unsigned short* stg = (LAS unsigned short*)(L + 36864 + w * 4096);
#pragma unroll
        for (int db = 0; db < 2; ++db)
#pragma unroll
            for (int r = 0; r < 16; ++r) stg[r32 * 64 + 32 * db + crow(r, hi)] = (unsigned short)f2bf(ot[db][r]);
        LDS_WAIT(); asm volatile("" ::: "memory");
        stat_t* ssa = stat_ptr(F, l, ST_SSA);
#pragma unroll
        for (int i = 0; i < 4; ++i) { const int row = i * 8 + (lane >> 3), ch = lane & 7; const v4u v = *(const LAS v4u*)(stg + row * 64 + ch * 8);
            float q = (bflo(v.x) * bflo(v.x) + bfhi(v.x) * bfhi(v.x)) + (bflo(v.y) * bflo(v.y) + bfhi(v.y) * bfhi(v.y)) + (bflo(v.z) * bflo(v.z) + bfhi(v.z) * bfhi(v.z)) + (bflo(v.w) * bflo(v.w) + bfhi(v.w) * bfhi(v.w));
            q += __shfl_xor(q, 1); q += __shfl_xor(q, 2); q += __shfl_xor(q, 4);
            if (ch == 0) pg8::stat_add(ssa + qrow0 + 32 * qh2 + row, q);
            *(GAS v4u*)(Ycat + (size_t)(qrow0 + 32 * qh2 + row) * 1024 + YC_A + h * 64 + ch * 8) = v; }
        LDS_WAIT(); asm volatile("" ::: "memory");
        }
    }
    __syncthreads();
}


constexpr int S5T = 32, S5NC = SEQ / S5T, S5RG = BATCH * S5NC, S5KU = 640;
constexpr size_t WS_U = 376 * MiB, WS_TZ = 416 * MiB, TZ_LAYER = 20 * MiB, WS_MG = 456 * MiB, MG_LAYER = 4 * MiB, WS_HQ = 464 * MiB, WS_END2 = 497 * MiB;
static_assert(WS_HQ + (size_t)MROWS * 1024 <= WS_WUKF && WS_WUVF + 128 * 1024 <= WS_END2 && WS_END2 <= 512 * MiB, "HQ buffer / fragment tables");
static_assert((size_t)32 * S5RG * S5KU * 2 <= WS_TZ - WS_U && (size_t)32 * 512 * S5KU * 2 <= TZ_LAYER && (size_t)32 * 128 * 512 * 2 <= MG_LAYER, "S5 buffers");

struct S5P { float lrdt, lidt, fr, fi; };
__device__ __forceinline__ S5P s5_params(const Args& A, int lg, int p) {
    const float dt = expf(A.in[10][lg]), lr = A.in[8][lg * 64 + p], li = A.in[9][lg * 64 + p];
    const float mag = expf(lr * dt), ar = mag * cosf(li * dt), ai = mag * sinf(li * dt);
    const float den = lr * lr + li * li, nr = ar - 1.0f, ni = ai;
    S5P o; o.lrdt = lr * dt; o.lidt = li * dt; o.fr = (nr * lr + ni * li) / den; o.fi = (ni * lr - nr * li) / den; return o;
}
__device__ __forceinline__ void s5_apow(const S5P& q, int n, float& re, float& im) { const float m = expf(q.lrdt * (float)n); re = m * cosf(q.lidt * (float)n); im = m * sinf(q.lidt * (float)n); }

__device__ __forceinline__ void s5_build_item(const Args& A, Frame& F, int l, int kind, int g, int x, LAS float* scr) {
    const int lane = lane_id(), lg = l * 32 + g, p = lane;
    bf16* TZ = (bf16*)(F.ws + WS_TZ + (size_t)l * TZ_LAYER) + (size_t)g * 512 * S5KU;
    bf16* MG = (bf16*)(F.ws + WS_MG + (size_t)l * MG_LAYER) + (size_t)g * 128 * 512;
    const S5P q = s5_params(A, lg, p);
    if (kind == 0) {
        const int d = x;
        float pr, pi; s5_apow(q, d, pr, pi);
        LDS_WAIT(); asm volatile("" ::: "memory");
#pragma unroll
        for (int ch = 0; ch < 16; ++ch) { const float br = A.in[11][((size_t)lg * 64 + p) * 16 + ch], bi = A.in[12][((size_t)lg * 64 + p) * 16 + ch];
            const float b1r = q.fr * br - q.fi * bi, b1i = q.fr * bi + q.fi * br;
            scr[p * 34 + ch] = pr * b1r - pi * b1i; scr[p * 34 + 16 + ch] = pr * b1i + pi * b1r; }
        LDS_WAIT(); asm volatile("" ::: "memory");
        const int ch = lane >> 2, c4 = 4 * (lane & 3); float k0 = 0.f, k1 = 0.f, k2 = 0.f, k3 = 0.f;
#pragma unroll 16
        for (int pp = 0; pp < 64; ++pp) { const float cr = A.in[13][((size_t)lg * 16 + ch) * 64 + pp], ci = A.in[14][((size_t)lg * 16 + ch) * 64 + pp]; const LAS float* xr = scr + pp * 34 + c4; const LAS float* xi = xr + 16;
            k0 += cr * xr[0] - ci * xi[0]; k1 += cr * xr[1] - ci * xi[1]; k2 += cr * xr[2] - ci * xi[2]; k3 += cr * xr[3] - ci * xi[3]; }
        const unsigned long long kv = (unsigned long long)pk2(k0, k1) | ((unsigned long long)pk2(k2, k3) << 32);
        for (int tau = d; tau < S5T; ++tau) *(GAS unsigned long long*)(TZ + (size_t)(tau * 16 + ch) * S5KU + (tau - d) * 16 + c4) = kv;
        if (d > 0) for (int tau = 0; tau + d < S5T; ++tau) *(GAS unsigned long long*)(TZ + (size_t)(tau * 16 + ch) * S5KU + (tau + d) * 16 + c4) = 0ull;
        LDS_WAIT(); asm volatile("" ::: "memory");
    } else if (kind == 1) {
        const int tau = x; float pr, pi; s5_apow(q, tau + 1, pr, pi);
#pragma unroll 4
        for (int ch = 0; ch < 16; ++ch) { const float cr = A.in[13][((size_t)lg * 16 + ch) * 64 + p], ci = A.in[14][((size_t)lg * 16 + ch) * 64 + p];
            const float wr_ = cr * pr - ci * pi, wi_ = cr * pi + ci * pr;
            bf16* rowp = TZ + (size_t)(tau * 16 + ch) * S5KU + 512;
            rowp[p] = (bf16)f2bf(wr_); rowp[64 + p] = (bf16)f2bf(-wi_); }
    } else {
        const int sg = x; float pr, pi; s5_apow(q, S5T - 1 - sg, pr, pi);
        unsigned wre[8], wim[8];
#pragma unroll
        for (int c2 = 0; c2 < 8; ++c2) { float vr[2], vi[2];
#pragma unroll
            for (int e = 0; e < 2; ++e) { const int ch = 2 * c2 + e; const float br = A.in[11][((size_t)lg * 64 + p) * 16 + ch], bi = A.in[12][((size_t)lg * 64 + p) * 16 + ch];
                const float b1r = q.fr * br - q.fi * bi, b1i = q.fr * bi + q.fi * br; vr[e] = pr * b1r - pi * b1i; vi[e] = pr * b1i + pi * b1r; }
            wre[c2] = pk2(vr[0], vr[1]); wim[c2] = pk2(vi[0], vi[1]); }
        GAS v4u* r0 = (GAS v4u*)(MG + (size_t)(2 * p) * 512 + sg * 16); GAS v4u* r1 = (GAS v4u*)(MG + (size_t)(2 * p + 1) * 512 + sg * 16);
        r0[0] = (v4u){wre[0], wre[1], wre[2], wre[3]}; r0[1] = (v4u){wre[4], wre[5], wre[6], wre[7]};
        r1[0] = (v4u){wim[0], wim[1], wim[2], wim[3]}; r1[1] = (v4u){wim[4], wim[5], wim[6], wim[7]};
    }
}

typedef float f32x4_t __attribute__((ext_vector_type(4)));
__device__ __forceinline__ void s5_scan_task(const Args& A, Frame& F, int l, int g) {
    const int lane = lane_id(), w = F.wave, bcol = lane & 15, kg = lane >> 4, lg = l * 32 + g;
    const bf16* P = (const bf16*)(F.ws + WS_P);
    bf16* U = (bf16*)(F.ws + WS_U) + (size_t)g * S5RG * S5KU;
    const bf16* MG = (const bf16*)(F.ws + WS_MG + (size_t)l * MG_LAYER) + (size_t)g * 128 * 512;
    LAS unsigned char* ring = F.lds + RING_OFF;
    asm volatile("s_waitcnt vmcnt(0)" ::: "memory");
    __syncthreads();
#define S5_DMA(k_) do { const int kk_ = (k_); _Pragma("unroll") for (int i_ = 0; i_ < 2; ++i_) { const int r_ = 2 * w + i_; \
        __builtin_amdgcn_global_load_lds((const unsigned*)(U + (size_t)(r_ * S5NC + kk_) * S5KU + 8 * (lane ^ r_)), (LAS unsigned*)(ring + (kk_ & 7) * 16384 + r_ * 1024), 16, 0, 0); } } while (0)
#pragma unroll
    for (int k0 = 0; k0 < 7; ++k0) S5_DMA(k0);
    bf16x8_t af[16];
#pragma unroll
    for (int ks = 0; ks < 16; ++ks) af[ks] = *(const GAS bf16x8_t*)(MG + (size_t)(16 * w + bcol) * 512 + 32 * ks + 8 * kg);
    const int pA = 8 * w + 2 * kg;
    float aTr[2], aTi[2];
#pragma unroll
    for (int e = 0; e < 2; ++e) { const S5P q = s5_params(A, lg, pA + e); s5_apow(q, S5T, aTr[e], aTi[e]); }
    f32x4_t h;
    {
        f32x4_t s = (f32x4_t){0.f, 0.f, 0.f, 0.f};
#pragma unroll
        for (int ks = 0; ks < 16; ++ks) { const int sg = 2 * ks + (kg >> 1);
            if (sg >= 16) { const bf16x8_t bfm = *(const GAS bf16x8_t*)(P + (size_t)(MREAL + sg - 16) * NIN + PC_UB + g * 16 + 8 * (kg & 1)); s = __builtin_amdgcn_mfma_f32_16x16x32_bf16(af[ks], bfm, s, 0, 0, 0); } }
        h = s;
        bf16* hp = U + (size_t)(bcol * S5NC) * S5KU + 512 + pA;
        *(GAS unsigned*)hp = pk2(h[0], h[2]); *(GAS unsigned*)(hp + 64) = pk2(h[1], h[3]);
    }
    const unsigned lbase = (unsigned)bcol * 1024u + 16u * (unsigned)((kg ^ bcol) & 3), bc2 = (unsigned)bcol >> 2;
#pragma unroll 1
    for (int c = 0; c < S5NC - 1; ++c) {
        if (c <= S5NC - 2 - 6) asm volatile("s_waitcnt vmcnt(12)" ::: "memory"); else asm volatile("s_waitcnt vmcnt(0)" ::: "memory");
        __syncthreads();
        if (c + 7 <= S5NC - 2) S5_DMA(c + 7);
        const LAS unsigned char* bufp = ring + (c & 7) * 16384 + lbase;
        f32x4_t s4[4];
#pragma unroll
        for (int j = 0; j < 4; ++j) s4[j] = (f32x4_t){0.f, 0.f, 0.f, 0.f};
#pragma unroll
        for (int m = 0; m < 4; ++m)
#pragma unroll
            for (int j = 0; j < 4; ++j) { const bf16x8_t bfr = *(const LAS bf16x8_t*)(bufp + 256 * m + 64u * ((unsigned)j ^ bc2)); s4[j] = __builtin_amdgcn_mfma_f32_16x16x32_bf16(af[4 * m + j], bfr, s4[j], 0, 0, 0); }
        const f32x4_t s = (s4[0] + s4[1]) + (s4[2] + s4[3]);
        { const float r0 = aTr[0] * h[0] - aTi[0] * h[1] + s[0], i0 = aTr[0] * h[1] + aTi[0] * h[0] + s[1], r1 = aTr[1] * h[2] - aTi[1] * h[3] + s[2], i1 = aTr[1] * h[3] + aTi[1] * h[2] + s[3];
          h = (f32x4_t){r0, i0, r1, i1}; }
        bf16* hp = U + (size_t)(bcol * S5NC + (c + 1)) * S5KU + 512 + pA;
        *(GAS unsigned*)hp = pk2(h[0], h[2]); *(GAS unsigned*)(hp + 64) = pk2(h[1], h[3]);
    }
#undef S5_DMA
    asm volatile("s_waitcnt vmcnt(0)" ::: "memory");
    __syncthreads();
    if (w == 0 && lane == 0) { __builtin_amdgcn_fence(__ATOMIC_RELEASE, "agent"); asm volatile("s_waitcnt vmcnt(0)" ::: "memory"); __hip_atomic_store(F.ctl + CW_SF + l * 32 + g, 1u, RLX_AGENT); }
}

struct OneUnit {
    pg8::Unit u0;
    __device__ __forceinline__ bool next(int i, pg8::Unit& u) const { if (i != 0) return false; u = u0; return true; }
    __device__ __forceinline__ void a_ready(const pg8::Unit&) const {}
    __device__ __forceinline__ void done(const pg8::Unit&) const {}
};
struct S5Order {
    int G, c;
    __device__ __forceinline__ bool next(int i, pg8::Unit& u) const { const int L = i * G + c; if (L >= 256) return false; const int g = L >> 3, wi = L & 7; u.pm = 4 * g + (wi >> 1); u.pn = 2 * g + (wi & 1); return true; }
    __device__ __forceinline__ void a_ready(const pg8::Unit&) const {}
    __device__ __forceinline__ void done(const pg8::Unit&) const {}
};
namespace pg8 {
struct EpiS5 {
    static constexpr bool PERM = true, AFTER_DRAIN = false; static constexpr int MIDT = 0, MIDT2 = 0;
    const bf16_t* Pm; bf16_t* YG; const float* dsk;
    __device__ __forceinline__ void operator()(const f32x4 (&acc)[2][2][4][2], const Unit& u, int wr, int wc, int fr, int fq) const {
        const int g = u.pm >> 2, rg0 = (u.pm & 3) * BM + wr * 64 + fr, cg0 = (u.pn & 1) * BM + wc * 32 + 8 * fq;
        const int colq = g * 16 + (cg0 & 15);
        const f32x4 d0 = *(const PG8_GAS f32x4*)(dsk + colq), d1 = *(const PG8_GAS f32x4*)(dsk + colq + 4);
#pragma unroll
        for (int ai = 0; ai < 2; ++ai) {
            u32x4 ul[4][2];
#pragma unroll
            for (int m = 0; m < 4; ++m) { const int rg = rg0 + ai * HALF + m * 16, b = rg >> 6, c = rg & 63;
#pragma unroll
                for (int bj = 0; bj < 2; ++bj) { const int cg = cg0 + bj * HALF, tau = cg >> 4, ch = cg & 15; const size_t row = (size_t)b * 2048 + c * 32 + tau; const int col = g * 16 + ch;
                    ul[m][bj] = *(const PG8_GAS u32x4*)(Pm + ((size_t)g * 1024 + rg) * 640 + cg); (void)row; (void)col; } }
#pragma unroll
            for (int m = 0; m < 4; ++m) { const int rg = rg0 + ai * HALF + m * 16, b = rg >> 6, c = rg & 63;
#pragma unroll
                for (int bj = 0; bj < 2; ++bj) { const int cg = cg0 + bj * HALF, tau = cg >> 4, ch = cg & 15; const size_t row = (size_t)b * 2048 + c * 32 + tau; const int col = g * 16 + ch;
                    const u32x4 u8 = ul[m][bj];
                    const f32x4 a0 = acc[ai][bj][m][0], a1 = acc[ai][bj][m][1];
                    float y[8] = {a0[0] + d0[0] * bf_lo(u8.x), a0[1] + d0[1] * bf_hi(u8.x), a0[2] + d0[2] * bf_lo(u8.y), a0[3] + d0[3] * bf_hi(u8.y),
                                  a1[0] + d1[0] * bf_lo(u8.z), a1[1] + d1[1] * bf_hi(u8.z), a1[2] + d1[2] * bf_lo(u8.w), a1[3] + d1[3] * bf_hi(u8.w)};
#pragma unroll
                    for (int j = 0; j < 8; ++j) { const float x = y[j], t = fminf(0.7978845608028654f * (x + 0.044715f * x * x * x), 15.0f); const float e = __expf(2.0f * t); y[j] = x * (1.0f - __builtin_amdgcn_rcpf(e + 1.0f)); }
                    u32x4 w; w.x = cvt_pk_bf16(y[0], y[1]); w.y = cvt_pk_bf16(y[2], y[3]); w.z = cvt_pk_bf16(y[4], y[5]); w.w = cvt_pk_bf16(y[6], y[7]);
                    *(PG8_GAS u32x4*)(YG + row * 512 + col) = w; } } }
    }
};
}


__device__ __forceinline__ void w2_quant_item(const Args& A, Frame& F, int l, int item, LAS float* scr) {
    const int lane = lane_id();
    const float* W = A.in[23] + (size_t)l * 4096 * 1024; unsigned char* WQ = (unsigned char*)wptr(F, l, WO_2);
    const int kb = item >> 5, nb = item & 31, k0 = 64 * kb, n0 = 32 * nb;
    const int kr = lane >> 3, c4 = lane & 7; float sc[4];
#pragma unroll
    for (int e_ = 0; e_ < 4; ++e_) sc[e_] = 448.0f / fmaxf(__uint_as_float(__hip_atomic_load(F.ctl + CW_WMAX + l * 1024 + n0 + 4 * c4 + e_, RLX_AGENT)), 1e-30f);
#pragma unroll
    for (int i = 0; i < 8; ++i) { const int kk = 8 * i + kr; const f32x4_t v = *(const GAS f32x4_t*)(W + (size_t)(k0 + kk) * 1024 + n0 + 4 * c4);
#pragma unroll
        for (int e_ = 0; e_ < 4; ++e_) scr[kk * 33 + 4 * c4 + e_] = v[e_] * sc[e_]; }
    LDS_WAIT(); asm volatile("" ::: "memory");
#pragma unroll
    for (int j = 0; j < 2; ++j) { const int c = lane + 64 * j, n = c >> 2, part = c & 3; const LAS float* s = scr + (16 * part) * 33 + n;
        v4u o;
#pragma unroll
        for (int q = 0; q < 4; ++q) o[q] = pg8::pk4_fp8(s[(4 * q) * 33], s[(4 * q + 1) * 33], s[(4 * q + 2) * 33], s[(4 * q + 3) * 33]);
        *(GAS v4u*)(WQ + (size_t)(n0 + n) * 4096 + k0 + 16 * part) = o; }
    LDS_WAIT(); asm volatile("" ::: "memory");
}

__device__ __forceinline__ void w1_quant_item(const Args& A, Frame& F, int l, int item, LAS float* scr) {
    const int lane = lane_id();
    const float* W = A.in[22] + (size_t)l * 1024 * 4096; unsigned char* WQ = (unsigned char*)wptr(F, l, WO_1);
    const int kb = item >> 7, nb = item & 127, k0 = 64 * kb, n0 = 32 * nb;
    const int kr = lane >> 3, c4 = lane & 7; float sc[4];
#pragma unroll
    for (int e_ = 0; e_ < 4; ++e_) sc[e_] = 448.0f / fmaxf(__uint_as_float(__hip_atomic_load(F.ctl + CW_WMAX1 + l * 4096 + n0 + 4 * c4 + e_, RLX_AGENT)), 1e-30f);
#pragma unroll
    for (int i = 0; i < 8; ++i) { const int kk = 8 * i + kr; const f32x4_t v = *(const GAS f32x4_t*)(W + (size_t)(k0 + kk) * 4096 + n0 + 4 * c4); const float g = A.in[21][l * 1024 + k0 + kk];
#pragma unroll
        for (int e_ = 0; e_ < 4; ++e_) scr[kk * 33 + 4 * c4 + e_] = v[e_] * g * sc[e_]; }
    LDS_WAIT(); asm volatile("" ::: "memory");
#pragma unroll
    for (int j = 0; j < 2; ++j) { const int c = lane + 64 * j, n = c >> 2, part = c & 3; const LAS float* s = scr + (16 * part) * 33 + n;
        v4u o;
#pragma unroll
        for (int q = 0; q < 4; ++q) o[q] = pg8::pk4_fp8(s[(4 * q) * 33], s[(4 * q + 1) * 33], s[(4 * q + 2) * 33], s[(4 * q + 3) * 33]);
        *(GAS v4u*)(WQ + (size_t)(n0 + n) * 1024 + k0 + 16 * part) = o; }
    LDS_WAIT(); asm volatile("" ::: "memory");
}
__device__ __forceinline__ void hq_phase(Frame& F, const stat_t* ss) {
    const int lane = lane_id();
    const int gw = F.vcu * NWAVES + F.wave, NGW = F.G * NWAVES;
    const bf16* Hb = (const bf16*)(F.ws + WS_HB); unsigned char* HQ = F.ws + WS_HQ;
    for (int s_ = 0; ; ++s_) { const int m0 = row_step(F, s_); if (m0 < 0) break;
        v4u hw[4][2]; float r[4];
#pragma unroll
        for (int q = 0; q < 4; ++q) { const GAS v4u* h16 = (const GAS v4u*)(Hb + (size_t)(m0 + q) * DM) + 2 * lane;
            hw[q][0] = h16[0]; hw[q][1] = h16[1];
            r[q] = 8.0f * rsqrtf(stat_get(ss + m0 + q) * (1.0f / 1024.0f) + pg8::RMS_EPS); }
#pragma unroll
        for (int q = 0; q < 4; ++q) { v4u o;
#pragma unroll
            for (int i = 0; i < 2; ++i) { const v4u hv = hw[q][i];
                o[2 * i] = pg8::pk4_fp8(bflo(hv.x) * r[q], bfhi(hv.x) * r[q], bflo(hv.y) * r[q], bfhi(hv.y) * r[q]); o[2 * i + 1] = pg8::pk4_fp8(bflo(hv.z) * r[q], bfhi(hv.z) * r[q], bflo(hv.w) * r[q], bfhi(hv.w) * r[q]); }
            *((GAS v4u*)(HQ + (size_t)(m0 + q) * 1024) + lane) = o; }
    }
}
__device__ __forceinline__ void mixers_naive_phase(const Args& A, Frame& F, int l) {
    LAS float* wl = (LAS float*)(F.lds + RING_OFF + F.wave * 16384);
    if (l == 0) {
        const int gw = F.vcu * NWAVES + F.wave, NGW = F.G * NWAVES;
        for (int it = gw; it < DEPTH * 2048; it += NGW) w2_quant_item(A, F, it >> 11, it & 2047, wl);
        for (int it = gw; it < DEPTH * 2048; it += NGW) w1_quant_item(A, F, it >> 11, it & 2047, wl);
        __syncthreads();
    }
    if (F.vcu < 8) { const int it = 8 * F.vcu + F.wave;
        if (it < 32) s5_naive_item(A, F, l, 0, it); else if (it < 32 + NMETA) dsa_naive_item(A, F, l, MREAL + (it - 32), wl); else sb_naive_item(A, F, l, MREAL + (it - 32 - NMETA), wl);
        __syncthreads(); }
    {
        const int x0 = (int)(xb_xcc_id() & 7u);
        int xq = x0;
        gu32* qbase = F.ctl + CW_Q + 64 * (4 + 8 * l);
        for (;;) {
            unsigned slot_a = (unsigned)(size_t)(F.MISC + 16); asm volatile("" : "+s"(slot_a));
            volatile LAS unsigned* slot = (volatile LAS unsigned*)(size_t)slot_a;
            if (F.wave == 0 && lane_id() == 0) {
                unsigned v = __hip_atomic_fetch_add(qbase + 64 * xq, 1u, RLX_AGENT); int nq = xq;
                if (v >= 68u) {
                    unsigned hd[7];
#pragma unroll
                    for (int q = 0; q < 7; ++q) hd[q] = __hip_atomic_load(qbase + 64 * ((x0 + 1 + q) & 7), RLX_AGENT);
                    nq = -1;
#pragma unroll
                    for (int q = 6; q >= 0; --q) if (hd[q] < 68u) nq = (x0 + 1 + q) & 7;
                }
                slot[0] = v; slot[1] = (unsigned)nq; }
            __syncthreads();
            const int idx = (int)slot[0], nq = (int)slot[1];
            __syncthreads();
            if (idx >= 4 + 64) { if (nq < 0) break; xq = nq; continue; }
            if (idx < 4) { s5_scan_task(A, F, l, 4 * xq + idx); continue; }
            { const int i2 = idx - 4; dsa_unit(A, F, l, 2 * xq + (i2 & 1), 31 - (i2 >> 1)); }
        }
    }
    {
        gu32* head3 = F.ctl + CW_Q + 64 * (20 + l);
        for (;;) {
            unsigned slot_a = (unsigned)(size_t)(F.MISC + 16); asm volatile("" : "+s"(slot_a));
            volatile LAS unsigned* slot = (volatile LAS unsigned*)(size_t)slot_a;
            if (F.wave == 0 && lane_id() == 0) { const unsigned v = __hip_atomic_fetch_add(head3, 1u, RLX_AGENT);
                if (v < 256u) { gu32* sf = F.ctl + CW_SF + l * 32 + (int)(v >> 3); unsigned sp = 0u; while (__hip_atomic_load(sf, RLX_AGENT) == 0u) { __builtin_amdgcn_s_sleep(2); if (++sp > (1u << 22)) break; }
                    __builtin_amdgcn_fence(__ATOMIC_ACQUIRE, "agent"); }
                slot[0] = v; }
            __syncthreads();
            const int idx = (int)slot[0];
            __syncthreads();
            if (idx >= 256) break;
            const int g_ = idx >> 3, wi = idx & 7;
            pg8::Gemm gm{(bf16*)(F.ws + WS_U), (bf16*)(F.ws + WS_TZ + (size_t)l * TZ_LAYER), 32 * S5RG, 32 * 512, S5KU};
            OneUnit S{pg8::Unit{4 * g_ + (wi >> 1), 2 * g_ + (wi & 1)}};
            pg8::EpiS5 E{(bf16*)(F.ws + WS_U), (bf16*)(F.ws + WS_YG), A.in[15] + l * 512};
            pg8::gemm_phase<pg8::EpiS5, OneUnit, true, true>(F.lds + RING_OFF, gm, S, E, F.wave);
        }
    }
    {
        gu32* qbase = F.ctl + CW_Q + 64 * (40 + 8 * l);
        const int x0 = (int)(xb_xcc_id() & 7u);
        int xq = x0;
        for (;;) {
            int idx = 0, nq = 0;
            if (lane_id() == 0) { idx = (int)__hip_atomic_fetch_add(qbase + 64 * xq, 1u, RLX_AGENT); nq = xq;
                if (idx >= 512) { unsigned hd[7];
#pragma unroll
                    for (int q = 0; q < 7; ++q) hd[q] = __hip_atomic_load(qbase + 64 * ((x0 + 1 + q) & 7), RLX_AGENT);
                    nq = -1;
#pragma unroll
                    for (int q = 6; q >= 0; --q) if (hd[q] < 512u) nq = (x0 + 1 + q) & 7; } }
            idx = __builtin_amdgcn_readfirstlane(idx); nq = __builtin_amdgcn_readfirstlane(nq);
            if (idx >= 512) { if (nq < 0) break; xq = nq; continue; }
            sb_mfma_unit(A, F, l, (xq << 9) + ((idx & ~63) | (63 - (idx & 63))), (LAS unsigned char*)wl);
        }
    }
}

__device__ __forceinline__ void final_phase(const Args& A, Frame& F) {
    const int lane = lane_id();
    const int gw = F.vcu * NWAVES + F.wave, NGW = F.G * NWAVES;
    const bf16* Hb = (const bf16*)(F.ws + WS_HB); const stat_t* ss = stat_ptr(F, DEPTH, ST_SS1); const float* fg = A.in[24];
    for (int s_ = 0; ; ++s_) { const int m0 = row_step(F, s_); if (m0 < 0 || m0 >= MREAL) break;
        v4u hw[4][2]; float r[4];
#pragma unroll
        for (int q = 0; q < 4; ++q) { const GAS v4u* h16 = (const GAS v4u*)(Hb + (size_t)(m0 + q) * DM) + lane;
            hw[q][0] = h16[0]; hw[q][1] = h16[64];
            r[q] = rsqrtf(stat_get(ss + m0 + q) * (1.0f / 1024.0f) + pg8::RMS_EPS); }
#pragma unroll
        for (int q = 0; q < 4; ++q) { GAS f32x4* o = (GAS f32x4*)(F.out + (size_t)(m0 + q) * DM) + 2 * lane;
#pragma unroll
            for (int jh = 0; jh < 2; ++jh) { const v4u hv = hw[q][jh]; const f32x4 g0 = *((const GAS f32x4*)fg + 2 * lane + 128 * jh), g1 = *((const GAS f32x4*)fg + 2 * lane + 128 * jh + 1);
                o[128 * jh] = (f32x4){bflo(hv.x) * r[q] * g0.x, bfhi(hv.x) * r[q] * g0.y, bflo(hv.y) * r[q] * g0.z, bfhi(hv.y) * r[q] * g0.w};
                o[128 * jh + 1] = (f32x4){bflo(hv.z) * r[q] * g1.x, bfhi(hv.z) * r[q] * g1.y, bflo(hv.w) * r[q] * g1.z, bfhi(hv.w) * r[q] * g1.w}; } }
    }
}


struct MetaArgs { const bf16* A; const bf16* Bt; int N, K; bf16* O; bf16* H; const bf16* Y; const stat_t* ss; stat_t* so; const stat_t* ssb; const stat_t* ssa; const stat_t* ssc; const unsigned* wmax; };
template <int KIND> __device__ __forceinline__ void meta_gemm(Frame& F, const MetaArgs& a, LAS float* red  ) {
    const int lane = lane_id(), w = F.wave, m16 = lane & 15, kg = lane >> 4;
    const int kw = a.K / 8;
    for (int cb = F.vcu; cb < a.N / 16; cb += F.G) {
        f32x4_t acc = (f32x4_t){0.f, 0.f, 0.f, 0.f};
        const bf16* ap = a.A + (size_t)(MREAL + m16) * a.K + w * kw + 8 * kg;
        const bf16* bp = a.Bt + (size_t)(cb * 16 + m16) * a.K + w * kw + 8 * kg;
        constexpr int KW = (KIND == 1 ? 512 : (KIND == 4 ? 4096 : 1024)) / 8, NS = KW / 32, GS = NS < 8 ? NS : 8;
        if constexpr (KIND == 3) {
            const unsigned char* ap8 = (const unsigned char*)a.A + (size_t)(MREAL + m16) * 1024 + w * 128 + 8 * kg;
            const unsigned char* bp8 = (const unsigned char*)a.Bt + (size_t)(cb * 16 + m16) * 1024 + w * 128 + 8 * kg;
            long fa[4], fb[4];
#pragma unroll
            for (int s = 0; s < 4; ++s) { fa[s] = *(const GAS long*)(ap8 + 32 * s); fb[s] = *(const GAS long*)(bp8 + 32 * s); }
#pragma unroll
            for (int s = 0; s < 4; ++s) acc = __builtin_amdgcn_mfma_f32_16x16x32_fp8_fp8(fa[s], fb[s], acc, 0, 0, 0);
        } else if constexpr (KIND == 4) {
            const unsigned char* ap8 = (const unsigned char*)a.A + (size_t)(MREAL + m16) * 4096 + w * 512 + 8 * kg;
            const unsigned char* bp8 = (const unsigned char*)a.Bt + (size_t)(cb * 16 + m16) * 4096 + w * 512 + 8 * kg;
#pragma unroll
            for (int s0 = 0; s0 < 16; s0 += 8) { long fa[8], fb[8];
#pragma unroll
                for (int s = 0; s < 8; ++s) { fa[s] = *(const GAS long*)(ap8 + 32 * (s0 + s)); fb[s] = *(const GAS long*)(bp8 + 32 * (s0 + s)); }
#pragma unroll
                for (int s = 0; s < 8; ++s) acc = __builtin_amdgcn_mfma_f32_16x16x32_fp8_fp8(fa[s], fb[s], acc, 0, 0, 0); }
        } else {
#pragma unroll
        for (int s0 = 0; s0 < NS; s0 += GS) { bf16x8_t fa[GS], fb[GS];
#pragma unroll
            for (int s = 0; s < GS; ++s) { fa[s] = *(const GAS bf16x8_t*)(ap + 32 * (s0 + s)); fb[s] = *(const GAS bf16x8_t*)(bp + 32 * (s0 + s)); }
#pragma unroll
            for (int s = 0; s < GS; ++s) acc = __builtin_amdgcn_mfma_f32_16x16x32_bf16(fa[s], fb[s], acc, 0, 0, 0); }
        }
        *(LAS f32x4_t*)(red + (w * 64 + lane) * 4) = acc;
        __syncthreads();
        if (w == 0) {
            const int col = cb * 16 + m16;
#pragma unroll
            for (int r = 0; r < 4; ++r) { const int row = MREAL + 4 * kg + r; float v = 0.f;
                if (KIND == 2) {
                    const float rb = rsqrtf(stat_get(a.ssb + row) * (1.0f / 512.0f) + pg8::RMS_EPS), ra = rsqrtf(stat_get(a.ssa + row) * (1.0f / 256.0f) + pg8::RMS_EPS), rc = rsqrtf(stat_get(a.ssc + row) * (1.0f / 256.0f) + pg8::RMS_EPS);
#pragma unroll
                    for (int ww = 0; ww < 8; ++ww) v += red[(ww * 64 + lane) * 4 + r] * (ww < 4 ? rb : (ww < 6 ? ra : rc));
                } else {
#pragma unroll
                    for (int ww = 0; ww < 8; ++ww) v += red[(ww * 64 + lane) * 4 + r];
                }
                float sq = 0.f; stat_t* sp = nullptr;
                if (KIND == 0) { v *= rsqrtf(stat_get(a.ss + row) * (1.0f / 1024.0f) + pg8::RMS_EPS); const unsigned wv = f2bf(v); a.O[(size_t)row * NIN + col] = (bf16)wv;
                    if (col >= PC_CKV && col < PC_IK) { const float x = __uint_as_float(wv << 16); sq = x * x; sp = a.so; } }
                else if (KIND == 1) { const float y = bf2f(a.Y[(size_t)row * 512 + col]); const unsigned wv = f2bf(y / (1.0f + __expf(-v))); a.O[(size_t)row * 1024 + col] = (bf16)wv; const float x = __uint_as_float(wv << 16); sq = x * x; sp = a.so; }
                else if (KIND == 2 || KIND == 4) { if (KIND == 4) v *= fmaxf(__uint_as_float(a.wmax[col]), 1e-30f) * (1.0f / (448.0f * pg8::HID_SCALE));
                    const unsigned wv = f2bf(bf2f(a.H[(size_t)row * 1024 + col]) + v); a.H[(size_t)row * 1024 + col] = (bf16)wv; const float x = __uint_as_float(wv << 16); sq = x * x; sp = a.so; }
                else { v *= fmaxf(__uint_as_float(a.wmax[col]), 1e-30f) * (1.0f / (448.0f * 8.0f)); v = fmaxf(v, 0.f); ((unsigned char*)a.O)[(size_t)row * DFF + col] = (unsigned char)(pg8::pk4_fp8(v * v * pg8::HID_SCALE, 0.f, 0.f, 0.f) & 0xffu); }
                if (KIND != 3) { sq += __shfl_xor(sq, 1); sq += __shfl_xor(sq, 2); sq += __shfl_xor(sq, 4); sq += __shfl_xor(sq, 8);
                    if (m16 == 0 && sp != nullptr) pg8::stat_add(sp + row, sq); }
            }
        }
        __syncthreads();
    }
}

#define IN(k) (lo <= (k) && (k) < hi)
#define SEAM(k) do { if (IN(k) && IN((k) + 1)) xcd_barrier(bar, F.wave); } while (0)
__device__ __forceinline__ unsigned char* opaque_ptr(unsigned char* p) { asm volatile("" : "+s"(p)); return p; }
__device__ __forceinline__ stat_t* stat_at(unsigned char* ws, int l, int id) { return (stat_t*)(ws + WS_STATS) + (size_t)(l * ST_PER_LAYER + id) * STAT_STRIDE; }
__device__ __forceinline__ bf16* w_at(unsigned char* ws, int l, size_t off) { return (bf16*)(ws + WS_W + (size_t)l * W_LAYER + off); }
template <int l> __device__ __forceinline__ void layer_phases(const Args& args, Frame& F, const XcdBarrier& bar, int lo, int hi) {
    const int pb = 8 * l;
    if (IN(pb + 1)) {
        unsigned char* ws = opaque_ptr(args.ws);
        { MetaArgs ma{(bf16*)(ws + WS_HB), w_at(ws, l, WO_IN), NIN, DM, (bf16*)(ws + WS_P), nullptr, nullptr, stat_at(ws, l, ST_SS1), stat_at(ws, l, ST_SSKV), nullptr, nullptr, nullptr, nullptr}; meta_gemm<0>(F, ma, (LAS float*)(F.lds + RING_OFF)); }
        pg8::Gemm g{(bf16*)(ws + WS_HB), w_at(ws, l, WO_IN), MREAL, NIN, DM}; pg8::StaticOrder S; S.init(MREAL, NIN, F.G, (int)blockIdx.x);
        LAS float* fac = (LAS float*)(F.lds + LDSCTL_OFF + 2048); int pm0 = 0;
        { pg8::Unit u_; const int tid_ = F.wave * 64 + lane_id();
          _Pragma("unroll") for (int i = 0; i < 4; i += 2) if (S.next(i, u_)) { if (i == 0) pm0 = u_.pm;
              if (tid_ < 256 && (i == 0 || u_.pm != pm0)) fac[((u_.pm != pm0) ? 256 : 0) + tid_] = rsqrtf(pg8::stat_get(stat_at(ws, l, ST_SS1) + u_.pm * 256 + tid_) * (1.0f / 1024.0f) + pg8::RMS_EPS); }
          __syncthreads(); }
        pg8::EpiIn E{(bf16*)(ws + WS_P), fac, pm0, stat_at(ws, l, ST_SSKV), (bf16*)(ws + WS_U)};
        pg8::gemm_phase<pg8::EpiIn, pg8::StaticOrder, true, true>(F.lds + RING_OFF, g, S, E, F.wave);
    } SEAM(pb + 1);
    if (IN(pb + 2)) { mixers_naive_phase(args, F, l); } SEAM(pb + 2);
    if (IN(pb + 4)) {
        unsigned char* ws = opaque_ptr(args.ws);
        { MetaArgs ma{(bf16*)(ws + WS_YG), w_at(ws, l, WO_GLU), 512, 512, (bf16*)(ws + WS_YCAT), nullptr, (bf16*)(ws + WS_YG), nullptr, stat_at(ws, l, ST_SSB), nullptr, nullptr, nullptr, nullptr}; meta_gemm<1>(F, ma, (LAS float*)(F.lds + RING_OFF)); }
        pg8::Gemm g{(bf16*)(ws + WS_YG), w_at(ws, l, WO_GLU), MREAL, 512, 512}; pg8::StaticOrder S; S.init(MREAL, 512, F.G, (int)blockIdx.x);
        pg8::EpiGlu E{(bf16*)(ws + WS_YG), (bf16*)(ws + WS_YCAT), stat_at(ws, l, ST_SSB)};
        pg8::gemm_phase<pg8::EpiGlu, pg8::StaticOrder, true, true>(F.lds + RING_OFF, g, S, E, F.wave);
    } SEAM(pb + 4);
    if (IN(pb + 5)) {
        unsigned char* ws = opaque_ptr(args.ws);
        { MetaArgs ma{(bf16*)(ws + WS_YCAT), w_at(ws, l, WO_OUT), DM, DM, nullptr, (bf16*)(ws + WS_HB), nullptr, nullptr, stat_at(ws, l, ST_SS2), stat_at(ws, l, ST_SSB), stat_at(ws, l, ST_SSA), stat_at(ws, l, ST_SSC), nullptr}; meta_gemm<2>(F, ma, (LAS float*)(F.lds + RING_OFF)); }
        pg8::Gemm g{(bf16*)(ws + WS_YCAT), w_at(ws, l, WO_OUT), MREAL, DM, DM}; pg8::StaticOrder S; S.init(MREAL, DM, F.G, (int)blockIdx.x);
        LAS float* fac = (LAS float*)(F.lds + LDSCTL_OFF + 2048); int pm0 = 0;
        { pg8::Unit u_; const int tid_ = F.wave * 64 + lane_id();
          _Pragma("unroll") for (int i = 0; i < 2; ++i) if (S.next(i, u_)) { if (i == 0) pm0 = u_.pm;
              if (tid_ < 256 && (i == 0 || u_.pm != pm0)) { const int row = u_.pm * 256 + tid_;
                  const float msb = pg8::stat_get(stat_at(ws, l, ST_SSB) + row) * (1.0f / 512.0f) + pg8::RMS_EPS, msa = pg8::stat_get(stat_at(ws, l, ST_SSA) + row) * (1.0f / 256.0f) + pg8::RMS_EPS, msc = pg8::stat_get(stat_at(ws, l, ST_SSC) + row) * (1.0f / 256.0f) + pg8::RMS_EPS;
                  LAS float* fo = fac + ((u_.pm != pm0) ? 1024 : 0) + tid_ * 4;
                  fo[0] = __builtin_amdgcn_sqrtf(msa * __builtin_amdgcn_rcpf(msb)); fo[1] = __builtin_amdgcn_sqrtf(msc * __builtin_amdgcn_rcpf(msa)); fo[2] = rsqrtf(msc); } }
          __syncthreads(); }
        pg8::EpiRes<true> E{(bf16*)(ws + WS_HB), stat_at(ws, l, ST_SS2), fac, pm0};
        pg8::gemm_phase<pg8::EpiRes<true>, pg8::StaticOrder, true, true>(F.lds + RING_OFF, g, S, E, F.wave);
    } SEAM(pb + 5);
    if (IN(pb + 6)) { hq_phase(F, stat_at(opaque_ptr(args.ws), l, ST_SS2)); } SEAM(pb + 6);
    if (IN(pb + 7)) {
        unsigned char* ws = opaque_ptr(args.ws);
        { MetaArgs ma{(bf16*)(ws + WS_HQ), w_at(ws, l, WO_1), DFF, DM, (bf16*)(ws + WS_BIG), nullptr, nullptr, nullptr, nullptr, nullptr, nullptr, nullptr, (const unsigned*)(ws + WS_CTL) + CW_WMAX1 + l * 4096}; meta_gemm<3>(F, ma, (LAS float*)(F.lds + RING_OFF)); }
        pg8::Gemm g{(bf16*)(ws + WS_HQ), w_at(ws, l, WO_1), MREAL, DFF, DM / 2}; pg8::StaticOrder S; S.init(MREAL, DFF, F.G, (int)blockIdx.x);
        pg8::EpiMlp1F8B E{(unsigned char*)(ws + WS_BIG), (const unsigned*)(ws + WS_CTL) + CW_WMAX1 + l * 4096};
        pg8::gemm_phase<pg8::EpiMlp1F8B, pg8::StaticOrder, true, true, true>(F.lds + RING_OFF, g, S, E, F.wave);
    } SEAM(pb + 7);
    if (IN(pb + 8)) {
        unsigned char* ws = opaque_ptr(args.ws);
        { MetaArgs ma{(bf16*)(ws + WS_BIG), w_at(ws, l, WO_2), DM, DFF, nullptr, (bf16*)(ws + WS_HB), nullptr, nullptr, stat_at(ws, l + 1, ST_SS1), nullptr, nullptr, nullptr, (const unsigned*)(ws + WS_CTL) + CW_WMAX + l * 1024}; meta_gemm<4>(F, ma, (LAS float*)(F.lds + RING_OFF)); }
        pg8::Gemm g{(bf16*)(ws + WS_BIG), w_at(ws, l, WO_2), MREAL, DM, DFF / 2}; pg8::StaticOrder S; S.init(MREAL, DM, F.G, (int)blockIdx.x);
        pg8::EpiRes8 E{(bf16*)(ws + WS_HB), stat_at(ws, l + 1, ST_SS1), (const unsigned*)(ws + WS_CTL) + CW_WMAX + l * 1024};
        pg8::gemm_phase<pg8::EpiRes8, pg8::StaticOrder, true, true, true>(F.lds + RING_OFF, g, S, E, F.wave);
    } SEAM(pb + 8);
}
#undef IN
#undef SEAM
constexpr int N_PHASES = 18;
#if defined(__HIP_DEVICE_COMPILE__)
#define MK_NO_PK_F32 __attribute__((target("no-packed-fp32-ops")))
#else
#define MK_NO_PK_F32
#endif
__global__ void __launch_bounds__(NWAVES * 64, 2) MK_NO_PK_F32 hymba_fwd(Args args) {
    extern __shared__ __attribute__((aligned(16))) unsigned char lds[];
    Frame F;
    F.lds = (LAS unsigned char*)lds;
    F.MISC = (volatile LAS unsigned*)(F.lds + MISC_OFF);
    F.wave = __builtin_amdgcn_readfirstlane((int)threadIdx.x >> 6);
    F.G = gridDim.x; { const int bx = blockIdx.x; F.vcu = (F.G % 8 == 0) ? (bx % 8) * (F.G / 8) + bx / 8 : bx; }
    F.out = args.out; F.ws = args.ws;
    F.ctl = (gu32*)(args.ws + WS_CTL);
    for (int u = threadIdx.x; u < (LDS_BYTES - LDSCTL_OFF) / 4; u += NWAVES * 64) ((LAS unsigned*)(F.lds + LDSCTL_OFF))[u] = 0u;
    __syncthreads();
    const int lo = args.ph_lo, hi = args.ph_hi;
    const bool multi = (hi - lo) > 1;
    XcdBarrier bar; bar.bar = (unsigned*)(F.ctl + CW_BAR); bar.x = 0; bar.st = F.MISC + 8;
    if (multi) bar = xcd_barrier_post((unsigned*)(F.ctl + CW_BAR), F.MISC + 8, F.wave);
#define IN(k) (lo <= (k) && (k) < hi)
#define SEAM(k) do { if (IN(k) && IN((k) + 1)) xcd_barrier(bar, F.wave); } while (0)
    if (IN(0)) { p0_prologue(args, F); } SEAM(0);
    layer_phases<0>(args, F, bar, lo, hi);
    layer_phases<1>(args, F, bar, lo, hi);
    if (IN(17)) { final_phase(args, F); }
#undef IN
#undef SEAM
}

#ifndef MK_ONE_LAUNCH
#define MK_ONE_LAUNCH 1
#endif
extern "C" void kernel_launch(void* const* d_in, const int* in_sizes, int n_in, void* d_out, int out_size, void* d_ws, size_t ws_size, hipStream_t stream) {
    static int grid = 0;
    if (grid == 0) {
        if (n_in != 25 || in_sizes[0] != MREAL * DM || out_size != MREAL * DM || ws_size < WS_END2) {
            fprintf(stderr, "kernel_launch: unexpected problem: n_in %d, in0 %d, out %d, ws %zu (need %zu); nothing launched\n", n_in, n_in > 0 ? in_sizes[0] : -1, out_size, ws_size, (size_t)WS_END2); grid = -1; return; }
        int dev = 0, cus = 0, per_cu = 0;
        if (hipGetDevice(&dev) != hipSuccess || hipDeviceGetAttribute(&cus, hipDeviceAttributeMultiprocessorCount, dev) != hipSuccess) { grid = -1; return; }
        if (hipFuncSetAttribute((const void*)hymba_fwd, hipFuncAttributeMaxDynamicSharedMemorySize, LDS_BYTES) != hipSuccess) { fprintf(stderr, "kernel_launch: hipFuncSetAttribute failed\n"); grid = -1; return; }
        if (hipOccupancyMaxActiveBlocksPerMultiprocessor(&per_cu, (const void*)hymba_fwd, NWAVES * 64, LDS_BYTES) != hipSuccess || per_cu < 1)
            fprintf(stderr, "kernel_launch: note: occupancy query reports %d workgroups per CU\n", per_cu);
        (void)hipGetLastError();
        if (cus < 256) { fprintf(stderr, "kernel_launch: %d CUs: the out-projection keeps the norm factors of two row panels per workgroup in LDS, which needs the full 256-CU grid; nothing launched\n", cus); grid = -1; return; }
        grid = cus;
    }
    if (grid < 0) return;
    if (hipMemsetAsync((char*)d_ws + WS_CTL, 0, CTL_ZERO_BYTES, stream) != hipSuccess) { fprintf(stderr, "kernel_launch: memset failed\n"); return; }
    Args a{};
    for (int i = 0; i < 25; ++i) a.in[i] = (const float*)d_in[i];
    a.out = (float*)d_out; a.ws = (unsigned char*)d_ws;
#if MK_ONE_LAUNCH
    a.ph_lo = 0; a.ph_hi = N_PHASES;
    hipLaunchKernelGGL(hymba_fwd, dim3(grid), dim3(NWAVES * 64), LDS_BYTES, stream, a);
#else
    for (int p = 0; p < N_PHASES; ++p) { a.ph_lo = p; a.ph_hi = p + 1;
        hipLaunchKernelGGL(hymba_fwd, dim3(grid), dim3(NWAVES * 64), LDS_BYTES, stream, a); }
#endif
    const hipError_t le = hipPeekAtLastError();
    if (le != hipSuccess) fprintf(stderr, "kernel_launch: launch failed: %s\n", hipGetErrorName(le));
}
```
